# Optimizing an MI355X kernel written in HIP

```python
import jax, jax.numpy as jnp
from jax import lax
import numpy as np

D_MODEL = 1024
BATCH = 8
SEQ = 2048
DEPTH = 2

CHUNK = 64
N_PREV_CHUNKS = 8
BAND = (N_PREV_CHUNKS + 1) * CHUNK
BAND_PAD = N_PREV_CHUNKS * CHUNK
D_CONV = D_MODEL // 2
D_ATT = D_MODEL - D_CONV
D_MIX = D_CONV + D_ATT
HEAD_DIM = 64
N_HEADS = D_ATT // HEAD_DIM
CONV_WIDTH = 31
MAX_REL = 128
N_REL = 2 * MAX_REL + 1
D_IN_COLS = 2 * D_CONV + 3 * D_ATT
D_FF_DENSE = 2816
N_EXPERTS = 8
TOP_K = 2
D_FF_EXPERT = 3584
N_DENSE = (DEPTH + 1) // 2
N_MOE = DEPTH // 2
EPS = 1e-6
NEG_INF = -1e30

kernel_name = "hybrid_conformer_chunkattn_moe_adaln"


def rmsnorm(x, g):
    xf = x.astype(jnp.float32)
    y = xf * lax.rsqrt(jnp.mean(xf * xf, axis=-1, keepdims=True) + EPS)
    return (y * g.astype(jnp.float32)).astype(x.dtype)


def layernorm(x, g, b):
    xf = x.astype(jnp.float32)
    mu = jnp.mean(xf, axis=-1, keepdims=True)
    xc = xf - mu
    var = jnp.mean(xc * xc, axis=-1, keepdims=True)
    y = xc * lax.rsqrt(var + EPS) * g.astype(jnp.float32) + b.astype(jnp.float32)
    return y.astype(x.dtype)


def modulate(h, shift, scale):
    return h * (1 + scale[:, None, :]) + shift[:, None, :]


def conformer_conv(u, conv_w, conv_b, ln_g, ln_b):
    a, g = jnp.split(u, 2, axis=-1)
    z = a * jax.nn.sigmoid(g)
    z = lax.conv_general_dilated(
        z, conv_w, window_strides=(1,), padding=[(CONV_WIDTH - 1, 0)],
        dimension_numbers=("NWC", "WIO", "NWC"),
        feature_group_count=D_CONV) + conv_b
    z = layernorm(z, ln_g, ln_b)
    return jax.nn.silu(z)


def chunk_band_attention(q, k, v, q_norm_g, k_norm_g, rel_bias):
    B, S = q.shape[0], q.shape[1]
    nc = S // CHUNK
    q = rmsnorm(q.reshape(B, S, N_HEADS, HEAD_DIM), q_norm_g)
    k = rmsnorm(k.reshape(B, S, N_HEADS, HEAD_DIM), k_norm_g)
    v = v.reshape(B, S, N_HEADS, HEAD_DIM)
    pad = ((0, 0), (BAND_PAD, 0), (0, 0), (0, 0))
    kp = jnp.pad(k, pad)
    vp = jnp.pad(v, pad)
    idx = jnp.arange(nc)[:, None] * CHUNK + jnp.arange(BAND)[None, :]
    kb = kp[:, idx]
    vb = vp[:, idx]
    qc = q.reshape(B, nc, CHUNK, N_HEADS, HEAD_DIM)
    s = jnp.einsum("bnqhd,bnkhd->bnhqk", qc, kb).astype(jnp.float32) * (HEAD_DIM ** -0.5)
    rel = jnp.arange(BAND)[None, :] - BAND_PAD - jnp.arange(CHUNK)[:, None]
    rel_idx = jnp.clip(rel, -MAX_REL, MAX_REL) + MAX_REL
    bias = rel_bias.astype(jnp.float32)[:, rel_idx]
    valid = idx >= BAND_PAD
    s = jnp.where(valid[None, :, None, None, :], s + bias[None, None], NEG_INF)
    p = jax.nn.softmax(s, axis=-1).astype(v.dtype)
    o = jnp.einsum("bnhqk,bnkhd->bnqhd", p, vb)
    return o.reshape(B, S, D_ATT)


def swiglu(h, w_gate, w_up, w_down):
    return (jax.nn.silu(h @ w_gate) * (h @ w_up)) @ w_down


def moe_swiglu(h, w_router, b_router, w_gate, w_up, w_down):
    B, S, D = h.shape
    t = h.reshape(B * S, D)
    logits = (t @ w_router).astype(jnp.float32) + b_router.astype(jnp.float32)
    top_val, top_idx = lax.top_k(logits, TOP_K)
    top_w = jax.nn.softmax(top_val, axis=-1)
    combine = jnp.sum(jax.nn.one_hot(top_idx, N_EXPERTS, dtype=jnp.float32)
                      * top_w[..., None], axis=1).astype(t.dtype)
    out = jnp.zeros_like(t)
    for e in range(N_EXPERTS):
        out = out + combine[:, e:e + 1] * swiglu(t, w_gate[e], w_up[e], w_down[e])
    return out.reshape(B, S, D)


def setup_inputs(seed: int = 0) -> dict:
    key = jax.random.key(seed)
    ks = jax.random.split(key, 24)
    f32 = jnp.float32

    def nrm(k, shape, scale):
        return jax.random.normal(k, shape, f32) * scale

    return {
        "x": nrm(ks[0], (BATCH, SEQ, D_MODEL), 1.0),
        "c": nrm(ks[1], (BATCH, D_MODEL), 1.0),
        "w_ada": nrm(ks[2], (DEPTH, D_MODEL, 6 * D_MODEL), 0.5 * D_MODEL ** -0.5),
        "b_ada": nrm(ks[3], (DEPTH, 6 * D_MODEL), 0.02),
        "norm_mix_g": 1.0 + nrm(ks[4], (DEPTH, D_MODEL), 0.02),
        "norm_ffn_g": 1.0 + nrm(ks[5], (DEPTH, D_MODEL), 0.02),
        "w_in": nrm(ks[6], (DEPTH, D_MODEL, D_IN_COLS), D_MODEL ** -0.5),
        "w_out": nrm(ks[7], (DEPTH, D_MIX, D_MODEL), D_MIX ** -0.5),
        "conv_w": nrm(ks[8], (DEPTH, CONV_WIDTH, 1, D_CONV), CONV_WIDTH ** -0.5),
        "conv_b": nrm(ks[9], (DEPTH, D_CONV), 0.02),
        "conv_ln_g": 1.0 + nrm(ks[10], (DEPTH, D_CONV), 0.02),
        "conv_ln_b": nrm(ks[11], (DEPTH, D_CONV), 0.02),
        "q_norm_g": 1.0 + nrm(ks[12], (DEPTH, HEAD_DIM), 0.02),
        "k_norm_g": 1.0 + nrm(ks[13], (DEPTH, HEAD_DIM), 0.02),
        "rel_bias": nrm(ks[14], (DEPTH, N_HEADS, N_REL), 0.5),
        "ffn_w_gate": nrm(ks[15], (N_DENSE, D_MODEL, D_FF_DENSE), D_MODEL ** -0.5),
        "ffn_w_up": nrm(ks[16], (N_DENSE, D_MODEL, D_FF_DENSE), D_MODEL ** -0.5),
        "ffn_w_down": nrm(ks[17], (N_DENSE, D_FF_DENSE, D_MODEL), D_FF_DENSE ** -0.5),
        "moe_w_router": nrm(ks[18], (N_MOE, D_MODEL, N_EXPERTS), D_MODEL ** -0.5),
        "moe_b_router": nrm(ks[19], (N_MOE, N_EXPERTS), 0.01),
        "moe_w_gate": nrm(ks[20], (N_MOE, N_EXPERTS, D_MODEL, D_FF_EXPERT), D_MODEL ** -0.5),
        "moe_w_up": nrm(ks[21], (N_MOE, N_EXPERTS, D_MODEL, D_FF_EXPERT), D_MODEL ** -0.5),
        "moe_w_down": nrm(ks[22], (N_MOE, N_EXPERTS, D_FF_EXPERT, D_MODEL), D_FF_EXPERT ** -0.5),
    }


def reference(x, c, w_ada, b_ada, norm_mix_g, norm_ffn_g, w_in, w_out,
              conv_w, conv_b, conv_ln_g, conv_ln_b, q_norm_g, k_norm_g, rel_bias,
              ffn_w_gate, ffn_w_up, ffn_w_down,
              moe_w_router, moe_b_router, moe_w_gate, moe_w_up, moe_w_down):
    c_act = jax.nn.silu(c)
    for l in range(DEPTH):
        mod = c_act @ w_ada[l] + b_ada[l]
        sh1, sc1, g1, sh2, sc2, g2 = jnp.split(mod, 6, axis=-1)

        h = modulate(rmsnorm(x, norm_mix_g[l]), sh1, sc1)
        proj = h @ w_in[l]
        u_conv = proj[..., :2 * D_CONV]
        q = proj[..., 2 * D_CONV:2 * D_CONV + D_ATT]
        k = proj[..., 2 * D_CONV + D_ATT:2 * D_CONV + 2 * D_ATT]
        v = proj[..., 2 * D_CONV + 2 * D_ATT:]
        y_conv = conformer_conv(u_conv, conv_w[l], conv_b[l], conv_ln_g[l], conv_ln_b[l])
        y_att = chunk_band_attention(q, k, v, q_norm_g[l], k_norm_g[l], rel_bias[l])
        y = jnp.concatenate([y_conv, y_att], axis=-1) @ w_out[l]
        x = x + g1[:, None, :] * y

        h = modulate(rmsnorm(x, norm_ffn_g[l]), sh2, sc2)
        if l % 2 == 0:
            i = l // 2
            f = swiglu(h, ffn_w_gate[i], ffn_w_up[i], ffn_w_down[i])
        else:
            i = l // 2
            f = moe_swiglu(h, moe_w_router[i], moe_b_router[i],
                           moe_w_gate[i], moe_w_up[i], moe_w_down[i])
        x = x + g2[:, None, :] * f
    return x
```

```cpp
#include <hip/hip_runtime.h>
#include <cstdio>
#include <cstdint>
namespace nv {
constexpr int B_ = 8, S_ = 2048, D_ = 1024, NTOK = B_ * S_, DIN = 2560, DC = 512, NH = 8, HD = 64, CW = 31, NREL = 257;
constexpr int FFD = 2816, NE = 8, FFE = 3584;

__global__ void k_cact(const float* c, float* o, int n) { int i = blockIdx.x * 256 + threadIdx.x; if (i < n) { float v = c[i]; o[i] = v / (1.f + expf(-v)); } }
__global__ void k_mod(const float* cact, const float* w_ada, const float* b_ada, float* mod) {
    int j = blockIdx.x * 256 + threadIdx.x, b = blockIdx.y, l = blockIdx.z; float s = 0.f;
    for (int k = 0; k < D_; ++k) s += cact[b * D_ + k] * w_ada[((size_t)l * D_ + k) * 6144 + j];
    mod[((size_t)l * B_ + b) * 6144 + j] = s + b_ada[l * 6144 + j];
}
__device__ __forceinline__ float block_sum(float v, float* sh) {
    for (int o = 32; o > 0; o >>= 1) v += __shfl_xor(v, o);
    const int w = threadIdx.x >> 6, nw = blockDim.x >> 6;
    __syncthreads(); if ((threadIdx.x & 63) == 0) sh[w] = v; __syncthreads();
    float t = 0.f; for (int i = 0; i < nw; ++i) t += sh[i]; return t;
}
__global__ void k_norm_mod(const float* x, const float* g, const float* mod_l, int sh_off, int sc_off, float* h) {
    __shared__ float red[8];
    const int t = blockIdx.x, b = t / S_; const float* xr = x + (size_t)t * D_; float v[4]; float s = 0.f;
    for (int i = 0; i < 4; ++i) { v[i] = xr[threadIdx.x + 256 * i]; s += v[i] * v[i]; }
    s = block_sum(s, red); const float r = rsqrtf(s / D_ + 1e-6f);
    for (int i = 0; i < 4; ++i) { const int c = threadIdx.x + 256 * i; h[(size_t)t * D_ + c] = v[i] * r * g[c] * (1.f + mod_l[b * 6144 + sc_off + c]) + mod_l[b * 6144 + sh_off + c]; }
}
struct NG { const float* A; const int* idx; const int* cntp; const float* Bm; const float* B2; float* C; const float* gate; const float* wl; const int* tokl; int lda, M, m0, ldb, N, K, ldc, pad; };
template <int MODE> __global__ __launch_bounds__(256) void k_gemm(NG p) {
    __shared__ float As[16][68]; __shared__ float Bs[16][64]; __shared__ float Bs2[16][64];
    const int Mv = p.cntp ? *p.cntp : p.M; const int mt = p.m0 + blockIdx.y * 64; if (mt >= Mv) return;
    const int nt = blockIdx.x * 64, tid = threadIdx.x, ty = tid >> 4, tx = tid & 15;
    float acc[4][4] = {}, acc2[4][4] = {};
    const int lr = tid >> 2, lk = (tid & 3) * 4; const int mrow = mt + lr; const bool rv = mrow < Mv;
    const float* arow = p.A + (size_t)(rv ? (p.idx ? p.idx[mrow] : mrow) : 0) * p.lda;
    const int bk = tid >> 4, bn = (tid & 15) * 4;
    for (int k0 = 0; k0 < p.K; k0 += 16) {
        float4 av = rv ? *(const float4*)(arow + k0 + lk) : make_float4(0, 0, 0, 0);
        As[lk + 0][lr] = av.x; As[lk + 1][lr] = av.y; As[lk + 2][lr] = av.z; As[lk + 3][lr] = av.w;
        *(float4*)&Bs[bk][bn] = *(const float4*)(p.Bm + (size_t)(k0 + bk) * p.ldb + nt + bn);
        if (MODE == 2) *(float4*)&Bs2[bk][bn] = *(const float4*)(p.B2 + (size_t)(k0 + bk) * p.ldb + nt + bn);
        __syncthreads();
#pragma unroll
        for (int k = 0; k < 16; ++k) {
            float a[4], b[4], b2[4];
#pragma unroll
            for (int i = 0; i < 4; ++i) { a[i] = As[k][ty * 4 + i]; b[i] = Bs[k][tx * 4 + i]; if (MODE == 2) b2[i] = Bs2[k][tx * 4 + i]; }
#pragma unroll
            for (int i = 0; i < 4; ++i)
#pragma unroll
                for (int j = 0; j < 4; ++j) { acc[i][j] += a[i] * b[j]; if (MODE == 2) acc2[i][j] += a[i] * b2[j]; }
        }
        __syncthreads();
    }
    for (int i = 0; i < 4; ++i) { const int m = mt + ty * 4 + i; if (m >= Mv) continue;
        for (int j = 0; j < 4; ++j) { const int n = nt + tx * 4 + j; const float a = acc[i][j];
            if (MODE == 0) p.C[(size_t)m * p.ldc + n] = a;
            else if (MODE == 1) { const int b = m / S_; p.C[(size_t)m * p.ldc + n] += p.gate[b * 6144 + n] * a; }
            else if (MODE == 2) { p.C[(size_t)m * p.ldc + n] = a / (1.f + expf(-a)) * acc2[i][j]; }
            else { const int tok = p.tokl[m]; const int b = tok / S_; p.C[(size_t)tok * p.ldc + n] += p.gate[b * 6144 + n] * p.wl[m] * a; } } }
}
__global__ void k_glu(const float* proj, float* z) { size_t i = (size_t)blockIdx.x * 256 + threadIdx.x; const size_t t = i / DC; const int c = (int)(i % DC);
    const float a = proj[t * DIN + c], g = proj[t * DIN + DC + c]; z[i] = a / (1.f + expf(-g)); }
__global__ void k_conv_ln(const float* z, const float* cw, const float* cb, const float* lg, const float* lb, float* yc  ) {
    __shared__ float red[8];
    const int t = blockIdx.x, c = threadIdx.x, tp = t % S_; float v = cb[c];
    for (int j = 0; j < CW; ++j) { const int ts = tp - 30 + j; if (ts >= 0) v += cw[j * DC + c] * z[(size_t)(t - 30 + j) * DC + c]; }
    const float mu = block_sum(v, red) / DC; const float xc = v - mu; const float var = block_sum(xc * xc, red) / DC;
    const float y = xc * rsqrtf(var + 1e-6f) * lg[c] + lb[c]; yc[(size_t)t * D_ + c] = y / (1.f + expf(-y));
}
__global__ void k_qknorm(const float* proj, const float* qg, const float* kg, float* qn, float* kn) {
    const int i = blockIdx.x * 256 + threadIdx.x; const int t = i / NH, h = i % NH;
    const float* q = proj + (size_t)t * DIN + 1024 + h * HD; const float* k = proj + (size_t)t * DIN + 1536 + h * HD;
    float sq = 0.f, sk = 0.f; for (int d = 0; d < HD; ++d) { sq += q[d] * q[d]; sk += k[d] * k[d]; }
    const float rq = rsqrtf(sq / HD + 1e-6f), rk = rsqrtf(sk / HD + 1e-6f);
    for (int d = 0; d < HD; ++d) { qn[(size_t)t * DC + h * HD + d] = q[d] * rq * qg[d]; kn[(size_t)t * DC + h * HD + d] = k[d] * rk * kg[d]; }
}
__global__ __launch_bounds__(64) void k_attn(const float* qn, const float* kn, const float* proj, const float* relb, float* yc  ) {
    const int bi = blockIdx.x; const int h = bi % NH, n = (bi / NH) % 32, b = bi / (NH * 32); const int qi = threadIdx.x;
    const int tq = n * 64 + qi; const size_t rowq = (size_t)b * S_ + tq;
    float q[HD]; for (int d = 0; d < HD; ++d) q[d] = qn[rowq * DC + h * HD + d];
    const int k0 = (n - 8 < 0 ? 0 : n - 8) * 64, k1 = n * 64 + 64;
    float mx = -3.0e38f;
    for (int kk = k0; kk < k1; ++kk) { const float* kr = kn + ((size_t)b * S_ + kk) * DC + h * HD; float s = 0.f; for (int d = 0; d < HD; ++d) s += q[d] * kr[d];
        int rel = kk - tq; rel = rel < -128 ? -128 : (rel > 128 ? 128 : rel); s = s * 0.125f + relb[h * NREL + rel + 128]; mx = fmaxf(mx, s); }
    float o[HD]; for (int d = 0; d < HD; ++d) o[d] = 0.f; float l = 0.f;
    for (int kk = k0; kk < k1; ++kk) { const float* kr = kn + ((size_t)b * S_ + kk) * DC + h * HD; float s = 0.f; for (int d = 0; d < HD; ++d) s += q[d] * kr[d];
        int rel = kk - tq; rel = rel < -128 ? -128 : (rel > 128 ? 128 : rel); s = s * 0.125f + relb[h * NREL + rel + 128]; const float p = expf(s - mx); l += p;
        const float* vr = proj + ((size_t)b * S_ + kk) * DIN + 2048 + h * HD; for (int d = 0; d < HD; ++d) o[d] += p * vr[d]; }
    const float il = 1.f / l; for (int d = 0; d < HD; ++d) yc[rowq * D_ + DC + h * HD + d] = o[d] * il;
}
__global__ void k_router(const float* h, const float* wr, const float* br, int* re, float* rw) {
    const int t = blockIdx.x * 4 + (threadIdx.x >> 6), lane = threadIdx.x & 63; float lg[NE]; for (int e = 0; e < NE; ++e) lg[e] = 0.f;
    for (int i = 0; i < 16; ++i) { const int k = lane + 64 * i; const float hv = h[(size_t)t * D_ + k]; for (int e = 0; e < NE; ++e) lg[e] += hv * wr[k * NE + e]; }
    for (int e = 0; e < NE; ++e) { for (int o = 32; o > 0; o >>= 1) lg[e] += __shfl_xor(lg[e], o); lg[e] += br[e]; }
    if (lane == 0) { int e1 = 0; for (int e = 1; e < NE; ++e) if (lg[e] > lg[e1]) e1 = e; int e2 = (e1 == 0) ? 1 : 0; for (int e = 0; e < NE; ++e) if (e != e1 && lg[e] > lg[e2]) e2 = e;
        const float m = lg[e1]; const float p2 = expf(lg[e2] - m); const float s = 1.f + p2; re[2 * t] = e1; re[2 * t + 1] = e2; rw[2 * t] = 1.f / s; rw[2 * t + 1] = p2 / s; }
}
__global__ void k_lists(const int* re, const float* rw, int* list, float* wl, int* cnt) {
    __shared__ int wsum[4]; __shared__ int base;
    const int e = blockIdx.x, tid = threadIdx.x, lane = tid & 63, w = tid >> 6; if (tid == 0) base = 0; __syncthreads();
    for (int t0 = 0; t0 < NTOK; t0 += 256) { const int t = t0 + tid; int k = -1; if (re[2 * t] == e) k = 0; else if (re[2 * t + 1] == e) k = 1;
        const unsigned long long m = __ballot(k >= 0); const int pre = __popcll(m & ((1ull << lane) - 1ull)); if (lane == 0) wsum[w] = __popcll(m); __syncthreads();
        int off = base; for (int i = 0; i < w; ++i) off += wsum[i];
        if (k >= 0) { list[e * NTOK + off + pre] = t; wl[e * NTOK + off + pre] = rw[2 * t + k]; }
        __syncthreads(); if (tid == 0) base += wsum[0] + wsum[1] + wsum[2] + wsum[3]; __syncthreads(); }
    if (tid == 0) cnt[e] = base;
}
__global__ void k_copy(const float* a, float* o, size_t n) { size_t i = (size_t)blockIdx.x * 256 + threadIdx.x; if (i < n) o[i] = a[i]; }

struct Bufs { float *cact, *mod, *h, *proj, *z, *qn, *kn, *yc, *act; int *re, *list, *cnt; float *rw, *wl; };
static inline Bufs carve(unsigned char* ws) {
    Bufs b; size_t o = 1u << 20; auto take = [&](size_t bytes) { void* p = ws + o; o += (bytes + 255) & ~(size_t)255; return p; };
    b.cact = (float*)take(B_ * D_ * 4); b.mod = (float*)take(2 * B_ * 6144 * 4);
    b.re = (int*)take(NTOK * 2 * 4); b.rw = (float*)take(NTOK * 2 * 4); b.list = (int*)take((size_t)NE * NTOK * 4); b.wl = (float*)take((size_t)NE * NTOK * 4); b.cnt = (int*)take(256);
    b.h = (float*)take((size_t)NTOK * D_ * 4);
    b.yc = (float*)take((size_t)NTOK * D_ * 4);
    b.proj = (float*)take((size_t)NTOK * DIN * 4);
    b.z = (float*)take((size_t)NTOK * DC * 4);
    b.qn = (float*)take((size_t)NTOK * DC * 4);
    b.kn = (float*)take((size_t)NTOK * DC * 4);
    b.act = b.proj;
    return b;
}
static void forward(void* const* d_in, float* out, unsigned char* ws, hipStream_t st, int ck_stage = 0, float* ck = nullptr) {
    const float* x = (const float*)d_in[0]; const float* c = (const float*)d_in[1]; const float* w_ada = (const float*)d_in[2]; const float* b_ada = (const float*)d_in[3];
    const float* nmg = (const float*)d_in[4]; const float* nfg = (const float*)d_in[5]; const float* w_in = (const float*)d_in[6]; const float* w_out = (const float*)d_in[7];
    const float* conv_w = (const float*)d_in[8]; const float* conv_b = (const float*)d_in[9]; const float* clg = (const float*)d_in[10]; const float* clb = (const float*)d_in[11];
    const float* qg = (const float*)d_in[12]; const float* kg = (const float*)d_in[13]; const float* relb = (const float*)d_in[14];
    const float* fwg = (const float*)d_in[15]; const float* fwu = (const float*)d_in[16]; const float* fwd = (const float*)d_in[17];
    const float* mwr = (const float*)d_in[18]; const float* mbr = (const float*)d_in[19]; const float* mwg = (const float*)d_in[20]; const float* mwu = (const float*)d_in[21]; const float* mwd = (const float*)d_in[22];
    Bufs b = carve(ws);
    k_cact<<<(B_ * D_ + 255) / 256, 256, 0, st>>>(c, b.cact, B_ * D_);
    k_mod<<<dim3(6144 / 256, B_, 2), 256, 0, st>>>(b.cact, w_ada, b_ada, b.mod);
    k_copy<<<(NTOK * D_) / 256, 256, 0, st>>>(x, out, (size_t)NTOK * D_);
    auto CK = [&](int stage, const float* src, size_t n) { if (ck && ck_stage == stage) k_copy<<<(unsigned)((n + 255) / 256), 256, 0, st>>>(src, ck, n); };
    for (int l = 0; l < 2; ++l) {
        const float* mod_l = b.mod + (size_t)l * B_ * 6144;
        k_norm_mod<<<NTOK, 256, 0, st>>>(out, nmg + l * D_, mod_l, 0, 1024, b.h);
        CK(10 * l + 1, b.h, (size_t)NTOK * D_);
        { NG p{}; p.A = b.h; p.lda = D_; p.M = NTOK; p.Bm = w_in + (size_t)l * D_ * DIN; p.ldb = DIN; p.N = DIN; p.K = D_; p.C = b.proj; p.ldc = DIN;
          k_gemm<0><<<dim3(DIN / 64, NTOK / 64), 256, 0, st>>>(p); }
        k_glu<<<(NTOK * DC) / 256, 256, 0, st>>>(b.proj, b.z);
        CK(10 * l + 2, b.z, (size_t)NTOK * DC);
        k_conv_ln<<<NTOK, 512, 0, st>>>(b.z, conv_w + l * CW * DC, conv_b + l * DC, clg + l * DC, clb + l * DC, b.yc);
        k_qknorm<<<(NTOK * NH) / 256, 256, 0, st>>>(b.proj, qg + l * HD, kg + l * HD, b.qn, b.kn);
        CK(10 * l + 3, b.qn, (size_t)NTOK * DC); CK(10 * l + 4, b.kn, (size_t)NTOK * DC);
        k_attn<<<B_ * 32 * NH, 64, 0, st>>>(b.qn, b.kn, b.proj, relb + l * NH * NREL, b.yc);
        CK(10 * l + 5, b.yc, (size_t)NTOK * D_);
        { NG p{}; p.A = b.yc; p.lda = D_; p.M = NTOK; p.Bm = w_out + (size_t)l * D_ * D_; p.ldb = D_; p.N = D_; p.K = D_; p.C = out; p.ldc = D_; p.gate = mod_l + 2048;
          k_gemm<1><<<dim3(D_ / 64, NTOK / 64), 256, 0, st>>>(p); }
        CK(10 * l + 6, out, (size_t)NTOK * D_);
        k_norm_mod<<<NTOK, 256, 0, st>>>(out, nfg + l * D_, mod_l, 3072, 4096, b.h);
        CK(10 * l + 7, b.h, (size_t)NTOK * D_);
        if (l == 0) {
            { NG p{}; p.A = b.h; p.lda = D_; p.M = NTOK; p.Bm = fwg; p.B2 = fwu; p.ldb = FFD; p.N = FFD; p.K = D_; p.C = b.act; p.ldc = FFD;
              k_gemm<2><<<dim3(FFD / 64, NTOK / 64), 256, 0, st>>>(p); }
            CK(8, b.act, (size_t)NTOK * 1024);
            { NG p{}; p.A = b.act; p.lda = FFD; p.M = NTOK; p.Bm = fwd; p.ldb = D_; p.N = D_; p.K = FFD; p.C = out; p.ldc = D_; p.gate = mod_l + 5120;
              k_gemm<1><<<dim3(D_ / 64, NTOK / 64), 256, 0, st>>>(p); }
            CK(9, out, (size_t)NTOK * D_);
        } else {
            k_router<<<NTOK / 4, 256, 0, st>>>(b.h, mwr, mbr, b.re, b.rw);
            k_lists<<<NE, 256, 0, st>>>(b.re, b.rw, b.list, b.wl, b.cnt);
            for (int e = 0; e < NE; ++e)
                for (int ch = 0; ch < 2; ++ch) {
                    { NG p{}; p.A = b.h; p.lda = D_; p.idx = b.list + e * NTOK; p.cntp = b.cnt + e; p.m0 = ch * 8192; p.Bm = mwg + (size_t)e * D_ * FFE; p.B2 = mwu + (size_t)e * D_ * FFE; p.ldb = FFE; p.N = FFE; p.K = D_;
                      p.C = b.act - (size_t)ch * 8192 * FFE; p.ldc = FFE; k_gemm<2><<<dim3(FFE / 64, 8192 / 64), 256, 0, st>>>(p); }
                    { NG p{}; p.A = b.act - (size_t)ch * 8192 * FFE; p.lda = FFE; p.cntp = b.cnt + e; p.m0 = ch * 8192; p.Bm = mwd + (size_t)e * FFE * D_; p.ldb = D_; p.N = D_; p.K = FFE;
                      p.C = out; p.ldc = D_; p.gate = mod_l + 5120; p.wl = b.wl + e * NTOK; p.tokl = b.list + e * NTOK; k_gemm<3><<<dim3(D_ / 64, 8192 / 64), 256, 0, st>>>(p); }
                }
        }
    }
}
}
extern "C" void kernel_launch(void* const* d_in, const int* in_sizes, int n_in, void* d_out, int out_size, void* d_ws, size_t ws_size, hipStream_t stream) {
    if (n_in != 23 || out_size != nv::NTOK * nv::D_ || ws_size < ((size_t)400 << 20)) { fprintf(stderr, "kernel_launch: unexpected shapes / workspace (%d inputs, out %d, ws %zu)\n", n_in, out_size, ws_size); return; }
    nv::forward(d_in, (float*)d_out, (unsigned char*)d_ws, stream);
}
```

```cpp
#include <hip/hip_runtime.h>
#include <cstdio>
#include <cstdint>
#define DBG_STAGE 0
namespace pg8 {
#define PG8_LAS __attribute__((address_space(3)))
typedef unsigned short bf16_t;
typedef short bf16x8 __attribute__((ext_vector_type(8)));
typedef float f32x4 __attribute__((ext_vector_type(4)));
typedef unsigned u32x4 __attribute__((ext_vector_type(4)));
constexpr int BM = 256, BK = 64, HALF = 128, HTB = HALF * BK * 2  , STAGE_BYTES = 8 * HTB, NXCD = 8, WGM = 8;

__host__ __device__ __forceinline__ int lds_byte(int r, int c) { const int st = (r >> 4) * 2 + (c >> 5), rr = r & 15, cc = c & 31, ob = rr * 64 + cc * 2; return st * 1024 + (ob ^ (((ob >> 9) & 1) << 5)); }
__host__ __device__ __forceinline__ void stage_rc(int b, int& R, int& C) { const int st = b / 1024, sb = b % 1024, swz = sb ^ (((sb >> 9) & 1) << 5); R = (st >> 1) * 16 + swz / 64; C = (st & 1) * 32 + (swz % 64) / 2; }
__host__ __device__ __forceinline__ int perm32(int rho) { const int n = rho >> 4, i = rho & 15; return 8 * (i >> 2) + 4 * n + (i & 3); }

struct Unit { int pm, pn, e; };
struct Gemm { const bf16_t* A; const bf16_t* Bt; int M, N, K; size_t bstride; };

struct StaticOrder {
    int nM, nN, nwg, G, c;
    __device__ void init(int M, int N, int G_, int c_) { nM = M / BM; nN = N / BM; nwg = nM * nN; G = G_; c = c_; }
    __device__ bool next(int i, Unit& u) const {
        const long L = (long)i * G + c; if (L >= nwg) return false;
        int wgid = (int)L; { const int q = nwg / NXCD, r = nwg % NXCD, xcd = wgid % NXCD, off = wgid / NXCD; wgid = (xcd < r ? xcd * (q + 1) : r * (q + 1) + (xcd - r) * q) + off; }
        const int nig = WGM * nN, gid = wgid / nig, fm = gid * WGM, gsz = (nM - fm) < WGM ? (nM - fm) : WGM;
        u.pm = fm + ((wgid % nig) % gsz); u.pn = (wgid % nig) / gsz; u.e = 0; return true;
    }
    __device__ __forceinline__ void a_ready(const Unit&) const {}
    __device__ __forceinline__ void done(const Unit&) const {}
};
struct MoeOrder {
    int nM, nN, nwg, G, c; int t1, t2, t3, t4, t5, t6, t7;
    __device__ bool next(int i, Unit& u) const {
        const long L = (long)i * G + c; if (L >= nwg) return false;
        int wgid = (int)L; { const int q = nwg / NXCD, r = nwg % NXCD, xcd = wgid % NXCD, off = wgid / NXCD; wgid = (xcd < r ? xcd * (q + 1) : r * (q + 1) + (xcd - r) * q) + off; }
        const int nig = WGM * nN, gid = wgid / nig, fm = gid * WGM, gsz = (nM - fm) < WGM ? (nM - fm) : WGM;
        u.pm = fm + ((wgid % nig) % gsz); u.pn = (wgid % nig) / gsz;
        const int p = u.pm; u.e = (p >= t1) + (p >= t2) + (p >= t3) + (p >= t4) + (p >= t5) + (p >= t6) + (p >= t7); return true;
    }
    __device__ __forceinline__ void a_ready(const Unit&) const {}
    __device__ __forceinline__ void done(const Unit&) const {}
};

__device__ __forceinline__ unsigned cvt_pk_bf16(float lo, float hi) { unsigned r; asm volatile("v_cvt_pk_bf16_f32 %0, %1, %2" : "=v"(r) : "v"(lo), "v"(hi)); return r; }
__device__ __forceinline__ float sigm(float x) { return __builtin_amdgcn_rcpf(1.f + __builtin_amdgcn_exp2f(-1.4426950408889634f * x)); }
__device__ __forceinline__ u32x4 pack8(f32x4 v0, f32x4 v1) { u32x4 w; w.x = cvt_pk_bf16(v0[0], v0[1]); w.y = cvt_pk_bf16(v0[2], v0[3]); w.z = cvt_pk_bf16(v1[0], v1[1]); w.w = cvt_pk_bf16(v1[2], v1[3]); return w; }

struct EpiBf16 {
    static constexpr bool PERM = true, AFTER_DRAIN = false;
    bf16_t* O; int ldc;
    __device__ __forceinline__ void operator()(const f32x4 (&acc)[2][2][4][2], const Unit& u, int wr, int wc, int fr, int fq) const {
        const int row0 = u.pm * BM + wr * 64 + fr; const int col0 = u.pn * BM + wc * 32 + 8 * fq;
#pragma unroll
        for (int ai = 0; ai < 2; ++ai)
#pragma unroll
            for (int m = 0; m < 4; ++m) { bf16_t* rowp = O + (size_t)(row0 + ai * HALF + m * 16) * ldc + col0;
#pragma unroll
                for (int bj = 0; bj < 2; ++bj) *(u32x4*)(rowp + bj * HALF) = pack8(acc[ai][bj][m][0], acc[ai][bj][m][1]); }
    }
};
struct EpiInProj {
    static constexpr bool PERM = true, AFTER_DRAIN = false;
    bf16_t *Z, *Q, *Kt; const float *qg, *kg; float qscale;
    __device__ __forceinline__ void operator()(const f32x4 (&acc)[2][2][4][2], const Unit& u, int wr, int wc, int fr, int fq) const {
        const int row0 = u.pm * BM + wr * 64 + fr;
        if (u.pn < 4) {
            const int col0 = u.pn * 128 + wc * 32 + 8 * fq;
#pragma unroll
            for (int ai = 0; ai < 2; ++ai)
#pragma unroll
                for (int m = 0; m < 4; ++m) { f32x4 z0, z1;
#pragma unroll
                    for (int i = 0; i < 4; ++i) { z0[i] = acc[ai][0][m][0][i] * sigm(acc[ai][1][m][0][i]); z1[i] = acc[ai][0][m][1][i] * sigm(acc[ai][1][m][1][i]); }
                    *(u32x4*)(Z + (size_t)(row0 + ai * HALF + m * 16) * 512 + col0) = pack8(z0, z1); }
        } else {
            const bool isq = u.pn < 6; bf16_t* O = isq ? Q : Kt; const float* gv = isq ? qg : kg; const float sc = isq ? qscale : 1.f;
            const int head = 4 * (u.pn & 1) + wc;
            f32x4 gw[2][2];
#pragma unroll
            for (int bj = 0; bj < 2; ++bj)
#pragma unroll
                for (int n = 0; n < 2; ++n) gw[bj][n] = *(const f32x4*)(gv + 32 * bj + 8 * fq + 4 * n) * sc;
#pragma unroll
            for (int ai = 0; ai < 2; ++ai)
#pragma unroll
                for (int m = 0; m < 4; ++m) { float ss = 0.f;
#pragma unroll
                    for (int bj = 0; bj < 2; ++bj)
#pragma unroll
                        for (int n = 0; n < 2; ++n) { const f32x4 x = acc[ai][bj][m][n]; ss += (x[0] * x[0] + x[1] * x[1]) + (x[2] * x[2] + x[3] * x[3]); }
                    ss += __shfl_xor(ss, 16); ss += __shfl_xor(ss, 32);
                    const float r = __builtin_amdgcn_rsqf(ss * (1.f / 64.f) + 1e-6f);
                    bf16_t* rowp = O + (size_t)(row0 + ai * HALF + m * 16) * 512 + head * 64 + 8 * fq;
#pragma unroll
                    for (int bj = 0; bj < 2; ++bj) *(u32x4*)(rowp + 32 * bj) = pack8(acc[ai][bj][m][0] * r * gw[bj][0], acc[ai][bj][m][1] * r * gw[bj][1]); }
        }
    }
};
struct EpiResGate {
    static constexpr bool PERM = false, AFTER_DRAIN = false;
    const float* xin; float* out; const float* gate;
    __device__ __forceinline__ void operator()(const f32x4 (&acc)[2][2][4][2], const Unit& u, int wr, int wc, int fr, int fq) const {
        const int row0 = u.pm * BM + wr * 64 + fr, col0 = u.pn * BM + wc * 32 + 4 * fq; const float* gp = gate + (size_t)(u.pm >> 3) * 6144 + col0;
        f32x4 gv[2][2];
#pragma unroll
        for (int bj = 0; bj < 2; ++bj)
#pragma unroll
            for (int n = 0; n < 2; ++n) gv[bj][n] = *(const f32x4*)(gp + bj * HALF + n * 16);
#pragma unroll
        for (int ai = 0; ai < 2; ++ai)
#pragma unroll
            for (int m = 0; m < 4; ++m) { const size_t off = (size_t)(row0 + ai * HALF + m * 16) * 1024 + col0;
#pragma unroll
                for (int bj = 0; bj < 2; ++bj)
#pragma unroll
                    for (int n = 0; n < 2; ++n) { const f32x4 xv = *(const f32x4*)(xin + off + bj * HALF + n * 16); *(f32x4*)(out + off + bj * HALF + n * 16) = xv + gv[bj][n] * acc[ai][bj][m][n]; } }
    }
};
struct EpiSwiGLU {
    static constexpr bool PERM = true, AFTER_DRAIN = false;
    bf16_t* O; int ldc; const float* rowscale;
    __device__ __forceinline__ void operator()(const f32x4 (&acc)[2][2][4][2], const Unit& u, int wr, int wc, int fr, int fq) const {
        const int row0 = u.pm * BM + wr * 64 + fr; const int col0 = u.pn * 128 + wc * 32 + 8 * fq;
#pragma unroll
        for (int ai = 0; ai < 2; ++ai)
#pragma unroll
            for (int m = 0; m < 4; ++m) { const int row = row0 + ai * HALF + m * 16; const float rs = rowscale ? rowscale[row] : 1.f; f32x4 z0, z1;
#pragma unroll
                for (int i = 0; i < 4; ++i) { const float g0 = acc[ai][0][m][0][i], g1 = acc[ai][0][m][1][i];
                    z0[i] = g0 * sigm(g0) * acc[ai][1][m][0][i] * rs; z1[i] = g1 * sigm(g1) * acc[ai][1][m][1][i] * rs; }
                *(u32x4*)(O + (size_t)row * ldc + col0) = pack8(z0, z1); }
    }
};
template <class Epi, class Sched, bool ALIGN_EPI = false, bool SP2 = false>
__device__ __forceinline__ void gemm_phase(PG8_LAS unsigned char* lds, const Gemm g, const Sched& S, const Epi& E) {
    int tid_ = threadIdx.x; asm volatile("" : "+v"(tid_)); const int tid = tid_, wid = __builtin_amdgcn_readfirstlane(tid >> 6), lane = tid & 63, wr = wid >> 2, wc = wid & 3, fr = lane & 15, fq = lane >> 4;
    const int K = g.K, nt = K / BK;
    unsigned voffA[2], voffB[2];
#pragma unroll
    for (int i = 0; i < 2; ++i) { int R, C; stage_rc(tid * 16 + i * 8192, R, C); const int Rb = Epi::PERM ? ((R & ~31) + perm32(R & 31)) : R;
        voffA[i] = (unsigned)(R * K + C) * 2u; voffB[i] = (unsigned)(Rb * K + C) * 2u; }
    const size_t kstep = (size_t)(BK * 2);
    const size_t hstep = (size_t)HALF * K * 2;
    const size_t tstep = 2 * hstep;
    const unsigned ldsw = (unsigned)wid * 1024u;
    const int aoff = lds_byte(wr * 64 + fr, fq * 8), boff = lds_byte(wc * 32 + fr, fq * 8);
#define PG8_SA(b, h) (((b) * 2 + (h)) * HTB)
#define PG8_SB(b, h) ((4 + (b) * 2 + (h)) * HTB)
#define PG8_STAGE(bufoff, gbase, voff) do { _Pragma("unroll") for (int _i = 0; _i < 2; ++_i) \
        __builtin_amdgcn_global_load_lds((const unsigned*)((const char*)(gbase) + (voff)[_i]), (PG8_LAS unsigned*)(lds + (bufoff) + ldsw + _i * 8192), 16, 0, 0); } while (0)
#define PG8_LDA(dst, b, h) do { _Pragma("unroll") for (int m = 0; m < 4; ++m) _Pragma("unroll") for (int k = 0; k < 2; ++k) dst[m][k] = *(const PG8_LAS bf16x8*)(lds + PG8_SA(b, h) + aoff + m * 2048 + k * 1024); } while (0)
#define PG8_LDB(dst, b, h) do { _Pragma("unroll") for (int n = 0; n < 2; ++n) _Pragma("unroll") for (int k = 0; k < 2; ++k) dst[n][k] = *(const PG8_LAS bf16x8*)(lds + PG8_SB(b, h) + boff + n * 2048 + k * 1024); } while (0)
#define PG8_MMA(ai, bj, At, Bt) do { __builtin_amdgcn_s_setprio(1); _Pragma("unroll") for (int m = 0; m < 4; ++m) _Pragma("unroll") for (int n = 0; n < 2; ++n) _Pragma("unroll") for (int k = 0; k < 2; ++k) \
        acc[ai][bj][m][n] = __builtin_amdgcn_mfma_f32_16x16x32_bf16(Bt[n][k], At[m][k], acc[ai][bj][m][n], 0, 0, 0); __builtin_amdgcn_s_setprio(0); } while (0)
#define PG8_WAIT_V(n) asm volatile("s_waitcnt vmcnt(" #n ")" ::: "memory")
#define PG8_WAIT_L(n) asm volatile("s_waitcnt lgkmcnt(" #n ")" ::: "memory")
#define PG8_BAR __builtin_amdgcn_s_barrier()
#define PG8_SCHED __builtin_amdgcn_sched_barrier(0)
    Unit cur, nxt; int ui = 0;
    if (!S.next(0, cur)) return;
    f32x4 acc[2][2][4][2];
#pragma unroll
    for (int a = 0; a < 2; ++a)
#pragma unroll
        for (int b = 0; b < 2; ++b)
#pragma unroll
            for (int m = 0; m < 4; ++m)
#pragma unroll
                for (int n = 0; n < 2; ++n) acc[a][b][m][n] = (f32x4){0.f, 0.f, 0.f, 0.f};
    bf16x8 At[4][2], B0[2][2], B1[2][2];
    const char* cA = (const char*)g.A + (size_t)cur.pm * tstep; const char* cB = (const char*)g.Bt + (size_t)cur.e * g.bstride + (size_t)cur.pn * tstep;
    S.a_ready(cur);
    if constexpr (SP2) {
        PG8_STAGE(PG8_SB(0, 0), cB, voffB); PG8_STAGE(PG8_SB(0, 1), cB + hstep, voffB); PG8_STAGE(PG8_SA(0, 0), cA, voffA); PG8_STAGE(PG8_SA(0, 1), cA + hstep, voffA);
        if (wr == 1) PG8_BAR;
        PG8_WAIT_V(2); PG8_BAR;
        PG8_STAGE(PG8_SB(1, 0), cB + kstep, voffB); PG8_STAGE(PG8_SA(1, 0), cA + kstep, voffA); PG8_STAGE(PG8_SB(1, 1), cB + hstep + kstep, voffB);
        PG8_WAIT_V(6); PG8_BAR;
    } else {
        PG8_STAGE(PG8_SB(0, 0), cB, voffB); PG8_STAGE(PG8_SA(0, 0), cA, voffA); PG8_STAGE(PG8_SB(0, 1), cB + hstep, voffB); PG8_STAGE(PG8_SA(0, 1), cA + hstep, voffA);
        if (wr == 1) PG8_BAR;
        PG8_WAIT_V(4); PG8_BAR;
        PG8_STAGE(PG8_SB(1, 0), cB + kstep, voffB); PG8_STAGE(PG8_SA(1, 0), cA + kstep, voffA); PG8_STAGE(PG8_SB(1, 1), cB + hstep + kstep, voffB);
        PG8_WAIT_V(6); PG8_BAR;
    }
    for (;;) {
        const bool has_next = S.next(ui + 1, nxt);
        const char* nA = has_next ? (const char*)g.A + (size_t)nxt.pm * tstep : cA; const char* nB = has_next ? (const char*)g.Bt + (size_t)nxt.e * g.bstride + (size_t)nxt.pn * tstep : cB;
        for (int t = 0; t < nt; t += 2) {
            const bool last = (t == nt - 2);
            const char* a1 = cA + (size_t)(t + 1) * kstep;
            const char* a2 = last ? nA : cA + (size_t)(t + 2) * kstep; const char* b2 = last ? nB : cB + (size_t)(t + 2) * kstep;
            const char* a3 = a2 + kstep; const char* b3 = b2 + kstep;
            if (last && has_next) S.a_ready(nxt);
            if constexpr (SP2) {
            PG8_LDB(B0, 0, 0); PG8_LDB(B1, 0, 1); PG8_SCHED; PG8_LDA(At, 0, 0); PG8_STAGE(PG8_SA(1, 1), a1 + hstep, voffA);
            PG8_WAIT_V(8); PG8_WAIT_L(0); PG8_BAR; PG8_MMA(0, 0, At, B0); PG8_MMA(0, 1, At, B1); PG8_BAR; PG8_SCHED;
            PG8_LDA(At, 0, 1); PG8_STAGE(PG8_SB(0, 0), b2, voffB); PG8_STAGE(PG8_SB(0, 1), b2 + hstep, voffB); PG8_STAGE(PG8_SA(0, 0), a2, voffA);
            PG8_WAIT_V(8); PG8_WAIT_L(0); PG8_BAR; PG8_MMA(1, 0, At, B0); PG8_MMA(1, 1, At, B1); PG8_BAR; PG8_SCHED;
            PG8_LDB(B0, 1, 0); PG8_LDB(B1, 1, 1); PG8_SCHED; PG8_LDA(At, 1, 0); PG8_STAGE(PG8_SA(0, 1), a2 + hstep, voffA);
            PG8_WAIT_V(8); PG8_WAIT_L(0); PG8_BAR; PG8_MMA(0, 0, At, B0); PG8_MMA(0, 1, At, B1); PG8_BAR; PG8_SCHED;
            PG8_LDA(At, 1, 1); PG8_STAGE(PG8_SB(1, 0), b3, voffB); PG8_STAGE(PG8_SB(1, 1), b3 + hstep, voffB); PG8_STAGE(PG8_SA(1, 0), a3, voffA);
            PG8_WAIT_V(8); PG8_WAIT_L(0); PG8_BAR; PG8_MMA(1, 0, At, B0); PG8_MMA(1, 1, At, B1); PG8_BAR; PG8_SCHED;
            } else {
            PG8_LDB(B0, 0, 0); PG8_SCHED; PG8_LDA(At, 0, 0); PG8_STAGE(PG8_SA(1, 1), a1 + hstep, voffA);
            PG8_WAIT_L(8); PG8_BAR; PG8_WAIT_L(0); PG8_MMA(0, 0, At, B0); PG8_BAR; PG8_SCHED;
            PG8_LDB(B1, 0, 1); PG8_STAGE(PG8_SB(0, 0), b2, voffB);
            PG8_BAR; PG8_WAIT_L(0); PG8_MMA(0, 1, At, B1); PG8_BAR;
            PG8_LDA(At, 0, 1); PG8_STAGE(PG8_SA(0, 0), a2, voffA);
            PG8_BAR; PG8_WAIT_L(0); PG8_MMA(1, 0, At, B0); PG8_BAR; PG8_SCHED;
            PG8_STAGE(PG8_SB(0, 1), b2 + hstep, voffB);
            PG8_WAIT_V(6); PG8_BAR; PG8_MMA(1, 1, At, B1); PG8_BAR;
            PG8_LDB(B0, 1, 0); PG8_SCHED; PG8_LDA(At, 1, 0); PG8_STAGE(PG8_SA(0, 1), a2 + hstep, voffA);
            PG8_WAIT_L(8); PG8_BAR; PG8_WAIT_L(0); PG8_MMA(0, 0, At, B0); PG8_BAR; PG8_SCHED;
            PG8_LDB(B1, 1, 1); PG8_STAGE(PG8_SB(1, 0), b3, voffB);
            PG8_BAR; PG8_WAIT_L(0); PG8_MMA(0, 1, At, B1); PG8_BAR;
            PG8_LDA(At, 1, 1); PG8_STAGE(PG8_SA(1, 0), a3, voffA);
            PG8_BAR; PG8_WAIT_L(0); PG8_MMA(1, 0, At, B0); PG8_BAR; PG8_SCHED;
            PG8_STAGE(PG8_SB(1, 1), b3 + hstep, voffB);
            PG8_WAIT_V(6); PG8_BAR; PG8_MMA(1, 1, At, B1); PG8_BAR;
            }
        }
        if constexpr (ALIGN_EPI) { if (wr == 0) PG8_BAR; }
        if constexpr (!Epi::AFTER_DRAIN) { E(acc, cur, wr, wc, fr, fq); S.done(cur); }
        if (!has_next) break;
#pragma unroll
        for (int a = 0; a < 2; ++a)
#pragma unroll
            for (int b = 0; b < 2; ++b)
#pragma unroll
                for (int m = 0; m < 4; ++m)
#pragma unroll
                    for (int n = 0; n < 2; ++n) acc[a][b][m][n] = (f32x4){0.f, 0.f, 0.f, 0.f};
        cur = nxt; cA = nA; cB = nB; ++ui;
        if constexpr (ALIGN_EPI) { if (wr == 1) PG8_BAR; }
    }
    PG8_WAIT_V(0);
    if constexpr (!ALIGN_EPI) { if (wr == 0) PG8_BAR; }
    PG8_BAR;
    if constexpr (Epi::AFTER_DRAIN) { E.fused(acc, cur, wr, wc, fr, fq, lds, wid, lane); S.done(cur); }
#undef PG8_SA
#undef PG8_SB
#undef PG8_STAGE
#undef PG8_LDA
#undef PG8_LDB
#undef PG8_MMA
#undef PG8_WAIT_V
#undef PG8_WAIT_L
#undef PG8_BAR
#undef PG8_SCHED
}
}

namespace fk {
using pg8::bf16_t; using pg8::bf16x8; using pg8::f32x4; using pg8::u32x4;
constexpr int NWAVES = 8, NTHR = 512, GRID = 256, NGW = GRID * NWAVES;
constexpr int B_ = 8, S_ = 2048, D = 1024, M = B_ * S_, DIN = 2560, DC = 512, FFD = 2816, NE = 8, FFE = 3584, CW = 31, NREL = 257;
constexpr float LOG2E = 1.4426950408889634f, QSCALE = 0.125f * LOG2E, EPS = 1e-6f;
constexpr size_t MiB = 1u << 20;
constexpr size_t WS_CTL = 0, CTL_ZERO_BYTES = 1 * MiB;
constexpr size_t WS_MODP = 1 * MiB;
constexpr size_t WS_MOD = 4 * MiB;
constexpr size_t WS_PAIR = 4 * MiB + 512 * 1024;
constexpr size_t WS_LIST = 5 * MiB;
constexpr size_t WS_WL = 5 * MiB + 512 * 1024;
constexpr size_t WS_WLG = 6 * MiB;
constexpr size_t WS_WMGU = 8 * MiB;
constexpr size_t WS_WMD = 120 * MiB;
constexpr size_t WS_WIN = 176 * MiB;
constexpr size_t WS_WOUT = 186 * MiB;
constexpr size_t WS_WGU = 190 * MiB;
constexpr size_t WS_WD = 201 * MiB;
constexpr size_t WS_H = 207 * MiB;
constexpr size_t WS_Z = 239 * MiB, WS_Q = 255 * MiB, WS_K = 271 * MiB, WS_VT = 287 * MiB;
constexpr size_t WS_YC = 303 * MiB;
constexpr size_t WS_ACT = 239 * MiB;
constexpr size_t WS_HG = 176 * MiB;
constexpr size_t WS_F = 176 * MiB;
constexpr size_t WS_ACTM = 244 * MiB;
constexpr size_t WS_END = 482 * MiB;
constexpr int MAXROWS = 34816;
constexpr int CW_BAR = 4096, CW_CNT = 16384;
constexpr int RING_BYTES = 131072, LDSCTL_OFF = RING_BYTES, MISC_OFF = LDSCTL_OFF + 320, MOETAB_OFF = LDSCTL_OFF + 512;
constexpr int LDS_BYTES = 147456;

#define GAS __attribute__((address_space(1)))
#define LAS __attribute__((address_space(3)))
typedef unsigned short bf16;
typedef unsigned v4u __attribute__((ext_vector_type(4)));
typedef unsigned v2u __attribute__((ext_vector_type(2)));
typedef float f32x16 __attribute__((ext_vector_type(16)));
typedef short s16x4 __attribute__((ext_vector_type(4)));
typedef float f32x2_t __attribute__((ext_vector_type(2))); typedef __bf16 bf16x2_t __attribute__((ext_vector_type(2)));
__device__ __forceinline__ unsigned pk2(float lo, float hi) { f32x2_t v = {lo, hi}; bf16x2_t b = __builtin_convertvector(v, bf16x2_t); return __builtin_bit_cast(unsigned, b); }
__device__ __forceinline__ float bf2f(bf16 v) { return __uint_as_float((unsigned)v << 16); }
__device__ __forceinline__ float wave_sum(float v) {
#pragma unroll
    for (int o = 1; o < 64; o <<= 1) v += __shfl_xor(v, o);
    return v;
}
__device__ __forceinline__ float sigm(float x) { return __builtin_amdgcn_rcpf(1.f + __builtin_amdgcn_exp2f(-LOG2E * x)); }
#define LDS_WAIT() asm volatile("s_waitcnt lgkmcnt(0)" ::: "memory")

#define XB_TMO      128
#define XB_XCNT(j)  (256  + 64 * (j))
#define XB_XSUB(j)  (1280 + 64 * (j))
#define XB_XGEN(j)  (2304 + 64 * (j))
#define XB_TOP      3328
#define XB_TOPGEN   3392
#define XCD_BAR_WORDS 3456
#define XB_SPIN_CAP (1u << 18)

__device__ __forceinline__ unsigned xb_ld(unsigned* p)              { return __hip_atomic_load(p, __ATOMIC_RELAXED, __HIP_MEMORY_SCOPE_AGENT); }
__device__ __forceinline__ unsigned xb_add(unsigned* p, unsigned v) { return __hip_atomic_fetch_add(p, v, __ATOMIC_RELAXED, __HIP_MEMORY_SCOPE_AGENT); }
__device__ __forceinline__ unsigned xb_xcc_id() { return (unsigned)__builtin_amdgcn_s_getreg((3 << 11) | 20) & 0xFu; }
#define XB_SPIN(cond, bar) do { unsigned _sp = 0; while (cond) { __builtin_amdgcn_s_sleep(1); \
    if ((++_sp & 255u) == 0u) { if (xb_ld(&(bar)[XB_TMO])) break; if (_sp > XB_SPIN_CAP) { atomicAdd(&(bar)[XB_TMO], 1u); break; } } } } while (0)

struct XcdBarrier {
    unsigned* bar; unsigned x;
    volatile LAS unsigned* st;
};

__device__ __forceinline__ XcdBarrier xcd_barrier_post(unsigned* bar, volatile LAS unsigned* st) {
    XcdBarrier b; b.bar = bar; b.x = xb_xcc_id(); b.st = st;
    if (threadIdx.x == 0) (void)xb_add(&bar[XB_XCNT(b.x)], 1u);
    return b;
}
__device__ __forceinline__ void xcd_barrier_complete(unsigned* bar, unsigned x, unsigned& nloc, unsigned& nx) {
    const unsigned G = gridDim.x * gridDim.y * gridDim.z;
    unsigned sum, cnt, mine, sp = 0u;
    for (;;) {
        sum = 0u; cnt = 0u; mine = 0u;
#pragma unroll
        for (unsigned j = 0; j < 16; ++j) { const unsigned c = xb_ld(&bar[XB_XCNT(j)]); sum += c; cnt += (c > 0u) ? 1u : 0u; mine = (j == x) ? c : mine; }
        if (sum == G) break;
        __builtin_amdgcn_s_sleep(1);
        if ((++sp & 255u) == 0u) { if (xb_ld(&bar[XB_TMO])) break; if (sp > XB_SPIN_CAP) { atomicAdd(&bar[XB_TMO], 1u); break; } }
    }
    nloc = mine > 0u ? mine : 1u; nx = cnt > 0u ? cnt : 1u;
}

__device__ __forceinline__ void xcd_barrier(const XcdBarrier& b) {
    asm volatile("s_waitcnt vmcnt(0)" ::: "memory");
    __syncthreads();
    if (threadIdx.x == 0) {
        unsigned* bar = b.bar;
        __builtin_amdgcn_s_waitcnt(0);
        unsigned nloc = b.st[0], nx = b.st[1];
        if (nloc == 0u) { xcd_barrier_complete(bar, b.x, nloc, nx); b.st[0] = nloc; b.st[1] = nx; }
        const unsigned old = xb_add(&bar[XB_XSUB(b.x)], 1u);
        const unsigned gen = old / nloc;
        if (old + 1u == (gen + 1u) * nloc) {
            __builtin_amdgcn_fence(__ATOMIC_RELEASE, "agent");
            asm volatile("s_waitcnt vmcnt(0)" ::: "memory");
            const unsigned og = xb_add(&bar[XB_TOP], 1u);
            const unsigned tg = og / nx;
            if (og + 1u == (tg + 1u) * nx) xb_add(&bar[XB_TOPGEN], 1u);
            else XB_SPIN(xb_ld(&bar[XB_TOPGEN]) == tg, bar);
            __builtin_amdgcn_fence(__ATOMIC_ACQUIRE, "agent");
            xb_add(&bar[XB_XGEN(b.x)], 1u);
            asm volatile("s_waitcnt vmcnt(0)" ::: "memory");
        } else {
            XB_SPIN(xb_ld(&bar[XB_XGEN(b.x)]) == gen, bar);
            __builtin_amdgcn_fence(__ATOMIC_ACQUIRE, "agent");
            asm volatile("s_waitcnt vmcnt(0)" ::: "memory");
        }
    }
    __syncthreads();
}


struct Params { const float* in[23]; float* out; unsigned char* ws; int stop; int pad; };

__device__ __forceinline__ void tr_item(const float* W, int K, int N, bf16* WT, int kb, int nb, int drow0, LAS float* scr, int lane) {
    const int k0 = 64 * kb, n0 = 32 * nb;
#pragma unroll 8
    for (int i = 0; i < 32; ++i) { const int kk = 2 * i + (lane >> 5); scr[kk * 33 + (lane & 31)] = W[(size_t)(k0 + kk) * N + n0 + (lane & 31)]; }
    LDS_WAIT(); asm volatile("" ::: "memory");
    const int c = lane & 7;
#pragma unroll
    for (int j = 0; j < 4; ++j) { const int n = (lane >> 3) + 8 * j; const LAS float* s = scr + (8 * c) * 33 + n;
        v4u o; o.x = pk2(s[0 * 33], s[1 * 33]); o.y = pk2(s[2 * 33], s[3 * 33]); o.z = pk2(s[4 * 33], s[5 * 33]); o.w = pk2(s[6 * 33], s[7 * 33]);
        *(GAS v4u*)(WT + (size_t)(drow0 + n) * K + k0 + 8 * c) = o; }
    LDS_WAIT(); asm volatile("" ::: "memory");
}
__device__ __forceinline__ int rowmap_win(int n0) {
    if (n0 < 512) return 256 * (n0 >> 7) + (n0 & 127);
    if (n0 < 1024) { const int m = n0 - 512; return 256 * (m >> 7) + 128 + (m & 127); }
    if (n0 < 2048) { const int isk = n0 >= 1536; const int m = n0 - (isk ? 1536 : 1024); const int head = m >> 6, bj = (m >> 5) & 1; return 256 * (4 + 2 * isk + (head >> 2)) + 128 * bj + 32 * (head & 3); }
    return n0;
}
__device__ __forceinline__ int rowmap_gu(int n0, int up) { return 256 * (n0 >> 7) + 128 * up + (n0 & 127); }

__device__ __forceinline__ void phase0(const Params& P, LAS unsigned char* lds, int tid, int lane, int wave, int gw) {
    LAS float* cact = (LAS float*)(lds + 69632);
    { const float* c = P.in[1]; for (int i = tid; i < B_ * D; i += NTHR) { const float v = c[i]; cact[i] = v * sigm(v); } }
    __syncthreads();
    {
        const float* w_ada = P.in[2]; float* modp = (float*)(P.ws + WS_MODP);
        for (int it = gw; it < 1536; it += NGW) {
            const int ks = it & 7, jb = (it >> 3) % 96, l = it / 768;
            const float* wp = w_ada + ((size_t)l * D + ks * 128) * 6144 + jb * 64 + lane;
            float acc[8];
#pragma unroll
            for (int b = 0; b < 8; ++b) acc[b] = 0.f;
#pragma unroll 8
            for (int k = 0; k < 128; ++k) { const float w = wp[(size_t)k * 6144];
#pragma unroll
                for (int b = 0; b < 8; ++b) acc[b] += cact[b * D + ks * 128 + k] * w; }
#pragma unroll
            for (int b = 0; b < 8; ++b) modp[(((size_t)ks * 2 + l) * 8 + b) * 6144 + jb * 64 + lane] = acc[b];
        }
    }
    LAS float* scr = (LAS float*)(lds + wave * 8448);
    constexpr int I_WIN = 16 * 80, I_WOUT = 16 * 32, I_FG = 16 * 88, I_FD = 44 * 32, I_MG = 16 * 112, I_MD = 56 * 32;
    constexpr int NITEMS = 2 * I_WIN + 2 * I_WOUT + 2 * I_FG + I_FD + 16 * I_MG + 8 * I_MD;
    for (int it = gw; it < NITEMS; it += NGW) {
        int r = it;
        if (r < 16 * I_MG) { const int mat = r / I_MG, q = r % I_MG, e = mat >> 1, up = mat & 1; const int kb = q / 112, nb = q % 112;
            tr_item((up ? P.in[21] : P.in[20]) + (size_t)e * D * FFE, D, FFE, (bf16*)(P.ws + WS_WMGU) + (size_t)e * 7168 * D, kb, nb, rowmap_gu(32 * nb, up), scr, lane); continue; }
        r -= 16 * I_MG;
        if (r < 8 * I_MD) { const int e = r / I_MD, q = r % I_MD; const int kb = q / 32, nb = q % 32;
            tr_item(P.in[22] + (size_t)e * FFE * D, FFE, D, (bf16*)(P.ws + WS_WMD) + (size_t)e * D * FFE, kb, nb, 32 * nb, scr, lane); continue; }
        r -= 8 * I_MD;
        if (r < 2 * I_WIN) { const int l = r / I_WIN, q = r % I_WIN; const int kb = q / 80, nb = q % 80;
            tr_item(P.in[6] + (size_t)l * D * DIN, D, DIN, (bf16*)(P.ws + WS_WIN) + (size_t)l * DIN * D, kb, nb, rowmap_win(32 * nb), scr, lane); continue; }
        r -= 2 * I_WIN;
        if (r < 2 * I_WOUT) { const int l = r / I_WOUT, q = r % I_WOUT; const int kb = q / 32, nb = q % 32;
            tr_item(P.in[7] + (size_t)l * D * D, D, D, (bf16*)(P.ws + WS_WOUT) + (size_t)l * D * D, kb, nb, 32 * nb, scr, lane); continue; }
        r -= 2 * I_WOUT;
        if (r < 2 * I_FG) { const int up = r / I_FG, q = r % I_FG; const int kb = q / 88, nb = q % 88;
            tr_item((up ? P.in[16] : P.in[15]), D, FFD, (bf16*)(P.ws + WS_WGU), kb, nb, rowmap_gu(32 * nb, up), scr, lane); continue; }
        r -= 2 * I_FG;
        { const int kb = r / 32, nb = r % 32; tr_item(P.in[17], FFD, D, (bf16*)(P.ws + WS_WD), kb, nb, 32 * nb, scr, lane); }
    }
}

__device__ __forceinline__ float modp_sum(const float* modp, const float* b_ada, int l, int b, int j) {
    float s = b_ada[l * 6144 + j];
#pragma unroll
    for (int ks = 0; ks < 8; ++ks) s += modp[(((size_t)ks * 2 + l) * 8 + b) * 6144 + j];
    return s;
}
__device__ __forceinline__ void norm_row(const float* xrow, const LAS float* gm, const LAS float* shv, int lane, f32x4 (&h)[4]) {
    const GAS f32x4* xr = (const GAS f32x4*)xrow + lane; float ss = 0.f;
#pragma unroll
    for (int j = 0; j < 4; ++j) { h[j] = xr[64 * j]; ss += (h[j].x * h[j].x + h[j].y * h[j].y) + (h[j].z * h[j].z + h[j].w * h[j].w); }
    const float r = __builtin_amdgcn_rsqf(wave_sum(ss) * (1.f / D) + EPS);
#pragma unroll
    for (int j = 0; j < 4; ++j) { const f32x4 g4 = *(const LAS f32x4*)(gm + 4 * lane + 256 * j), s4 = *(const LAS f32x4*)(shv + 4 * lane + 256 * j); h[j] = h[j] * r * g4 + s4; }
}
__device__ __forceinline__ void store_row_bf16(bf16* orow, int lane, const f32x4 (&h)[4]) {
    GAS v2u* o8 = (GAS v2u*)orow + lane;
#pragma unroll
    for (int j = 0; j < 4; ++j) { v2u w; w.x = pk2(h[j].x, h[j].y); w.y = pk2(h[j].z, h[j].w); o8[64 * j] = w; }
}
__device__ __forceinline__ void norm_phase(const Params& P, LAS unsigned char* lds, const float* xin, const float* gvec, int l, int sh_off, int sc_off, bool from_partials, int tid, int lane, int wave, int wgi) {
    LAS float* gm = (LAS float*)lds; LAS float* shv = (LAS float*)(lds + 4096);
    const float* modp = (const float*)(P.ws + WS_MODP); float* mod = (float*)(P.ws + WS_MOD); const float* b_ada = P.in[3];
    const int b = wgi >> 5;
    if (from_partials) {
        if (tid < 384) { const int idx = wgi * 384 + tid; const int ll = idx / 49152, rem = idx % 49152, bb = rem / 6144, j = rem % 6144; mod[idx] = modp_sum(modp, b_ada, ll, bb, j); }
        for (int c = tid; c < D; c += NTHR) { gm[c] = gvec[c] * (1.f + modp_sum(modp, b_ada, l, b, sc_off + c)); shv[c] = modp_sum(modp, b_ada, l, b, sh_off + c); }
    } else {
        const float* ml = mod + ((size_t)l * 8 + b) * 6144;
        for (int c = tid; c < D; c += NTHR) { gm[c] = gvec[c] * (1.f + ml[sc_off + c]); shv[c] = ml[sh_off + c]; }
    }
    __syncthreads();
    bf16* H = (bf16*)(P.ws + WS_H);
    for (int i = 0; i < 8; ++i) { const int row = wgi * 64 + wave * 8 + i; f32x4 h[4]; norm_row(xin + (size_t)row * D, gm, shv, lane, h); store_row_bf16(H + (size_t)row * D, lane, h); }
    __syncthreads();
}
__device__ __forceinline__ void router_phase(const Params& P, LAS unsigned char* lds, const float* xin, int tid, int lane, int wave, int wgi) {
    LAS float* gm = (LAS float*)lds; LAS float* shv = (LAS float*)(lds + 4096); LAS float* wrT = (LAS float*)(lds + 8192);
    LAS int* pe = (LAS int*)(lds + 40960); LAS float* pw = (LAS float*)(lds + 41472); LAS int* cw = (LAS int*)(lds + 41984); LAS int* baseL = (LAS int*)(lds + 42048);
    const float* mod = (const float*)(P.ws + WS_MOD); const int b = wgi >> 5; const float* ml = mod + ((size_t)1 * 8 + b) * 6144; const float* gvec = P.in[5] + D;
    for (int c = tid; c < D; c += NTHR) { gm[c] = gvec[c] * (1.f + ml[4096 + c]); shv[c] = ml[3072 + c]; }
    { const float* wr = P.in[18]; for (int i = tid; i < D * NE; i += NTHR) { const int c = i >> 3, e = i & 7; wrT[e * D + c] = wr[i]; } }
    __syncthreads();
    const float* br = P.in[19];
    for (int i = 0; i < 8; ++i) { const int rl = wave * 8 + i, row = wgi * 64 + rl; f32x4 h[4]; norm_row(xin + (size_t)row * D, gm, shv, lane, h);
        float lg[8];
#pragma unroll
        for (int e = 0; e < 8; ++e) { float s = 0.f;
#pragma unroll
            for (int j = 0; j < 4; ++j) { const f32x4 w4 = *(const LAS f32x4*)(wrT + e * D + 4 * lane + 256 * j); s += (h[j].x * w4.x + h[j].y * w4.y) + (h[j].z * w4.z + h[j].w * w4.w); }
            lg[e] = wave_sum(s) + br[e]; }
        int e1 = 0; float v1 = lg[0];
#pragma unroll
        for (int e = 1; e < 8; ++e) if (lg[e] > v1) { v1 = lg[e]; e1 = e; }
        int e2 = -1; float v2 = -3.0e38f;
#pragma unroll
        for (int e = 0; e < 8; ++e) if (e != e1 && lg[e] > v2) { v2 = lg[e]; e2 = e; }
        const float p2 = __expf(v2 - v1), inv = 1.f / (1.f + p2);
        if (lane == 0) { pe[2 * rl] = e1; pe[2 * rl + 1] = e2; pw[2 * rl] = inv; pw[2 * rl + 1] = p2 * inv; } }
    __syncthreads();
    int e = 0, rank = 0;
    if (tid < 128) { e = pe[tid];
#pragma unroll
        for (int ee = 0; ee < 8; ++ee) { const unsigned long long mk = __ballot(e == ee); if (e == ee) rank = __popcll(mk & ((1ull << lane) - 1ull)); if (lane == 0) cw[wave * 8 + ee] = __popcll(mk); } }
    __syncthreads();
    if (tid < 8) { const int tot = cw[tid] + cw[8 + tid]; unsigned* cnt = (unsigned*)(P.ws + WS_CTL) + CW_CNT + 64 * tid;
        baseL[tid] = (int)__hip_atomic_fetch_add(cnt, (unsigned)tot, __ATOMIC_RELAXED, __HIP_MEMORY_SCOPE_AGENT); }
    __syncthreads();
    if (tid < 128) { const int slot = baseL[e] + rank + (wave == 1 ? cw[e] : 0); const int token = wgi * 64 + (tid >> 1);
        ((int*)(P.ws + WS_LIST))[e * M + slot] = token; ((float*)(P.ws + WS_WL))[e * M + slot] = pw[tid]; ((int*)(P.ws + WS_PAIR))[token * 2 + (tid & 1)] = e * M + slot; }
    __syncthreads();
}
__device__ __forceinline__ void moe_tables(const Params& P, LAS unsigned char* lds, int tid) {
    LAS int* tab = (LAS int*)(lds + MOETAB_OFF);
    if (tid == 0) { const unsigned* ctl = (const unsigned*)(P.ws + WS_CTL); int rb = 0;
        for (int e = 0; e < 8; ++e) { int c = (int)__hip_atomic_load(ctl + CW_CNT + 64 * e, __ATOMIC_RELAXED, __HIP_MEMORY_SCOPE_AGENT); c = c < 0 ? 0 : (c > M ? M : c); tab[e] = rb; tab[9 + e] = c; rb += (c + 255) & ~255; }
        tab[8] = rb; }
    __syncthreads();
}
__device__ __forceinline__ void gather_phase(const Params& P, LAS unsigned char* lds, const float* xin, int tid, int lane, int wave, int gw) {
    LAS float* gmA = (LAS float*)lds; LAS float* shA = (LAS float*)(lds + 32768); const LAS int* tab = (const LAS int*)(lds + MOETAB_OFF);
    const float* mod1 = (const float*)(P.ws + WS_MOD) + (size_t)8 * 6144; const float* gvec = P.in[5] + D;
    for (int i = tid; i < 8 * D; i += NTHR) { const int b = i >> 10, c = i & 1023; gmA[i] = gvec[c] * (1.f + mod1[b * 6144 + 4096 + c]); shA[i] = mod1[b * 6144 + 3072 + c]; }
    __syncthreads();
    const int ptot = tab[8]; const int* list = (const int*)(P.ws + WS_LIST); const float* wl = (const float*)(P.ws + WS_WL); float* wlg = (float*)(P.ws + WS_WLG); bf16* HG = (bf16*)(P.ws + WS_HG);
    for (int p = gw; p < ptot; p += NGW) {
        int e = 0;
#pragma unroll
        for (int k = 1; k < 8; ++k) e += (p >= tab[k]);
        const int slot = p - tab[e], cn = tab[9 + e]; const bool valid = slot < cn; const int token = list[e * M + (valid ? slot : cn - 1)]; const int b = token >> 11;
        f32x4 h[4]; norm_row(xin + (size_t)token * D, gmA + b * D, shA + b * D, lane, h); store_row_bf16(HG + (size_t)p * D, lane, h);
        if (lane == 0) wlg[p] = valid ? wl[e * M + slot] : 0.f;
    }
    __syncthreads();
}
__device__ __forceinline__ void combine_phase(const Params& P, LAS unsigned char* lds, int lane, int gw) {
    const LAS int* tab = (const LAS int*)(lds + MOETAB_OFF); const int* pair = (const int*)(P.ws + WS_PAIR); const bf16* F = (const bf16*)(P.ws + WS_F);
    const float* mod1 = (const float*)(P.ws + WS_MOD) + (size_t)8 * 6144;
    for (int t = gw; t < M; t += NGW) {
        const int pa = pair[2 * t], pb = pair[2 * t + 1]; const int ra = tab[pa >> 14] + (pa & 16383), rb = tab[pb >> 14] + (pb & 16383); const int b = t >> 11;
        const GAS v2u* fa = (const GAS v2u*)(F + (size_t)ra * D) + lane; const GAS v2u* fb = (const GAS v2u*)(F + (size_t)rb * D) + lane;
        GAS f32x4* xo = (GAS f32x4*)(P.out + (size_t)t * D) + lane; const GAS f32x4* g2 = (const GAS f32x4*)(mod1 + b * 6144 + 5120) + lane;
#pragma unroll
        for (int j = 0; j < 4; ++j) { const v2u a = fa[64 * j], c = fb[64 * j]; f32x4 f;
            f.x = __uint_as_float(a.x << 16) + __uint_as_float(c.x << 16); f.y = __uint_as_float(a.x & 0xffff0000u) + __uint_as_float(c.x & 0xffff0000u);
            f.z = __uint_as_float(a.y << 16) + __uint_as_float(c.y << 16); f.w = __uint_as_float(a.y & 0xffff0000u) + __uint_as_float(c.y & 0xffff0000u);
            xo[64 * j] = xo[64 * j] + g2[64 * j] * f; }
    }
}

__device__ __forceinline__ void conv_unit(const bf16* Z, bf16* YC, const float* cw, const float* cb, const float* lg, const float* lb, LAS float* tile, int unit, int tid, int wave, int lane) {
    const int tok0 = unit * 32, tp0 = tok0 & (S_ - 1), c = tid;
    float w[CW];
#pragma unroll
    for (int j = 0; j < CW; ++j) w[j] = cw[j * DC + c];
    const float bias = cb[c];
#pragma unroll
    for (int half = 0; half < 2; ++half) {
        float in[46];
#pragma unroll
        for (int i = 0; i < 46; ++i) { const int dt = 16 * half - 30 + i; in[i] = (tp0 + dt >= 0) ? bf2f(Z[(size_t)(tok0 + dt) * DC + c]) : 0.f; }
#pragma unroll
        for (int q = 0; q < 16; ++q) { float a = bias;
#pragma unroll
            for (int j = 0; j < CW; ++j) a += w[j] * in[q + j];
            tile[(16 * half + q) * DC + c] = a; }
    }
    __syncthreads();
    const f32x4 g0 = *(const f32x4*)(lg + lane * 8), g1 = *(const f32x4*)(lg + lane * 8 + 4), b0 = *(const f32x4*)(lb + lane * 8), b1 = *(const f32x4*)(lb + lane * 8 + 4);
#pragma unroll
    for (int tt = 0; tt < 4; ++tt) { const int t = wave * 4 + tt;
        f32x4 v0 = *(const LAS f32x4*)(tile + t * DC + lane * 8), v1 = *(const LAS f32x4*)(tile + t * DC + lane * 8 + 4);
        const float mean = wave_sum((v0.x + v0.y) + (v0.z + v0.w) + (v1.x + v1.y) + (v1.z + v1.w)) * (1.f / DC);
        v0 = v0 - mean; v1 = v1 - mean;
        const float var = wave_sum((v0.x * v0.x + v0.y * v0.y) + (v0.z * v0.z + v0.w * v0.w) + (v1.x * v1.x + v1.y * v1.y) + (v1.z * v1.z + v1.w * v1.w)) * (1.f / DC);
        const float rstd = __builtin_amdgcn_rsqf(var + EPS);
        f32x4 y0 = v0 * rstd * g0 + b0, y1 = v1 * rstd * g1 + b1;
#pragma unroll
        for (int i = 0; i < 4; ++i) { y0[i] = y0[i] * sigm(y0[i]); y1[i] = y1[i] * sigm(y1[i]); }
        v4u o; o.x = pk2(y0.x, y0.y); o.y = pk2(y0.z, y0.w); o.z = pk2(y1.x, y1.y); o.w = pk2(y1.z, y1.w);
        *(GAS v4u*)(YC + (size_t)(tok0 + t) * D + lane * 8) = o; }
    __syncthreads();
}
__device__ __forceinline__ int crow(int r, int hi) { return (r & 3) + 8 * (r >> 2) + 4 * hi; }
#define MFMA32(a, b, c) __builtin_amdgcn_mfma_f32_32x32x16_bf16((a), (b), (c), 0, 0, 0)
__device__ __forceinline__ void attn_wave(const bf16* Q, const bf16* K, const bf16* VT, bf16* YC, const LAS float* biasL, int b, int n, int h, int qh, int lane) {
    const int r32 = lane & 31, hi = lane >> 5;
    const size_t rowq = (size_t)b * S_ + n * 64 + qh * 32 + r32;
    bf16x8 qf[4];
#pragma unroll
    for (int d0 = 0; d0 < 4; ++d0) qf[d0] = *(const GAS bf16x8*)(Q + rowq * DC + h * 64 + d0 * 16 + hi * 8);
    float m = -1.0e30f, l = 0.f; f32x16 o0, o1;
#pragma unroll
    for (int r = 0; r < 16; ++r) { o0[r] = 0.f; o1[r] = 0.f; }
    const int kc0 = n - 8 < 0 ? 0 : n - 8;
    const bf16* Kb = K + ((size_t)b * S_ + r32) * DC + h * 64 + hi * 8;
    const bf16* Vb = VT + (size_t)(h * 64 + r32) * M + (size_t)b * S_ + 4 * hi;
    const int qbase = n * 64 + qh * 32, qpos = qbase + r32;
    for (int blk = kc0 * 2; blk < n * 2 + 2; ++blk) {
        const int key0 = blk * 32;
        bf16x8 kf[4];
#pragma unroll
        for (int d0 = 0; d0 < 4; ++d0) kf[d0] = *(const GAS bf16x8*)(Kb + (size_t)key0 * DC + d0 * 16);
        s16x4 va[2][2][2];
#pragma unroll
        for (int db = 0; db < 2; ++db)
#pragma unroll
            for (int s2 = 0; s2 < 2; ++s2)
#pragma unroll
                for (int hf = 0; hf < 2; ++hf) va[db][s2][hf] = *(const GAS s16x4*)(Vb + (size_t)db * 32 * M + key0 + 16 * s2 + 8 * hf);
        f32x16 s;
#pragma unroll
        for (int r = 0; r < 16; ++r) s[r] = 0.f;
#pragma unroll
        for (int d0 = 0; d0 < 4; ++d0) s = MFMA32(kf[d0], qf[d0], s);
        if (key0 + 31 - qbase <= -128) { const float b0 = biasL[0];
#pragma unroll
            for (int r = 0; r < 16; ++r) s[r] += b0;
        } else {
#pragma unroll
            for (int r = 0; r < 16; ++r) { int rel = key0 + crow(r, hi) - qpos; rel = rel < -128 ? -128 : (rel > 128 ? 128 : rel); s[r] += biasL[rel + 128]; }
        }
        float mx = s[0];
#pragma unroll
        for (int r = 1; r < 16; ++r) mx = fmaxf(mx, s[r]);
        mx = fmaxf(mx, __shfl_xor(mx, 32));
        const float mn = fmaxf(m, mx), alpha = __builtin_amdgcn_exp2f(m - mn); m = mn;
        float ps = 0.f;
#pragma unroll
        for (int r = 0; r < 16; ++r) { s[r] = __builtin_amdgcn_exp2f(s[r] - mn); ps += s[r]; }
        l = l * alpha + ps;
#pragma unroll
        for (int r = 0; r < 16; ++r) { o0[r] *= alpha; o1[r] *= alpha; }
        v4u p0, p1;
        p0.x = pk2(s[0], s[1]); p0.y = pk2(s[2], s[3]); p0.z = pk2(s[4], s[5]); p0.w = pk2(s[6], s[7]);
        p1.x = pk2(s[8], s[9]); p1.y = pk2(s[10], s[11]); p1.z = pk2(s[12], s[13]); p1.w = pk2(s[14], s[15]);
        const bf16x8 pb0 = __builtin_bit_cast(bf16x8, p0), pb1 = __builtin_bit_cast(bf16x8, p1);
#define VA8(db, s2) (bf16x8){va[db][s2][0][0], va[db][s2][0][1], va[db][s2][0][2], va[db][s2][0][3], va[db][s2][1][0], va[db][s2][1][1], va[db][s2][1][2], va[db][s2][1][3]}
        o0 = MFMA32(VA8(0, 0), pb0, o0); o0 = MFMA32(VA8(0, 1), pb1, o0);
        o1 = MFMA32(VA8(1, 0), pb0, o1); o1 = MFMA32(VA8(1, 1), pb1, o1);
#undef VA8
    }
    l += __shfl_xor(l, 32); const float il = 1.f / l;
    bf16* yp = YC + rowq * D + DC + h * 64 + 4 * hi;
#pragma unroll
    for (int g = 0; g < 4; ++g) { v2u w0, w1; w0.x = pk2(o0[4 * g] * il, o0[4 * g + 1] * il); w0.y = pk2(o0[4 * g + 2] * il, o0[4 * g + 3] * il);
        w1.x = pk2(o1[4 * g] * il, o1[4 * g + 1] * il); w1.y = pk2(o1[4 * g + 2] * il, o1[4 * g + 3] * il);
        *(GAS v2u*)(yp + 8 * g) = w0; *(GAS v2u*)(yp + 32 + 8 * g) = w1; }
}
__device__ __forceinline__ void mixer_phase(const Params& P, LAS unsigned char* lds, int l, int tid, int lane, int wave, int wgi) {
    LAS float* tile = (LAS float*)lds; LAS float* biasL = (LAS float*)(lds + 65536);
    { const float* rb = P.in[14] + l * 8 * NREL; for (int i = tid; i < 8 * NREL; i += NTHR) biasL[i] = rb[i] * LOG2E; }
    __syncthreads();
    const bf16* Z = (const bf16*)(P.ws + WS_Z); const bf16* Q = (const bf16*)(P.ws + WS_Q); const bf16* K = (const bf16*)(P.ws + WS_K); const bf16* VT = (const bf16*)(P.ws + WS_VT); bf16* YC = (bf16*)(P.ws + WS_YC);
    for (int cu = 0; cu < 2; ++cu) conv_unit(Z, YC, P.in[8] + l * CW * DC, P.in[9] + l * DC, P.in[10] + l * DC, P.in[11] + l * DC, tile, wgi * 2 + cu, tid, wave, lane);
    for (int au = 0; au < 2; ++au) { const int unit = wgi * 2 + au; const int b = unit >> 6, rem = unit & 63, n = rem >> 1, hg = rem & 1; const int h = hg * 4 + (wave >> 1), qh = wave & 1;
        attn_wave(Q, K, VT, YC, biasL + h * NREL, b, n, h, qh, lane); }
    __syncthreads();
}

#ifndef PHMASK
#define PHMASK 0xFFFF
#endif
#define PH(k) if constexpr ((PHMASK >> (k)) & 1)
__global__ void __launch_bounds__(NTHR, 2) fwd(Params P) {
    extern __shared__ __attribute__((aligned(16))) unsigned char lds_raw[];
    LAS unsigned char* lds = (LAS unsigned char*)lds_raw;
    int tid = threadIdx.x, lane = tid & 63, wave = __builtin_amdgcn_readfirstlane(tid >> 6); const int wgi = blockIdx.x; int gw = wgi * NWAVES + wave;
#define RETID() do { tid = threadIdx.x; asm volatile("" : "+v"(tid)); lane = tid & 63; wave = __builtin_amdgcn_readfirstlane(tid >> 6); gw = wgi * NWAVES + wave; } while (0)
    for (int u = tid; u < (LDS_BYTES - LDSCTL_OFF) / 4; u += NTHR) ((LAS unsigned*)(lds + LDSCTL_OFF))[u] = 0u;
    __syncthreads();
    unsigned* ctl = (unsigned*)(P.ws + WS_CTL);
    XcdBarrier bar = xcd_barrier_post(ctl + CW_BAR, (volatile LAS unsigned*)(lds + MISC_OFF) + 8);
    const int stop = P.stop;
#define SEAM(k) do { if (stop == (k)) return; xcd_barrier(bar); RETID(); } while (0)
    bf16* H = (bf16*)(P.ws + WS_H); float* mod = (float*)(P.ws + WS_MOD);

    PH(0) phase0(P, lds, tid, lane, wave, gw);                                                       SEAM(0);
    PH(1) norm_phase(P, lds, P.in[0], P.in[4], 0, 0, 1024, true, tid, lane, wave, wgi);              SEAM(1);
    { constexpr int l = 0;
        const int pb = 2 + 7 * l;
        const float* xin = (l == 0) ? P.in[0] : P.out;
        PH(2) {
            const bf16* Wl = (const bf16*)(P.ws + WS_WIN) + (size_t)l * DIN * D;
            { pg8::Gemm g{H, Wl, M, 2048, D, 0}; pg8::StaticOrder S; S.init(M, 2048, GRID, wgi);
              pg8::EpiInProj E{(bf16*)(P.ws + WS_Z), (bf16*)(P.ws + WS_Q), (bf16*)(P.ws + WS_K), P.in[12] + l * 64, P.in[13] + l * 64, QSCALE};
              pg8::gemm_phase<pg8::EpiInProj, pg8::StaticOrder, true, true>(lds, g, S, E); }
            { pg8::Gemm g{Wl + (size_t)2048 * D, H, 512, M, D, 0}; pg8::StaticOrder S; S.init(512, M, GRID, wgi);
              pg8::EpiBf16 E{(bf16*)(P.ws + WS_VT), M};
              pg8::gemm_phase<pg8::EpiBf16, pg8::StaticOrder, true, true>(lds, g, S, E); }
        }
        SEAM(pb);
        PH(3) mixer_phase(P, lds, l, tid, lane, wave, wgi);                                           SEAM(pb + 1);
        PH(4) {
            pg8::Gemm g{(const bf16*)(P.ws + WS_YC), (const bf16*)(P.ws + WS_WOUT) + (size_t)l * D * D, M, D, D, 0}; pg8::StaticOrder S; S.init(M, D, GRID, wgi);
            pg8::EpiResGate E{xin, P.out, mod + (size_t)l * 8 * 6144 + 2048};
            pg8::gemm_phase<pg8::EpiResGate, pg8::StaticOrder, false, true>(lds, g, S, E);
        }
        SEAM(pb + 2);
        if constexpr (l == 0) {
            PH(5) norm_phase(P, lds, P.out, P.in[5], 0, 3072, 4096, false, tid, lane, wave, wgi);   SEAM(5);
            PH(6) {   pg8::Gemm g{H, (const bf16*)(P.ws + WS_WGU), M, 2 * FFD, D, 0}; pg8::StaticOrder S; S.init(M, 2 * FFD, GRID, wgi);
                pg8::EpiSwiGLU E{(bf16*)(P.ws + WS_ACT), FFD, nullptr};
                pg8::gemm_phase<pg8::EpiSwiGLU, pg8::StaticOrder, true, true>(lds, g, S, E); }
            SEAM(6);
            PH(7) {   pg8::Gemm g{(const bf16*)(P.ws + WS_ACT), (const bf16*)(P.ws + WS_WD), M, D, FFD, 0}; pg8::StaticOrder S; S.init(M, D, GRID, wgi);
                pg8::EpiResGate E{P.out, P.out, mod + 5120};
                pg8::gemm_phase<pg8::EpiResGate, pg8::StaticOrder, false, true>(lds, g, S, E); }
            SEAM(7);
            PH(8) norm_phase(P, lds, P.out, P.in[4] + D, 1, 0, 1024, false, tid, lane, wave, wgi);  SEAM(8);
        } else {
            PH(9) router_phase(P, lds, P.out, tid, lane, wave, wgi);                                  SEAM(12);
            moe_tables(P, lds, tid);
            PH(10) gather_phase(P, lds, P.out, tid, lane, wave, gw);                                   SEAM(13);
            const LAS int* tab = (const LAS int*)(lds + MOETAB_OFF);
            const int ptot = tab[8];
            PH(11) {   pg8::Gemm g{(const bf16*)(P.ws + WS_HG), (const bf16*)(P.ws + WS_WMGU), ptot, 2 * FFE, D, (size_t)2 * FFE * D * 2};
                pg8::MoeOrder S; S.nM = ptot >> 8; S.nN = 2 * FFE / 256; S.nwg = S.nM * S.nN; S.G = GRID; S.c = wgi;
                S.t1 = tab[1] >> 8; S.t2 = tab[2] >> 8; S.t3 = tab[3] >> 8; S.t4 = tab[4] >> 8; S.t5 = tab[5] >> 8; S.t6 = tab[6] >> 8; S.t7 = tab[7] >> 8;
                pg8::EpiSwiGLU E{(bf16*)(P.ws + WS_ACTM), FFE, (const float*)(P.ws + WS_WLG)};
                pg8::gemm_phase<pg8::EpiSwiGLU, pg8::MoeOrder, true, true>(lds, g, S, E); }
            SEAM(14);
            PH(12) {   pg8::Gemm g{(const bf16*)(P.ws + WS_ACTM), (const bf16*)(P.ws + WS_WMD), ptot, D, FFE, (size_t)D * FFE * 2};
                pg8::MoeOrder S; S.nM = ptot >> 8; S.nN = D / 256; S.nwg = S.nM * S.nN; S.G = GRID; S.c = wgi;
                S.t1 = tab[1] >> 8; S.t2 = tab[2] >> 8; S.t3 = tab[3] >> 8; S.t4 = tab[4] >> 8; S.t5 = tab[5] >> 8; S.t6 = tab[6] >> 8; S.t7 = tab[7] >> 8;
                pg8::EpiBf16 E{(bf16*)(P.ws + WS_F), D};
                pg8::gemm_phase<pg8::EpiBf16, pg8::MoeOrder, true, true>(lds, g, S, E); }
            SEAM(15);
            PH(13) combine_phase(P, lds, lane, gw);
        }
    }
    { constexpr int l = 1;
        const int pb = 2 + 7 * l;
        const float* xin = (l == 0) ? P.in[0] : P.out;
        PH(2) {
            const bf16* Wl = (const bf16*)(P.ws + WS_WIN) + (size_t)l * DIN * D;
            { pg8::Gemm g{H, Wl, M, 2048, D, 0}; pg8::StaticOrder S; S.init(M, 2048, GRID, wgi);
              pg8::EpiInProj E{(bf16*)(P.ws + WS_Z), (bf16*)(P.ws + WS_Q), (bf16*)(P.ws + WS_K), P.in[12] + l * 64, P.in[13] + l * 64, QSCALE};
              pg8::gemm_phase<pg8::EpiInProj, pg8::StaticOrder, true, true>(lds, g, S, E); }
            { pg8::Gemm g{Wl + (size_t)2048 * D, H, 512, M, D, 0}; pg8::StaticOrder S; S.init(512, M, GRID, wgi);
              pg8::EpiBf16 E{(bf16*)(P.ws + WS_VT), M};
              pg8::gemm_phase<pg8::EpiBf16, pg8::StaticOrder, true, true>(lds, g, S, E); }
        }
        SEAM(pb);
        PH(3) mixer_phase(P, lds, l, tid, lane, wave, wgi);                                           SEAM(pb + 1);
        PH(4) {
            pg8::Gemm g{(const bf16*)(P.ws + WS_YC), (const bf16*)(P.ws + WS_WOUT) + (size_t)l * D * D, M, D, D, 0}; pg8::StaticOrder S; S.init(M, D, GRID, wgi);
            pg8::EpiResGate E{xin, P.out, mod + (size_t)l * 8 * 6144 + 2048};
            pg8::gemm_phase<pg8::EpiResGate, pg8::StaticOrder, false, true>(lds, g, S, E);
        }
        SEAM(pb + 2);
        if constexpr (l == 0) {
            PH(5) norm_phase(P, lds, P.out, P.in[5], 0, 3072, 4096, false, tid, lane, wave, wgi);   SEAM(5);
            PH(6) {   pg8::Gemm g{H, (const bf16*)(P.ws + WS_WGU), M, 2 * FFD, D, 0}; pg8::StaticOrder S; S.init(M, 2 * FFD, GRID, wgi);
                pg8::EpiSwiGLU E{(bf16*)(P.ws + WS_ACT), FFD, nullptr};
                pg8::gemm_phase<pg8::EpiSwiGLU, pg8::StaticOrder, true, true>(lds, g, S, E); }
            SEAM(6);
            PH(7) {   pg8::Gemm g{(const bf16*)(P.ws + WS_ACT), (const bf16*)(P.ws + WS_WD), M, D, FFD, 0}; pg8::StaticOrder S; S.init(M, D, GRID, wgi);
                pg8::EpiResGate E{P.out, P.out, mod + 5120};
                pg8::gemm_phase<pg8::EpiResGate, pg8::StaticOrder, false, true>(lds, g, S, E); }
            SEAM(7);
            PH(8) norm_phase(P, lds, P.out, P.in[4] + D, 1, 0, 1024, false, tid, lane, wave, wgi);  SEAM(8);
        } else {
            PH(9) router_phase(P, lds, P.out, tid, lane, wave, wgi);                                  SEAM(12);
            moe_tables(P, lds, tid);
            PH(10) gather_phase(P, lds, P.out, tid, lane, wave, gw);                                   SEAM(13);
            const LAS int* tab = (const LAS int*)(lds + MOETAB_OFF);
            const int ptot = tab[8];
            PH(11) {   pg8::Gemm g{(const bf16*)(P.ws + WS_HG), (const bf16*)(P.ws + WS_WMGU), ptot, 2 * FFE, D, (size_t)2 * FFE * D * 2};
                pg8::MoeOrder S; S.nM = ptot >> 8; S.nN = 2 * FFE / 256; S.nwg = S.nM * S.nN; S.G = GRID; S.c = wgi;
                S.t1 = tab[1] >> 8; S.t2 = tab[2] >> 8; S.t3 = tab[3] >> 8; S.t4 = tab[4] >> 8; S.t5 = tab[5] >> 8; S.t6 = tab[6] >> 8; S.t7 = tab[7] >> 8;
                pg8::EpiSwiGLU E{(bf16*)(P.ws + WS_ACTM), FFE, (const float*)(P.ws + WS_WLG)};
                pg8::gemm_phase<pg8::EpiSwiGLU, pg8::MoeOrder, true, true>(lds, g, S, E); }
            SEAM(14);
            PH(12) {   pg8::Gemm g{(const bf16*)(P.ws + WS_ACTM), (const bf16*)(P.ws + WS_WMD), ptot, D, FFE, (size_t)D * FFE * 2};
                pg8::MoeOrder S; S.nM = ptot >> 8; S.nN = D / 256; S.nwg = S.nM * S.nN; S.G = GRID; S.c = wgi;
                S.t1 = tab[1] >> 8; S.t2 = tab[2] >> 8; S.t3 = tab[3] >> 8; S.t4 = tab[4] >> 8; S.t5 = tab[5] >> 8; S.t6 = tab[6] >> 8; S.t7 = tab[7] >> 8;
                pg8::EpiBf16 E{(bf16*)(P.ws + WS_F), D};
                pg8::gemm_phase<pg8::EpiBf16, pg8::MoeOrder, true, true>(lds, g, S, E); }
            SEAM(15);
            PH(13) combine_phase(P, lds, lane, gw);
        }
    }
#undef SEAM
}
static int launch_fast(void* const* d_in, float* out, unsigned char* ws, hipStream_t stream, int stop) {
    static int ready = 0;
    if (ready == 0) {
        if (hipFuncSetAttribute((const void*)fwd, hipFuncAttributeMaxDynamicSharedMemorySize, LDS_BYTES) != hipSuccess) { fprintf(stderr, "kernel_launch: hipFuncSetAttribute failed\n"); ready = -1; return -1; }
        int per_cu = 0; if (hipOccupancyMaxActiveBlocksPerMultiprocessor(&per_cu, (const void*)fwd, NTHR, LDS_BYTES) != hipSuccess || per_cu < 1) fprintf(stderr, "kernel_launch: occupancy query reports %d blocks per CU\n", per_cu);
        (void)hipGetLastError(); ready = 1;
    }
    if (ready < 0) return -1;
    if (hipMemsetAsync(ws + WS_CTL, 0, CTL_ZERO_BYTES, stream) != hipSuccess) return -1;
    Params p{}; for (int i = 0; i < 23; ++i) p.in[i] = (const float*)d_in[i]; p.out = out; p.ws = ws; p.stop = stop; p.pad = 0;
    hipLaunchKernelGGL(fwd, dim3(GRID), dim3(NTHR), LDS_BYTES, stream, p);
    return hipPeekAtLastError() == hipSuccess ? 0 : -1;
}
}
#ifndef DBG_STAGE
#define DBG_STAGE 0
#endif
extern "C" void kernel_launch(void* const* d_in, const int* in_sizes, int n_in, void* d_out, int out_size, void* d_ws, size_t ws_size, hipStream_t stream) {
    if (n_in != 23 || out_size != fk::M * fk::D || ws_size < fk::WS_END) { fprintf(stderr, "kernel_launch: unexpected shapes / workspace (%d inputs, out %d, ws %zu)\n", n_in, out_size, ws_size); return; }
    unsigned char* ws = (unsigned char*)d_ws; float* out = (float*)d_out;
#if DBG_STAGE == 0
    fk::launch_fast(d_in, out, ws, stream, -1);
#else
    constexpr int S = DBG_STAGE; constexpr size_t MiB = 1u << 20;
    float* ckf = (float*)(ws + 390 * MiB); float* acc = (float*)(ws + 389 * MiB);
    int stop = -1; size_t off = 0, n = 0; float scale = 1.f; bool isf32 = false;
    const size_t NM = (size_t)fk::M;
    switch (S) {
        case 1: stop = 1; off = fk::WS_H; n = NM * 1024; break;
        case 2: stop = 2; off = fk::WS_Z; n = NM * 512; break;
        case 3: stop = 2; off = fk::WS_Q; n = NM * 512; scale = 1.f / fk::QSCALE; break;
        case 4: stop = 2; off = fk::WS_K; n = NM * 512; break;
        case 5: stop = 3; off = fk::WS_YC; n = NM * 1024; break;
        case 6: stop = 4; isf32 = true; n = NM * 1024; break;
        case 7: stop = 5; off = fk::WS_H; n = NM * 1024; break;
        case 8: stop = 6; off = fk::WS_ACT; n = NM * 1024; break;
        case 9: stop = 7; isf32 = true; n = NM * 1024; break;
        case 11: stop = 8; off = fk::WS_H; n = NM * 1024; break;
        case 12: stop = 9; off = fk::WS_Z; n = NM * 512; break;
        case 13: stop = 9; off = fk::WS_Q; n = NM * 512; scale = 1.f / fk::QSCALE; break;
        case 14: stop = 9; off = fk::WS_K; n = NM * 512; break;
        case 15: stop = 10; off = fk::WS_YC; n = NM * 1024; break;
        case 16: stop = 11; isf32 = true; n = NM * 1024; break;
        default: stop = -1; isf32 = true; n = NM * 1024; break;
    }
    fk::launch_fast(d_in, out, ws, stream, stop);
    if (isf32) nv::k_copy<<<(unsigned)((n + 255) / 256), 256, 0, stream>>>(out, ckf, n);
    else nv::k_cvt<<<(unsigned)((n + 255) / 256), 256, 0, stream>>>((const unsigned short*)(ws + off), ckf, n, scale);
    hipMemsetAsync(acc, 0, 256, stream);
    nv::forward(d_in, out, ws, stream, S, ckf, acc);
    if (S == 99) nv::k_cmp<<<1024, 256, 0, stream>>>(ckf, out, n, acc);
    nv::k_scale<<<(unsigned)((NM * 1024 + 255) / 256), 256, 0, stream>>>(out, NM * 1024, acc);
#endif
}
```

```cpp
#include <hip/hip_runtime.h>
#include <cstdio>
#include <cstdint>
#define DBG_STAGE 0
#define REPMASK 0
namespace pg8 {
#define PG8_LAS __attribute__((address_space(3)))
typedef unsigned short bf16_t;
typedef short bf16x8 __attribute__((ext_vector_type(8)));
typedef float f32x4 __attribute__((ext_vector_type(4)));
typedef unsigned u32x4 __attribute__((ext_vector_type(4)));
constexpr int BM = 256, BK = 64, HALF = 128, HTB = HALF * BK * 2  , STAGE_BYTES = 8 * HTB, NXCD = 8, WGM = 8;

__host__ __device__ __forceinline__ int lds_byte(int r, int c) { const int st = (r >> 4) * 2 + (c >> 5), rr = r & 15, cc = c & 31, ob = rr * 64 + cc * 2; return st * 1024 + (ob ^ (((ob >> 9) & 1) << 5)); }
__host__ __device__ __forceinline__ void stage_rc(int b, int& R, int& C) { const int st = b / 1024, sb = b % 1024, swz = sb ^ (((sb >> 9) & 1) << 5); R = (st >> 1) * 16 + swz / 64; C = (st & 1) * 32 + (swz % 64) / 2; }
__host__ __device__ __forceinline__ int perm32(int rho) { const int n = rho >> 4, i = rho & 15; return 8 * (i >> 2) + 4 * n + (i & 3); }

struct Unit { int pm, pn, e; };
struct Gemm { const bf16_t* A; const bf16_t* Bt; int M, N, K; size_t bstride; };

struct StaticOrder {
    int nM, nN, nwg, G, c;
    __device__ void init(int M, int N, int G_, int c_) { nM = M / BM; nN = N / BM; nwg = nM * nN; G = G_; c = c_; }
    __device__ bool next(int i, Unit& u) const {
        const long L = (long)i * G + c; if (L >= nwg) return false;
        int wgid = (int)L; { const int q = nwg / NXCD, r = nwg % NXCD, xcd = wgid % NXCD, off = wgid / NXCD; wgid = (xcd < r ? xcd * (q + 1) : r * (q + 1) + (xcd - r) * q) + off; }
        const int nig = WGM * nN, gid = wgid / nig, fm = gid * WGM, gsz = (nM - fm) < WGM ? (nM - fm) : WGM;
        u.pm = fm + ((wgid % nig) % gsz); u.pn = (wgid % nig) / gsz; u.e = 0; return true;
    }
    __device__ __forceinline__ void a_ready(const Unit&) const {}
    __device__ __forceinline__ void done(const Unit&) const {}
};
struct MoeOrder {
    int nM, nN, nwg, G, c; int t1, t2, t3, t4, t5, t6, t7;
    __device__ bool next(int i, Unit& u) const {
        const long L = (long)i * G + c; if (L >= nwg) return false;
        int wgid = (int)L; { const int q = nwg / NXCD, r = nwg % NXCD, xcd = wgid % NXCD, off = wgid / NXCD; wgid = (xcd < r ? xcd * (q + 1) : r * (q + 1) + (xcd - r) * q) + off; }
        const int nig = WGM * nN, gid = wgid / nig, fm = gid * WGM, gsz = (nM - fm) < WGM ? (nM - fm) : WGM;
        u.pm = fm + ((wgid % nig) % gsz); u.pn = (wgid % nig) / gsz;
        const int p = u.pm; u.e = (p >= t1) + (p >= t2) + (p >= t3) + (p >= t4) + (p >= t5) + (p >= t6) + (p >= t7); return true;
    }
    __device__ __forceinline__ void a_ready(const Unit&) const {}
    __device__ __forceinline__ void done(const Unit&) const {}
};

__device__ __forceinline__ unsigned cvt_pk_bf16(float lo, float hi) { unsigned r; asm volatile("v_cvt_pk_bf16_f32 %0, %1, %2" : "=v"(r) : "v"(lo), "v"(hi)); return r; }
__device__ __forceinline__ float sigm(float x) { return __builtin_amdgcn_rcpf(1.f + __builtin_amdgcn_exp2f(-1.4426950408889634f * x)); }
__device__ __forceinline__ u32x4 pack8(f32x4 v0, f32x4 v1) { u32x4 w; w.x = cvt_pk_bf16(v0[0], v0[1]); w.y = cvt_pk_bf16(v0[2], v0[3]); w.z = cvt_pk_bf16(v1[0], v1[1]); w.w = cvt_pk_bf16(v1[2], v1[3]); return w; }

struct EpiBf16 {
    static constexpr bool PERM = true, AFTER_DRAIN = false;
    bf16_t* O; int ldc;
    __device__ __forceinline__ void operator()(const f32x4 (&acc)[2][2][4][2], const Unit& u, int wr, int wc, int fr, int fq) const {
        const int row0 = u.pm * BM + wr * 64 + fr; const int col0 = u.pn * BM + wc * 32 + 8 * fq;
#pragma unroll
        for (int ai = 0; ai < 2; ++ai)
#pragma unroll
            for (int m = 0; m < 4; ++m) { bf16_t* rowp = O + (size_t)(row0 + ai * HALF + m * 16) * ldc + col0;
#pragma unroll
                for (int bj = 0; bj < 2; ++bj) *(u32x4*)(rowp + bj * HALF) = pack8(acc[ai][bj][m][0], acc[ai][bj][m][1]); }
    }
};
struct EpiInProj {
    static constexpr bool PERM = true, AFTER_DRAIN = false;
    bf16_t *Z, *Q, *Kt; const float *qg, *kg; float qscale;
    __device__ __forceinline__ void operator()(const f32x4 (&acc)[2][2][4][2], const Unit& u, int wr, int wc, int fr, int fq) const {
        const int row0 = u.pm * BM + wr * 64 + fr;
        if (u.pn < 4) {
            const int col0 = u.pn * 128 + wc * 32 + 8 * fq;
#pragma unroll
            for (int ai = 0; ai < 2; ++ai)
#pragma unroll
                for (int m = 0; m < 4; ++m) { f32x4 z0, z1;
#pragma unroll
                    for (int i = 0; i < 4; ++i) { z0[i] = acc[ai][0][m][0][i] * sigm(acc[ai][1][m][0][i]); z1[i] = acc[ai][0][m][1][i] * sigm(acc[ai][1][m][1][i]); }
                    *(u32x4*)(Z + (size_t)(row0 + ai * HALF + m * 16) * 512 + col0) = pack8(z0, z1); }
        } else {
            const bool isq = u.pn < 6; bf16_t* O = isq ? Q : Kt; const float* gv = isq ? qg : kg; const float sc = isq ? qscale : 1.f;
            const int head = 4 * (u.pn & 1) + wc;
            f32x4 gw[2][2];
#pragma unroll
            for (int bj = 0; bj < 2; ++bj)
#pragma unroll
                for (int n = 0; n < 2; ++n) gw[bj][n] = *(const f32x4*)(gv + 32 * bj + 8 * fq + 4 * n) * sc;
#pragma unroll
            for (int ai = 0; ai < 2; ++ai)
#pragma unroll
                for (int m = 0; m < 4; ++m) { float ss = 0.f;
#pragma unroll
                    for (int bj = 0; bj < 2; ++bj)
#pragma unroll
                        for (int n = 0; n < 2; ++n) { const f32x4 x = acc[ai][bj][m][n]; ss += (x[0] * x[0] + x[1] * x[1]) + (x[2] * x[2] + x[3] * x[3]); }
                    ss += __shfl_xor(ss, 16); ss += __shfl_xor(ss, 32);
                    const float r = __builtin_amdgcn_rsqf(ss * (1.f / 64.f) + 1e-6f);
                    bf16_t* rowp = O + (size_t)(row0 + ai * HALF + m * 16) * 512 + head * 64 + 8 * fq;
#pragma unroll
                    for (int bj = 0; bj < 2; ++bj) *(u32x4*)(rowp + 32 * bj) = pack8(acc[ai][bj][m][0] * r * gw[bj][0], acc[ai][bj][m][1] * r * gw[bj][1]); }
        }
    }
};
struct EpiResGate {
    static constexpr bool PERM = false, AFTER_DRAIN = false;
    const float* xin; float* out; const float* gate;
    __device__ __forceinline__ void operator()(const f32x4 (&acc)[2][2][4][2], const Unit& u, int wr, int wc, int fr, int fq) const {
        const int row0 = u.pm * BM + wr * 64 + fr, col0 = u.pn * BM + wc * 32 + 4 * fq; const float* gp = gate + (size_t)(u.pm >> 3) * 6144 + col0;
        f32x4 gv[2][2];
#pragma unroll
        for (int bj = 0; bj < 2; ++bj)
#pragma unroll
            for (int n = 0; n < 2; ++n) gv[bj][n] = *(const f32x4*)(gp + bj * HALF + n * 16);
#pragma unroll
        for (int ai = 0; ai < 2; ++ai)
#pragma unroll
            for (int m = 0; m < 4; ++m) { const size_t off = (size_t)(row0 + ai * HALF + m * 16) * 1024 + col0;
#pragma unroll
                for (int bj = 0; bj < 2; ++bj)
#pragma unroll
                    for (int n = 0; n < 2; ++n) { const f32x4 xv = *(const f32x4*)(xin + off + bj * HALF + n * 16); *(f32x4*)(out + off + bj * HALF + n * 16) = xv + gv[bj][n] * acc[ai][bj][m][n]; } }
    }
};
struct EpiSwiGLU {
    static constexpr bool PERM = true, AFTER_DRAIN = false;
    bf16_t* O; int ldc; const float* rowscale;
    __device__ __forceinline__ void operator()(const f32x4 (&acc)[2][2][4][2], const Unit& u, int wr, int wc, int fr, int fq) const {
        const int row0 = u.pm * BM + wr * 64 + fr; const int col0 = u.pn * 128 + wc * 32 + 8 * fq;
#pragma unroll
        for (int ai = 0; ai < 2; ++ai)
#pragma unroll
            for (int m = 0; m < 4; ++m) { const int row = row0 + ai * HALF + m * 16; const float rs = rowscale ? rowscale[row] : 1.f; f32x4 z0, z1;
#pragma unroll
                for (int i = 0; i < 4; ++i) { const float g0 = acc[ai][0][m][0][i], g1 = acc[ai][0][m][1][i];
                    z0[i] = g0 * sigm(g0) * acc[ai][1][m][0][i] * rs; z1[i] = g1 * sigm(g1) * acc[ai][1][m][1][i] * rs; }
                *(u32x4*)(O + (size_t)row * ldc + col0) = pack8(z0, z1); }
    }
};
template <class Epi, class Sched, bool ALIGN_EPI = false, bool SP2 = false>
__device__ __forceinline__ void gemm_phase(PG8_LAS unsigned char* lds, const Gemm g, const Sched& S, const Epi& E) {
    int tid_ = threadIdx.x; asm volatile("" : "+v"(tid_)); const int tid = tid_, wid = __builtin_amdgcn_readfirstlane(tid >> 6), lane = tid & 63, wr = wid >> 2, wc = wid & 3, fr = lane & 15, fq = lane >> 4;
    const int K = g.K, nt = K / BK;
    unsigned voffA[2], voffB[2];
#pragma unroll
    for (int i = 0; i < 2; ++i) { int R, C; stage_rc(tid * 16 + i * 8192, R, C); const int Rb = Epi::PERM ? ((R & ~31) + perm32(R & 31)) : R;
        voffA[i] = (unsigned)(R * K + C) * 2u; voffB[i] = (unsigned)(Rb * K + C) * 2u; }
    const size_t kstep = (size_t)(BK * 2);
    const size_t hstep = (size_t)HALF * K * 2;
    const size_t tstep = 2 * hstep;
    const unsigned ldsw = (unsigned)wid * 1024u;
    const int aoff = lds_byte(wr * 64 + fr, fq * 8), boff = lds_byte(wc * 32 + fr, fq * 8);
#define PG8_SA(b, h) (((b) * 2 + (h)) * HTB)
#define PG8_SB(b, h) ((4 + (b) * 2 + (h)) * HTB)
#define PG8_STAGE(bufoff, gbase, voff) do { _Pragma("unroll") for (int _i = 0; _i < 2; ++_i) \
        __builtin_amdgcn_global_load_lds((const unsigned*)((const char*)(gbase) + (voff)[_i]), (PG8_LAS unsigned*)(lds + (bufoff) + ldsw + _i * 8192), 16, 0, 0); } while (0)
#define PG8_LDA(dst, b, h) do { _Pragma("unroll") for (int m = 0; m < 4; ++m) _Pragma("unroll") for (int k = 0; k < 2; ++k) dst[m][k] = *(const PG8_LAS bf16x8*)(lds + PG8_SA(b, h) + aoff + m * 2048 + k * 1024); } while (0)
#define PG8_LDB(dst, b, h) do { _Pragma("unroll") for (int n = 0; n < 2; ++n) _Pragma("unroll") for (int k = 0; k < 2; ++k) dst[n][k] = *(const PG8_LAS bf16x8*)(lds + PG8_SB(b, h) + boff + n * 2048 + k * 1024); } while (0)
#define PG8_MMA(ai, bj, At, Bt) do { __builtin_amdgcn_s_setprio(1); _Pragma("unroll") for (int m = 0; m < 4; ++m) _Pragma("unroll") for (int n = 0; n < 2; ++n) _Pragma("unroll") for (int k = 0; k < 2; ++k) \
        acc[ai][bj][m][n] = __builtin_amdgcn_mfma_f32_16x16x32_bf16(Bt[n][k], At[m][k], acc[ai][bj][m][n], 0, 0, 0); __builtin_amdgcn_s_setprio(0); } while (0)
#define PG8_WAIT_V(n) asm volatile("s_waitcnt vmcnt(" #n ")" ::: "memory")
#define PG8_WAIT_L(n) asm volatile("s_waitcnt lgkmcnt(" #n ")" ::: "memory")
#define PG8_BAR __builtin_amdgcn_s_barrier()
#define PG8_SCHED __builtin_amdgcn_sched_barrier(0)
    Unit cur, nxt; int ui = 0;
    if (!S.next(0, cur)) return;
    f32x4 acc[2][2][4][2];
#pragma unroll
    for (int a = 0; a < 2; ++a)
#pragma unroll
        for (int b = 0; b < 2; ++b)
#pragma unroll
            for (int m = 0; m < 4; ++m)
#pragma unroll
                for (int n = 0; n < 2; ++n) acc[a][b][m][n] = (f32x4){0.f, 0.f, 0.f, 0.f};
    bf16x8 At[4][2], B0[2][2], B1[2][2];
    const char* cA = (const char*)g.A + (size_t)cur.pm * tstep; const char* cB = (const char*)g.Bt + (size_t)cur.e * g.bstride + (size_t)cur.pn * tstep;
    S.a_ready(cur);
    if constexpr (SP2) {
        PG8_STAGE(PG8_SB(0, 0), cB, voffB); PG8_STAGE(PG8_SB(0, 1), cB + hstep, voffB); PG8_STAGE(PG8_SA(0, 0), cA, voffA); PG8_STAGE(PG8_SA(0, 1), cA + hstep, voffA);
        if (wr == 1) PG8_BAR;
        PG8_WAIT_V(2); PG8_BAR;
        PG8_STAGE(PG8_SB(1, 0), cB + kstep, voffB); PG8_STAGE(PG8_SA(1, 0), cA + kstep, voffA); PG8_STAGE(PG8_SB(1, 1), cB + hstep + kstep, voffB);
        PG8_WAIT_V(6); PG8_BAR;
    } else {
        PG8_STAGE(PG8_SB(0, 0), cB, voffB); PG8_STAGE(PG8_SA(0, 0), cA, voffA); PG8_STAGE(PG8_SB(0, 1), cB + hstep, voffB); PG8_STAGE(PG8_SA(0, 1), cA + hstep, voffA);
        if (wr == 1) PG8_BAR;
        PG8_WAIT_V(4); PG8_BAR;
        PG8_STAGE(PG8_SB(1, 0), cB + kstep, voffB); PG8_STAGE(PG8_SA(1, 0), cA + kstep, voffA); PG8_STAGE(PG8_SB(1, 1), cB + hstep + kstep, voffB);
        PG8_WAIT_V(6); PG8_BAR;
    }
    for (;;) {
        const bool has_next = S.next(ui + 1, nxt);
        const char* nA = has_next ? (const char*)g.A + (size_t)nxt.pm * tstep : cA; const char* nB = has_next ? (const char*)g.Bt + (size_t)nxt.e * g.bstride + (size_t)nxt.pn * tstep : cB;
        for (int t = 0; t < nt; t += 2) {
            const bool last = (t == nt - 2);
            const char* a1 = cA + (size_t)(t + 1) * kstep;
            const char* a2 = last ? nA : cA + (size_t)(t + 2) * kstep; const char* b2 = last ? nB : cB + (size_t)(t + 2) * kstep;
            const char* a3 = a2 + kstep; const char* b3 = b2 + kstep;
            if (last && has_next) S.a_ready(nxt);
            if constexpr (SP2) {
            PG8_LDB(B0, 0, 0); PG8_LDB(B1, 0, 1); PG8_SCHED; PG8_LDA(At, 0, 0); PG8_STAGE(PG8_SA(1, 1), a1 + hstep, voffA);
            PG8_WAIT_V(8); PG8_WAIT_L(0); PG8_BAR; PG8_MMA(0, 0, At, B0); PG8_MMA(0, 1, At, B1); PG8_BAR; PG8_SCHED;
            PG8_LDA(At, 0, 1); PG8_STAGE(PG8_SB(0, 0), b2, voffB); PG8_STAGE(PG8_SB(0, 1), b2 + hstep, voffB); PG8_STAGE(PG8_SA(0, 0), a2, voffA);
            PG8_WAIT_V(8); PG8_WAIT_L(0); PG8_BAR; PG8_MMA(1, 0, At, B0); PG8_MMA(1, 1, At, B1); PG8_BAR; PG8_SCHED;
            PG8_LDB(B0, 1, 0); PG8_LDB(B1, 1, 1); PG8_SCHED; PG8_LDA(At, 1, 0); PG8_STAGE(PG8_SA(0, 1), a2 + hstep, voffA);
            PG8_WAIT_V(8); PG8_WAIT_L(0); PG8_BAR; PG8_MMA(0, 0, At, B0); PG8_MMA(0, 1, At, B1); PG8_BAR; PG8_SCHED;
            PG8_LDA(At, 1, 1); PG8_STAGE(PG8_SB(1, 0), b3, voffB); PG8_STAGE(PG8_SB(1, 1), b3 + hstep, voffB); PG8_STAGE(PG8_SA(1, 0), a3, voffA);
            PG8_WAIT_V(8); PG8_WAIT_L(0); PG8_BAR; PG8_MMA(1, 0, At, B0); PG8_MMA(1, 1, At, B1); PG8_BAR; PG8_SCHED;
            } else {
            PG8_LDB(B0, 0, 0); PG8_SCHED; PG8_LDA(At, 0, 0); PG8_STAGE(PG8_SA(1, 1), a1 + hstep, voffA);
            PG8_WAIT_L(8); PG8_BAR; PG8_WAIT_L(0); PG8_MMA(0, 0, At, B0); PG8_BAR; PG8_SCHED;
            PG8_LDB(B1, 0, 1); PG8_STAGE(PG8_SB(0, 0), b2, voffB);
            PG8_BAR; PG8_WAIT_L(0); PG8_MMA(0, 1, At, B1); PG8_BAR;
            PG8_LDA(At, 0, 1); PG8_STAGE(PG8_SA(0, 0), a2, voffA);
            PG8_BAR; PG8_WAIT_L(0); PG8_MMA(1, 0, At, B0); PG8_BAR; PG8_SCHED;
            PG8_STAGE(PG8_SB(0, 1), b2 + hstep, voffB);
            PG8_WAIT_V(6); PG8_BAR; PG8_MMA(1, 1, At, B1); PG8_BAR;
            PG8_LDB(B0, 1, 0); PG8_SCHED; PG8_LDA(At, 1, 0); PG8_STAGE(PG8_SA(0, 1), a2 + hstep, voffA);
            PG8_WAIT_L(8); PG8_BAR; PG8_WAIT_L(0); PG8_MMA(0, 0, At, B0); PG8_BAR; PG8_SCHED;
            PG8_LDB(B1, 1, 1); PG8_STAGE(PG8_SB(1, 0), b3, voffB);
            PG8_BAR; PG8_WAIT_L(0); PG8_MMA(0, 1, At, B1); PG8_BAR;
            PG8_LDA(At, 1, 1); PG8_STAGE(PG8_SA(1, 0), a3, voffA);
            PG8_BAR; PG8_WAIT_L(0); PG8_MMA(1, 0, At, B0); PG8_BAR; PG8_SCHED;
            PG8_STAGE(PG8_SB(1, 1), b3 + hstep, voffB);
            PG8_WAIT_V(6); PG8_BAR; PG8_MMA(1, 1, At, B1); PG8_BAR;
            }
        }
        if constexpr (ALIGN_EPI) { if (wr == 0) PG8_BAR; }
        if constexpr (!Epi::AFTER_DRAIN) { E(acc, cur, wr, wc, fr, fq); S.done(cur); }
        if (!has_next) break;
#pragma unroll
        for (int a = 0; a < 2; ++a)
#pragma unroll
            for (int b = 0; b < 2; ++b)
#pragma unroll
                for (int m = 0; m < 4; ++m)
#pragma unroll
                    for (int n = 0; n < 2; ++n) acc[a][b][m][n] = (f32x4){0.f, 0.f, 0.f, 0.f};
        cur = nxt; cA = nA; cB = nB; ++ui;
        if constexpr (ALIGN_EPI) { if (wr == 1) PG8_BAR; }
    }
    PG8_WAIT_V(0);
    if constexpr (!ALIGN_EPI) { if (wr == 0) PG8_BAR; }
    PG8_BAR;
    if constexpr (Epi::AFTER_DRAIN) { E.fused(acc, cur, wr, wc, fr, fq, lds, wid, lane); S.done(cur); }
#undef PG8_SA
#undef PG8_SB
#undef PG8_STAGE
#undef PG8_LDA
#undef PG8_LDB
#undef PG8_MMA
#undef PG8_WAIT_V
#undef PG8_WAIT_L
#undef PG8_BAR
#undef PG8_SCHED
}
}

namespace fk {
using pg8::bf16_t; using pg8::bf16x8; using pg8::f32x4; using pg8::u32x4;
constexpr int NWAVES = 8, NTHR = 512, GRID = 256, NGW = GRID * NWAVES;
constexpr int B_ = 8, S_ = 2048, D = 1024, M = B_ * S_, DIN = 2560, DC = 512, FFD = 2816, NE = 8, FFE = 3584, CW = 31, NREL = 257;
constexpr float LOG2E = 1.4426950408889634f, QSCALE = 0.125f * LOG2E, EPS = 1e-6f;
constexpr size_t MiB = 1u << 20;
constexpr size_t WS_CTL = 0, CTL_ZERO_BYTES = 1 * MiB;
constexpr size_t WS_MODP = 1 * MiB;
constexpr size_t WS_MOD = 4 * MiB;
constexpr size_t WS_PAIR = 4 * MiB + 512 * 1024;
constexpr size_t WS_LIST = 5 * MiB;
constexpr size_t WS_WL = 5 * MiB + 512 * 1024;
constexpr size_t WS_WLG = 6 * MiB;
constexpr size_t WS_WMGU = 8 * MiB;
constexpr size_t WS_WMD = 120 * MiB;
constexpr size_t WS_WIN = 176 * MiB;
constexpr size_t WS_WOUT = 186 * MiB;
constexpr size_t WS_WGU = 190 * MiB;
constexpr size_t WS_WD = 201 * MiB;
constexpr size_t WS_H = 207 * MiB;
constexpr size_t WS_Z = 239 * MiB, WS_Q = 255 * MiB, WS_K = 271 * MiB, WS_VT = 287 * MiB;
constexpr size_t WS_YC = 303 * MiB;
constexpr size_t WS_ACT = 239 * MiB;
constexpr size_t WS_HG = 176 * MiB;
constexpr size_t WS_F = 176 * MiB;
constexpr size_t WS_ACTM = 244 * MiB;
constexpr size_t WS_END = 482 * MiB;
constexpr int MAXROWS = 34816;
constexpr int CW_BAR = 4096, CW_CNT = 16384;
constexpr int RING_BYTES = 131072, LDSCTL_OFF = RING_BYTES, MISC_OFF = LDSCTL_OFF + 320, MOETAB_OFF = LDSCTL_OFF + 512;
constexpr int LDS_BYTES = 147456;

#define GAS __attribute__((address_space(1)))
#define LAS __attribute__((address_space(3)))
typedef unsigned short bf16;
typedef unsigned v4u __attribute__((ext_vector_type(4)));
typedef unsigned v2u __attribute__((ext_vector_type(2)));
typedef float f32x16 __attribute__((ext_vector_type(16)));
typedef short s16x4 __attribute__((ext_vector_type(4)));
typedef float f32x2_t __attribute__((ext_vector_type(2))); typedef __bf16 bf16x2_t __attribute__((ext_vector_type(2)));
__device__ __forceinline__ unsigned pk2(float lo, float hi) { f32x2_t v = {lo, hi}; bf16x2_t b = __builtin_convertvector(v, bf16x2_t); return __builtin_bit_cast(unsigned, b); }
__device__ __forceinline__ float bf2f(bf16 v) { return __uint_as_float((unsigned)v << 16); }
__device__ __forceinline__ float wave_sum(float v) {
#pragma unroll
    for (int o = 1; o < 64; o <<= 1) v += __shfl_xor(v, o);
    return v;
}
__device__ __forceinline__ float sigm(float x) { return __builtin_amdgcn_rcpf(1.f + __builtin_amdgcn_exp2f(-LOG2E * x)); }
#define LDS_WAIT() asm volatile("s_waitcnt lgkmcnt(0)" ::: "memory")

#define XB_TMO      128
#define XB_XCNT(j)  (256  + 64 * (j))
#define XB_XSUB(j)  (1280 + 64 * (j))
#define XB_XGEN(j)  (2304 + 64 * (j))
#define XB_TOP      3328
#define XB_TOPGEN   3392
#define XCD_BAR_WORDS 3456
#define XB_SPIN_CAP (1u << 18)

__device__ __forceinline__ unsigned xb_ld(unsigned* p)              { return __hip_atomic_load(p, __ATOMIC_RELAXED, __HIP_MEMORY_SCOPE_AGENT); }
__device__ __forceinline__ unsigned xb_add(unsigned* p, unsigned v) { return __hip_atomic_fetch_add(p, v, __ATOMIC_RELAXED, __HIP_MEMORY_SCOPE_AGENT); }
__device__ __forceinline__ unsigned xb_xcc_id() { return (unsigned)__builtin_amdgcn_s_getreg((3 << 11) | 20) & 0xFu; }
#define XB_SPIN(cond, bar) do { unsigned _sp = 0; while (cond) { __builtin_amdgcn_s_sleep(1); \
    if ((++_sp & 255u) == 0u) { if (xb_ld(&(bar)[XB_TMO])) break; if (_sp > XB_SPIN_CAP) { atomicAdd(&(bar)[XB_TMO], 1u); break; } } } } while (0)

struct XcdBarrier {
    unsigned* bar; unsigned x;
    volatile LAS unsigned* st;
};

__device__ __forceinline__ XcdBarrier xcd_barrier_post(unsigned* bar, volatile LAS unsigned* st) {
    XcdBarrier b; b.bar = bar; b.x = xb_xcc_id(); b.st = st;
    if (threadIdx.x == 0) (void)xb_add(&bar[XB_XCNT(b.x)], 1u);
    return b;
}
__device__ __forceinline__ void xcd_barrier_complete(unsigned* bar, unsigned x, unsigned& nloc, unsigned& nx) {
    const unsigned G = gridDim.x * gridDim.y * gridDim.z;
    unsigned sum, cnt, mine, sp = 0u;
    for (;;) {
        sum = 0u; cnt = 0u; mine = 0u;
#pragma unroll
        for (unsigned j = 0; j < 16; ++j) { const unsigned c = xb_ld(&bar[XB_XCNT(j)]); sum += c; cnt += (c > 0u) ? 1u : 0u; mine = (j == x) ? c : mine; }
        if (sum == G) break;
        __builtin_amdgcn_s_sleep(1);
        if ((++sp & 255u) == 0u) { if (xb_ld(&bar[XB_TMO])) break; if (sp > XB_SPIN_CAP) { atomicAdd(&bar[XB_TMO], 1u); break; } }
    }
    nloc = mine > 0u ? mine : 1u; nx = cnt > 0u ? cnt : 1u;
}

__device__ __forceinline__ void xcd_barrier(const XcdBarrier& b) {
    asm volatile("s_waitcnt vmcnt(0)" ::: "memory");
    __syncthreads();
    if (threadIdx.x == 0) {
        unsigned* bar = b.bar;
        __builtin_amdgcn_s_waitcnt(0);
        unsigned nloc = b.st[0], nx = b.st[1];
        if (nloc == 0u) { xcd_barrier_complete(bar, b.x, nloc, nx); b.st[0] = nloc; b.st[1] = nx; }
        const unsigned old = xb_add(&bar[XB_XSUB(b.x)], 1u);
        const unsigned gen = old / nloc;
        if (old + 1u == (gen + 1u) * nloc) {
            __builtin_amdgcn_fence(__ATOMIC_RELEASE, "agent");
            asm volatile("s_waitcnt vmcnt(0)" ::: "memory");
            const unsigned og = xb_add(&bar[XB_TOP], 1u);
            const unsigned tg = og / nx;
            if (og + 1u == (tg + 1u) * nx) xb_add(&bar[XB_TOPGEN], 1u);
            else XB_SPIN(xb_ld(&bar[XB_TOPGEN]) == tg, bar);
            __builtin_amdgcn_fence(__ATOMIC_ACQUIRE, "agent");
            xb_add(&bar[XB_XGEN(b.x)], 1u);
            asm volatile("s_waitcnt vmcnt(0)" ::: "memory");
        } else {
            XB_SPIN(xb_ld(&bar[XB_XGEN(b.x)]) == gen, bar);
            __builtin_amdgcn_fence(__ATOMIC_ACQUIRE, "agent");
            asm volatile("s_waitcnt vmcnt(0)" ::: "memory");
        }
    }
    __syncthreads();
}


struct Params { const float* in[23]; float* out; unsigned char* ws; int stop; int pad; };

__device__ __forceinline__ void tr_item(const float* W, int K, int N, bf16* WT, int kb, int nb, int drow0, LAS float* scr, int lane) {
    const int k0 = 64 * kb, n0 = 32 * nb;
#pragma unroll 8
    for (int i = 0; i < 32; ++i) { const int kk = 2 * i + (lane >> 5); scr[kk * 33 + (lane & 31)] = W[(size_t)(k0 + kk) * N + n0 + (lane & 31)]; }
    LDS_WAIT(); asm volatile("" ::: "memory");
    const int c = lane & 7;
#pragma unroll
    for (int j = 0; j < 4; ++j) { const int n = (lane >> 3) + 8 * j; const LAS float* s = scr + (8 * c) * 33 + n;
        v4u o; o.x = pk2(s[0 * 33], s[1 * 33]); o.y = pk2(s[2 * 33], s[3 * 33]); o.z = pk2(s[4 * 33], s[5 * 33]); o.w = pk2(s[6 * 33], s[7 * 33]);
        *(GAS v4u*)(WT + (size_t)(drow0 + n) * K + k0 + 8 * c) = o; }
    LDS_WAIT(); asm volatile("" ::: "memory");
}
__device__ __forceinline__ int rowmap_win(int n0) {
    if (n0 < 512) return 256 * (n0 >> 7) + (n0 & 127);
    if (n0 < 1024) { const int m = n0 - 512; return 256 * (m >> 7) + 128 + (m & 127); }
    if (n0 < 2048) { const int isk = n0 >= 1536; const int m = n0 - (isk ? 1536 : 1024); const int head = m >> 6, bj = (m >> 5) & 1; return 256 * (4 + 2 * isk + (head >> 2)) + 128 * bj + 32 * (head & 3); }
    return n0;
}
__device__ __forceinline__ int rowmap_gu(int n0, int up) { return 256 * (n0 >> 7) + 128 * up + (n0 & 127); }

__device__ __forceinline__ void phase0(const Params& P, LAS unsigned char* lds, int tid, int lane, int wave, int gw) {
    LAS float* cact = (LAS float*)(lds + 69632);
    { const float* c = P.in[1]; for (int i = tid; i < B_ * D; i += NTHR) { const float v = c[i]; cact[i] = v * sigm(v); } }
    __syncthreads();
    {
        const float* w_ada = P.in[2]; float* modp = (float*)(P.ws + WS_MODP);
        for (int it = gw; it < 1536; it += NGW) {
            const int ks = it & 7, jb = (it >> 3) % 96, l = it / 768;
            const float* wp = w_ada + ((size_t)l * D + ks * 128) * 6144 + jb * 64 + lane;
            float acc[8];
#pragma unroll
            for (int b = 0; b < 8; ++b) acc[b] = 0.f;
#pragma unroll 8
            for (int k = 0; k < 128; ++k) { const float w = wp[(size_t)k * 6144];
#pragma unroll
                for (int b = 0; b < 8; ++b) acc[b] += cact[b * D + ks * 128 + k] * w; }
#pragma unroll
            for (int b = 0; b < 8; ++b) modp[(((size_t)ks * 2 + l) * 8 + b) * 6144 + jb * 64 + lane] = acc[b];
        }
    }
    LAS float* scr = (LAS float*)(lds + wave * 8448);
    constexpr int I_WIN = 16 * 80, I_WOUT = 16 * 32, I_FG = 16 * 88, I_FD = 44 * 32, I_MG = 16 * 112, I_MD = 56 * 32;
    constexpr int NITEMS = 2 * I_WIN + 2 * I_WOUT + 2 * I_FG + I_FD + 16 * I_MG + 8 * I_MD;
    for (int it = gw; it < NITEMS; it += NGW) {
        int r = it;
        if (r < 16 * I_MG) { const int mat = r / I_MG, q = r % I_MG, e = mat >> 1, up = mat & 1; const int kb = q / 112, nb = q % 112;
            tr_item((up ? P.in[21] : P.in[20]) + (size_t)e * D * FFE, D, FFE, (bf16*)(P.ws + WS_WMGU) + (size_t)e * 7168 * D, kb, nb, rowmap_gu(32 * nb, up), scr, lane); continue; }
        r -= 16 * I_MG;
        if (r < 8 * I_MD) { const int e = r / I_MD, q = r % I_MD; const int kb = q / 32, nb = q % 32;
            tr_item(P.in[22] + (size_t)e * FFE * D, FFE, D, (bf16*)(P.ws + WS_WMD) + (size_t)e * D * FFE, kb, nb, 32 * nb, scr, lane); continue; }
        r -= 8 * I_MD;
        if (r < 2 * I_WIN) { const int l = r / I_WIN, q = r % I_WIN; const int kb = q / 80, nb = q % 80;
            tr_item(P.in[6] + (size_t)l * D * DIN, D, DIN, (bf16*)(P.ws + WS_WIN) + (size_t)l * DIN * D, kb, nb, rowmap_win(32 * nb), scr, lane); continue; }
        r -= 2 * I_WIN;
        if (r < 2 * I_WOUT) { const int l = r / I_WOUT, q = r % I_WOUT; const int kb = q / 32, nb = q % 32;
            tr_item(P.in[7] + (size_t)l * D * D, D, D, (bf16*)(P.ws + WS_WOUT) + (size_t)l * D * D, kb, nb, 32 * nb, scr, lane); continue; }
        r -= 2 * I_WOUT;
        if (r < 2 * I_FG) { const int up = r / I_FG, q = r % I_FG; const int kb = q / 88, nb = q % 88;
            tr_item((up ? P.in[16] : P.in[15]), D, FFD, (bf16*)(P.ws + WS_WGU), kb, nb, rowmap_gu(32 * nb, up), scr, lane); continue; }
        r -= 2 * I_FG;
        { const int kb = r / 32, nb = r % 32; tr_item(P.in[17], FFD, D, (bf16*)(P.ws + WS_WD), kb, nb, 32 * nb, scr, lane); }
    }
}

__device__ __forceinline__ float modp_sum(const float* modp, const float* b_ada, int l, int b, int j) {
    float s = b_ada[l * 6144 + j];
#pragma unroll
    for (int ks = 0; ks < 8; ++ks) s += modp[(((size_t)ks * 2 + l) * 8 + b) * 6144 + j];
    return s;
}
__device__ __forceinline__ void norm_row(const float* xrow, const LAS float* gm, const LAS float* shv, int lane, f32x4 (&h)[4]) {
    const GAS f32x4* xr = (const GAS f32x4*)xrow + lane; float ss = 0.f;
#pragma unroll
    for (int j = 0; j < 4; ++j) { h[j] = xr[64 * j]; ss += (h[j].x * h[j].x + h[j].y * h[j].y) + (h[j].z * h[j].z + h[j].w * h[j].w); }
    const float r = __builtin_amdgcn_rsqf(wave_sum(ss) * (1.f / D) + EPS);
#pragma unroll
    for (int j = 0; j < 4; ++j) { const f32x4 g4 = *(const LAS f32x4*)(gm + 4 * lane + 256 * j), s4 = *(const LAS f32x4*)(shv + 4 * lane + 256 * j); h[j] = h[j] * r * g4 + s4; }
}
__device__ __forceinline__ void store_row_bf16(bf16* orow, int lane, const f32x4 (&h)[4]) {
    GAS v2u* o8 = (GAS v2u*)orow + lane;
#pragma unroll
    for (int j = 0; j < 4; ++j) { v2u w; w.x = pk2(h[j].x, h[j].y); w.y = pk2(h[j].z, h[j].w); o8[64 * j] = w; }
}
__device__ __forceinline__ void norm_phase(const Params& P, LAS unsigned char* lds, const float* xin, const float* gvec, int l, int sh_off, int sc_off, bool from_partials, int tid, int lane, int wave, int wgi) {
    LAS float* gm = (LAS float*)lds; LAS float* shv = (LAS float*)(lds + 4096);
    const float* modp = (const float*)(P.ws + WS_MODP); float* mod = (float*)(P.ws + WS_MOD); const float* b_ada = P.in[3];
    const int b = wgi >> 5;
    if (from_partials) {
        if (tid < 384) { const int idx = wgi * 384 + tid; const int ll = idx / 49152, rem = idx % 49152, bb = rem / 6144, j = rem % 6144; mod[idx] = modp_sum(modp, b_ada, ll, bb, j); }
        for (int c = tid; c < D; c += NTHR) { gm[c] = gvec[c] * (1.f + modp_sum(modp, b_ada, l, b, sc_off + c)); shv[c] = modp_sum(modp, b_ada, l, b, sh_off + c); }
    } else {
        const float* ml = mod + ((size_t)l * 8 + b) * 6144;
        for (int c = tid; c < D; c += NTHR) { gm[c] = gvec[c] * (1.f + ml[sc_off + c]); shv[c] = ml[sh_off + c]; }
    }
    __syncthreads();
    bf16* H = (bf16*)(P.ws + WS_H);
    for (int i = 0; i < 8; ++i) { const int row = wgi * 64 + wave * 8 + i; f32x4 h[4]; norm_row(xin + (size_t)row * D, gm, shv, lane, h); store_row_bf16(H + (size_t)row * D, lane, h); }
    __syncthreads();
}
__device__ __forceinline__ void router_phase(const Params& P, LAS unsigned char* lds, const float* xin, int tid, int lane, int wave, int wgi) {
    LAS float* gm = (LAS float*)lds; LAS float* shv = (LAS float*)(lds + 4096); LAS float* wrT = (LAS float*)(lds + 8192);
    LAS int* pe = (LAS int*)(lds + 40960); LAS float* pw = (LAS float*)(lds + 41472); LAS int* cw = (LAS int*)(lds + 41984); LAS int* baseL = (LAS int*)(lds + 42048);
    const float* mod = (const float*)(P.ws + WS_MOD); const int b = wgi >> 5; const float* ml = mod + ((size_t)1 * 8 + b) * 6144; const float* gvec = P.in[5] + D;
    for (int c = tid; c < D; c += NTHR) { gm[c] = gvec[c] * (1.f + ml[4096 + c]); shv[c] = ml[3072 + c]; }
    { const float* wr = P.in[18]; for (int i = tid; i < D * NE; i += NTHR) { const int c = i >> 3, e = i & 7; wrT[e * D + c] = wr[i]; } }
    __syncthreads();
    const float* br = P.in[19];
    for (int i = 0; i < 8; ++i) { const int rl = wave * 8 + i, row = wgi * 64 + rl; f32x4 h[4]; norm_row(xin + (size_t)row * D, gm, shv, lane, h);
        float lg[8];
#pragma unroll
        for (int e = 0; e < 8; ++e) { float s = 0.f;
#pragma unroll
            for (int j = 0; j < 4; ++j) { const f32x4 w4 = *(const LAS f32x4*)(wrT + e * D + 4 * lane + 256 * j); s += (h[j].x * w4.x + h[j].y * w4.y) + (h[j].z * w4.z + h[j].w * w4.w); }
            lg[e] = wave_sum(s) + br[e]; }
        int e1 = 0; float v1 = lg[0];
#pragma unroll
        for (int e = 1; e < 8; ++e) if (lg[e] > v1) { v1 = lg[e]; e1 = e; }
        int e2 = -1; float v2 = -3.0e38f;
#pragma unroll
        for (int e = 0; e < 8; ++e) if (e != e1 && lg[e] > v2) { v2 = lg[e]; e2 = e; }
        const float p2 = __expf(v2 - v1), inv = 1.f / (1.f + p2);
        if (lane == 0) { pe[2 * rl] = e1; pe[2 * rl + 1] = e2; pw[2 * rl] = inv; pw[2 * rl + 1] = p2 * inv; } }
    __syncthreads();
    int e = 0, rank = 0;
    if (tid < 128) { e = pe[tid];
#pragma unroll
        for (int ee = 0; ee < 8; ++ee) { const unsigned long long mk = __ballot(e == ee); if (e == ee) rank = __popcll(mk & ((1ull << lane) - 1ull)); if (lane == 0) cw[wave * 8 + ee] = __popcll(mk); } }
    __syncthreads();
    if (tid < 8) { const int tot = cw[tid] + cw[8 + tid]; unsigned* cnt = (unsigned*)(P.ws + WS_CTL) + CW_CNT + 64 * tid;
        baseL[tid] = (int)__hip_atomic_fetch_add(cnt, (unsigned)tot, __ATOMIC_RELAXED, __HIP_MEMORY_SCOPE_AGENT); }
    __syncthreads();
    if (tid < 128) { const int slot = baseL[e] + rank + (wave == 1 ? cw[e] : 0); const int token = wgi * 64 + (tid >> 1);
        ((int*)(P.ws + WS_LIST))[e * M + slot] = token; ((float*)(P.ws + WS_WL))[e * M + slot] = pw[tid]; ((int*)(P.ws + WS_PAIR))[token * 2 + (tid & 1)] = e * M + slot; }
    __syncthreads();
}
__device__ __forceinline__ void moe_tables(const Params& P, LAS unsigned char* lds, int tid) {
    LAS int* tab = (LAS int*)(lds + MOETAB_OFF);
    if (tid == 0) { const unsigned* ctl = (const unsigned*)(P.ws + WS_CTL); int rb = 0;
        for (int e = 0; e < 8; ++e) { int c = (int)__hip_atomic_load(ctl + CW_CNT + 64 * e, __ATOMIC_RELAXED, __HIP_MEMORY_SCOPE_AGENT); c = c < 0 ? 0 : (c > M ? M : c); tab[e] = rb; tab[9 + e] = c; rb += (c + 255) & ~255; }
        tab[8] = rb; }
    __syncthreads();
}
__device__ __forceinline__ void gather_phase(const Params& P, LAS unsigned char* lds, const float* xin, int tid, int lane, int wave, int gw) {
    LAS float* gmA = (LAS float*)lds; LAS float* shA = (LAS float*)(lds + 32768); const LAS int* tab = (const LAS int*)(lds + MOETAB_OFF);
    const float* mod1 = (const float*)(P.ws + WS_MOD) + (size_t)8 * 6144; const float* gvec = P.in[5] + D;
    for (int i = tid; i < 8 * D; i += NTHR) { const int b = i >> 10, c = i & 1023; gmA[i] = gvec[c] * (1.f + mod1[b * 6144 + 4096 + c]); shA[i] = mod1[b * 6144 + 3072 + c]; }
    __syncthreads();
    const int ptot = tab[8]; const int* list = (const int*)(P.ws + WS_LIST); const float* wl = (const float*)(P.ws + WS_WL); float* wlg = (float*)(P.ws + WS_WLG); bf16* HG = (bf16*)(P.ws + WS_HG);
    for (int p = gw; p < ptot; p += NGW) {
        int e = 0;
#pragma unroll
        for (int k = 1; k < 8; ++k) e += (p >= tab[k]);
        const int slot = p - tab[e], cn = tab[9 + e]; const bool valid = slot < cn; const int token = list[e * M + (valid ? slot : cn - 1)]; const int b = token >> 11;
        f32x4 h[4]; norm_row(xin + (size_t)token * D, gmA + b * D, shA + b * D, lane, h); store_row_bf16(HG + (size_t)p * D, lane, h);
        if (lane == 0) wlg[p] = valid ? wl[e * M + slot] : 0.f;
    }
    __syncthreads();
}
__device__ __forceinline__ void combine_phase(const Params& P, LAS unsigned char* lds, int lane, int gw) {
    const LAS int* tab = (const LAS int*)(lds + MOETAB_OFF); const int* pair = (const int*)(P.ws + WS_PAIR); const bf16* F = (const bf16*)(P.ws + WS_F);
    const float* mod1 = (const float*)(P.ws + WS_MOD) + (size_t)8 * 6144;
    for (int t = gw; t < M; t += NGW) {
        const int pa = pair[2 * t], pb = pair[2 * t + 1]; const int ra = tab[pa >> 14] + (pa & 16383), rb = tab[pb >> 14] + (pb & 16383); const int b = t >> 11;
        const GAS v2u* fa = (const GAS v2u*)(F + (size_t)ra * D) + lane; const GAS v2u* fb = (const GAS v2u*)(F + (size_t)rb * D) + lane;
        GAS f32x4* xo = (GAS f32x4*)(P.out + (size_t)t * D) + lane; const GAS f32x4* g2 = (const GAS f32x4*)(mod1 + b * 6144 + 5120) + lane;
#pragma unroll
        for (int j = 0; j < 4; ++j) { const v2u a = fa[64 * j], c = fb[64 * j]; f32x4 f;
            f.x = __uint_as_float(a.x << 16) + __uint_as_float(c.x << 16); f.y = __uint_as_float(a.x & 0xffff0000u) + __uint_as_float(c.x & 0xffff0000u);
            f.z = __uint_as_float(a.y << 16) + __uint_as_float(c.y << 16); f.w = __uint_as_float(a.y & 0xffff0000u) + __uint_as_float(c.y & 0xffff0000u);
            xo[64 * j] = xo[64 * j] + g2[64 * j] * f; }
    }
}

__device__ __forceinline__ void conv_unit(const bf16* Z, bf16* YC, const float* cw, const float* cb, const float* lg, const float* lb, LAS float* tile, int unit, int tid, int wave, int lane) {
    const int tok0 = unit * 32, tp0 = tok0 & (S_ - 1), c = tid;
    float w[CW];
#pragma unroll
    for (int j = 0; j < CW; ++j) w[j] = cw[j * DC + c];
    const float bias = cb[c];
#pragma unroll
    for (int half = 0; half < 2; ++half) {
        float in[46];
#pragma unroll
        for (int i = 0; i < 46; ++i) { const int dt = 16 * half - 30 + i; in[i] = (tp0 + dt >= 0) ? bf2f(Z[(size_t)(tok0 + dt) * DC + c]) : 0.f; }
#pragma unroll
        for (int q = 0; q < 16; ++q) { float a = bias;
#pragma unroll
            for (int j = 0; j < CW; ++j) a += w[j] * in[q + j];
            tile[(16 * half + q) * DC + c] = a; }
    }
    __syncthreads();
    const f32x4 g0 = *(const f32x4*)(lg + lane * 8), g1 = *(const f32x4*)(lg + lane * 8 + 4), b0 = *(const f32x4*)(lb + lane * 8), b1 = *(const f32x4*)(lb + lane * 8 + 4);
#pragma unroll
    for (int tt = 0; tt < 4; ++tt) { const int t = wave * 4 + tt;
        f32x4 v0 = *(const LAS f32x4*)(tile + t * DC + lane * 8), v1 = *(const LAS f32x4*)(tile + t * DC + lane * 8 + 4);
        const float mean = wave_sum((v0.x + v0.y) + (v0.z + v0.w) + (v1.x + v1.y) + (v1.z + v1.w)) * (1.f / DC);
        v0 = v0 - mean; v1 = v1 - mean;
        const float var = wave_sum((v0.x * v0.x + v0.y * v0.y) + (v0.z * v0.z + v0.w * v0.w) + (v1.x * v1.x + v1.y * v1.y) + (v1.z * v1.z + v1.w * v1.w)) * (1.f / DC);
        const float rstd = __builtin_amdgcn_rsqf(var + EPS);
        f32x4 y0 = v0 * rstd * g0 + b0, y1 = v1 * rstd * g1 + b1;
#pragma unroll
        for (int i = 0; i < 4; ++i) { y0[i] = y0[i] * sigm(y0[i]); y1[i] = y1[i] * sigm(y1[i]); }
        v4u o; o.x = pk2(y0.x, y0.y); o.y = pk2(y0.z, y0.w); o.z = pk2(y1.x, y1.y); o.w = pk2(y1.z, y1.w);
        *(GAS v4u*)(YC + (size_t)(tok0 + t) * D + lane * 8) = o; }
    __syncthreads();
}
__device__ __forceinline__ int crow(int r, int hi) { return (r & 3) + 8 * (r >> 2) + 4 * hi; }
#define MFMA32(a, b, c) __builtin_amdgcn_mfma_f32_32x32x16_bf16((a), (b), (c), 0, 0, 0)
__device__ __forceinline__ void attn_unit(const bf16* Q, const bf16* K, const bf16* VT, bf16* YC, const LAS float* biasL, LAS unsigned char* kv, int b, int h, int g, int tid, int wave, int lane) {
    const int r32 = lane & 31, hi = lane >> 5;
    const int n0 = 4 * g, n = n0 + (wave >> 1), qh = wave & 1;
    const size_t rowq = (size_t)b * S_ + n * 64 + qh * 32 + r32;
    bf16x8 qf[4];
#pragma unroll
    for (int d0 = 0; d0 < 4; ++d0) qf[d0] = *(const GAS bf16x8*)(Q + rowq * DC + h * 64 + d0 * 16 + hi * 8);
    float m = -1.0e30f, l = 0.f; f32x16 o0, o1;
#pragma unroll
    for (int r = 0; r < 16; ++r) { o0[r] = 0.f; o1[r] = 0.f; }
    const int kc_lo = n0 - 8 < 0 ? 0 : n0 - 8, ns = n0 + 4 - kc_lo;
    const int qbase = n * 64 + qh * 32, qpos = qbase + r32;
    const int lrow = tid >> 3, lc = tid & 7; const int lofs = lrow * 128 + ((lc ^ ((lrow >> 1) & 7)) << 4);
    const bf16* kg = K + ((size_t)b * S_ + lrow) * DC + h * 64 + lc * 8;
    const bf16* vg = VT + (size_t)(h * 64 + lrow) * M + (size_t)b * S_ + lc * 8;
    v4u kreg = *(const GAS v4u*)(kg + (size_t)kc_lo * 64 * DC), vreg = *(const GAS v4u*)(vg + kc_lo * 64);
    *(LAS v4u*)(kv + lofs) = kreg; *(LAS v4u*)(kv + 8192 + lofs) = vreg;
    __syncthreads();
    const int fsw = (r32 >> 1) & 7;
    for (int s = 0; s < ns; ++s) {
        const int kc = kc_lo + s; const LAS unsigned char* buf = kv + (s & 1) * 16384;
        if (s + 1 < ns) { kreg = *(const GAS v4u*)(kg + (size_t)(kc + 1) * 64 * DC); vreg = *(const GAS v4u*)(vg + (kc + 1) * 64); }
        if (kc >= n - 8 && kc <= n) {
#pragma unroll
            for (int kb = 0; kb < 2; ++kb) {
                const int key0 = kc * 64 + kb * 32;
                bf16x8 kf[4];
#pragma unroll
                for (int d0 = 0; d0 < 4; ++d0) kf[d0] = *(const LAS bf16x8*)(buf + (kb * 32 + r32) * 128 + (((2 * d0 + hi) ^ fsw) << 4));
                s16x4 va[2][2][2];
#pragma unroll
                for (int db = 0; db < 2; ++db)
#pragma unroll
                    for (int s2 = 0; s2 < 2; ++s2)
#pragma unroll
                        for (int hf = 0; hf < 2; ++hf) va[db][s2][hf] = *(const LAS s16x4*)(buf + 8192 + (db * 32 + r32) * 128 + (((kb * 4 + 2 * s2 + hf) ^ fsw) << 4) + 8 * hi);
                f32x16 sc;
#pragma unroll
                for (int r = 0; r < 16; ++r) sc[r] = 0.f;
#pragma unroll
                for (int d0 = 0; d0 < 4; ++d0) sc = MFMA32(kf[d0], qf[d0], sc);
                if (key0 + 31 - qbase <= -128) { const float b0 = biasL[0];
#pragma unroll
                    for (int r = 0; r < 16; ++r) sc[r] += b0;
                } else {
#pragma unroll
                    for (int r = 0; r < 16; ++r) { int rel = key0 + crow(r, hi) - qpos; rel = rel < -128 ? -128 : (rel > 128 ? 128 : rel); sc[r] += biasL[rel + 128]; }
                }
                float mx = sc[0];
#pragma unroll
                for (int r = 1; r < 16; ++r) mx = fmaxf(mx, sc[r]);
                mx = fmaxf(mx, __shfl_xor(mx, 32));
                const float mn = fmaxf(m, mx);
                if (__any(mn > m)) { const float alpha = __builtin_amdgcn_exp2f(m - mn); l *= alpha;
#pragma unroll
                    for (int r = 0; r < 16; ++r) { o0[r] *= alpha; o1[r] *= alpha; } }
                m = mn;
                float ps = 0.f;
#pragma unroll
                for (int r = 0; r < 16; ++r) { sc[r] = __builtin_amdgcn_exp2f(sc[r] - mn); ps += sc[r]; }
                l += ps;
                v4u p0, p1;
                p0.x = pk2(sc[0], sc[1]); p0.y = pk2(sc[2], sc[3]); p0.z = pk2(sc[4], sc[5]); p0.w = pk2(sc[6], sc[7]);
                p1.x = pk2(sc[8], sc[9]); p1.y = pk2(sc[10], sc[11]); p1.z = pk2(sc[12], sc[13]); p1.w = pk2(sc[14], sc[15]);
                const bf16x8 pb0 = __builtin_bit_cast(bf16x8, p0), pb1 = __builtin_bit_cast(bf16x8, p1);
#define VA8(db, s2) (bf16x8){va[db][s2][0][0], va[db][s2][0][1], va[db][s2][0][2], va[db][s2][0][3], va[db][s2][1][0], va[db][s2][1][1], va[db][s2][1][2], va[db][s2][1][3]}
                o0 = MFMA32(VA8(0, 0), pb0, o0); o0 = MFMA32(VA8(0, 1), pb1, o0);
                o1 = MFMA32(VA8(1, 0), pb0, o1); o1 = MFMA32(VA8(1, 1), pb1, o1);
#undef VA8
            }
        }
        if (s + 1 < ns) { LAS unsigned char* nb = kv + ((s + 1) & 1) * 16384; *(LAS v4u*)(nb + lofs) = kreg; *(LAS v4u*)(nb + 8192 + lofs) = vreg; }
        __syncthreads();
    }
    l += __shfl_xor(l, 32); const float il = 1.f / l;
    bf16* yp = YC + rowq * D + DC + h * 64 + 4 * hi;
#pragma unroll
    for (int gq = 0; gq < 4; ++gq) { v2u w0, w1; w0.x = pk2(o0[4 * gq] * il, o0[4 * gq + 1] * il); w0.y = pk2(o0[4 * gq + 2] * il, o0[4 * gq + 3] * il);
        w1.x = pk2(o1[4 * gq] * il, o1[4 * gq + 1] * il); w1.y = pk2(o1[4 * gq + 2] * il, o1[4 * gq + 3] * il);
        *(GAS v2u*)(yp + 8 * gq) = w0; *(GAS v2u*)(yp + 32 + 8 * gq) = w1; }
}
__device__ __forceinline__ void mixer_phase(const Params& P, LAS unsigned char* lds, int l, int tid, int lane, int wave, int wgi) {
    LAS float* tile = (LAS float*)lds; LAS float* biasL = (LAS float*)(lds + 65536); LAS unsigned char* kv = lds + 73728;
    { const float* rb = P.in[14] + l * 8 * NREL; for (int i = tid; i < 8 * NREL; i += NTHR) biasL[i] = rb[i] * LOG2E; }
    __syncthreads();
    const bf16* Z = (const bf16*)(P.ws + WS_Z); const bf16* Q = (const bf16*)(P.ws + WS_Q); const bf16* K = (const bf16*)(P.ws + WS_K); const bf16* VT = (const bf16*)(P.ws + WS_VT); bf16* YC = (bf16*)(P.ws + WS_YC);
    for (int cu = 0; cu < 2; ++cu) conv_unit(Z, YC, P.in[8] + l * CW * DC, P.in[9] + l * DC, P.in[10] + l * DC, P.in[11] + l * DC, tile, wgi * 2 + cu, tid, wave, lane);
    { const int b = wgi >> 5, h = (wgi >> 2) & 7, gp = wgi & 3;
      for (int au = 0; au < 2; ++au) attn_unit(Q, K, VT, YC, biasL + h * NREL, kv, b, h, au ? 7 - gp : gp, tid, wave, lane); }
    __syncthreads();
}

#ifndef REPMASK
#define REPMASK 0
#endif
#define PHASE(k, ...) do { { __VA_ARGS__ } if constexpr ((REPMASK >> (k)) & 1) { xcd_barrier(bar); RETID(); { __VA_ARGS__ } } } while (0)
__global__ void __launch_bounds__(NTHR, 2) fwd(Params P) {
    extern __shared__ __attribute__((aligned(16))) unsigned char lds_raw[];
    LAS unsigned char* lds = (LAS unsigned char*)lds_raw;
    int tid = threadIdx.x, lane = tid & 63, wave = __builtin_amdgcn_readfirstlane(tid >> 6); const int wgi = blockIdx.x; int gw = wgi * NWAVES + wave;
#define RETID() do { tid = threadIdx.x; asm volatile("" : "+v"(tid)); lane = tid & 63; wave = __builtin_amdgcn_readfirstlane(tid >> 6); gw = wgi * NWAVES + wave; } while (0)
    for (int u = tid; u < (LDS_BYTES - LDSCTL_OFF) / 4; u += NTHR) ((LAS unsigned*)(lds + LDSCTL_OFF))[u] = 0u;
    __syncthreads();
    unsigned* ctl = (unsigned*)(P.ws + WS_CTL);
    XcdBarrier bar = xcd_barrier_post(ctl + CW_BAR, (volatile LAS unsigned*)(lds + MISC_OFF) + 8);
    const int stop = P.stop;
#define SEAM(k) do { if (stop == (k)) return; xcd_barrier(bar); RETID(); } while (0)
    bf16* H = (bf16*)(P.ws + WS_H); float* mod = (float*)(P.ws + WS_MOD);

    PHASE(0, phase0(P, lds, tid, lane, wave, gw););                                                      SEAM(0);
    PHASE(1, norm_phase(P, lds, P.in[0], P.in[4], 0, 0, 1024, true, tid, lane, wave, wgi););             SEAM(1);
#define LAYER_COMMON(l, pb, xin) \
    PHASE(2,   \
        const bf16* Wl = (const bf16*)(P.ws + WS_WIN) + (size_t)(l) * DIN * D; \
        { pg8::Gemm g{H, Wl, M, 2048, D, 0}; pg8::StaticOrder S; S.init(M, 2048, GRID, wgi); \
          pg8::EpiInProj E{(bf16*)(P.ws + WS_Z), (bf16*)(P.ws + WS_Q), (bf16*)(P.ws + WS_K), P.in[12] + (l) * 64, P.in[13] + (l) * 64, QSCALE}; \
          pg8::gemm_phase<pg8::EpiInProj, pg8::StaticOrder, true, true>(lds, g, S, E); } \
        { pg8::Gemm g{Wl + (size_t)2048 * D, H, 512, M, D, 0}; pg8::StaticOrder S; S.init(512, M, GRID, wgi); \
          pg8::EpiBf16 E{(bf16*)(P.ws + WS_VT), M}; \
          pg8::gemm_phase<pg8::EpiBf16, pg8::StaticOrder, true, true>(lds, g, S, E); } ); \
    SEAM(pb); \
    PHASE(3, mixer_phase(P, lds, (l), tid, lane, wave, wgi);); \
    SEAM((pb) + 1); \
    PHASE(4 + 10 * (l),   \
        pg8::Gemm g{(const bf16*)(P.ws + WS_YC), (const bf16*)(P.ws + WS_WOUT) + (size_t)(l) * D * D, M, D, D, 0}; pg8::StaticOrder S; S.init(M, D, GRID, wgi); \
        pg8::EpiResGate E{(xin), P.out, mod + (size_t)(l) * 8 * 6144 + 2048}; \
        pg8::gemm_phase<pg8::EpiResGate, pg8::StaticOrder, false, true>(lds, g, S, E); ); \
    SEAM((pb) + 2);

    LAYER_COMMON(0, 2, P.in[0])
    PHASE(5, norm_phase(P, lds, P.out, P.in[5], 0, 3072, 4096, false, tid, lane, wave, wgi););          SEAM(5);
    PHASE(6, pg8::Gemm g{H, (const bf16*)(P.ws + WS_WGU), M, 2 * FFD, D, 0}; pg8::StaticOrder S; S.init(M, 2 * FFD, GRID, wgi);
             pg8::EpiSwiGLU E{(bf16*)(P.ws + WS_ACT), FFD, nullptr};
             pg8::gemm_phase<pg8::EpiSwiGLU, pg8::StaticOrder, true, true>(lds, g, S, E););
    SEAM(6);
    PHASE(30, pg8::Gemm g{(const bf16*)(P.ws + WS_ACT), (const bf16*)(P.ws + WS_WD), M, D, FFD, 0}; pg8::StaticOrder S; S.init(M, D, GRID, wgi);
              pg8::EpiResGate E{P.out, P.out, mod + 5120};
              pg8::gemm_phase<pg8::EpiResGate, pg8::StaticOrder, false, true>(lds, g, S, E););
    SEAM(7);
    PHASE(8, norm_phase(P, lds, P.out, P.in[4] + D, 1, 0, 1024, false, tid, lane, wave, wgi););         SEAM(8);
    LAYER_COMMON(1, 9, P.out)
    PHASE(31, router_phase(P, lds, P.out, tid, lane, wave, wgi););                                       SEAM(12);
    moe_tables(P, lds, tid);
    PHASE(10, gather_phase(P, lds, P.out, tid, lane, wave, gw););                                        SEAM(13);
    {
        const LAS int* tab = (const LAS int*)(lds + MOETAB_OFF);
        const int ptot = tab[8];
        PHASE(11, pg8::Gemm g{(const bf16*)(P.ws + WS_HG), (const bf16*)(P.ws + WS_WMGU), ptot, 2 * FFE, D, (size_t)2 * FFE * D * 2};
                  pg8::MoeOrder S; S.nM = ptot >> 8; S.nN = 2 * FFE / 256; S.nwg = S.nM * S.nN; S.G = GRID; S.c = wgi;
                  S.t1 = tab[1] >> 8; S.t2 = tab[2] >> 8; S.t3 = tab[3] >> 8; S.t4 = tab[4] >> 8; S.t5 = tab[5] >> 8; S.t6 = tab[6] >> 8; S.t7 = tab[7] >> 8;
                  pg8::EpiSwiGLU E{(bf16*)(P.ws + WS_ACTM), FFE, (const float*)(P.ws + WS_WLG)};
                  pg8::gemm_phase<pg8::EpiSwiGLU, pg8::MoeOrder, true, true>(lds, g, S, E););
        SEAM(14);
        PHASE(12, pg8::Gemm g{(const bf16*)(P.ws + WS_ACTM), (const bf16*)(P.ws + WS_WMD), ptot, D, FFE, (size_t)D * FFE * 2};
                  pg8::MoeOrder S; S.nM = ptot >> 8; S.nN = D / 256; S.nwg = S.nM * S.nN; S.G = GRID; S.c = wgi;
                  S.t1 = tab[1] >> 8; S.t2 = tab[2] >> 8; S.t3 = tab[3] >> 8; S.t4 = tab[4] >> 8; S.t5 = tab[5] >> 8; S.t6 = tab[6] >> 8; S.t7 = tab[7] >> 8;
                  pg8::EpiBf16 E{(bf16*)(P.ws + WS_F), D};
                  pg8::gemm_phase<pg8::EpiBf16, pg8::MoeOrder, true, true>(lds, g, S, E););
        SEAM(15);
        PHASE(29, combine_phase(P, lds, lane, gw););
    }
#undef SEAM
}
static int launch_fast(void* const* d_in, float* out, unsigned char* ws, hipStream_t stream, int stop) {
    static int ready = 0;
    if (ready == 0) {
        if (hipFuncSetAttribute((const void*)fwd, hipFuncAttributeMaxDynamicSharedMemorySize, LDS_BYTES) != hipSuccess) { fprintf(stderr, "kernel_launch: hipFuncSetAttribute failed\n"); ready = -1; return -1; }
        int per_cu = 0; if (hipOccupancyMaxActiveBlocksPerMultiprocessor(&per_cu, (const void*)fwd, NTHR, LDS_BYTES) != hipSuccess || per_cu < 1) fprintf(stderr, "kernel_launch: occupancy query reports %d blocks per CU\n", per_cu);
        (void)hipGetLastError(); ready = 1;
    }
    if (ready < 0) return -1;
    if (hipMemsetAsync(ws + WS_CTL, 0, CTL_ZERO_BYTES, stream) != hipSuccess) return -1;
    Params p{}; for (int i = 0; i < 23; ++i) p.in[i] = (const float*)d_in[i]; p.out = out; p.ws = ws; p.stop = stop; p.pad = 0;
    hipLaunchKernelGGL(fwd, dim3(GRID), dim3(NTHR), LDS_BYTES, stream, p);
    return hipPeekAtLastError() == hipSuccess ? 0 : -1;
}
}
#ifndef DBG_STAGE
#define DBG_STAGE 0
#endif
extern "C" void kernel_launch(void* const* d_in, const int* in_sizes, int n_in, void* d_out, int out_size, void* d_ws, size_t ws_size, hipStream_t stream) {
    if (n_in != 23 || out_size != fk::M * fk::D || ws_size < fk::WS_END) { fprintf(stderr, "kernel_launch: unexpected shapes / workspace (%d inputs, out %d, ws %zu)\n", n_in, out_size, ws_size); return; }
    unsigned char* ws = (unsigned char*)d_ws; float* out = (float*)d_out;
#if DBG_STAGE == 0
    fk::launch_fast(d_in, out, ws, stream, -1);
#else
    constexpr int S = DBG_STAGE; constexpr size_t MiB = 1u << 20;
    float* ckf = (float*)(ws + 390 * MiB); float* acc = (float*)(ws + 389 * MiB);
    int stop = -1; size_t off = 0, n = 0; float scale = 1.f; bool isf32 = false;
    const size_t NM = (size_t)fk::M;
    switch (S) {
        case 1: stop = 1; off = fk::WS_H; n = NM * 1024; break;
        case 2: stop = 2; off = fk::WS_Z; n = NM * 512; break;
        case 3: stop = 2; off = fk::WS_Q; n = NM * 512; scale = 1.f / fk::QSCALE; break;
        case 4: stop = 2; off = fk::WS_K; n = NM * 512; break;
        case 5: stop = 3; off = fk::WS_YC; n = NM * 1024; break;
        case 6: stop = 4; isf32 = true; n = NM * 1024; break;
        case 7: stop = 5; off = fk::WS_H; n = NM * 1024; break;
        case 8: stop = 6; off = fk::WS_ACT; n = NM * 1024; break;
        case 9: stop = 7; isf32 = true; n = NM * 1024; break;
        case 11: stop = 8; off = fk::WS_H; n = NM * 1024; break;
        case 12: stop = 9; off = fk::WS_Z; n = NM * 512; break;
        case 13: stop = 9; off = fk::WS_Q; n = NM * 512; scale = 1.f / fk::QSCALE; break;
        case 14: stop = 9; off = fk::WS_K; n = NM * 512; break;
        case 15: stop = 10; off = fk::WS_YC; n = NM * 1024; break;
        case 16: stop = 11; isf32 = true; n = NM * 1024; break;
        default: stop = -1; isf32 = true; n = NM * 1024; break;
    }
    fk::launch_fast(d_in, out, ws, stream, stop);
    if (isf32) nv::k_copy<<<(unsigned)((n + 255) / 256), 256, 0, stream>>>(out, ckf, n);
    else nv::k_cvt<<<(unsigned)((n + 255) / 256), 256, 0, stream>>>((const unsigned short*)(ws + off), ckf, n, scale);
    hipMemsetAsync(acc, 0, 256, stream);
    nv::forward(d_in, out, ws, stream, S, ckf, acc);
    if (S == 99) nv::k_cmp<<<1024, 256, 0, stream>>>(ckf, out, n, acc);
    nv::k_scale<<<(unsigned)((NM * 1024 + 255) / 256), 256, 0, stream>>>(out, NM * 1024, acc);
#endif
}
```

```cpp
#include <hip/hip_runtime.h>
#include <cstdio>
#include <cstdint>
#define DBG_STAGE 0
#define REPMASK 0
namespace pg8 {
#define PG8_LAS __attribute__((address_space(3)))
typedef unsigned short bf16_t;
typedef short bf16x8 __attribute__((ext_vector_type(8)));
typedef float f32x4 __attribute__((ext_vector_type(4)));
typedef unsigned u32x4 __attribute__((ext_vector_type(4)));
constexpr int BM = 256, BK = 64, HALF = 128, HTB = HALF * BK * 2  , STAGE_BYTES = 8 * HTB, NXCD = 8, WGM = 8;

__host__ __device__ __forceinline__ int lds_byte(int r, int c) { const int st = (r >> 4) * 2 + (c >> 5), rr = r & 15, cc = c & 31, ob = rr * 64 + cc * 2; return st * 1024 + (ob ^ (((ob >> 9) & 1) << 5)); }
__host__ __device__ __forceinline__ void stage_rc(int b, int& R, int& C) { const int st = b / 1024, sb = b % 1024, swz = sb ^ (((sb >> 9) & 1) << 5); R = (st >> 1) * 16 + swz / 64; C = (st & 1) * 32 + (swz % 64) / 2; }
__host__ __device__ __forceinline__ int perm32(int rho) { const int n = rho >> 4, i = rho & 15; return 8 * (i >> 2) + 4 * n + (i & 3); }

struct Unit { int pm, pn, e; };
struct Gemm { const bf16_t* A; const bf16_t* Bt; int M, N, K; unsigned bstride; };

struct StaticOrder {
    int nM, nN, nwg, G, c;
    __device__ void init(int M, int N, int G_, int c_) { nM = M / BM; nN = N / BM; nwg = nM * nN; G = G_; c = c_; }
    __device__ bool next(int i, Unit& u) const {
        const long L = (long)i * G + c; if (L >= nwg) return false;
        int wgid = (int)L; { const int q = nwg / NXCD, r = nwg % NXCD, xcd = wgid % NXCD, off = wgid / NXCD; wgid = (xcd < r ? xcd * (q + 1) : r * (q + 1) + (xcd - r) * q) + off; }
        const int nig = WGM * nN, gid = wgid / nig, fm = gid * WGM, gsz = (nM - fm) < WGM ? (nM - fm) : WGM;
        u.pm = fm + ((wgid % nig) % gsz); u.pn = (wgid % nig) / gsz; u.e = 0; return true;
    }
    __device__ __forceinline__ void a_ready(const Unit&) const {}
    __device__ __forceinline__ void done(const Unit&) const {}
};
struct MoeOrder {
    int nM, nN, nwg, G, c; int t1, t2, t3, t4, t5, t6, t7;
    __device__ bool next(int i, Unit& u) const {
        const long L = (long)i * G + c; if (L >= nwg) return false;
        int wgid = (int)L; { const int q = nwg / NXCD, r = nwg % NXCD, xcd = wgid % NXCD, off = wgid / NXCD; wgid = (xcd < r ? xcd * (q + 1) : r * (q + 1) + (xcd - r) * q) + off; }
        const int nig = WGM * nN, gid = wgid / nig, fm = gid * WGM, gsz = (nM - fm) < WGM ? (nM - fm) : WGM;
        u.pm = fm + ((wgid % nig) % gsz); u.pn = (wgid % nig) / gsz;
        const int p = u.pm; u.e = (p >= t1) + (p >= t2) + (p >= t3) + (p >= t4) + (p >= t5) + (p >= t6) + (p >= t7); return true;
    }
    __device__ __forceinline__ void a_ready(const Unit&) const {}
    __device__ __forceinline__ void done(const Unit&) const {}
};

__device__ __forceinline__ unsigned cvt_pk_bf16(float lo, float hi) { unsigned r; asm volatile("v_cvt_pk_bf16_f32 %0, %1, %2" : "=v"(r) : "v"(lo), "v"(hi)); return r; }
typedef int v8i __attribute__((ext_vector_type(8))); typedef int v4i __attribute__((ext_vector_type(4)));
__device__ __forceinline__ v8i cat8(bf16x8 lo, bf16x8 hi) { const v4i a = __builtin_bit_cast(v4i, lo), b = __builtin_bit_cast(v4i, hi); return __builtin_shufflevector(a, b, 0, 1, 2, 3, 4, 5, 6, 7); }
__device__ __forceinline__ unsigned pk4_fp8(float a, float b, float c, float d) { int w = __builtin_amdgcn_cvt_pk_fp8_f32(a, b, 0, false); w = __builtin_amdgcn_cvt_pk_fp8_f32(c, d, w, true); return (unsigned)w; }
__device__ __forceinline__ float sigm(float x) { return __builtin_amdgcn_rcpf(1.f + __builtin_amdgcn_exp2f(-1.4426950408889634f * x)); }
__device__ __forceinline__ u32x4 pack8(f32x4 v0, f32x4 v1) { u32x4 w; w.x = cvt_pk_bf16(v0[0], v0[1]); w.y = cvt_pk_bf16(v0[2], v0[3]); w.z = cvt_pk_bf16(v1[0], v1[1]); w.w = cvt_pk_bf16(v1[2], v1[3]); return w; }

struct EpiBf16 {
    static constexpr bool PERM = true, AFTER_DRAIN = false;
    bf16_t* O; int ldc; float scale;
    __device__ __forceinline__ void operator()(const f32x4 (&acc)[2][2][4][2], const Unit& u, int wr, int wc, int fr, int fq) const {
        const int row0 = u.pm * BM + wr * 64 + fr; const int col0 = u.pn * BM + wc * 32 + 8 * fq;
#pragma unroll
        for (int ai = 0; ai < 2; ++ai)
#pragma unroll
            for (int m = 0; m < 4; ++m) { bf16_t* rowp = O + (size_t)(row0 + ai * HALF + m * 16) * ldc + col0;
#pragma unroll
                for (int bj = 0; bj < 2; ++bj) *(u32x4*)(rowp + bj * HALF) = pack8(acc[ai][bj][m][0] * scale, acc[ai][bj][m][1] * scale); }
    }
};
struct EpiInProj {
    static constexpr bool PERM = true, AFTER_DRAIN = false;
    bf16_t *Z, *Q, *Kt; const float *qg, *kg; float qscale;
    __device__ __forceinline__ void operator()(const f32x4 (&acc)[2][2][4][2], const Unit& u, int wr, int wc, int fr, int fq) const {
        const int row0 = u.pm * BM + wr * 64 + fr;
        if (u.pn < 4) {
            const int col0 = u.pn * 128 + wc * 32 + 8 * fq;
#pragma unroll
            for (int ai = 0; ai < 2; ++ai)
#pragma unroll
                for (int m = 0; m < 4; ++m) { f32x4 z0, z1;
#pragma unroll
                    for (int i = 0; i < 4; ++i) { z0[i] = acc[ai][0][m][0][i] * sigm(acc[ai][1][m][0][i]); z1[i] = acc[ai][0][m][1][i] * sigm(acc[ai][1][m][1][i]); }
                    *(u32x4*)(Z + (size_t)(row0 + ai * HALF + m * 16) * 512 + col0) = pack8(z0, z1); }
        } else {
            const bool isq = u.pn < 6; bf16_t* O = isq ? Q : Kt; const float* gv = isq ? qg : kg; const float sc = isq ? qscale : 1.f;
            const int head = 4 * (u.pn & 1) + wc;
            f32x4 gw[2][2];
#pragma unroll
            for (int bj = 0; bj < 2; ++bj)
#pragma unroll
                for (int n = 0; n < 2; ++n) gw[bj][n] = *(const f32x4*)(gv + 32 * bj + 8 * fq + 4 * n) * sc;
#pragma unroll
            for (int ai = 0; ai < 2; ++ai)
#pragma unroll
                for (int m = 0; m < 4; ++m) { float ss = 0.f;
#pragma unroll
                    for (int bj = 0; bj < 2; ++bj)
#pragma unroll
                        for (int n = 0; n < 2; ++n) { const f32x4 x = acc[ai][bj][m][n]; ss += (x[0] * x[0] + x[1] * x[1]) + (x[2] * x[2] + x[3] * x[3]); }
                    ss += __shfl_xor(ss, 16); ss += __shfl_xor(ss, 32);
                    const float r = __builtin_amdgcn_rsqf(ss * (1.f / 64.f) + 1e-6f);
                    bf16_t* rowp = O + (size_t)(row0 + ai * HALF + m * 16) * 512 + head * 64 + 8 * fq;
#pragma unroll
                    for (int bj = 0; bj < 2; ++bj) *(u32x4*)(rowp + 32 * bj) = pack8(acc[ai][bj][m][0] * r * gw[bj][0], acc[ai][bj][m][1] * r * gw[bj][1]); }
        }
    }
};
struct EpiResGate {
    static constexpr bool PERM = false, AFTER_DRAIN = false;
    const float* xin; float* out; const float* gate;
    __device__ __forceinline__ void operator()(const f32x4 (&acc)[2][2][4][2], const Unit& u, int wr, int wc, int fr, int fq) const {
        const int row0 = u.pm * BM + wr * 64 + fr, col0 = u.pn * BM + wc * 32 + 4 * fq; const float* gp = gate + (size_t)(u.pm >> 3) * 6144 + col0;
        f32x4 gv[2][2];
#pragma unroll
        for (int bj = 0; bj < 2; ++bj)
#pragma unroll
            for (int n = 0; n < 2; ++n) gv[bj][n] = *(const f32x4*)(gp + bj * HALF + n * 16);
#pragma unroll
        for (int ai = 0; ai < 2; ++ai)
#pragma unroll
            for (int m = 0; m < 4; ++m) { const size_t off = (size_t)(row0 + ai * HALF + m * 16) * 1024 + col0;
#pragma unroll
                for (int bj = 0; bj < 2; ++bj)
#pragma unroll
                    for (int n = 0; n < 2; ++n) { const f32x4 xv = *(const f32x4*)(xin + off + bj * HALF + n * 16); *(f32x4*)(out + off + bj * HALF + n * 16) = xv + gv[bj][n] * acc[ai][bj][m][n]; } }
    }
};
template <bool F8OUT> struct EpiSwiGLU {
    static constexpr bool PERM = true, AFTER_DRAIN = false;
    bf16_t* O; int ldc; const float* rowscale; float oscale, iscale;
    __device__ __forceinline__ void operator()(const f32x4 (&acc)[2][2][4][2], const Unit& u, int wr, int wc, int fr, int fq) const {
        const int row0 = u.pm * BM + wr * 64 + fr; const int col0 = u.pn * 128 + wc * 32 + 8 * fq;
#pragma unroll
        for (int ai = 0; ai < 2; ++ai)
#pragma unroll
            for (int m = 0; m < 4; ++m) { const int row = row0 + ai * HALF + m * 16; const float rs = (rowscale ? rowscale[row] : 1.f) * oscale;   f32x4 z0, z1;
#pragma unroll
                for (int i = 0; i < 4; ++i) { const float g0 = acc[ai][0][m][0][i] * iscale, g1 = acc[ai][0][m][1][i] * iscale;
                    z0[i] = g0 * sigm(g0) * acc[ai][1][m][0][i] * rs; z1[i] = g1 * sigm(g1) * acc[ai][1][m][1][i] * rs; }
                if constexpr (F8OUT) { typedef unsigned u32x2 __attribute__((ext_vector_type(2))); u32x2 w; w.x = pk4_fp8(z0[0], z0[1], z0[2], z0[3]); w.y = pk4_fp8(z1[0], z1[1], z1[2], z1[3]);
                    *(u32x2*)((unsigned char*)O + (size_t)row * ldc + col0) = w; }
                else *(u32x4*)(O + (size_t)row * ldc + col0) = pack8(z0, z1); }
    }
};
struct EpiNone {
    static constexpr bool PERM = true, AFTER_DRAIN = false;
    __device__ __forceinline__ void operator()(const f32x4 (&acc)[2][2][4][2], const Unit& u, int wr, int wc, int fr, int fq) const {
#pragma unroll
        for (int ai = 0; ai < 2; ++ai)
#pragma unroll
            for (int bj = 0; bj < 2; ++bj)
#pragma unroll
                for (int m = 0; m < 4; ++m)
#pragma unroll
                    for (int n = 0; n < 2; ++n) asm volatile("" :: "v"(acc[ai][bj][m][n]));
    }
};
__device__ __forceinline__ const char* uptr(const char* p) { unsigned long long v = (unsigned long long)p; const unsigned lo = __builtin_amdgcn_readfirstlane((unsigned)v), hi = __builtin_amdgcn_readfirstlane((unsigned)(v >> 32)); unsigned long long r = ((unsigned long long)hi << 32) | lo; asm volatile("" : "+s"(r)); return (const char*)r; }
template <class Epi, class Sched, bool ALIGN_EPI = false, bool SP2 = false, bool FP8 = false>
__device__ __forceinline__ void gemm_phase(PG8_LAS unsigned char* lds, const Gemm g, const Sched& S, const Epi& E) {
    int tid_ = threadIdx.x; asm volatile("" : "+v"(tid_)); const int tid = tid_, wid = __builtin_amdgcn_readfirstlane(tid >> 6), lane = tid & 63, wr = wid >> 2, wc = wid & 3, fr = lane & 15, fq = lane >> 4;
    const int KB = FP8 ? g.K : g.K * 2, nt = KB / (BK * 2);
    unsigned voffA, voffB;
    { int R, C; stage_rc(tid * 16, R, C); const int Rb = Epi::PERM ? ((R & ~31) + perm32(R & 31)) : R;
        voffA = (unsigned)(R * KB + C * 2); voffB = (unsigned)(Rb * KB + C * 2); }
    const unsigned pstep = 64u * KB;
    constexpr unsigned kstep = BK * 2;
    const unsigned hstep = (unsigned)HALF * KB;
    const unsigned tstep = 2 * hstep;
    const unsigned ldsw = (unsigned)wid * 1024u;
    const int aoff = lds_byte(wr * 64 + fr, fq * 8), boff = lds_byte(wc * 32 + fr, fq * 8);
#define PG8_SA(b, h) (((b) * 2 + (h)) * HTB)
#define PG8_SB(b, h) ((4 + (b) * 2 + (h)) * HTB)
#define PG8_STAGE(bufoff, gbase, voff) do { unsigned vo_ = (voff); asm volatile("" : "+v"(vo_));   \
        _Pragma("unroll") for (int _i = 0; _i < 2; ++_i) \
        __builtin_amdgcn_global_load_lds((const unsigned*)((const char*)(gbase) + _i * pstep + vo_), (PG8_LAS unsigned*)(lds + (bufoff) + ldsw + _i * 8192), 16, 0, 0); } while (0)
#define PG8_LDA(dst, b, h) do { _Pragma("unroll") for (int m = 0; m < 4; ++m) { if constexpr (FP8) { const v4i lo_ = *(const PG8_LAS v4i*)(lds + PG8_SA(b, h) + aoff + m * 2048), hi_ = *(const PG8_LAS v4i*)(lds + PG8_SA(b, h) + aoff + m * 2048 + 1024); dst##8[m] = __builtin_shufflevector(lo_, hi_, 0, 1, 2, 3, 4, 5, 6, 7); } \
        else { _Pragma("unroll") for (int k = 0; k < 2; ++k) dst[m][k] = *(const PG8_LAS bf16x8*)(lds + PG8_SA(b, h) + aoff + m * 2048 + k * 1024); } } } while (0)
#define PG8_LDB(dst, b, h) do { _Pragma("unroll") for (int n = 0; n < 2; ++n) { if constexpr (FP8) { const v4i lo_ = *(const PG8_LAS v4i*)(lds + PG8_SB(b, h) + boff + n * 2048), hi_ = *(const PG8_LAS v4i*)(lds + PG8_SB(b, h) + boff + n * 2048 + 1024); dst##8[n] = __builtin_shufflevector(lo_, hi_, 0, 1, 2, 3, 4, 5, 6, 7); } \
        else { _Pragma("unroll") for (int k = 0; k < 2; ++k) dst[n][k] = *(const PG8_LAS bf16x8*)(lds + PG8_SB(b, h) + boff + n * 2048 + k * 1024); } } } while (0)
#define PG8_MMA(ai, bj, At, Bt) do { __builtin_amdgcn_s_setprio(1); _Pragma("unroll") for (int m = 0; m < 4; ++m) _Pragma("unroll") for (int n = 0; n < 2; ++n) { \
        if constexpr (FP8) asm volatile("v_mfma_f32_16x16x128_f8f6f4 %0, %1, %2, %0" : "+v"(acc[ai][bj][m][n]) : "v"(Bt##8[n]), "v"(At##8[m]));   \
        else { _Pragma("unroll") for (int k = 0; k < 2; ++k) acc[ai][bj][m][n] = __builtin_amdgcn_mfma_f32_16x16x32_bf16(Bt[n][k], At[m][k], acc[ai][bj][m][n], 0, 0, 0); } } \
        __builtin_amdgcn_s_setprio(0); } while (0)
#define PG8_WAIT_V(n) asm volatile("s_waitcnt vmcnt(" #n ")" ::: "memory")
#define PG8_WAIT_L(n) asm volatile("s_waitcnt lgkmcnt(" #n ")" ::: "memory")
#define PG8_BAR __builtin_amdgcn_s_barrier()
#define PG8_SCHED __builtin_amdgcn_sched_barrier(0)
    Unit cur, nxt; int ui = 0;
    if (!S.next(0, cur)) return;
    f32x4 acc[2][2][4][2];
#pragma unroll
    for (int a = 0; a < 2; ++a)
#pragma unroll
        for (int b = 0; b < 2; ++b)
#pragma unroll
            for (int m = 0; m < 4; ++m)
#pragma unroll
                for (int n = 0; n < 2; ++n) acc[a][b][m][n] = (f32x4){0.f, 0.f, 0.f, 0.f};
    bf16x8 At[4][2], B0[2][2], B1[2][2]; v8i At8[4], B08[2], B18[2];
    const char* cA = (const char*)g.A + (unsigned)cur.pm * tstep; const char* cB = (const char*)g.Bt + (unsigned)cur.e * g.bstride + (unsigned)cur.pn * tstep;
    S.a_ready(cur);
    if constexpr (SP2) {
        PG8_STAGE(PG8_SB(0, 0), cB, voffB); PG8_STAGE(PG8_SB(0, 1), cB + hstep, voffB); PG8_STAGE(PG8_SA(0, 0), cA, voffA); PG8_STAGE(PG8_SA(0, 1), cA + hstep, voffA);
        if (wr == 1) PG8_BAR;
        PG8_WAIT_V(2); PG8_BAR;
        PG8_STAGE(PG8_SB(1, 0), cB + kstep, voffB); PG8_STAGE(PG8_SA(1, 0), cA + kstep, voffA); PG8_STAGE(PG8_SB(1, 1), cB + hstep + kstep, voffB);
        PG8_WAIT_V(6); PG8_BAR;
    } else {
        PG8_STAGE(PG8_SB(0, 0), cB, voffB); PG8_STAGE(PG8_SA(0, 0), cA, voffA); PG8_STAGE(PG8_SB(0, 1), cB + hstep, voffB); PG8_STAGE(PG8_SA(0, 1), cA + hstep, voffA);
        if (wr == 1) PG8_BAR;
        PG8_WAIT_V(4); PG8_BAR;
        PG8_STAGE(PG8_SB(1, 0), cB + kstep, voffB); PG8_STAGE(PG8_SA(1, 0), cA + kstep, voffA); PG8_STAGE(PG8_SB(1, 1), cB + hstep + kstep, voffB);
        PG8_WAIT_V(6); PG8_BAR;
    }
    for (;;) {
        const bool has_next = S.next(ui + 1, nxt);
        const char* nA = has_next ? (const char*)g.A + (unsigned)nxt.pm * tstep : cA; const char* nB = has_next ? (const char*)g.Bt + (unsigned)nxt.e * g.bstride + (unsigned)nxt.pn * tstep : cB;
#pragma unroll 1
        for (int t = 0; t < nt; t += 2) {
            const bool last = (t == nt - 2);
            const char* a1 = cA + (unsigned)(t + 1) * kstep;
            const char* a2 = last ? nA : cA + (unsigned)(t + 2) * kstep; const char* b2 = last ? nB : cB + (unsigned)(t + 2) * kstep;
            const char* a3 = a2 + kstep; const char* b3 = b2 + kstep;
            a1 = uptr(a1); a2 = uptr(a2); b2 = uptr(b2); a3 = uptr(a3); b3 = uptr(b3);
            if (last && has_next) S.a_ready(nxt);
            if constexpr (SP2) {
            PG8_LDB(B0, 0, 0); PG8_LDB(B1, 0, 1); PG8_SCHED; PG8_LDA(At, 0, 0); PG8_STAGE(PG8_SA(1, 1), a1 + hstep, voffA);
            PG8_WAIT_V(8); PG8_WAIT_L(0); PG8_BAR; PG8_MMA(0, 0, At, B0); PG8_MMA(0, 1, At, B1); PG8_BAR; PG8_SCHED;
            PG8_LDA(At, 0, 1); PG8_STAGE(PG8_SB(0, 0), b2, voffB); PG8_STAGE(PG8_SB(0, 1), b2 + hstep, voffB); PG8_STAGE(PG8_SA(0, 0), a2, voffA);
            PG8_WAIT_V(8); PG8_WAIT_L(0); PG8_BAR; PG8_MMA(1, 0, At, B0); PG8_MMA(1, 1, At, B1); PG8_BAR; PG8_SCHED;
            PG8_LDB(B0, 1, 0); PG8_LDB(B1, 1, 1); PG8_SCHED; PG8_LDA(At, 1, 0); PG8_STAGE(PG8_SA(0, 1), a2 + hstep, voffA);
            PG8_WAIT_V(8); PG8_WAIT_L(0); PG8_BAR; PG8_MMA(0, 0, At, B0); PG8_MMA(0, 1, At, B1); PG8_BAR; PG8_SCHED;
            PG8_LDA(At, 1, 1); PG8_STAGE(PG8_SB(1, 0), b3, voffB); PG8_STAGE(PG8_SB(1, 1), b3 + hstep, voffB); PG8_STAGE(PG8_SA(1, 0), a3, voffA);
            PG8_WAIT_V(8); PG8_WAIT_L(0); PG8_BAR; PG8_MMA(1, 0, At, B0); PG8_MMA(1, 1, At, B1); PG8_BAR; PG8_SCHED;
            } else {
            PG8_LDB(B0, 0, 0); PG8_SCHED; PG8_LDA(At, 0, 0); PG8_STAGE(PG8_SA(1, 1), a1 + hstep, voffA);
            PG8_WAIT_L(8); PG8_BAR; PG8_WAIT_L(0); PG8_MMA(0, 0, At, B0); PG8_BAR; PG8_SCHED;
            PG8_LDB(B1, 0, 1); PG8_STAGE(PG8_SB(0, 0), b2, voffB);
            PG8_BAR; PG8_WAIT_L(0); PG8_MMA(0, 1, At, B1); PG8_BAR;
            PG8_LDA(At, 0, 1); PG8_STAGE(PG8_SA(0, 0), a2, voffA);
            PG8_BAR; PG8_WAIT_L(0); PG8_MMA(1, 0, At, B0); PG8_BAR; PG8_SCHED;
            PG8_STAGE(PG8_SB(0, 1), b2 + hstep, voffB);
            PG8_WAIT_V(6); PG8_BAR; PG8_MMA(1, 1, At, B1); PG8_BAR;
            PG8_LDB(B0, 1, 0); PG8_SCHED; PG8_LDA(At, 1, 0); PG8_STAGE(PG8_SA(0, 1), a2 + hstep, voffA);
            PG8_WAIT_L(8); PG8_BAR; PG8_WAIT_L(0); PG8_MMA(0, 0, At, B0); PG8_BAR; PG8_SCHED;
            PG8_LDB(B1, 1, 1); PG8_STAGE(PG8_SB(1, 0), b3, voffB);
            PG8_BAR; PG8_WAIT_L(0); PG8_MMA(0, 1, At, B1); PG8_BAR;
            PG8_LDA(At, 1, 1); PG8_STAGE(PG8_SA(1, 0), a3, voffA);
            PG8_BAR; PG8_WAIT_L(0); PG8_MMA(1, 0, At, B0); PG8_BAR; PG8_SCHED;
            PG8_STAGE(PG8_SB(1, 1), b3 + hstep, voffB);
            PG8_WAIT_V(6); PG8_BAR; PG8_MMA(1, 1, At, B1); PG8_BAR;
            }
        }
        if constexpr (FP8) asm volatile("s_nop 15\n\ts_nop 15" ::: "memory");
        if constexpr (ALIGN_EPI) { if (wr == 0) PG8_BAR; }
        if constexpr (!Epi::AFTER_DRAIN) { int l_ = threadIdx.x; asm volatile("" : "+v"(l_)); const int fr_ = l_ & 15, fq_ = (l_ >> 4) & 3; E(acc, cur, wr, wc, fr_, fq_); S.done(cur); }
        if (!has_next) break;
#pragma unroll
        for (int a = 0; a < 2; ++a)
#pragma unroll
            for (int b = 0; b < 2; ++b)
#pragma unroll
                for (int m = 0; m < 4; ++m)
#pragma unroll
                    for (int n = 0; n < 2; ++n) acc[a][b][m][n] = (f32x4){0.f, 0.f, 0.f, 0.f};
        cur = nxt; cA = nA; cB = nB; ++ui;
        if constexpr (ALIGN_EPI) { if (wr == 1) PG8_BAR; }
    }
    PG8_WAIT_V(0);
    if constexpr (!ALIGN_EPI) { if (wr == 0) PG8_BAR; }
    PG8_BAR;
    if constexpr (Epi::AFTER_DRAIN) { E.fused(acc, cur, wr, wc, fr, fq, lds, wid, lane); S.done(cur); }
#undef PG8_SA
#undef PG8_SB
#undef PG8_STAGE
#undef PG8_LDA
#undef PG8_LDB
#undef PG8_MMA
#undef PG8_WAIT_V
#undef PG8_WAIT_L
#undef PG8_BAR
#undef PG8_SCHED
}
}

namespace fk {
using pg8::bf16_t; using pg8::bf16x8; using pg8::f32x4; using pg8::u32x4;
constexpr int NWAVES = 8, NTHR = 512, GRID = 256, NGW = GRID * NWAVES;
constexpr int B_ = 8, S_ = 2048, D = 1024, M = B_ * S_, DIN = 2560, DC = 512, FFD = 2816, NE = 8, FFE = 3584, CW = 31, NREL = 257;
constexpr float LOG2E = 1.4426950408889634f, QSCALE = 0.125f * LOG2E, EPS = 1e-6f;
constexpr size_t MiB = 1u << 20;
constexpr size_t WS_CTL = 0, CTL_ZERO_BYTES = 1 * MiB;
constexpr size_t WS_MODP = 1 * MiB;
constexpr size_t WS_MOD = 4 * MiB;
constexpr size_t WS_PAIR = 4 * MiB + 512 * 1024;
constexpr size_t WS_LIST = 5 * MiB;
constexpr size_t WS_WL = 5 * MiB + 512 * 1024;
constexpr size_t WS_WLG = 6 * MiB;
constexpr size_t WS_WMGU = 8 * MiB;
constexpr size_t WS_WMD = 120 * MiB;
constexpr size_t WS_WIN = 176 * MiB;
constexpr size_t WS_WOUT = 186 * MiB;
constexpr size_t WS_WGU = 190 * MiB;
constexpr size_t WS_WD = 201 * MiB;
constexpr size_t WS_H = 207 * MiB;
constexpr size_t WS_Z = 239 * MiB, WS_Q = 255 * MiB, WS_K = 271 * MiB, WS_VT = 287 * MiB;
constexpr size_t WS_YC = 303 * MiB;
constexpr size_t WS_ACT = 239 * MiB;
constexpr size_t WS_HG = 64 * MiB;
constexpr size_t WS_F = 176 * MiB;
constexpr size_t WS_ACTM = 244 * MiB;
constexpr size_t WS_END = 482 * MiB;
constexpr int MAXROWS = 34816;
constexpr int CW_BAR = 4096, CW_CNT = 16384;
constexpr int RING_BYTES = 131072, LDSCTL_OFF = RING_BYTES, MISC_OFF = LDSCTL_OFF + 320, MOETAB_OFF = LDSCTL_OFF + 512;
constexpr int LDS_BYTES = 147456;

#define GAS __attribute__((address_space(1)))
#define LAS __attribute__((address_space(3)))
typedef unsigned short bf16;
typedef unsigned v4u __attribute__((ext_vector_type(4)));
typedef unsigned v2u __attribute__((ext_vector_type(2)));
typedef float f32x16 __attribute__((ext_vector_type(16)));
typedef short s16x4 __attribute__((ext_vector_type(4)));
typedef float f32x2_t __attribute__((ext_vector_type(2))); typedef __bf16 bf16x2_t __attribute__((ext_vector_type(2)));
__device__ __forceinline__ unsigned pk2(float lo, float hi) { f32x2_t v = {lo, hi}; bf16x2_t b = __builtin_convertvector(v, bf16x2_t); return __builtin_bit_cast(unsigned, b); }
__device__ __forceinline__ float bf2f(bf16 v) { return __uint_as_float((unsigned)v << 16); }
__device__ __forceinline__ float wave_sum(float v) {
#pragma unroll
    for (int o = 1; o < 64; o <<= 1) v += __shfl_xor(v, o);
    return v;
}
__device__ __forceinline__ float sigm(float x) { return __builtin_amdgcn_rcpf(1.f + __builtin_amdgcn_exp2f(-LOG2E * x)); }
using pg8::pk4_fp8;
constexpr float W8_SCALE = 64.f, H8_SCALE = 8.f, A8_SCALE = 4.f;
constexpr int E8_W = (127 - 6) * 0x01010101, E8_H = (127 - 3) * 0x01010101, E8_A = (127 - 2) * 0x01010101;
#define LDS_WAIT() asm volatile("s_waitcnt lgkmcnt(0)" ::: "memory")
#define RFL(x) __builtin_amdgcn_readfirstlane(x)

#define XB_TMO      128
#define XB_XCNT(j)  (256  + 64 * (j))
#define XB_XSUB(j)  (1280 + 64 * (j))
#define XB_XGEN(j)  (2304 + 64 * (j))
#define XB_TOP      3328
#define XB_TOPGEN   3392
#define XCD_BAR_WORDS 3456
#define XB_SPIN_CAP (1u << 18)

__device__ __forceinline__ unsigned xb_ld(unsigned* p)              { return __hip_atomic_load(p, __ATOMIC_RELAXED, __HIP_MEMORY_SCOPE_AGENT); }
__device__ __forceinline__ unsigned xb_add(unsigned* p, unsigned v) { return __hip_atomic_fetch_add(p, v, __ATOMIC_RELAXED, __HIP_MEMORY_SCOPE_AGENT); }
__device__ __forceinline__ unsigned xb_xcc_id() { return (unsigned)__builtin_amdgcn_s_getreg((3 << 11) | 20) & 0xFu; }
#define XB_SPIN(cond, bar) do { unsigned _sp = 0; while (cond) { __builtin_amdgcn_s_sleep(1); \
    if ((++_sp & 255u) == 0u) { if (xb_ld(&(bar)[XB_TMO])) break; if (_sp > XB_SPIN_CAP) { atomicAdd(&(bar)[XB_TMO], 1u); break; } } } } while (0)

struct XcdBarrier {
    unsigned* bar; unsigned x;
    volatile LAS unsigned* st;
};

__device__ __forceinline__ XcdBarrier xcd_barrier_post(unsigned* bar, volatile LAS unsigned* st) {
    XcdBarrier b; b.bar = bar; b.x = xb_xcc_id(); b.st = st;
    if (threadIdx.x == 0) (void)xb_add(&bar[XB_XCNT(b.x)], 1u);
    return b;
}
__device__ __forceinline__ void xcd_barrier_complete(unsigned* bar, unsigned x, unsigned& nloc, unsigned& nx) {
    const unsigned G = gridDim.x * gridDim.y * gridDim.z;
    unsigned sum, cnt, mine, sp = 0u;
    for (;;) {
        sum = 0u; cnt = 0u; mine = 0u;
#pragma unroll
        for (unsigned j = 0; j < 16; ++j) { const unsigned c = xb_ld(&bar[XB_XCNT(j)]); sum += c; cnt += (c > 0u) ? 1u : 0u; mine = (j == x) ? c : mine; }
        if (sum == G) break;
        __builtin_amdgcn_s_sleep(1);
        if ((++sp & 255u) == 0u) { if (xb_ld(&bar[XB_TMO])) break; if (sp > XB_SPIN_CAP) { atomicAdd(&bar[XB_TMO], 1u); break; } }
    }
    nloc = mine > 0u ? mine : 1u; nx = cnt > 0u ? cnt : 1u;
}

__device__ __forceinline__ void xcd_barrier(const XcdBarrier& b) {
    asm volatile("s_waitcnt vmcnt(0)" ::: "memory");
    __syncthreads();
    if (threadIdx.x == 0) {
        unsigned* bar = b.bar;
        __builtin_amdgcn_s_waitcnt(0);
        unsigned nloc = b.st[0], nx = b.st[1];
        if (nloc == 0u) { xcd_barrier_complete(bar, b.x, nloc, nx); b.st[0] = nloc; b.st[1] = nx; }
        const unsigned old = xb_add(&bar[XB_XSUB(b.x)], 1u);
        const unsigned gen = old / nloc;
        if (old + 1u == (gen + 1u) * nloc) {
            __builtin_amdgcn_fence(__ATOMIC_RELEASE, "agent");
            asm volatile("s_waitcnt vmcnt(0)" ::: "memory");
            const unsigned og = xb_add(&bar[XB_TOP], 1u);
            const unsigned tg = og / nx;
            if (og + 1u == (tg + 1u) * nx) xb_add(&bar[XB_TOPGEN], 1u);
            else XB_SPIN(xb_ld(&bar[XB_TOPGEN]) == tg, bar);
            __builtin_amdgcn_fence(__ATOMIC_ACQUIRE, "agent");
            xb_add(&bar[XB_XGEN(b.x)], 1u);
            asm volatile("s_waitcnt vmcnt(0)" ::: "memory");
        } else {
            XB_SPIN(xb_ld(&bar[XB_XGEN(b.x)]) == gen, bar);
            __builtin_amdgcn_fence(__ATOMIC_ACQUIRE, "agent");
            asm volatile("s_waitcnt vmcnt(0)" ::: "memory");
        }
    }
    __syncthreads();
}


#ifndef REPMASK
#define REPMASK 0
#endif
struct Params { const float* in[23]; float* out; unsigned char* ws; int stop; int pad; };

__device__ __forceinline__ void tr_item(const float* W, int K, int N, bf16* WT, int kb, int nb, int drow0, LAS float* scr, int lane) {
    const int k0 = 64 * kb, n0 = 32 * nb;
#pragma unroll 8
    for (int i = 0; i < 32; ++i) { const int kk = 2 * i + (lane >> 5); scr[kk * 33 + (lane & 31)] = W[(size_t)(k0 + kk) * N + n0 + (lane & 31)]; }
    LDS_WAIT(); asm volatile("" ::: "memory");
    const int c = lane & 7;
#pragma unroll
    for (int j = 0; j < 4; ++j) { const int n = (lane >> 3) + 8 * j; const LAS float* s = scr + (8 * c) * 33 + n;
        v4u o; o.x = pk2(s[0 * 33], s[1 * 33]); o.y = pk2(s[2 * 33], s[3 * 33]); o.z = pk2(s[4 * 33], s[5 * 33]); o.w = pk2(s[6 * 33], s[7 * 33]);
        *(GAS v4u*)(WT + (size_t)(drow0 + n) * K + k0 + 8 * c) = o; }
    LDS_WAIT(); asm volatile("" ::: "memory");
}
__device__ __forceinline__ void tr_item_f8(const float* W, int K, int N, unsigned char* WT, int kb, int nb, int drow0, LAS float* scr, int lane, float scale) {
    const int k0 = 64 * kb, n0 = 32 * nb;
#pragma unroll 8
    for (int i = 0; i < 32; ++i) { const int kk = 2 * i + (lane >> 5); scr[kk * 33 + (lane & 31)] = W[(size_t)(k0 + kk) * N + n0 + (lane & 31)]; }
    LDS_WAIT(); asm volatile("" ::: "memory");
    const int c = lane & 7;
#pragma unroll
    for (int j = 0; j < 4; ++j) { const int n = (lane >> 3) + 8 * j; const LAS float* s = scr + (8 * c) * 33 + n;
        v2u o; o.x = pk4_fp8(s[0 * 33] * scale, s[1 * 33] * scale, s[2 * 33] * scale, s[3 * 33] * scale); o.y = pk4_fp8(s[4 * 33] * scale, s[5 * 33] * scale, s[6 * 33] * scale, s[7 * 33] * scale);
        *(GAS v2u*)(WT + (size_t)(drow0 + n) * K + k0 + 8 * c) = o; }
    LDS_WAIT(); asm volatile("" ::: "memory");
}
__device__ __forceinline__ int rowmap_win(int n0) {
    if (n0 < 512) return 256 * (n0 >> 7) + (n0 & 127);
    if (n0 < 1024) { const int m = n0 - 512; return 256 * (m >> 7) + 128 + (m & 127); }
    if (n0 < 2048) { const int isk = n0 >= 1536; const int m = n0 - (isk ? 1536 : 1024); const int head = m >> 6, bj = (m >> 5) & 1; return 256 * (4 + 2 * isk + (head >> 2)) + 128 * bj + 32 * (head & 3); }
    return n0;
}
__device__ __forceinline__ int rowmap_gu(int n0, int up) { return 256 * (n0 >> 7) + 128 * up + (n0 & 127); }

__device__ __forceinline__ void phase0(const Params& P, LAS unsigned char* lds, int tid, int lane, int wave, int gw) {
    LAS float* cact = (LAS float*)(lds + 69632);
    { const float* c = P.in[1]; for (int i = tid; i < B_ * D; i += NTHR) { const float v = c[i]; cact[i] = v * sigm(v); } }
    __syncthreads();
    {
        const float* w_ada = P.in[2]; float* modp = (float*)(P.ws + WS_MODP);
        for (int it = gw; it < 1536; it += NGW) {
            const int ks = it & 7, jb = (it >> 3) % 96, l = it / 768;
            const float* wp = w_ada + ((size_t)l * D + ks * 128) * 6144 + jb * 64 + lane;
            float acc[8];
#pragma unroll
            for (int b = 0; b < 8; ++b) acc[b] = 0.f;
#pragma unroll 8
            for (int k = 0; k < 128; ++k) { const float w = wp[(size_t)k * 6144];
#pragma unroll
                for (int b = 0; b < 8; ++b) acc[b] += cact[b * D + ks * 128 + k] * w; }
#pragma unroll
            for (int b = 0; b < 8; ++b) modp[(((size_t)ks * 2 + l) * 8 + b) * 6144 + jb * 64 + lane] = acc[b];
        }
    }
    LAS float* scr = (LAS float*)(lds + wave * 8448);
    constexpr int I_WIN = 16 * 80, I_WOUT = 16 * 32, I_FG = 16 * 88, I_FD = 44 * 32, I_MG = 16 * 112, I_MD = 56 * 32;
    constexpr int NITEMS = 2 * I_WIN + 2 * I_WOUT + 2 * I_FG + I_FD + 16 * I_MG + 8 * I_MD;
    for (int it = gw; it < NITEMS; it += NGW) {
        int r = it;
        if (r < 16 * I_MG) { const int mat = r / I_MG, q = r % I_MG, e = mat >> 1, up = mat & 1; const int kb = q / 112, nb = q % 112;
            tr_item_f8((up ? P.in[21] : P.in[20]) + (size_t)e * D * FFE, D, FFE, (unsigned char*)(P.ws + WS_WMGU) + (size_t)e * 7168 * D, kb, nb, rowmap_gu(32 * nb, up), scr, lane, W8_SCALE); continue; }
        r -= 16 * I_MG;
        if (r < 8 * I_MD) { const int e = r / I_MD, q = r % I_MD; const int kb = q / 32, nb = q % 32;
            tr_item_f8(P.in[22] + (size_t)e * FFE * D, FFE, D, (unsigned char*)(P.ws + WS_WMD) + (size_t)e * D * FFE, kb, nb, 32 * nb, scr, lane, W8_SCALE); continue; }
        r -= 8 * I_MD;
        if (r < 2 * I_WIN) { const int l = r / I_WIN, q = r % I_WIN; const int kb = q / 80, nb = q % 80;
            tr_item(P.in[6] + (size_t)l * D * DIN, D, DIN, (bf16*)(P.ws + WS_WIN) + (size_t)l * DIN * D, kb, nb, rowmap_win(32 * nb), scr, lane); continue; }
        r -= 2 * I_WIN;
        if (r < 2 * I_WOUT) { const int l = r / I_WOUT, q = r % I_WOUT; const int kb = q / 32, nb = q % 32;
            tr_item(P.in[7] + (size_t)l * D * D, D, D, (bf16*)(P.ws + WS_WOUT) + (size_t)l * D * D, kb, nb, 32 * nb, scr, lane); continue; }
        r -= 2 * I_WOUT;
        if (r < 2 * I_FG) { const int up = r / I_FG, q = r % I_FG; const int kb = q / 88, nb = q % 88;
            tr_item((up ? P.in[16] : P.in[15]), D, FFD, (bf16*)(P.ws + WS_WGU), kb, nb, rowmap_gu(32 * nb, up), scr, lane); continue; }
        r -= 2 * I_FG;
        { const int kb = r / 32, nb = r % 32; tr_item(P.in[17], FFD, D, (bf16*)(P.ws + WS_WD), kb, nb, 32 * nb, scr, lane); }
    }
}

__device__ __forceinline__ float modp_sum(const float* modp, const float* b_ada, int l, int b, int j) {
    float s = b_ada[l * 6144 + j];
#pragma unroll
    for (int ks = 0; ks < 8; ++ks) s += modp[(((size_t)ks * 2 + l) * 8 + b) * 6144 + j];
    return s;
}
__device__ __forceinline__ void norm_row(const float* xrow, const LAS float* gm, const LAS float* shv, int lane, f32x4 (&h)[4]) {
    const GAS f32x4* xr = (const GAS f32x4*)xrow + lane; float ss = 0.f;
#pragma unroll
    for (int j = 0; j < 4; ++j) { h[j] = xr[64 * j]; ss += (h[j].x * h[j].x + h[j].y * h[j].y) + (h[j].z * h[j].z + h[j].w * h[j].w); }
    const float r = __builtin_amdgcn_rsqf(wave_sum(ss) * (1.f / D) + EPS);
#pragma unroll
    for (int j = 0; j < 4; ++j) { const f32x4 g4 = *(const LAS f32x4*)(gm + 4 * lane + 256 * j), s4 = *(const LAS f32x4*)(shv + 4 * lane + 256 * j); h[j] = h[j] * r * g4 + s4; }
}
__device__ __forceinline__ void store_row_bf16(bf16* orow, int lane, const f32x4 (&h)[4]) {
    GAS v2u* o8 = (GAS v2u*)orow + lane;
#pragma unroll
    for (int j = 0; j < 4; ++j) { v2u w; w.x = pk2(h[j].x, h[j].y); w.y = pk2(h[j].z, h[j].w); o8[64 * j] = w; }
}
__device__ __forceinline__ void norm_phase(const Params& P, LAS unsigned char* lds, const float* xin, const float* gvec, int l, int sh_off, int sc_off, bool from_partials, int tid, int lane, int wave, int wgi) {
    LAS float* gm = (LAS float*)lds; LAS float* shv = (LAS float*)(lds + 4096);
    const float* modp = (const float*)(P.ws + WS_MODP); float* mod = (float*)(P.ws + WS_MOD); const float* b_ada = P.in[3];
    const int b = wgi >> 5;
    if (from_partials) {
        if (tid < 384) { const int idx = wgi * 384 + tid; const int ll = idx / 49152, rem = idx % 49152, bb = rem / 6144, j = rem % 6144; mod[idx] = modp_sum(modp, b_ada, ll, bb, j); }
        for (int c = tid; c < D; c += NTHR) { gm[c] = gvec[c] * (1.f + modp_sum(modp, b_ada, l, b, sc_off + c)); shv[c] = modp_sum(modp, b_ada, l, b, sh_off + c); }
    } else {
        const float* ml = mod + ((size_t)l * 8 + b) * 6144;
        for (int c = tid; c < D; c += NTHR) { gm[c] = gvec[c] * (1.f + ml[sc_off + c]); shv[c] = ml[sh_off + c]; }
    }
    __syncthreads();
    bf16* H = (bf16*)(P.ws + WS_H);
    for (int i = 0; i < 8; ++i) { const int row = wgi * 64 + wave * 8 + i; f32x4 h[4]; norm_row(xin + (size_t)row * D, gm, shv, lane, h); store_row_bf16(H + (size_t)row * D, lane, h); }
    __syncthreads();
}
__device__ __forceinline__ void router_phase(const Params& P, LAS unsigned char* lds, const float* xin, int tid, int lane, int wave, int wgi) {
    LAS float* gm = (LAS float*)lds; LAS float* shv = (LAS float*)(lds + 4096); LAS float* wrT = (LAS float*)(lds + 8192);
    LAS int* pe = (LAS int*)(lds + 40960); LAS float* pw = (LAS float*)(lds + 41472); LAS int* cw = (LAS int*)(lds + 41984); LAS int* baseL = (LAS int*)(lds + 42048);
    const float* mod = (const float*)(P.ws + WS_MOD); const int b = wgi >> 5; const float* ml = mod + ((size_t)1 * 8 + b) * 6144; const float* gvec = P.in[5] + D;
    for (int c = tid; c < D; c += NTHR) { gm[c] = gvec[c] * (1.f + ml[4096 + c]); shv[c] = ml[3072 + c]; }
    { const float* wr = P.in[18]; for (int i = tid; i < D * NE; i += NTHR) { const int c = i >> 3, e = i & 7; wrT[e * D + c] = wr[i]; } }
    __syncthreads();
    const float* br = P.in[19];
    for (int i = 0; i < 8; ++i) { const int rl = wave * 8 + i, row = wgi * 64 + rl; f32x4 h[4]; norm_row(xin + (size_t)row * D, gm, shv, lane, h);
        float lg[8];
#pragma unroll
        for (int e = 0; e < 8; ++e) { float s = 0.f;
#pragma unroll
            for (int j = 0; j < 4; ++j) { const f32x4 w4 = *(const LAS f32x4*)(wrT + e * D + 4 * lane + 256 * j); s += (h[j].x * w4.x + h[j].y * w4.y) + (h[j].z * w4.z + h[j].w * w4.w); }
            lg[e] = wave_sum(s) + br[e]; }
        int e1 = 0; float v1 = lg[0];
#pragma unroll
        for (int e = 1; e < 8; ++e) if (lg[e] > v1) { v1 = lg[e]; e1 = e; }
        int e2 = -1; float v2 = -3.0e38f;
#pragma unroll
        for (int e = 0; e < 8; ++e) if (e != e1 && lg[e] > v2) { v2 = lg[e]; e2 = e; }
        const float p2 = __expf(v2 - v1), inv = 1.f / (1.f + p2);
        if (lane == 0) { pe[2 * rl] = e1; pe[2 * rl + 1] = e2; pw[2 * rl] = inv; pw[2 * rl + 1] = p2 * inv; } }
    __syncthreads();
    int e = 0, rank = 0;
    if (tid < 128) { e = pe[tid];
#pragma unroll
        for (int ee = 0; ee < 8; ++ee) { const unsigned long long mk = __ballot(e == ee); if (e == ee) rank = __popcll(mk & ((1ull << lane) - 1ull)); if (lane == 0) cw[wave * 8 + ee] = __popcll(mk); } }
    __syncthreads();
    if (tid < 8) { const int tot = cw[tid] + cw[8 + tid]; unsigned* cnt = (unsigned*)(P.ws + WS_CTL) + CW_CNT + 64 * tid;
        baseL[tid] = (int)__hip_atomic_fetch_add(cnt, (unsigned)tot, __ATOMIC_RELAXED, __HIP_MEMORY_SCOPE_AGENT); }
    __syncthreads();
    if (tid < 128) { const int slot = baseL[e] + rank + (wave == 1 ? cw[e] : 0); const int token = wgi * 64 + (tid >> 1);
        ((int*)(P.ws + WS_LIST))[e * M + slot] = token; ((float*)(P.ws + WS_WL))[e * M + slot] = pw[tid]; ((int*)(P.ws + WS_PAIR))[token * 2 + (tid & 1)] = e * M + slot; }
    __syncthreads();
}
__device__ __forceinline__ void moe_tables(const Params& P, LAS unsigned char* lds, int tid) {
    LAS int* tab = (LAS int*)(lds + MOETAB_OFF);
    if (tid == 0) { const unsigned* ctl = (const unsigned*)(P.ws + WS_CTL); int rb = 0;
        for (int e = 0; e < 8; ++e) { int c = (int)__hip_atomic_load(ctl + CW_CNT + 64 * e, __ATOMIC_RELAXED, __HIP_MEMORY_SCOPE_AGENT); c = c < 0 ? 0 : (c > M ? M : c); tab[e] = rb; tab[9 + e] = c; rb += (c + 255) & ~255; }
        tab[8] = rb; }
    __syncthreads();
}
__device__ __forceinline__ void gather_phase(const Params& P, LAS unsigned char* lds, const float* xin, int tid, int lane, int wave, int gw) {
    LAS float* gmA = (LAS float*)lds; LAS float* shA = (LAS float*)(lds + 32768); const LAS int* tab = (const LAS int*)(lds + MOETAB_OFF);
    const float* mod1 = (const float*)(P.ws + WS_MOD) + (size_t)8 * 6144; const float* gvec = P.in[5] + D;
    for (int i = tid; i < 8 * D; i += NTHR) { const int b = i >> 10, c = i & 1023; gmA[i] = gvec[c] * (1.f + mod1[b * 6144 + 4096 + c]); shA[i] = mod1[b * 6144 + 3072 + c]; }
    __syncthreads();
    const int ptot = tab[8]; const int* list = (const int*)(P.ws + WS_LIST); const float* wl = (const float*)(P.ws + WS_WL); float* wlg = (float*)(P.ws + WS_WLG); unsigned char* HG = (unsigned char*)(P.ws + WS_HG);
    for (int p = gw; p < ptot; p += NGW) {
        int e = 0;
#pragma unroll
        for (int k = 1; k < 8; ++k) e += (p >= tab[k]);
        const int slot = p - tab[e], cn = tab[9 + e]; const bool valid = slot < cn; const int token = list[e * M + (valid ? slot : cn - 1)]; const int b = token >> 11;
        f32x4 h[4]; norm_row(xin + (size_t)token * D, gmA + b * D, shA + b * D, lane, h);
        { GAS unsigned* o4 = (GAS unsigned*)(HG + (size_t)p * D) + lane;
#pragma unroll
          for (int j = 0; j < 4; ++j) o4[64 * j] = pk4_fp8(h[j].x * H8_SCALE, h[j].y * H8_SCALE, h[j].z * H8_SCALE, h[j].w * H8_SCALE); }
        if (lane == 0) wlg[p] = valid ? wl[e * M + slot] : 0.f;
    }
    __syncthreads();
}
__device__ __forceinline__ void combine_phase(const Params& P, LAS unsigned char* lds, int lane, int gw) {
    const LAS int* tab = (const LAS int*)(lds + MOETAB_OFF); const int* pair = (const int*)(P.ws + WS_PAIR); const bf16* F = (const bf16*)(P.ws + WS_F);
    const float* mod1 = (const float*)(P.ws + WS_MOD) + (size_t)8 * 6144;
    for (int t = gw; t < M; t += NGW) {
        const int pa = pair[2 * t], pb = pair[2 * t + 1]; const int ra = tab[pa >> 14] + (pa & 16383), rb = tab[pb >> 14] + (pb & 16383); const int b = t >> 11;
        const GAS v2u* fa = (const GAS v2u*)(F + (size_t)ra * D) + lane; const GAS v2u* fb = (const GAS v2u*)(F + (size_t)rb * D) + lane;
        GAS f32x4* xo = (GAS f32x4*)(P.out + (size_t)t * D) + lane; const GAS f32x4* g2 = (const GAS f32x4*)(mod1 + b * 6144 + 5120) + lane;
#pragma unroll
        for (int j = 0; j < 4; ++j) { const v2u a = fa[64 * j], c = fb[64 * j]; f32x4 f;
            f.x = __uint_as_float(a.x << 16) + __uint_as_float(c.x << 16); f.y = __uint_as_float(a.x & 0xffff0000u) + __uint_as_float(c.x & 0xffff0000u);
            f.z = __uint_as_float(a.y << 16) + __uint_as_float(c.y << 16); f.w = __uint_as_float(a.y & 0xffff0000u) + __uint_as_float(c.y & 0xffff0000u);
            xo[64 * j] = xo[64 * j] + g2[64 * j] * f; }
    }
}

__device__ __forceinline__ void conv_unit(const bf16* Z, bf16* YC, const float* cw, const float* cb, const float* lg, const float* lb, LAS float* tile, int unit, int tid, int wave, int lane) {
    const int tok0 = unit * 32, tp0 = tok0 & (S_ - 1), c = tid;
    float w[CW];
#pragma unroll
    for (int j = 0; j < CW; ++j) w[j] = cw[j * DC + c];
    const float bias = cb[c];
#pragma unroll
    for (int half = 0; half < 2; ++half) {
        float in[46];
#pragma unroll
        for (int i = 0; i < 46; ++i) { const int dt = 16 * half - 30 + i; in[i] = (tp0 + dt >= 0) ? bf2f(Z[(size_t)(tok0 + dt) * DC + c]) : 0.f; }
#pragma unroll
        for (int q = 0; q < 16; ++q) { float a = bias;
#pragma unroll
            for (int j = 0; j < CW; ++j) a += w[j] * in[q + j];
            tile[(16 * half + q) * DC + c] = a; }
    }
    __syncthreads();
    const f32x4 g0 = *(const f32x4*)(lg + lane * 8), g1 = *(const f32x4*)(lg + lane * 8 + 4), b0 = *(const f32x4*)(lb + lane * 8), b1 = *(const f32x4*)(lb + lane * 8 + 4);
#pragma unroll
    for (int tt = 0; tt < 4; ++tt) { const int t = wave * 4 + tt;
        f32x4 v0 = *(const LAS f32x4*)(tile + t * DC + lane * 8), v1 = *(const LAS f32x4*)(tile + t * DC + lane * 8 + 4);
        const float mean = wave_sum((v0.x + v0.y) + (v0.z + v0.w) + (v1.x + v1.y) + (v1.z + v1.w)) * (1.f / DC);
        v0 = v0 - mean; v1 = v1 - mean;
        const float var = wave_sum((v0.x * v0.x + v0.y * v0.y) + (v0.z * v0.z + v0.w * v0.w) + (v1.x * v1.x + v1.y * v1.y) + (v1.z * v1.z + v1.w * v1.w)) * (1.f / DC);
        const float rstd = __builtin_amdgcn_rsqf(var + EPS);
        f32x4 y0 = v0 * rstd * g0 + b0, y1 = v1 * rstd * g1 + b1;
#pragma unroll
        for (int i = 0; i < 4; ++i) { y0[i] = y0[i] * sigm(y0[i]); y1[i] = y1[i] * sigm(y1[i]); }
        v4u o; o.x = pk2(y0.x, y0.y); o.y = pk2(y0.z, y0.w); o.z = pk2(y1.x, y1.y); o.w = pk2(y1.z, y1.w);
        *(GAS v4u*)(YC + (size_t)(tok0 + t) * D + lane * 8) = o; }
    __syncthreads();
}
__device__ __forceinline__ int crow(int r, int hi) { return (r & 3) + 8 * (r >> 2) + 4 * hi; }
#define MFMA32(a, b, c) __builtin_amdgcn_mfma_f32_32x32x16_bf16((a), (b), (c), 0, 0, 0)
__device__ __forceinline__ void attn_unit(const bf16* Q, const bf16* K, const bf16* VT, bf16* YC, const LAS float* biasL, LAS unsigned char* kv, int b, int h, int g, int tid, int wave, int lane) {
    const int r32 = lane & 31, hi = lane >> 5;
    const int n0 = 4 * g, n = n0 + (wave >> 1), qh = wave & 1;
    const size_t rowq = (size_t)b * S_ + n * 64 + qh * 32 + r32;
    bf16x8 qf[4];
#pragma unroll
    for (int d0 = 0; d0 < 4; ++d0) qf[d0] = *(const GAS bf16x8*)(Q + rowq * DC + h * 64 + d0 * 16 + hi * 8);
    float m = -1.0e30f, l = 0.f; f32x16 o0, o1;
#pragma unroll
    for (int r = 0; r < 16; ++r) { o0[r] = 0.f; o1[r] = 0.f; }
    const int kc_lo = n0 - 8 < 0 ? 0 : n0 - 8, ns = n0 + 4 - kc_lo;
    const int qbase = n * 64 + qh * 32, qpos = qbase + r32;
    const int lrow = tid >> 3, lc = tid & 7; const int lofs = lrow * 128 + ((lc ^ ((lrow >> 1) & 7)) << 4);
    const bf16* kg = K + ((size_t)b * S_ + lrow) * DC + h * 64 + lc * 8;
    const bf16* vg = VT + (size_t)(h * 64 + lrow) * M + (size_t)b * S_ + lc * 8;
    v4u kreg = *(const GAS v4u*)(kg + (size_t)kc_lo * 64 * DC), vreg = *(const GAS v4u*)(vg + kc_lo * 64);
    *(LAS v4u*)(kv + lofs) = kreg; *(LAS v4u*)(kv + 8192 + lofs) = vreg;
    __syncthreads();
    const int fsw = (r32 >> 1) & 7;
    for (int s = 0; s < ns; ++s) {
        const int kc = kc_lo + s; const LAS unsigned char* buf = kv + (s & 1) * 16384;
        if (s + 1 < ns) { kreg = *(const GAS v4u*)(kg + (size_t)(kc + 1) * 64 * DC); vreg = *(const GAS v4u*)(vg + (kc + 1) * 64); }
        if (kc >= n - 8 && kc <= n) {
#pragma unroll
            for (int kb = 0; kb < 2; ++kb) {
                const int key0 = kc * 64 + kb * 32;
                bf16x8 kf[4];
#pragma unroll
                for (int d0 = 0; d0 < 4; ++d0) kf[d0] = *(const LAS bf16x8*)(buf + (kb * 32 + r32) * 128 + (((2 * d0 + hi) ^ fsw) << 4));
                s16x4 va[2][2][2];
#pragma unroll
                for (int db = 0; db < 2; ++db)
#pragma unroll
                    for (int s2 = 0; s2 < 2; ++s2)
#pragma unroll
                        for (int hf = 0; hf < 2; ++hf) va[db][s2][hf] = *(const LAS s16x4*)(buf + 8192 + (db * 32 + r32) * 128 + (((kb * 4 + 2 * s2 + hf) ^ fsw) << 4) + 8 * hi);
                f32x16 sc;
#pragma unroll
                for (int r = 0; r < 16; ++r) sc[r] = 0.f;
#pragma unroll
                for (int d0 = 0; d0 < 4; ++d0) sc = MFMA32(kf[d0], qf[d0], sc);
                if (key0 + 31 - qbase <= -128) { const float b0 = biasL[0];
#pragma unroll
                    for (int r = 0; r < 16; ++r) sc[r] += b0;
                } else {
#pragma unroll
                    for (int r = 0; r < 16; ++r) { int rel = key0 + crow(r, hi) - qpos; rel = rel < -128 ? -128 : (rel > 128 ? 128 : rel); sc[r] += biasL[rel + 128]; }
                }
                float mx = sc[0];
#pragma unroll
                for (int r = 1; r < 16; ++r) mx = fmaxf(mx, sc[r]);
                mx = fmaxf(mx, __shfl_xor(mx, 32));
                const float mn = fmaxf(m, mx);
                if (__any(mn > m)) { const float alpha = __builtin_amdgcn_exp2f(m - mn); l *= alpha;
#pragma unroll
                    for (int r = 0; r < 16; ++r) { o0[r] *= alpha; o1[r] *= alpha; } }
                m = mn;
                float ps = 0.f;
#pragma unroll
                for (int r = 0; r < 16; ++r) { sc[r] = __builtin_amdgcn_exp2f(sc[r] - mn); ps += sc[r]; }
                l += ps;
                v4u p0, p1;
                p0.x = pk2(sc[0], sc[1]); p0.y = pk2(sc[2], sc[3]); p0.z = pk2(sc[4], sc[5]); p0.w = pk2(sc[6], sc[7]);
                p1.x = pk2(sc[8], sc[9]); p1.y = pk2(sc[10], sc[11]); p1.z = pk2(sc[12], sc[13]); p1.w = pk2(sc[14], sc[15]);
                const bf16x8 pb0 = __builtin_bit_cast(bf16x8, p0), pb1 = __builtin_bit_cast(bf16x8, p1);
#define VA8(db, s2) (bf16x8){va[db][s2][0][0], va[db][s2][0][1], va[db][s2][0][2], va[db][s2][0][3], va[db][s2][1][0], va[db][s2][1][1], va[db][s2][1][2], va[db][s2][1][3]}
                o0 = MFMA32(VA8(0, 0), pb0, o0); o0 = MFMA32(VA8(0, 1), pb1, o0);
                o1 = MFMA32(VA8(1, 0), pb0, o1); o1 = MFMA32(VA8(1, 1), pb1, o1);
#undef VA8
            }
        }
        if (s + 1 < ns) { LAS unsigned char* nb = kv + ((s + 1) & 1) * 16384; *(LAS v4u*)(nb + lofs) = kreg; *(LAS v4u*)(nb + 8192 + lofs) = vreg; }
        __syncthreads();
    }
    l += __shfl_xor(l, 32); const float il = 1.f / l;
    bf16* yp = YC + rowq * D + DC + h * 64 + 4 * hi;
#pragma unroll
    for (int gq = 0; gq < 4; ++gq) { v2u w0, w1; w0.x = pk2(o0[4 * gq] * il, o0[4 * gq + 1] * il); w0.y = pk2(o0[4 * gq + 2] * il, o0[4 * gq + 3] * il);
        w1.x = pk2(o1[4 * gq] * il, o1[4 * gq + 1] * il); w1.y = pk2(o1[4 * gq + 2] * il, o1[4 * gq + 3] * il);
        *(GAS v2u*)(yp + 8 * gq) = w0; *(GAS v2u*)(yp + 32 + 8 * gq) = w1; }
}
__device__ __forceinline__ void mixer_phase(const Params& P, LAS unsigned char* lds, int l, int tid, int lane, int wave, int wgi) {
    LAS float* tile = (LAS float*)lds; LAS float* biasL = (LAS float*)(lds + 65536); LAS unsigned char* kv = lds + 73728;
    { const float* rb = P.in[14] + l * 8 * NREL; for (int i = tid; i < 8 * NREL; i += NTHR) biasL[i] = rb[i] * LOG2E; }
    __syncthreads();
    const bf16* Z = (const bf16*)(P.ws + WS_Z); const bf16* Q = (const bf16*)(P.ws + WS_Q); const bf16* K = (const bf16*)(P.ws + WS_K); const bf16* VT = (const bf16*)(P.ws + WS_VT); bf16* YC = (bf16*)(P.ws + WS_YC);
    for (int rp = 0; rp < 1 + ((REPMASK >> 20) & 1); ++rp)
    for (int cu = 0; cu < 2; ++cu) conv_unit(Z, YC, P.in[8] + l * CW * DC, P.in[9] + l * DC, P.in[10] + l * DC, P.in[11] + l * DC, tile, wgi * 2 + cu, tid, wave, lane);
    { const int b = wgi >> 5, h = (wgi >> 2) & 7, gp = wgi & 3;
      for (int rp = 0; rp < 1 + ((REPMASK >> 21) & 1); ++rp)
      for (int au = 0; au < 2; ++au) attn_unit(Q, K, VT, YC, biasL + h * NREL, kv, b, h, au ? 7 - gp : gp, tid, wave, lane); }
    __syncthreads();
}

#define PHASE(k, ...) do { { __VA_ARGS__ } if constexpr ((REPMASK >> (k)) & 1) { xcd_barrier(bar); RETID(); { __VA_ARGS__ } } } while (0)
__global__ void __launch_bounds__(NTHR, 2) fwd(Params P) {
    extern __shared__ __attribute__((aligned(16))) unsigned char lds_raw[];
    LAS unsigned char* lds = (LAS unsigned char*)lds_raw;
    int tid = threadIdx.x, lane = tid & 63, wave = __builtin_amdgcn_readfirstlane(tid >> 6); const int wgi = blockIdx.x; int gw = wgi * NWAVES + wave;
#define RETID() do { tid = threadIdx.x; asm volatile("" : "+v"(tid)); lane = tid & 63; wave = __builtin_amdgcn_readfirstlane(tid >> 6); gw = wgi * NWAVES + wave; } while (0)
    for (int u = tid; u < (LDS_BYTES - LDSCTL_OFF) / 4; u += NTHR) ((LAS unsigned*)(lds + LDSCTL_OFF))[u] = 0u;
    __syncthreads();
    unsigned* ctl = (unsigned*)(P.ws + WS_CTL);
    XcdBarrier bar = xcd_barrier_post(ctl + CW_BAR, (volatile LAS unsigned*)(lds + MISC_OFF) + 8);
    const int stop = P.stop;
#define SEAM(k) do { if (stop == (k)) return; xcd_barrier(bar); RETID(); } while (0)
    bf16* H = (bf16*)(P.ws + WS_H); float* mod = (float*)(P.ws + WS_MOD);

    PHASE(0, phase0(P, lds, tid, lane, wave, gw););                                                      SEAM(0);
    PHASE(1, norm_phase(P, lds, P.in[0], P.in[4], 0, 0, 1024, true, tid, lane, wave, wgi););             SEAM(1);
#define LAYER_COMMON(l, pb, xin) \
    PHASE(2,   \
        const bf16* Wl = (const bf16*)(P.ws + WS_WIN) + (size_t)(l) * DIN * D; \
        { pg8::Gemm g{H, Wl, M, 2048, D, 0}; pg8::StaticOrder S; S.init(M, 2048, GRID, wgi); \
          pg8::EpiInProj E{(bf16*)(P.ws + WS_Z), (bf16*)(P.ws + WS_Q), (bf16*)(P.ws + WS_K), P.in[12] + (l) * 64, P.in[13] + (l) * 64, QSCALE}; \
          pg8::gemm_phase<pg8::EpiInProj, pg8::StaticOrder, true, true>(lds, g, S, E); } \
        { pg8::Gemm g{Wl + (size_t)2048 * D, H, 512, M, D, 0}; pg8::StaticOrder S; S.init(512, M, GRID, wgi); \
          pg8::EpiBf16 E{(bf16*)(P.ws + WS_VT), M, 1.f}; \
          pg8::gemm_phase<pg8::EpiBf16, pg8::StaticOrder, true, true>(lds, g, S, E); } ); \
    SEAM(pb); \
    PHASE(3, mixer_phase(P, lds, (l), tid, lane, wave, wgi);); \
    SEAM((pb) + 1); \
    PHASE(4 + 10 * (l),   \
        pg8::Gemm g{(const bf16*)(P.ws + WS_YC), (const bf16*)(P.ws + WS_WOUT) + (size_t)(l) * D * D, M, D, D, 0}; pg8::StaticOrder S; S.init(M, D, GRID, wgi); \
        pg8::EpiResGate E{(xin), P.out, mod + (size_t)(l) * 8 * 6144 + 2048}; \
        pg8::gemm_phase<pg8::EpiResGate, pg8::StaticOrder, false, true>(lds, g, S, E); ); \
    SEAM((pb) + 2);

    LAYER_COMMON(0, 2, P.in[0])
    PHASE(5, norm_phase(P, lds, P.out, P.in[5], 0, 3072, 4096, false, tid, lane, wave, wgi););          SEAM(5);
    PHASE(6, pg8::Gemm g{H, (const bf16*)(P.ws + WS_WGU), M, 2 * FFD, D, 0}; pg8::StaticOrder S; S.init(M, 2 * FFD, GRID, wgi);
             pg8::EpiSwiGLU<false> E{(bf16*)(P.ws + WS_ACT), FFD, nullptr, 1.f, 1.f};
             pg8::gemm_phase<pg8::EpiSwiGLU<false>, pg8::StaticOrder, true, true>(lds, g, S, E););
    SEAM(6);
    PHASE(30, pg8::Gemm g{(const bf16*)(P.ws + WS_ACT), (const bf16*)(P.ws + WS_WD), M, D, FFD, 0}; pg8::StaticOrder S; S.init(M, D, GRID, wgi);
              pg8::EpiResGate E{P.out, P.out, mod + 5120};
              pg8::gemm_phase<pg8::EpiResGate, pg8::StaticOrder, false, true>(lds, g, S, E););
    SEAM(7);
    PHASE(8, norm_phase(P, lds, P.out, P.in[4] + D, 1, 0, 1024, false, tid, lane, wave, wgi););         SEAM(8);
    LAYER_COMMON(1, 9, P.out)
    PHASE(31, router_phase(P, lds, P.out, tid, lane, wave, wgi););                                       SEAM(12);
    moe_tables(P, lds, tid);
    PHASE(10, gather_phase(P, lds, P.out, tid, lane, wave, gw););                                        SEAM(13);
    {
        const LAS int* tab = (const LAS int*)(lds + MOETAB_OFF);
        const int ptot = RFL(tab[8]);
        PHASE(11, pg8::Gemm g{(const bf16*)(P.ws + WS_HG), (const bf16*)(P.ws + WS_WMGU), ptot, 2 * FFE, D, (unsigned)(2 * FFE * D)};
                  pg8::MoeOrder S; S.nM = ptot >> 8; S.nN = 2 * FFE / 256; S.nwg = S.nM * S.nN; S.G = GRID; S.c = wgi;
                  S.t1 = RFL(tab[1] >> 8); S.t2 = RFL(tab[2] >> 8); S.t3 = RFL(tab[3] >> 8); S.t4 = RFL(tab[4] >> 8); S.t5 = RFL(tab[5] >> 8); S.t6 = RFL(tab[6] >> 8); S.t7 = RFL(tab[7] >> 8);
                  pg8::EpiSwiGLU<true> E{(bf16*)(P.ws + WS_ACTM), FFE, (const float*)(P.ws + WS_WLG), A8_SCALE / (H8_SCALE * W8_SCALE), 1.f / (H8_SCALE * W8_SCALE)};
                  pg8::gemm_phase<pg8::EpiSwiGLU<true>, pg8::MoeOrder, true, true, true>(lds, g, S, E););
        if constexpr ((REPMASK >> 22) & 1) { xcd_barrier(bar); RETID();
                  pg8::Gemm g{(const bf16*)(P.ws + WS_HG), (const bf16*)(P.ws + WS_WMGU), ptot, 2 * FFE, D, (unsigned)(2 * FFE * D)};
                  pg8::MoeOrder S; S.nM = ptot >> 8; S.nN = 2 * FFE / 256; S.nwg = S.nM * S.nN; S.G = GRID; S.c = wgi;
                  S.t1 = RFL(tab[1] >> 8); S.t2 = RFL(tab[2] >> 8); S.t3 = RFL(tab[3] >> 8); S.t4 = RFL(tab[4] >> 8); S.t5 = RFL(tab[5] >> 8); S.t6 = RFL(tab[6] >> 8); S.t7 = RFL(tab[7] >> 8);
                  pg8::EpiNone E{};
                  pg8::gemm_phase<pg8::EpiNone, pg8::MoeOrder, true, true, true>(lds, g, S, E); }
        SEAM(14);
        PHASE(12, pg8::Gemm g{(const bf16*)(P.ws + WS_ACTM), (const bf16*)(P.ws + WS_WMD), ptot, D, FFE, (unsigned)(D * FFE)};
                  pg8::MoeOrder S; S.nM = ptot >> 8; S.nN = D / 256; S.nwg = S.nM * S.nN; S.G = GRID; S.c = wgi;
                  S.t1 = RFL(tab[1] >> 8); S.t2 = RFL(tab[2] >> 8); S.t3 = RFL(tab[3] >> 8); S.t4 = RFL(tab[4] >> 8); S.t5 = RFL(tab[5] >> 8); S.t6 = RFL(tab[6] >> 8); S.t7 = RFL(tab[7] >> 8);
                  pg8::EpiBf16 E{(bf16*)(P.ws + WS_F), D, 1.f / (A8_SCALE * W8_SCALE)};
                  pg8::gemm_phase<pg8::EpiBf16, pg8::MoeOrder, true, true, true>(lds, g, S, E););
        SEAM(15);
        PHASE(29, combine_phase(P, lds, lane, gw););
    }
#undef SEAM
}
static int launch_fast(void* const* d_in, float* out, unsigned char* ws, hipStream_t stream, int stop) {
    static int ready = 0;
    if (ready == 0) {
        if (hipFuncSetAttribute((const void*)fwd, hipFuncAttributeMaxDynamicSharedMemorySize, LDS_BYTES) != hipSuccess) { fprintf(stderr, "kernel_launch: hipFuncSetAttribute failed\n"); ready = -1; return -1; }
        int per_cu = 0; if (hipOccupancyMaxActiveBlocksPerMultiprocessor(&per_cu, (const void*)fwd, NTHR, LDS_BYTES) != hipSuccess || per_cu < 1) fprintf(stderr, "kernel_launch: occupancy query reports %d blocks per CU\n", per_cu);
        (void)hipGetLastError(); ready = 1;
    }
    if (ready < 0) return -1;
    if (hipMemsetAsync(ws + WS_CTL, 0, CTL_ZERO_BYTES, stream) != hipSuccess) return -1;
    Params p{}; for (int i = 0; i < 23; ++i) p.in[i] = (const float*)d_in[i]; p.out = out; p.ws = ws; p.stop = stop; p.pad = 0;
    hipLaunchKernelGGL(fwd, dim3(GRID), dim3(NTHR), LDS_BYTES, stream, p);
    return hipPeekAtLastError() == hipSuccess ? 0 : -1;
}
}
#ifndef DBG_STAGE
#define DBG_STAGE 0
#endif
extern "C" void kernel_launch(void* const* d_in, const int* in_sizes, int n_in, void* d_out, int out_size, void* d_ws, size_t ws_size, hipStream_t stream) {
    if (n_in != 23 || out_size != fk::M * fk::D || ws_size < fk::WS_END) { fprintf(stderr, "kernel_launch: unexpected shapes / workspace (%d inputs, out %d, ws %zu)\n", n_in, out_size, ws_size); return; }
    unsigned char* ws = (unsigned char*)d_ws; float* out = (float*)d_out;
#if DBG_STAGE == 0
    fk::launch_fast(d_in, out, ws, stream, -1);
#else
    constexpr int S = DBG_STAGE; constexpr size_t MiB = 1u << 20;
    float* ckf = (float*)(ws + 390 * MiB); float* acc = (float*)(ws + 389 * MiB);
    int stop = -1; size_t off = 0, n = 0; float scale = 1.f; bool isf32 = false;
    const size_t NM = (size_t)fk::M;
    switch (S) {
        case 1: stop = 1; off = fk::WS_H; n = NM * 1024; break;
        case 2: stop = 2; off = fk::WS_Z; n = NM * 512; break;
        case 3: stop = 2; off = fk::WS_Q; n = NM * 512; scale = 1.f / fk::QSCALE; break;
        case 4: stop = 2; off = fk::WS_K; n = NM * 512; break;
        case 5: stop = 3; off = fk::WS_YC; n = NM * 1024; break;
        case 6: stop = 4; isf32 = true; n = NM * 1024; break;
        case 7: stop = 5; off = fk::WS_H; n = NM * 1024; break;
        case 8: stop = 6; off = fk::WS_ACT; n = NM * 1024; break;
        case 9: stop = 7; isf32 = true; n = NM * 1024; break;
        case 11: stop = 8; off = fk::WS_H; n = NM * 1024; break;
        case 12: stop = 9; off = fk::WS_Z; n = NM * 512; break;
        case 13: stop = 9; off = fk::WS_Q; n = NM * 512; scale = 1.f / fk::QSCALE; break;
        case 14: stop = 9; off = fk::WS_K; n = NM * 512; break;
        case 15: stop = 10; off = fk::WS_YC; n = NM * 1024; break;
        case 16: stop = 11; isf32 = true; n = NM * 1024; break;
        default: stop = -1; isf32 = true; n = NM * 1024; break;
    }
    fk::launch_fast(d_in, out, ws, stream, stop);
    if (isf32) nv::k_copy<<<(unsigned)((n + 255) / 256), 256, 0, stream>>>(out, ckf, n);
    else nv::k_cvt<<<(unsigned)((n + 255) / 256), 256, 0, stream>>>((const unsigned short*)(ws + off), ckf, n, scale);
    hipMemsetAsync(acc, 0, 256, stream);
    nv::forward(d_in, out, ws, stream, S, ckf, acc);
    if (S == 99) nv::k_cmp<<<1024, 256, 0, stream>>>(ckf, out, n, acc);
    nv::k_scale<<<(unsigned)((NM * 1024 + 255) / 256), 256, 0, stream>>>(out, NM * 1024, acc);
#endif
}
```

```cpp
#include <hip/hip_runtime.h>
#include <cstdio>
#include <cstdint>
#define DBG_STAGE 0
#define REPMASK 0
namespace pg8 {
#define PG8_LAS __attribute__((address_space(3)))
typedef unsigned short bf16_t;
typedef short bf16x8 __attribute__((ext_vector_type(8)));
typedef float f32x4 __attribute__((ext_vector_type(4)));
typedef unsigned u32x4 __attribute__((ext_vector_type(4)));
constexpr int BM = 256, BK = 64, HALF = 128, HTB = HALF * BK * 2  , STAGE_BYTES = 8 * HTB, NXCD = 8, WGM = 8;

__host__ __device__ __forceinline__ int lds_byte(int r, int c) { const int st = (r >> 4) * 2 + (c >> 5), rr = r & 15, cc = c & 31, ob = rr * 64 + cc * 2; return st * 1024 + (ob ^ (((ob >> 9) & 1) << 5)); }
__host__ __device__ __forceinline__ void stage_rc(int b, int& R, int& C) { const int st = b / 1024, sb = b % 1024, swz = sb ^ (((sb >> 9) & 1) << 5); R = (st >> 1) * 16 + swz / 64; C = (st & 1) * 32 + (swz % 64) / 2; }
__host__ __device__ __forceinline__ int perm32(int rho) { const int n = rho >> 4, i = rho & 15; return 8 * (i >> 2) + 4 * n + (i & 3); }

struct Unit { int pm, pn, e; };
struct Gemm { const bf16_t* A; const bf16_t* Bt; int M, N, K; unsigned bstride; };

struct StaticOrder {
    int nM, nN, nwg, G, c;
    __device__ void init(int M, int N, int G_, int c_) { nM = M / BM; nN = N / BM; nwg = nM * nN; G = G_; c = c_; }
    __device__ bool next(int i, Unit& u) const {
        const long L = (long)i * G + c; if (L >= nwg) return false;
        int wgid = (int)L; { const int q = nwg / NXCD, r = nwg % NXCD, xcd = wgid % NXCD, off = wgid / NXCD; wgid = (xcd < r ? xcd * (q + 1) : r * (q + 1) + (xcd - r) * q) + off; }
        const int nig = WGM * nN, gid = wgid / nig, fm = gid * WGM, gsz = (nM - fm) < WGM ? (nM - fm) : WGM;
        u.pm = fm + ((wgid % nig) % gsz); u.pn = (wgid % nig) / gsz; u.e = 0; return true;
    }
    __device__ __forceinline__ void a_ready(const Unit&) const {}
    __device__ __forceinline__ void done(const Unit&) const {}
};
struct MoeOrder {
    int nM, nN, nwg, G, c; int t1, t2, t3, t4, t5, t6, t7;
    __device__ bool next(int i, Unit& u) const {
        const long L = (long)i * G + c; if (L >= nwg) return false;
        int wgid = (int)L; { const int q = nwg / NXCD, r = nwg % NXCD, xcd = wgid % NXCD, off = wgid / NXCD; wgid = (xcd < r ? xcd * (q + 1) : r * (q + 1) + (xcd - r) * q) + off; }
        const int nig = WGM * nN, gid = wgid / nig, fm = gid * WGM, gsz = (nM - fm) < WGM ? (nM - fm) : WGM;
        u.pm = fm + ((wgid % nig) % gsz); u.pn = (wgid % nig) / gsz;
        const int p = u.pm; u.e = (p >= t1) + (p >= t2) + (p >= t3) + (p >= t4) + (p >= t5) + (p >= t6) + (p >= t7); return true;
    }
    __device__ __forceinline__ void a_ready(const Unit&) const {}
    __device__ __forceinline__ void done(const Unit&) const {}
};

__device__ __forceinline__ unsigned cvt_pk_bf16(float lo, float hi) { unsigned r; asm volatile("v_cvt_pk_bf16_f32 %0, %1, %2" : "=v"(r) : "v"(lo), "v"(hi)); return r; }
typedef int v8i __attribute__((ext_vector_type(8))); typedef int v4i __attribute__((ext_vector_type(4)));
__device__ __forceinline__ v8i cat8(bf16x8 lo, bf16x8 hi) { const v4i a = __builtin_bit_cast(v4i, lo), b = __builtin_bit_cast(v4i, hi); return __builtin_shufflevector(a, b, 0, 1, 2, 3, 4, 5, 6, 7); }
__device__ __forceinline__ unsigned pk4_fp8(float a, float b, float c, float d) { int w = __builtin_amdgcn_cvt_pk_fp8_f32(a, b, 0, false); w = __builtin_amdgcn_cvt_pk_fp8_f32(c, d, w, true); return (unsigned)w; }
__device__ __forceinline__ float sigm(float x) { return __builtin_amdgcn_rcpf(1.f + __builtin_amdgcn_exp2f(-1.4426950408889634f * x)); }
__device__ __forceinline__ u32x4 pack8(f32x4 v0, f32x4 v1) { u32x4 w; w.x = cvt_pk_bf16(v0[0], v0[1]); w.y = cvt_pk_bf16(v0[2], v0[3]); w.z = cvt_pk_bf16(v1[0], v1[1]); w.w = cvt_pk_bf16(v1[2], v1[3]); return w; }

struct EpiBf16 {
    static constexpr bool PERM = true, AFTER_DRAIN = false;
    bf16_t* O; int ldc; float scale;
    __device__ __forceinline__ void operator()(const f32x4 (&acc)[2][2][4][2], const Unit& u, int wr, int wc, int fr, int fq) const {
        const int row0 = u.pm * BM + wr * 64 + fr; const int col0 = u.pn * BM + wc * 32 + 8 * fq;
#pragma unroll
        for (int ai = 0; ai < 2; ++ai)
#pragma unroll
            for (int m = 0; m < 4; ++m) { bf16_t* rowp = O + (size_t)(row0 + ai * HALF + m * 16) * ldc + col0;
#pragma unroll
                for (int bj = 0; bj < 2; ++bj) *(u32x4*)(rowp + bj * HALF) = pack8(acc[ai][bj][m][0] * scale, acc[ai][bj][m][1] * scale); }
    }
};
struct EpiInProj {
    static constexpr bool PERM = true, AFTER_DRAIN = false;
    bf16_t *Z, *Q, *Kt; const float *qg, *kg; float qscale;
    __device__ __forceinline__ void operator()(const f32x4 (&acc)[2][2][4][2], const Unit& u, int wr, int wc, int fr, int fq) const {
        const int row0 = u.pm * BM + wr * 64 + fr;
        if (u.pn < 4) {
            const int col0 = u.pn * 128 + wc * 32 + 8 * fq;
#pragma unroll
            for (int ai = 0; ai < 2; ++ai)
#pragma unroll
                for (int m = 0; m < 4; ++m) { f32x4 z0, z1;
#pragma unroll
                    for (int i = 0; i < 4; ++i) { z0[i] = acc[ai][0][m][0][i] * sigm(acc[ai][1][m][0][i]); z1[i] = acc[ai][0][m][1][i] * sigm(acc[ai][1][m][1][i]); }
                    *(u32x4*)(Z + (size_t)(row0 + ai * HALF + m * 16) * 512 + col0) = pack8(z0, z1); }
        } else {
            const bool isq = u.pn < 6; bf16_t* O = isq ? Q : Kt; const float* gv = isq ? qg : kg; const float sc = isq ? qscale : 1.f;
            const int head = 4 * (u.pn & 1) + wc;
            f32x4 gw[2][2];
#pragma unroll
            for (int bj = 0; bj < 2; ++bj)
#pragma unroll
                for (int n = 0; n < 2; ++n) gw[bj][n] = *(const f32x4*)(gv + 32 * bj + 8 * fq + 4 * n) * sc;
#pragma unroll
            for (int ai = 0; ai < 2; ++ai)
#pragma unroll
                for (int m = 0; m < 4; ++m) { float ss = 0.f;
#pragma unroll
                    for (int bj = 0; bj < 2; ++bj)
#pragma unroll
                        for (int n = 0; n < 2; ++n) { const f32x4 x = acc[ai][bj][m][n]; ss += (x[0] * x[0] + x[1] * x[1]) + (x[2] * x[2] + x[3] * x[3]); }
                    ss += __shfl_xor(ss, 16); ss += __shfl_xor(ss, 32);
                    const float r = __builtin_amdgcn_rsqf(ss * (1.f / 64.f) + 1e-6f);
                    bf16_t* rowp = O + (size_t)(row0 + ai * HALF + m * 16) * 512 + head * 64 + 8 * fq;
#pragma unroll
                    for (int bj = 0; bj < 2; ++bj) *(u32x4*)(rowp + 32 * bj) = pack8(acc[ai][bj][m][0] * r * gw[bj][0], acc[ai][bj][m][1] * r * gw[bj][1]); }
        }
    }
};
struct EpiResGate {
    static constexpr bool PERM = false, AFTER_DRAIN = false;
    const float* xin; float* out; const float* gate;
    __device__ __forceinline__ void operator()(const f32x4 (&acc)[2][2][4][2], const Unit& u, int wr, int wc, int fr, int fq) const {
        const int row0 = u.pm * BM + wr * 64 + fr, col0 = u.pn * BM + wc * 32 + 4 * fq; const float* gp = gate + (size_t)(u.pm >> 3) * 6144 + col0;
        f32x4 gv[2][2];
#pragma unroll
        for (int bj = 0; bj < 2; ++bj)
#pragma unroll
            for (int n = 0; n < 2; ++n) gv[bj][n] = *(const f32x4*)(gp + bj * HALF + n * 16);
#pragma unroll
        for (int ai = 0; ai < 2; ++ai)
#pragma unroll
            for (int m = 0; m < 4; ++m) { const size_t off = (size_t)(row0 + ai * HALF + m * 16) * 1024 + col0;
#pragma unroll
                for (int bj = 0; bj < 2; ++bj)
#pragma unroll
                    for (int n = 0; n < 2; ++n) { const f32x4 xv = *(const f32x4*)(xin + off + bj * HALF + n * 16); *(f32x4*)(out + off + bj * HALF + n * 16) = xv + gv[bj][n] * acc[ai][bj][m][n]; } }
    }
};
template <bool F8OUT> struct EpiSwiGLU {
    static constexpr bool PERM = true, AFTER_DRAIN = false;
    bf16_t* O; int ldc; const float* rowscale; float oscale, iscale;
    __device__ __forceinline__ void operator()(const f32x4 (&acc)[2][2][4][2], const Unit& u, int wr, int wc, int fr, int fq) const {
        const int row0 = u.pm * BM + wr * 64 + fr; const int col0 = u.pn * 128 + wc * 32 + 8 * fq;
#pragma unroll
        for (int ai = 0; ai < 2; ++ai)
#pragma unroll
            for (int m = 0; m < 4; ++m) { const int row = row0 + ai * HALF + m * 16; const float rs = (rowscale ? rowscale[row] : 1.f) * oscale;   f32x4 z0, z1;
#pragma unroll
                for (int i = 0; i < 4; ++i) { const float g0 = acc[ai][0][m][0][i] * iscale, g1 = acc[ai][0][m][1][i] * iscale;
                    z0[i] = g0 * sigm(g0) * acc[ai][1][m][0][i] * rs; z1[i] = g1 * sigm(g1) * acc[ai][1][m][1][i] * rs; }
                if constexpr (F8OUT) { typedef unsigned u32x2 __attribute__((ext_vector_type(2))); u32x2 w; w.x = pk4_fp8(z0[0], z0[1], z0[2], z0[3]); w.y = pk4_fp8(z1[0], z1[1], z1[2], z1[3]);
                    *(u32x2*)((unsigned char*)O + (size_t)row * ldc + col0) = w; }
                else *(u32x4*)(O + (size_t)row * ldc + col0) = pack8(z0, z1); }
    }
};
struct EpiNone {
    static constexpr bool PERM = true, AFTER_DRAIN = false;
    __device__ __forceinline__ void operator()(const f32x4 (&acc)[2][2][4][2], const Unit& u, int wr, int wc, int fr, int fq) const {
#pragma unroll
        for (int ai = 0; ai < 2; ++ai)
#pragma unroll
            for (int bj = 0; bj < 2; ++bj)
#pragma unroll
                for (int m = 0; m < 4; ++m)
#pragma unroll
                    for (int n = 0; n < 2; ++n) asm volatile("" :: "v"(acc[ai][bj][m][n]));
    }
};
__device__ __forceinline__ const char* uptr(const char* p) { unsigned long long v = (unsigned long long)p; const unsigned lo = __builtin_amdgcn_readfirstlane((unsigned)v), hi = __builtin_amdgcn_readfirstlane((unsigned)(v >> 32)); unsigned long long r = ((unsigned long long)hi << 32) | lo; asm volatile("" : "+s"(r)); return (const char*)r; }
template <class Epi, class Sched, bool ALIGN_EPI = false, bool SP2 = false, bool FP8 = false>
__device__ __forceinline__ void gemm_phase(PG8_LAS unsigned char* lds, const Gemm g, const Sched& S, const Epi& E) {
    int tid_ = threadIdx.x; asm volatile("" : "+v"(tid_)); const int tid = tid_, wid = __builtin_amdgcn_readfirstlane(tid >> 6), lane = tid & 63, wr = wid >> 2, wc = wid & 3, fr = lane & 15, fq = lane >> 4;
    const int KB = FP8 ? g.K : g.K * 2, nt = KB / (BK * 2);
    unsigned voffA, voffB;
    { int R, C; stage_rc(tid * 16, R, C); const int Rb = Epi::PERM ? ((R & ~31) + perm32(R & 31)) : R;
        voffA = (unsigned)(R * KB + C * 2); voffB = (unsigned)(Rb * KB + C * 2); }
    const unsigned pstep = 64u * KB;
    constexpr unsigned kstep = BK * 2;
    const unsigned hstep = (unsigned)HALF * KB;
    const unsigned tstep = 2 * hstep;
    const unsigned ldsw = (unsigned)wid * 1024u;
    const int aoff = lds_byte(wr * 64 + fr, fq * 8), boff = lds_byte(wc * 32 + fr, fq * 8);
#define PG8_SA(b, h) (((b) * 2 + (h)) * HTB)
#define PG8_SB(b, h) ((4 + (b) * 2 + (h)) * HTB)
#define PG8_STAGE(bufoff, gbase, voff) do { unsigned vo_ = (voff); asm volatile("" : "+v"(vo_));   \
        _Pragma("unroll") for (int _i = 0; _i < 2; ++_i) \
        __builtin_amdgcn_global_load_lds((const unsigned*)((const char*)(gbase) + _i * pstep + vo_), (PG8_LAS unsigned*)(lds + (bufoff) + ldsw + _i * 8192), 16, 0, 0); } while (0)
#define PG8_LDA(dst, b, h) do { _Pragma("unroll") for (int m = 0; m < 4; ++m) { if constexpr (FP8) { const v4i lo_ = *(const PG8_LAS v4i*)(lds + PG8_SA(b, h) + aoff + m * 2048), hi_ = *(const PG8_LAS v4i*)(lds + PG8_SA(b, h) + aoff + m * 2048 + 1024); dst##8[m] = __builtin_shufflevector(lo_, hi_, 0, 1, 2, 3, 4, 5, 6, 7); } \
        else { _Pragma("unroll") for (int k = 0; k < 2; ++k) dst[m][k] = *(const PG8_LAS bf16x8*)(lds + PG8_SA(b, h) + aoff + m * 2048 + k * 1024); } } } while (0)
#define PG8_LDB(dst, b, h) do { _Pragma("unroll") for (int n = 0; n < 2; ++n) { if constexpr (FP8) { const v4i lo_ = *(const PG8_LAS v4i*)(lds + PG8_SB(b, h) + boff + n * 2048), hi_ = *(const PG8_LAS v4i*)(lds + PG8_SB(b, h) + boff + n * 2048 + 1024); dst##8[n] = __builtin_shufflevector(lo_, hi_, 0, 1, 2, 3, 4, 5, 6, 7); } \
        else { _Pragma("unroll") for (int k = 0; k < 2; ++k) dst[n][k] = *(const PG8_LAS bf16x8*)(lds + PG8_SB(b, h) + boff + n * 2048 + k * 1024); } } } while (0)
#define PG8_MMA(ai, bj, At, Bt) do { __builtin_amdgcn_s_setprio(1); _Pragma("unroll") for (int m = 0; m < 4; ++m) _Pragma("unroll") for (int n = 0; n < 2; ++n) { \
        if constexpr (FP8) asm volatile("v_mfma_f32_16x16x128_f8f6f4 %0, %1, %2, %0" : "+v"(acc[ai][bj][m][n]) : "v"(Bt##8[n]), "v"(At##8[m]));   \
        else { _Pragma("unroll") for (int k = 0; k < 2; ++k) acc[ai][bj][m][n] = __builtin_amdgcn_mfma_f32_16x16x32_bf16(Bt[n][k], At[m][k], acc[ai][bj][m][n], 0, 0, 0); } } \
        __builtin_amdgcn_s_setprio(0); } while (0)
#define PG8_WAIT_V(n) asm volatile("s_waitcnt vmcnt(" #n ")" ::: "memory")
#define PG8_WAIT_L(n) asm volatile("s_waitcnt lgkmcnt(" #n ")" ::: "memory")
#define PG8_BAR __builtin_amdgcn_s_barrier()
#define PG8_SCHED __builtin_amdgcn_sched_barrier(0)
    Unit cur, nxt; int ui = 0;
    if (!S.next(0, cur)) return;
    f32x4 acc[2][2][4][2];
#pragma unroll
    for (int a = 0; a < 2; ++a)
#pragma unroll
        for (int b = 0; b < 2; ++b)
#pragma unroll
            for (int m = 0; m < 4; ++m)
#pragma unroll
                for (int n = 0; n < 2; ++n) acc[a][b][m][n] = (f32x4){0.f, 0.f, 0.f, 0.f};
    bf16x8 At[4][2], B0[2][2], B1[2][2]; v8i At8[4], B08[2], B18[2];
    const char* cA = (const char*)g.A + (unsigned)cur.pm * tstep; const char* cB = (const char*)g.Bt + (unsigned)cur.e * g.bstride + (unsigned)cur.pn * tstep;
    S.a_ready(cur);
    if constexpr (SP2) {
        PG8_STAGE(PG8_SB(0, 0), cB, voffB); PG8_STAGE(PG8_SB(0, 1), cB + hstep, voffB); PG8_STAGE(PG8_SA(0, 0), cA, voffA); PG8_STAGE(PG8_SA(0, 1), cA + hstep, voffA);
        if (wr == 1) PG8_BAR;
        PG8_WAIT_V(2); PG8_BAR;
        PG8_STAGE(PG8_SB(1, 0), cB + kstep, voffB); PG8_STAGE(PG8_SA(1, 0), cA + kstep, voffA); PG8_STAGE(PG8_SB(1, 1), cB + hstep + kstep, voffB);
        PG8_WAIT_V(6); PG8_BAR;
    } else {
        PG8_STAGE(PG8_SB(0, 0), cB, voffB); PG8_STAGE(PG8_SA(0, 0), cA, voffA); PG8_STAGE(PG8_SB(0, 1), cB + hstep, voffB); PG8_STAGE(PG8_SA(0, 1), cA + hstep, voffA);
        if (wr == 1) PG8_BAR;
        PG8_WAIT_V(4); PG8_BAR;
        PG8_STAGE(PG8_SB(1, 0), cB + kstep, voffB); PG8_STAGE(PG8_SA(1, 0), cA + kstep, voffA); PG8_STAGE(PG8_SB(1, 1), cB + hstep + kstep, voffB);
        PG8_WAIT_V(6); PG8_BAR;
    }
    for (;;) {
        const bool has_next = S.next(ui + 1, nxt);
        const char* nA = has_next ? (const char*)g.A + (unsigned)nxt.pm * tstep : cA; const char* nB = has_next ? (const char*)g.Bt + (unsigned)nxt.e * g.bstride + (unsigned)nxt.pn * tstep : cB;
#pragma unroll 1
        for (int t = 0; t < nt; t += 2) {
            const bool last = (t == nt - 2);
            const char* a1 = cA + (unsigned)(t + 1) * kstep;
            const char* a2 = last ? nA : cA + (unsigned)(t + 2) * kstep; const char* b2 = last ? nB : cB + (unsigned)(t + 2) * kstep;
            const char* a3 = a2 + kstep; const char* b3 = b2 + kstep;
            a1 = uptr(a1); a2 = uptr(a2); b2 = uptr(b2); a3 = uptr(a3); b3 = uptr(b3);
            if (last && has_next) S.a_ready(nxt);
            if constexpr (SP2) {
            PG8_LDB(B0, 0, 0); PG8_LDB(B1, 0, 1); PG8_SCHED; PG8_LDA(At, 0, 0); PG8_STAGE(PG8_SA(1, 1), a1 + hstep, voffA);
            PG8_WAIT_V(8); PG8_WAIT_L(0); PG8_BAR; PG8_MMA(0, 0, At, B0); PG8_MMA(0, 1, At, B1); PG8_BAR; PG8_SCHED;
            PG8_LDA(At, 0, 1); PG8_STAGE(PG8_SB(0, 0), b2, voffB); PG8_STAGE(PG8_SB(0, 1), b2 + hstep, voffB); PG8_STAGE(PG8_SA(0, 0), a2, voffA);
            PG8_WAIT_V(8); PG8_WAIT_L(0); PG8_BAR; PG8_MMA(1, 0, At, B0); PG8_MMA(1, 1, At, B1); PG8_BAR; PG8_SCHED;
            PG8_LDB(B0, 1, 0); PG8_LDB(B1, 1, 1); PG8_SCHED; PG8_LDA(At, 1, 0); PG8_STAGE(PG8_SA(0, 1), a2 + hstep, voffA);
            PG8_WAIT_V(8); PG8_WAIT_L(0); PG8_BAR; PG8_MMA(0, 0, At, B0); PG8_MMA(0, 1, At, B1); PG8_BAR; PG8_SCHED;
            PG8_LDA(At, 1, 1); PG8_STAGE(PG8_SB(1, 0), b3, voffB); PG8_STAGE(PG8_SB(1, 1), b3 + hstep, voffB); PG8_STAGE(PG8_SA(1, 0), a3, voffA);
            PG8_WAIT_V(8); PG8_WAIT_L(0); PG8_BAR; PG8_MMA(1, 0, At, B0); PG8_MMA(1, 1, At, B1); PG8_BAR; PG8_SCHED;
            } else {
            PG8_LDB(B0, 0, 0); PG8_SCHED; PG8_LDA(At, 0, 0); PG8_STAGE(PG8_SA(1, 1), a1 + hstep, voffA);
            PG8_WAIT_L(8); PG8_BAR; PG8_WAIT_L(0); PG8_MMA(0, 0, At, B0); PG8_BAR; PG8_SCHED;
            PG8_LDB(B1, 0, 1); PG8_STAGE(PG8_SB(0, 0), b2, voffB);
            PG8_BAR; PG8_WAIT_L(0); PG8_MMA(0, 1, At, B1); PG8_BAR;
            PG8_LDA(At, 0, 1); PG8_STAGE(PG8_SA(0, 0), a2, voffA);
            PG8_BAR; PG8_WAIT_L(0); PG8_MMA(1, 0, At, B0); PG8_BAR; PG8_SCHED;
            PG8_STAGE(PG8_SB(0, 1), b2 + hstep, voffB);
            PG8_WAIT_V(6); PG8_BAR; PG8_MMA(1, 1, At, B1); PG8_BAR;
            PG8_LDB(B0, 1, 0); PG8_SCHED; PG8_LDA(At, 1, 0); PG8_STAGE(PG8_SA(0, 1), a2 + hstep, voffA);
            PG8_WAIT_L(8); PG8_BAR; PG8_WAIT_L(0); PG8_MMA(0, 0, At, B0); PG8_BAR; PG8_SCHED;
            PG8_LDB(B1, 1, 1); PG8_STAGE(PG8_SB(1, 0), b3, voffB);
            PG8_BAR; PG8_WAIT_L(0); PG8_MMA(0, 1, At, B1); PG8_BAR;
            PG8_LDA(At, 1, 1); PG8_STAGE(PG8_SA(1, 0), a3, voffA);
            PG8_BAR; PG8_WAIT_L(0); PG8_MMA(1, 0, At, B0); PG8_BAR; PG8_SCHED;
            PG8_STAGE(PG8_SB(1, 1), b3 + hstep, voffB);
            PG8_WAIT_V(6); PG8_BAR; PG8_MMA(1, 1, At, B1); PG8_BAR;
            }
        }
        if constexpr (FP8) asm volatile("s_nop 15\n\ts_nop 15" ::: "memory");
        if constexpr (ALIGN_EPI) { if (wr == 0) PG8_BAR; }
        if constexpr (!Epi::AFTER_DRAIN) { int l_ = threadIdx.x; asm volatile("" : "+v"(l_)); const int fr_ = l_ & 15, fq_ = (l_ >> 4) & 3; E(acc, cur, wr, wc, fr_, fq_); S.done(cur); }
        if (!has_next) break;
#pragma unroll
        for (int a = 0; a < 2; ++a)
#pragma unroll
            for (int b = 0; b < 2; ++b)
#pragma unroll
                for (int m = 0; m < 4; ++m)
#pragma unroll
                    for (int n = 0; n < 2; ++n) acc[a][b][m][n] = (f32x4){0.f, 0.f, 0.f, 0.f};
        cur = nxt; cA = nA; cB = nB; ++ui;
        if constexpr (ALIGN_EPI) { if (wr == 1) PG8_BAR; }
    }
    PG8_WAIT_V(0);
    if constexpr (!ALIGN_EPI) { if (wr == 0) PG8_BAR; }
    PG8_BAR;
    if constexpr (Epi::AFTER_DRAIN) { E.fused(acc, cur, wr, wc, fr, fq, lds, wid, lane); S.done(cur); }
#undef PG8_SA
#undef PG8_SB
#undef PG8_STAGE
#undef PG8_LDA
#undef PG8_LDB
#undef PG8_MMA
#undef PG8_WAIT_V
#undef PG8_WAIT_L
#undef PG8_BAR
#undef PG8_SCHED
}
}

namespace fk {
using pg8::bf16_t; using pg8::bf16x8; using pg8::f32x4; using pg8::u32x4;
constexpr int NWAVES = 8, NTHR = 512, GRID = 256, NGW = GRID * NWAVES;
constexpr int B_ = 8, S_ = 2048, D = 1024, M = B_ * S_, DIN = 2560, DC = 512, FFD = 2816, NE = 8, FFE = 3584, CW = 31, NREL = 257;
constexpr float LOG2E = 1.4426950408889634f, QSCALE = 0.125f * LOG2E, EPS = 1e-6f;
constexpr size_t MiB = 1u << 20;
constexpr size_t WS_CTL = 0, CTL_ZERO_BYTES = 1 * MiB;
constexpr size_t WS_MODP = 1 * MiB;
constexpr size_t WS_MOD = 4 * MiB;
constexpr size_t WS_PAIR = 4 * MiB + 512 * 1024;
constexpr size_t WS_LIST = 5 * MiB;
constexpr size_t WS_WL = 5 * MiB + 512 * 1024;
constexpr size_t WS_WLG = 6 * MiB;
constexpr size_t WS_WMGU = 8 * MiB;
constexpr size_t WS_WMD = 120 * MiB;
constexpr size_t WS_WIN = 176 * MiB;
constexpr size_t WS_WOUT = 186 * MiB;
constexpr size_t WS_WGU = 190 * MiB;
constexpr size_t WS_WD = 201 * MiB;
constexpr size_t WS_H = 207 * MiB;
constexpr size_t WS_Z = 239 * MiB, WS_Q = 255 * MiB, WS_K = 271 * MiB, WS_VT = 287 * MiB;
constexpr size_t WS_YC = 303 * MiB;
constexpr size_t WS_ACT = 239 * MiB;
constexpr size_t WS_HG = 64 * MiB;
constexpr size_t WS_F = 176 * MiB;
constexpr size_t WS_ACTM = 244 * MiB;
constexpr size_t WS_END = 482 * MiB;
constexpr int MAXROWS = 34816;
constexpr int CW_BAR = 4096, CW_CNT = 16384;
constexpr int RING_BYTES = 131072, LDSCTL_OFF = RING_BYTES, MISC_OFF = LDSCTL_OFF + 320, MOETAB_OFF = LDSCTL_OFF + 512;
constexpr int LDS_BYTES = 147456;

#define GAS __attribute__((address_space(1)))
#define LAS __attribute__((address_space(3)))
typedef unsigned short bf16;
typedef unsigned v4u __attribute__((ext_vector_type(4)));
typedef unsigned v2u __attribute__((ext_vector_type(2)));
typedef float f32x16 __attribute__((ext_vector_type(16)));
typedef short s16x4 __attribute__((ext_vector_type(4)));
typedef float f32x2_t __attribute__((ext_vector_type(2))); typedef __bf16 bf16x2_t __attribute__((ext_vector_type(2)));
__device__ __forceinline__ unsigned pk2(float lo, float hi) { f32x2_t v = {lo, hi}; bf16x2_t b = __builtin_convertvector(v, bf16x2_t); return __builtin_bit_cast(unsigned, b); }
__device__ __forceinline__ float bf2f(bf16 v) { return __uint_as_float((unsigned)v << 16); }
__device__ __forceinline__ float wave_sum(float v) {
#pragma unroll
    for (int o = 1; o < 64; o <<= 1) v += __shfl_xor(v, o);
    return v;
}
__device__ __forceinline__ float sigm(float x) { return __builtin_amdgcn_rcpf(1.f + __builtin_amdgcn_exp2f(-LOG2E * x)); }
using pg8::pk4_fp8;
constexpr float W8_SCALE = 64.f, H8_SCALE = 8.f, A8_SCALE = 4.f;
constexpr int E8_W = (127 - 6) * 0x01010101, E8_H = (127 - 3) * 0x01010101, E8_A = (127 - 2) * 0x01010101;
#define LDS_WAIT() asm volatile("s_waitcnt lgkmcnt(0)" ::: "memory")
#define RFL(x) __builtin_amdgcn_readfirstlane(x)

#define XB_TMO      128
#define XB_XCNT(j)  (256  + 64 * (j))
#define XB_XSUB(j)  (1280 + 64 * (j))
#define XB_XGEN(j)  (2304 + 64 * (j))
#define XB_TOP      3328
#define XB_TOPGEN   3392
#define XCD_BAR_WORDS 3456
#define XB_SPIN_CAP (1u << 18)

__device__ __forceinline__ unsigned xb_ld(unsigned* p)              { return __hip_atomic_load(p, __ATOMIC_RELAXED, __HIP_MEMORY_SCOPE_AGENT); }
__device__ __forceinline__ unsigned xb_add(unsigned* p, unsigned v) { return __hip_atomic_fetch_add(p, v, __ATOMIC_RELAXED, __HIP_MEMORY_SCOPE_AGENT); }
__device__ __forceinline__ unsigned xb_xcc_id() { return (unsigned)__builtin_amdgcn_s_getreg((3 << 11) | 20) & 0xFu; }
#define XB_SPIN(cond, bar) do { unsigned _sp = 0; while (cond) { __builtin_amdgcn_s_sleep(1); \
    if ((++_sp & 255u) == 0u) { if (xb_ld(&(bar)[XB_TMO])) break; if (_sp > XB_SPIN_CAP) { atomicAdd(&(bar)[XB_TMO], 1u); break; } } } } while (0)

struct XcdBarrier {
    unsigned* bar; unsigned x;
    volatile LAS unsigned* st;
};

__device__ __forceinline__ XcdBarrier xcd_barrier_post(unsigned* bar, volatile LAS unsigned* st) {
    XcdBarrier b; b.bar = bar; b.x = xb_xcc_id(); b.st = st;
    if (threadIdx.x == 0) (void)xb_add(&bar[XB_XCNT(b.x)], 1u);
    return b;
}
__device__ __forceinline__ void xcd_barrier_complete(unsigned* bar, unsigned x, unsigned& nloc, unsigned& nx) {
    const unsigned G = gridDim.x * gridDim.y * gridDim.z;
    unsigned sum, cnt, mine, sp = 0u;
    for (;;) {
        sum = 0u; cnt = 0u; mine = 0u;
#pragma unroll
        for (unsigned j = 0; j < 16; ++j) { const unsigned c = xb_ld(&bar[XB_XCNT(j)]); sum += c; cnt += (c > 0u) ? 1u : 0u; mine = (j == x) ? c : mine; }
        if (sum == G) break;
        __builtin_amdgcn_s_sleep(1);
        if ((++sp & 255u) == 0u) { if (xb_ld(&bar[XB_TMO])) break; if (sp > XB_SPIN_CAP) { atomicAdd(&bar[XB_TMO], 1u); break; } }
    }
    nloc = mine > 0u ? mine : 1u; nx = cnt > 0u ? cnt : 1u;
}

__device__ __forceinline__ void xcd_barrier(const XcdBarrier& b) {
    asm volatile("s_waitcnt vmcnt(0)" ::: "memory");
    __syncthreads();
    if (threadIdx.x == 0) {
        unsigned* bar = b.bar;
        __builtin_amdgcn_s_waitcnt(0);
        unsigned nloc = b.st[0], nx = b.st[1];
        if (nloc == 0u) { xcd_barrier_complete(bar, b.x, nloc, nx); b.st[0] = nloc; b.st[1] = nx; }
        const unsigned old = xb_add(&bar[XB_XSUB(b.x)], 1u);
        const unsigned gen = old / nloc;
        if (old + 1u == (gen + 1u) * nloc) {
            __builtin_amdgcn_fence(__ATOMIC_RELEASE, "agent");
            asm volatile("s_waitcnt vmcnt(0)" ::: "memory");
            const unsigned og = xb_add(&bar[XB_TOP], 1u);
            const unsigned tg = og / nx;
            if (og + 1u == (tg + 1u) * nx) xb_add(&bar[XB_TOPGEN], 1u);
            else XB_SPIN(xb_ld(&bar[XB_TOPGEN]) == tg, bar);
            __builtin_amdgcn_fence(__ATOMIC_ACQUIRE, "agent");
            xb_add(&bar[XB_XGEN(b.x)], 1u);
            asm volatile("s_waitcnt vmcnt(0)" ::: "memory");
        } else {
            XB_SPIN(xb_ld(&bar[XB_XGEN(b.x)]) == gen, bar);
            __builtin_amdgcn_fence(__ATOMIC_ACQUIRE, "agent");
            asm volatile("s_waitcnt vmcnt(0)" ::: "memory");
        }
    }
    __syncthreads();
}


#ifndef REPMASK
#define REPMASK 0
#endif
struct Params { const float* in[23]; float* out; unsigned char* ws; int stop; int pad; };

__device__ __forceinline__ void tr_item(const float* W, int K, int N, bf16* WT, int kb, int nb, int drow0, LAS float* scr, int lane) {
    const int k0 = 64 * kb, n0 = 32 * nb;
#pragma unroll 8
    for (int i = 0; i < 32; ++i) { const int kk = 2 * i + (lane >> 5); scr[kk * 33 + (lane & 31)] = W[(size_t)(k0 + kk) * N + n0 + (lane & 31)]; }
    LDS_WAIT(); asm volatile("" ::: "memory");
    const int c = lane & 7;
#pragma unroll
    for (int j = 0; j < 4; ++j) { const int n = (lane >> 3) + 8 * j; const LAS float* s = scr + (8 * c) * 33 + n;
        v4u o; o.x = pk2(s[0 * 33], s[1 * 33]); o.y = pk2(s[2 * 33], s[3 * 33]); o.z = pk2(s[4 * 33], s[5 * 33]); o.w = pk2(s[6 * 33], s[7 * 33]);
        *(GAS v4u*)(WT + (size_t)(drow0 + n) * K + k0 + 8 * c) = o; }
    LDS_WAIT(); asm volatile("" ::: "memory");
}
__device__ __forceinline__ void tr_item_f8(const float* W, int K, int N, unsigned char* WT, int kb, int nb, int drow0, LAS float* scr, int lane, float scale) {
    const int k0 = 64 * kb, n0 = 32 * nb;
#pragma unroll 8
    for (int i = 0; i < 32; ++i) { const int kk = 2 * i + (lane >> 5); scr[kk * 33 + (lane & 31)] = W[(size_t)(k0 + kk) * N + n0 + (lane & 31)]; }
    LDS_WAIT(); asm volatile("" ::: "memory");
    const int c = lane & 7;
#pragma unroll
    for (int j = 0; j < 4; ++j) { const int n = (lane >> 3) + 8 * j; const LAS float* s = scr + (8 * c) * 33 + n;
        v2u o; o.x = pk4_fp8(s[0 * 33] * scale, s[1 * 33] * scale, s[2 * 33] * scale, s[3 * 33] * scale); o.y = pk4_fp8(s[4 * 33] * scale, s[5 * 33] * scale, s[6 * 33] * scale, s[7 * 33] * scale);
        *(GAS v2u*)(WT + (size_t)(drow0 + n) * K + k0 + 8 * c) = o; }
    LDS_WAIT(); asm volatile("" ::: "memory");
}
__device__ __forceinline__ int rowmap_win(int n0) {
    if (n0 < 512) return 256 * (n0 >> 7) + (n0 & 127);
    if (n0 < 1024) { const int m = n0 - 512; return 256 * (m >> 7) + 128 + (m & 127); }
    if (n0 < 2048) { const int isk = n0 >= 1536; const int m = n0 - (isk ? 1536 : 1024); const int head = m >> 6, bj = (m >> 5) & 1; return 256 * (4 + 2 * isk + (head >> 2)) + 128 * bj + 32 * (head & 3); }
    return n0;
}
__device__ __forceinline__ int rowmap_gu(int n0, int up) { return 256 * (n0 >> 7) + 128 * up + (n0 & 127); }

__device__ __forceinline__ void phase0(const Params& P, LAS unsigned char* lds, int tid, int lane, int wave, int gw) {
    LAS float* cact = (LAS float*)(lds + 69632);
    { const float* c = P.in[1]; for (int i = tid; i < B_ * D; i += NTHR) { const float v = c[i]; cact[i] = v * sigm(v); } }
    __syncthreads();
    {
        const float* w_ada = P.in[2]; float* modp = (float*)(P.ws + WS_MODP);
        for (int it = gw; it < 1536; it += NGW) {
            const int ks = it & 7, jb = (it >> 3) % 96, l = it / 768;
            const float* wp = w_ada + ((size_t)l * D + ks * 128) * 6144 + jb * 64 + lane;
            float acc[8];
#pragma unroll
            for (int b = 0; b < 8; ++b) acc[b] = 0.f;
#pragma unroll 8
            for (int k = 0; k < 128; ++k) { const float w = wp[(size_t)k * 6144];
#pragma unroll
                for (int b = 0; b < 8; ++b) acc[b] += cact[b * D + ks * 128 + k] * w; }
#pragma unroll
            for (int b = 0; b < 8; ++b) modp[(((size_t)ks * 2 + l) * 8 + b) * 6144 + jb * 64 + lane] = acc[b];
        }
    }
    LAS float* scr = (LAS float*)(lds + wave * 8448);
    constexpr int I_WIN = 16 * 80, I_WOUT = 16 * 32, I_FG = 16 * 88, I_FD = 44 * 32, I_MG = 16 * 112, I_MD = 56 * 32;
    constexpr int NITEMS = 2 * I_WIN + 2 * I_WOUT + 2 * I_FG + I_FD + 16 * I_MG + 8 * I_MD;
    for (int it = gw; it < NITEMS; it += NGW) {
        int r = it;
        if (r < 16 * I_MG) { const int mat = r / I_MG, q = r % I_MG, e = mat >> 1, up = mat & 1; const int kb = q / 112, nb = q % 112;
            tr_item_f8((up ? P.in[21] : P.in[20]) + (size_t)e * D * FFE, D, FFE, (unsigned char*)(P.ws + WS_WMGU) + (size_t)e * 7168 * D, kb, nb, rowmap_gu(32 * nb, up), scr, lane, W8_SCALE); continue; }
        r -= 16 * I_MG;
        if (r < 8 * I_MD) { const int e = r / I_MD, q = r % I_MD; const int kb = q / 32, nb = q % 32;
            tr_item_f8(P.in[22] + (size_t)e * FFE * D, FFE, D, (unsigned char*)(P.ws + WS_WMD) + (size_t)e * D * FFE, kb, nb, 32 * nb, scr, lane, W8_SCALE); continue; }
        r -= 8 * I_MD;
        if (r < 2 * I_WIN) { const int l = r / I_WIN, q = r % I_WIN; const int kb = q / 80, nb = q % 80;
            tr_item(P.in[6] + (size_t)l * D * DIN, D, DIN, (bf16*)(P.ws + WS_WIN) + (size_t)l * DIN * D, kb, nb, rowmap_win(32 * nb), scr, lane); continue; }
        r -= 2 * I_WIN;
        if (r < 2 * I_WOUT) { const int l = r / I_WOUT, q = r % I_WOUT; const int kb = q / 32, nb = q % 32;
            tr_item(P.in[7] + (size_t)l * D * D, D, D, (bf16*)(P.ws + WS_WOUT) + (size_t)l * D * D, kb, nb, 32 * nb, scr, lane); continue; }
        r -= 2 * I_WOUT;
        if (r < 2 * I_FG) { const int up = r / I_FG, q = r % I_FG; const int kb = q / 88, nb = q % 88;
            tr_item((up ? P.in[16] : P.in[15]), D, FFD, (bf16*)(P.ws + WS_WGU), kb, nb, rowmap_gu(32 * nb, up), scr, lane); continue; }
        r -= 2 * I_FG;
        { const int kb = r / 32, nb = r % 32; tr_item(P.in[17], FFD, D, (bf16*)(P.ws + WS_WD), kb, nb, 32 * nb, scr, lane); }
    }
}

__device__ __forceinline__ float modp_sum(const float* modp, const float* b_ada, int l, int b, int j) {
    float s = b_ada[l * 6144 + j];
#pragma unroll
    for (int ks = 0; ks < 8; ++ks) s += modp[(((size_t)ks * 2 + l) * 8 + b) * 6144 + j];
    return s;
}
__device__ __forceinline__ void norm_row(const float* xrow, const LAS float* gm, const LAS float* shv, int lane, f32x4 (&h)[4]) {
    const GAS f32x4* xr = (const GAS f32x4*)xrow + lane; float ss = 0.f;
#pragma unroll
    for (int j = 0; j < 4; ++j) { h[j] = xr[64 * j]; ss += (h[j].x * h[j].x + h[j].y * h[j].y) + (h[j].z * h[j].z + h[j].w * h[j].w); }
    const float r = __builtin_amdgcn_rsqf(wave_sum(ss) * (1.f / D) + EPS);
#pragma unroll
    for (int j = 0; j < 4; ++j) { const f32x4 g4 = *(const LAS f32x4*)(gm + 4 * lane + 256 * j), s4 = *(const LAS f32x4*)(shv + 4 * lane + 256 * j); h[j] = h[j] * r * g4 + s4; }
}
__device__ __forceinline__ void store_row_bf16(bf16* orow, int lane, const f32x4 (&h)[4]) {
    GAS v2u* o8 = (GAS v2u*)orow + lane;
#pragma unroll
    for (int j = 0; j < 4; ++j) { v2u w; w.x = pk2(h[j].x, h[j].y); w.y = pk2(h[j].z, h[j].w); o8[64 * j] = w; }
}
__device__ __forceinline__ void norm_phase(const Params& P, LAS unsigned char* lds, const float* xin, const float* gvec, int l, int sh_off, int sc_off, bool from_partials, int tid, int lane, int wave, int wgi) {
    LAS float* gm = (LAS float*)lds; LAS float* shv = (LAS float*)(lds + 4096);
    const float* modp = (const float*)(P.ws + WS_MODP); float* mod = (float*)(P.ws + WS_MOD); const float* b_ada = P.in[3];
    const int b = wgi >> 5;
    if (from_partials) {
        if (tid < 384) { const int idx = wgi * 384 + tid; const int ll = idx / 49152, rem = idx % 49152, bb = rem / 6144, j = rem % 6144; mod[idx] = modp_sum(modp, b_ada, ll, bb, j); }
        for (int c = tid; c < D; c += NTHR) { gm[c] = gvec[c] * (1.f + modp_sum(modp, b_ada, l, b, sc_off + c)); shv[c] = modp_sum(modp, b_ada, l, b, sh_off + c); }
    } else {
        const float* ml = mod + ((size_t)l * 8 + b) * 6144;
        for (int c = tid; c < D; c += NTHR) { gm[c] = gvec[c] * (1.f + ml[sc_off + c]); shv[c] = ml[sh_off + c]; }
    }
    __syncthreads();
    bf16* H = (bf16*)(P.ws + WS_H);
    for (int i = 0; i < 8; ++i) { const int row = wgi * 64 + wave * 8 + i; f32x4 h[4]; norm_row(xin + (size_t)row * D, gm, shv, lane, h); store_row_bf16(H + (size_t)row * D, lane, h); }
    __syncthreads();
}
__device__ __forceinline__ void router_phase(const Params& P, LAS unsigned char* lds, const float* xin, int tid, int lane, int wave, int wgi) {
    LAS float* gm = (LAS float*)lds; LAS float* shv = (LAS float*)(lds + 4096); LAS float* wrT = (LAS float*)(lds + 8192);
    LAS int* pe = (LAS int*)(lds + 40960); LAS float* pw = (LAS float*)(lds + 41472); LAS int* cw = (LAS int*)(lds + 41984); LAS int* baseL = (LAS int*)(lds + 42048);
    const float* mod = (const float*)(P.ws + WS_MOD); const int b = wgi >> 5; const float* ml = mod + ((size_t)1 * 8 + b) * 6144; const float* gvec = P.in[5] + D;
    for (int c = tid; c < D; c += NTHR) { gm[c] = gvec[c] * (1.f + ml[4096 + c]); shv[c] = ml[3072 + c]; }
    { const float* wr = P.in[18]; for (int i = tid; i < D * NE; i += NTHR) { const int c = i >> 3, e = i & 7; wrT[e * D + c] = wr[i]; } }
    __syncthreads();
    const float* br = P.in[19];
    for (int i = 0; i < 8; ++i) { const int rl = wave * 8 + i, row = wgi * 64 + rl; f32x4 h[4]; norm_row(xin + (size_t)row * D, gm, shv, lane, h);
        float lg[8];
#pragma unroll
        for (int e = 0; e < 8; ++e) { float s = 0.f;
#pragma unroll
            for (int j = 0; j < 4; ++j) { const f32x4 w4 = *(const LAS f32x4*)(wrT + e * D + 4 * lane + 256 * j); s += (h[j].x * w4.x + h[j].y * w4.y) + (h[j].z * w4.z + h[j].w * w4.w); }
            lg[e] = wave_sum(s) + br[e]; }
        int e1 = 0; float v1 = lg[0];
#pragma unroll
        for (int e = 1; e < 8; ++e) if (lg[e] > v1) { v1 = lg[e]; e1 = e; }
        int e2 = -1; float v2 = -3.0e38f;
#pragma unroll
        for (int e = 0; e < 8; ++e) if (e != e1 && lg[e] > v2) { v2 = lg[e]; e2 = e; }
        const float p2 = __expf(v2 - v1), inv = 1.f / (1.f + p2);
        if (lane == 0) { pe[2 * rl] = e1; pe[2 * rl + 1] = e2; pw[2 * rl] = inv; pw[2 * rl + 1] = p2 * inv; } }
    __syncthreads();
    int e = 0, rank = 0;
    if (tid < 128) { e = pe[tid];
#pragma unroll
        for (int ee = 0; ee < 8; ++ee) { const unsigned long long mk = __ballot(e == ee); if (e == ee) rank = __popcll(mk & ((1ull << lane) - 1ull)); if (lane == 0) cw[wave * 8 + ee] = __popcll(mk); } }
    __syncthreads();
    if (tid < 8) { const int tot = cw[tid] + cw[8 + tid]; unsigned* cnt = (unsigned*)(P.ws + WS_CTL) + CW_CNT + 64 * tid;
        baseL[tid] = (int)__hip_atomic_fetch_add(cnt, (unsigned)tot, __ATOMIC_RELAXED, __HIP_MEMORY_SCOPE_AGENT); }
    __syncthreads();
    if (tid < 128) { const int slot = baseL[e] + rank + (wave == 1 ? cw[e] : 0); const int token = wgi * 64 + (tid >> 1);
        ((int*)(P.ws + WS_LIST))[e * M + slot] = token; ((float*)(P.ws + WS_WL))[e * M + slot] = pw[tid]; ((int*)(P.ws + WS_PAIR))[token * 2 + (tid & 1)] = e * M + slot; }
    __syncthreads();
}
__device__ __forceinline__ void moe_tables(const Params& P, LAS unsigned char* lds, int tid) {
    LAS int* tab = (LAS int*)(lds + MOETAB_OFF);
    if (tid == 0) { const unsigned* ctl = (const unsigned*)(P.ws + WS_CTL); int rb = 0;
        for (int e = 0; e < 8; ++e) { int c = (int)__hip_atomic_load(ctl + CW_CNT + 64 * e, __ATOMIC_RELAXED, __HIP_MEMORY_SCOPE_AGENT); c = c < 0 ? 0 : (c > M ? M : c); tab[e] = rb; tab[9 + e] = c; rb += (c + 255) & ~255; }
        tab[8] = rb; }
    __syncthreads();
}
__device__ __forceinline__ void gather_phase(const Params& P, LAS unsigned char* lds, const float* xin, int tid, int lane, int wave, int gw) {
    LAS float* gmA = (LAS float*)lds; LAS float* shA = (LAS float*)(lds + 32768); const LAS int* tab = (const LAS int*)(lds + MOETAB_OFF);
    const float* mod1 = (const float*)(P.ws + WS_MOD) + (size_t)8 * 6144; const float* gvec = P.in[5] + D;
    for (int i = tid; i < 8 * D; i += NTHR) { const int b = i >> 10, c = i & 1023; gmA[i] = gvec[c] * (1.f + mod1[b * 6144 + 4096 + c]); shA[i] = mod1[b * 6144 + 3072 + c]; }
    __syncthreads();
    const int ptot = tab[8]; const int* list = (const int*)(P.ws + WS_LIST); const float* wl = (const float*)(P.ws + WS_WL); float* wlg = (float*)(P.ws + WS_WLG); unsigned char* HG = (unsigned char*)(P.ws + WS_HG);
    for (int p = gw; p < ptot; p += NGW) {
        int e = 0;
#pragma unroll
        for (int k = 1; k < 8; ++k) e += (p >= tab[k]);
        const int slot = p - tab[e], cn = tab[9 + e]; const bool valid = slot < cn; const int token = list[e * M + (valid ? slot : cn - 1)]; const int b = token >> 11;
        f32x4 h[4]; norm_row(xin + (size_t)token * D, gmA + b * D, shA + b * D, lane, h);
        { GAS unsigned* o4 = (GAS unsigned*)(HG + (size_t)p * D) + lane;
#pragma unroll
          for (int j = 0; j < 4; ++j) o4[64 * j] = pk4_fp8(h[j].x * H8_SCALE, h[j].y * H8_SCALE, h[j].z * H8_SCALE, h[j].w * H8_SCALE); }
        if (lane == 0) wlg[p] = valid ? wl[e * M + slot] : 0.f;
    }
    __syncthreads();
}
__device__ __forceinline__ void combine_phase(const Params& P, LAS unsigned char* lds, int lane, int gw) {
    const LAS int* tab = (const LAS int*)(lds + MOETAB_OFF); const int* pair = (const int*)(P.ws + WS_PAIR); const bf16* F = (const bf16*)(P.ws + WS_F);
    const float* mod1 = (const float*)(P.ws + WS_MOD) + (size_t)8 * 6144;
    for (int t = gw; t < M; t += NGW) {
        const int pa = pair[2 * t], pb = pair[2 * t + 1]; const int ra = tab[pa >> 14] + (pa & 16383), rb = tab[pb >> 14] + (pb & 16383); const int b = t >> 11;
        const GAS v2u* fa = (const GAS v2u*)(F + (size_t)ra * D) + lane; const GAS v2u* fb = (const GAS v2u*)(F + (size_t)rb * D) + lane;
        GAS f32x4* xo = (GAS f32x4*)(P.out + (size_t)t * D) + lane; const GAS f32x4* g2 = (const GAS f32x4*)(mod1 + b * 6144 + 5120) + lane;
#pragma unroll
        for (int j = 0; j < 4; ++j) { const v2u a = fa[64 * j], c = fb[64 * j]; f32x4 f;
            f.x = __uint_as_float(a.x << 16) + __uint_as_float(c.x << 16); f.y = __uint_as_float(a.x & 0xffff0000u) + __uint_as_float(c.x & 0xffff0000u);
            f.z = __uint_as_float(a.y << 16) + __uint_as_float(c.y << 16); f.w = __uint_as_float(a.y & 0xffff0000u) + __uint_as_float(c.y & 0xffff0000u);
            xo[64 * j] = xo[64 * j] + g2[64 * j] * f; }
    }
}

__device__ __forceinline__ void conv_unit(const bf16* Z, bf16* YC, const float* cw, const float* cb, const float* lg, const float* lb, LAS float* tile, int unit, int tid, int wave, int lane) {
    const int tok0 = unit * 32, tp0 = tok0 & (S_ - 1), c = tid;
    float w[CW];
#pragma unroll
    for (int j = 0; j < CW; ++j) w[j] = cw[j * DC + c];
    const float bias = cb[c];
#pragma unroll
    for (int half = 0; half < 2; ++half) {
        float in[46];
#pragma unroll
        for (int i = 0; i < 46; ++i) { const int dt = 16 * half - 30 + i; const bool ok = tp0 + dt >= 0; const int dtc = ok ? dt : -tp0;
            const float zv = bf2f(Z[(size_t)(tok0 + dtc) * DC + c]); in[i] = ok ? zv : 0.f; }
#pragma unroll
        for (int q = 0; q < 16; ++q) { float a = bias;
#pragma unroll
            for (int j = 0; j < CW; ++j) a += w[j] * in[q + j];
            tile[(16 * half + q) * DC + c] = a; }
    }
    __syncthreads();
    const f32x4 g0 = *(const f32x4*)(lg + lane * 8), g1 = *(const f32x4*)(lg + lane * 8 + 4), b0 = *(const f32x4*)(lb + lane * 8), b1 = *(const f32x4*)(lb + lane * 8 + 4);
#pragma unroll
    for (int tt = 0; tt < 4; ++tt) { const int t = wave * 4 + tt;
        f32x4 v0 = *(const LAS f32x4*)(tile + t * DC + lane * 8), v1 = *(const LAS f32x4*)(tile + t * DC + lane * 8 + 4);
        const float mean = wave_sum((v0.x + v0.y) + (v0.z + v0.w) + (v1.x + v1.y) + (v1.z + v1.w)) * (1.f / DC);
        v0 = v0 - mean; v1 = v1 - mean;
        const float var = wave_sum((v0.x * v0.x + v0.y * v0.y) + (v0.z * v0.z + v0.w * v0.w) + (v1.x * v1.x + v1.y * v1.y) + (v1.z * v1.z + v1.w * v1.w)) * (1.f / DC);
        const float rstd = __builtin_amdgcn_rsqf(var + EPS);
        f32x4 y0 = v0 * rstd * g0 + b0, y1 = v1 * rstd * g1 + b1;
#pragma unroll
        for (int i = 0; i < 4; ++i) { y0[i] = y0[i] * sigm(y0[i]); y1[i] = y1[i] * sigm(y1[i]); }
        v4u o; o.x = pk2(y0.x, y0.y); o.y = pk2(y0.z, y0.w); o.z = pk2(y1.x, y1.y); o.w = pk2(y1.z, y1.w);
        *(GAS v4u*)(YC + (size_t)(tok0 + t) * D + lane * 8) = o; }
    __syncthreads();
}
__device__ __forceinline__ int crow(int r, int hi) { return (r & 3) + 8 * (r >> 2) + 4 * hi; }
#define MFMA32(a, b, c) __builtin_amdgcn_mfma_f32_32x32x16_bf16((a), (b), (c), 0, 0, 0)
__device__ __forceinline__ void attn_unit(const bf16* Q, const bf16* K, const bf16* VT, bf16* YC, const LAS float* btile, float b0, LAS unsigned char* kv, int b, int h, int g, int tid, int wave, int lane) {
    const int r32 = lane & 31, hi = lane >> 5;
    const int n0 = 4 * g, n = n0 + (wave >> 1), qh = wave & 1;
    const size_t rowq = (size_t)b * S_ + n * 64 + qh * 32 + r32;
    bf16x8 qf[4];
#pragma unroll
    for (int d0 = 0; d0 < 4; ++d0) qf[d0] = *(const GAS bf16x8*)(Q + rowq * DC + h * 64 + d0 * 16 + hi * 8);
    float m = -1.0e30f, l = 0.f; f32x16 o0, o1;
#pragma unroll
    for (int r = 0; r < 16; ++r) { o0[r] = 0.f; o1[r] = 0.f; }
    const int kc_lo = n0 - 8 < 0 ? 0 : n0 - 8, ns = n0 + 4 - kc_lo;
    const int lrow = tid >> 3, lc = tid & 7; const int lofs = lrow * 128 + ((lc ^ ((lrow >> 1) & 7)) << 4);
    const bf16* kg = K + ((size_t)b * S_ + lrow) * DC + h * 64 + lc * 8;
    const bf16* vg = VT + (size_t)(h * 64 + lrow) * M + (size_t)b * S_ + lc * 8;
    v4u kreg = *(const GAS v4u*)(kg + (size_t)kc_lo * 64 * DC), vreg = *(const GAS v4u*)(vg + kc_lo * 64);
    *(LAS v4u*)(kv + lofs) = kreg; *(LAS v4u*)(kv + 8192 + lofs) = vreg;
    __syncthreads();
    const int fsw = (r32 >> 1) & 7;
    for (int s = 0; s < ns; ++s) {
        const int kc = kc_lo + s; const LAS unsigned char* buf = kv + (s & 1) * 16384;
        if (s + 1 < ns) { kreg = *(const GAS v4u*)(kg + (size_t)(kc + 1) * 64 * DC); vreg = *(const GAS v4u*)(vg + (kc + 1) * 64); }
        if (kc >= n - 8 && kc <= n) {
#pragma unroll
            for (int kb = 0; kb < 2; ++kb) {
                const int key0 = kc * 64 + kb * 32;
                bf16x8 kf[4];
#pragma unroll
                for (int d0 = 0; d0 < 4; ++d0) kf[d0] = *(const LAS bf16x8*)(buf + (kb * 32 + r32) * 128 + (((2 * d0 + hi) ^ fsw) << 4));
                s16x4 va[2][2][2];
#pragma unroll
                for (int db = 0; db < 2; ++db)
#pragma unroll
                    for (int s2 = 0; s2 < 2; ++s2)
#pragma unroll
                        for (int hf = 0; hf < 2; ++hf) va[db][s2][hf] = *(const LAS s16x4*)(buf + 8192 + (db * 32 + r32) * 128 + (((kb * 4 + 2 * s2 + hf) ^ fsw) << 4) + 8 * hi);
                f32x16 sc; const int jb = (n - kc) * 2 + kb;
                if (n - kc >= 3) {
#pragma unroll
                    for (int r = 0; r < 16; ++r) sc[r] = b0;
                } else { const LAS f32x4* tp = (const LAS f32x4*)(btile + ((qh * 6 + jb) * 4) * 256) + lane;
#pragma unroll
                    for (int q4 = 0; q4 < 4; ++q4) { const f32x4 t4 = tp[q4 * 64]; sc[4 * q4] = t4.x; sc[4 * q4 + 1] = t4.y; sc[4 * q4 + 2] = t4.z; sc[4 * q4 + 3] = t4.w; } }
#pragma unroll
                for (int d0 = 0; d0 < 4; ++d0) sc = MFMA32(kf[d0], qf[d0], sc);
                float mx = sc[0];
#pragma unroll
                for (int r = 1; r < 16; ++r) mx = fmaxf(mx, sc[r]);
                mx = fmaxf(mx, __shfl_xor(mx, 32));
                const float mn = fmaxf(m, mx);
                if (__any(mn > m)) { const float alpha = __builtin_amdgcn_exp2f(m - mn); l *= alpha;
#pragma unroll
                    for (int r = 0; r < 16; ++r) { o0[r] *= alpha; o1[r] *= alpha; } }
                m = mn;
                float ps = 0.f;
#pragma unroll
                for (int r = 0; r < 16; ++r) { sc[r] = __builtin_amdgcn_exp2f(sc[r] - mn); ps += sc[r]; }
                l += ps;
                v4u p0, p1;
                p0.x = pk2(sc[0], sc[1]); p0.y = pk2(sc[2], sc[3]); p0.z = pk2(sc[4], sc[5]); p0.w = pk2(sc[6], sc[7]);
                p1.x = pk2(sc[8], sc[9]); p1.y = pk2(sc[10], sc[11]); p1.z = pk2(sc[12], sc[13]); p1.w = pk2(sc[14], sc[15]);
                const bf16x8 pb0 = __builtin_bit_cast(bf16x8, p0), pb1 = __builtin_bit_cast(bf16x8, p1);
#define VA8(db, s2) (bf16x8){va[db][s2][0][0], va[db][s2][0][1], va[db][s2][0][2], va[db][s2][0][3], va[db][s2][1][0], va[db][s2][1][1], va[db][s2][1][2], va[db][s2][1][3]}
                o0 = MFMA32(VA8(0, 0), pb0, o0); o0 = MFMA32(VA8(0, 1), pb1, o0);
                o1 = MFMA32(VA8(1, 0), pb0, o1); o1 = MFMA32(VA8(1, 1), pb1, o1);
#undef VA8
            }
        }
        if (s + 1 < ns) { LAS unsigned char* nb = kv + ((s + 1) & 1) * 16384; *(LAS v4u*)(nb + lofs) = kreg; *(LAS v4u*)(nb + 8192 + lofs) = vreg; }
        __syncthreads();
    }
    l += __shfl_xor(l, 32); const float il = 1.f / l;
    bf16* yp = YC + rowq * D + DC + h * 64 + 4 * hi;
#pragma unroll
    for (int gq = 0; gq < 4; ++gq) { v2u w0, w1; w0.x = pk2(o0[4 * gq] * il, o0[4 * gq + 1] * il); w0.y = pk2(o0[4 * gq + 2] * il, o0[4 * gq + 3] * il);
        w1.x = pk2(o1[4 * gq] * il, o1[4 * gq + 1] * il); w1.y = pk2(o1[4 * gq + 2] * il, o1[4 * gq + 3] * il);
        *(GAS v2u*)(yp + 8 * gq) = w0; *(GAS v2u*)(yp + 32 + 8 * gq) = w1; }
}
__device__ __forceinline__ void mixer_phase(const Params& P, LAS unsigned char* lds, int l, int tid, int lane, int wave, int wgi) {
    LAS float* tile = (LAS float*)lds; LAS float* biasL = (LAS float*)(lds + 65536); LAS unsigned char* kv = lds + 73728;
    { const float* rb = P.in[14] + l * 8 * NREL; for (int i = tid; i < 8 * NREL; i += NTHR) biasL[i] = rb[i] * LOG2E; }
    __syncthreads();
    const bf16* Z = (const bf16*)(P.ws + WS_Z); const bf16* Q = (const bf16*)(P.ws + WS_Q); const bf16* K = (const bf16*)(P.ws + WS_K); const bf16* VT = (const bf16*)(P.ws + WS_VT); bf16* YC = (bf16*)(P.ws + WS_YC);
    for (int rp = 0; rp < 1 + ((REPMASK >> 20) & 1); ++rp)
    for (int cu = 0; cu < 2; ++cu) conv_unit(Z, YC, P.in[8] + l * CW * DC, P.in[9] + l * DC, P.in[10] + l * DC, P.in[11] + l * DC, tile, wgi * 2 + cu, tid, wave, lane);
    { const int b = wgi >> 5, h = (wgi >> 2) & 7, gp = wgi & 3;
      for (int i = tid; i < 2 * 6 * 16 * 64; i += NTHR) { const int ln = (i >> 2) & 63, r = ((i >> 8) & 3) * 4 + (i & 3), jb = (i >> 10) % 6, qh = i / 6144;
          int rel = -64 * (jb >> 1) + 32 * (jb & 1) - 32 * qh + crow(r, ln >> 5) - (ln & 31); rel = rel < -128 ? -128 : (rel > 128 ? 128 : rel); tile[i] = biasL[h * NREL + rel + 128]; }
      const float b0 = biasL[h * NREL];
      __syncthreads();
      for (int rp = 0; rp < 1 + ((REPMASK >> 21) & 1); ++rp)
      for (int au = 0; au < 2; ++au) attn_unit(Q, K, VT, YC, tile, b0, kv, b, h, au ? 7 - gp : gp, tid, wave, lane); }
    __syncthreads();
}

#define PHASE(k, ...) do { { __VA_ARGS__ } if constexpr ((REPMASK >> (k)) & 1) { xcd_barrier(bar); RETID(); { __VA_ARGS__ } } } while (0)
__global__ void __launch_bounds__(NTHR, 2) fwd(Params P) {
    extern __shared__ __attribute__((aligned(16))) unsigned char lds_raw[];
    LAS unsigned char* lds = (LAS unsigned char*)lds_raw;
    int tid = threadIdx.x, lane = tid & 63, wave = __builtin_amdgcn_readfirstlane(tid >> 6); const int wgi = blockIdx.x; int gw = wgi * NWAVES + wave;
#define RETID() do { tid = threadIdx.x; asm volatile("" : "+v"(tid)); lane = tid & 63; wave = __builtin_amdgcn_readfirstlane(tid >> 6); gw = wgi * NWAVES + wave; } while (0)
    for (int u = tid; u < (LDS_BYTES - LDSCTL_OFF) / 4; u += NTHR) ((LAS unsigned*)(lds + LDSCTL_OFF))[u] = 0u;
    __syncthreads();
    unsigned* ctl = (unsigned*)(P.ws + WS_CTL);
    XcdBarrier bar = xcd_barrier_post(ctl + CW_BAR, (volatile LAS unsigned*)(lds + MISC_OFF) + 8);
    const int stop = P.stop;
#define SEAM(k) do { if (stop == (k)) return; xcd_barrier(bar); RETID(); } while (0)
    bf16* H = (bf16*)(P.ws + WS_H); float* mod = (float*)(P.ws + WS_MOD);

    PHASE(0, phase0(P, lds, tid, lane, wave, gw););                                                      SEAM(0);
    PHASE(1, norm_phase(P, lds, P.in[0], P.in[4], 0, 0, 1024, true, tid, lane, wave, wgi););             SEAM(1);
#define LAYER_COMMON(l, pb, xin) \
    PHASE(2,   \
        const bf16* Wl = (const bf16*)(P.ws + WS_WIN) + (size_t)(l) * DIN * D; \
        { pg8::Gemm g{H, Wl, M, 2048, D, 0}; pg8::StaticOrder S; S.init(M, 2048, GRID, wgi); \
          pg8::EpiInProj E{(bf16*)(P.ws + WS_Z), (bf16*)(P.ws + WS_Q), (bf16*)(P.ws + WS_K), P.in[12] + (l) * 64, P.in[13] + (l) * 64, QSCALE}; \
          pg8::gemm_phase<pg8::EpiInProj, pg8::StaticOrder, true, true>(lds, g, S, E); } \
        { pg8::Gemm g{Wl + (size_t)2048 * D, H, 512, M, D, 0}; pg8::StaticOrder S; S.init(512, M, GRID, wgi); \
          pg8::EpiBf16 E{(bf16*)(P.ws + WS_VT), M, 1.f}; \
          pg8::gemm_phase<pg8::EpiBf16, pg8::StaticOrder, true, true>(lds, g, S, E); } ); \
    SEAM(pb); \
    PHASE(3, mixer_phase(P, lds, (l), tid, lane, wave, wgi);); \
    SEAM((pb) + 1); \
    PHASE(4 + 10 * (l),   \
        pg8::Gemm g{(const bf16*)(P.ws + WS_YC), (const bf16*)(P.ws + WS_WOUT) + (size_t)(l) * D * D, M, D, D, 0}; pg8::StaticOrder S; S.init(M, D, GRID, wgi); \
        pg8::EpiResGate E{(xin), P.out, mod + (size_t)(l) * 8 * 6144 + 2048}; \
        pg8::gemm_phase<pg8::EpiResGate, pg8::StaticOrder, false, true>(lds, g, S, E); ); \
    SEAM((pb) + 2);

    LAYER_COMMON(0, 2, P.in[0])
    PHASE(5, norm_phase(P, lds, P.out, P.in[5], 0, 3072, 4096, false, tid, lane, wave, wgi););          SEAM(5);
    PHASE(6, pg8::Gemm g{H, (const bf16*)(P.ws + WS_WGU), M, 2 * FFD, D, 0}; pg8::StaticOrder S; S.init(M, 2 * FFD, GRID, wgi);
             pg8::EpiSwiGLU<false> E{(bf16*)(P.ws + WS_ACT), FFD, nullptr, 1.f, 1.f};
             pg8::gemm_phase<pg8::EpiSwiGLU<false>, pg8::StaticOrder, true, true>(lds, g, S, E););
    SEAM(6);
    PHASE(30, pg8::Gemm g{(const bf16*)(P.ws + WS_ACT), (const bf16*)(P.ws + WS_WD), M, D, FFD, 0}; pg8::StaticOrder S; S.init(M, D, GRID, wgi);
              pg8::EpiResGate E{P.out, P.out, mod + 5120};
              pg8::gemm_phase<pg8::EpiResGate, pg8::StaticOrder, false, true>(lds, g, S, E););
    SEAM(7);
    PHASE(8, norm_phase(P, lds, P.out, P.in[4] + D, 1, 0, 1024, false, tid, lane, wave, wgi););         SEAM(8);
    LAYER_COMMON(1, 9, P.out)
    PHASE(31, router_phase(P, lds, P.out, tid, lane, wave, wgi););                                       SEAM(12);
    moe_tables(P, lds, tid);
    PHASE(10, gather_phase(P, lds, P.out, tid, lane, wave, gw););                                        SEAM(13);
    {
        const LAS int* tab = (const LAS int*)(lds + MOETAB_OFF);
        const int ptot = RFL(tab[8]);
        PHASE(11, pg8::Gemm g{(const bf16*)(P.ws + WS_HG), (const bf16*)(P.ws + WS_WMGU), ptot, 2 * FFE, D, (unsigned)(2 * FFE * D)};
                  pg8::MoeOrder S; S.nM = ptot >> 8; S.nN = 2 * FFE / 256; S.nwg = S.nM * S.nN; S.G = GRID; S.c = wgi;
                  S.t1 = RFL(tab[1] >> 8); S.t2 = RFL(tab[2] >> 8); S.t3 = RFL(tab[3] >> 8); S.t4 = RFL(tab[4] >> 8); S.t5 = RFL(tab[5] >> 8); S.t6 = RFL(tab[6] >> 8); S.t7 = RFL(tab[7] >> 8);
                  pg8::EpiSwiGLU<true> E{(bf16*)(P.ws + WS_ACTM), FFE, (const float*)(P.ws + WS_WLG), A8_SCALE / (H8_SCALE * W8_SCALE), 1.f / (H8_SCALE * W8_SCALE)};
                  pg8::gemm_phase<pg8::EpiSwiGLU<true>, pg8::MoeOrder, true, true, true>(lds, g, S, E););
        if constexpr ((REPMASK >> 22) & 1) { xcd_barrier(bar); RETID();
                  pg8::Gemm g{(const bf16*)(P.ws + WS_HG), (const bf16*)(P.ws + WS_WMGU), ptot, 2 * FFE, D, (unsigned)(2 * FFE * D)};
                  pg8::MoeOrder S; S.nM = ptot >> 8; S.nN = 2 * FFE / 256; S.nwg = S.nM * S.nN; S.G = GRID; S.c = wgi;
                  S.t1 = RFL(tab[1] >> 8); S.t2 = RFL(tab[2] >> 8); S.t3 = RFL(tab[3] >> 8); S.t4 = RFL(tab[4] >> 8); S.t5 = RFL(tab[5] >> 8); S.t6 = RFL(tab[6] >> 8); S.t7 = RFL(tab[7] >> 8);
                  pg8::EpiNone E{};
                  pg8::gemm_phase<pg8::EpiNone, pg8::MoeOrder, true, true, true>(lds, g, S, E); }
        SEAM(14);
        PHASE(12, pg8::Gemm g{(const bf16*)(P.ws + WS_ACTM), (const bf16*)(P.ws + WS_WMD), ptot, D, FFE, (unsigned)(D * FFE)};
                  pg8::MoeOrder S; S.nM = ptot >> 8; S.nN = D / 256; S.nwg = S.nM * S.nN; S.G = GRID; S.c = wgi;
                  S.t1 = RFL(tab[1] >> 8); S.t2 = RFL(tab[2] >> 8); S.t3 = RFL(tab[3] >> 8); S.t4 = RFL(tab[4] >> 8); S.t5 = RFL(tab[5] >> 8); S.t6 = RFL(tab[6] >> 8); S.t7 = RFL(tab[7] >> 8);
                  pg8::EpiBf16 E{(bf16*)(P.ws + WS_F), D, 1.f / (A8_SCALE * W8_SCALE)};
                  pg8::gemm_phase<pg8::EpiBf16, pg8::MoeOrder, true, true, true>(lds, g, S, E););
        SEAM(15);
        PHASE(29, combine_phase(P, lds, lane, gw););
    }
#undef SEAM
}
static int launch_fast(void* const* d_in, float* out, unsigned char* ws, hipStream_t stream, int stop) {
    static int ready = 0;
    if (ready == 0) {
        if (hipFuncSetAttribute((const void*)fwd, hipFuncAttributeMaxDynamicSharedMemorySize, LDS_BYTES) != hipSuccess) { fprintf(stderr, "kernel_launch: hipFuncSetAttribute failed\n"); ready = -1; return -1; }
        int per_cu = 0; if (hipOccupancyMaxActiveBlocksPerMultiprocessor(&per_cu, (const void*)fwd, NTHR, LDS_BYTES) != hipSuccess || per_cu < 1) fprintf(stderr, "kernel_launch: occupancy query reports %d blocks per CU\n", per_cu);
        (void)hipGetLastError(); ready = 1;
    }
    if (ready < 0) return -1;
    if (hipMemsetAsync(ws + WS_CTL, 0, CTL_ZERO_BYTES, stream) != hipSuccess) return -1;
    Params p{}; for (int i = 0; i < 23; ++i) p.in[i] = (const float*)d_in[i]; p.out = out; p.ws = ws; p.stop = stop; p.pad = 0;
    hipLaunchKernelGGL(fwd, dim3(GRID), dim3(NTHR), LDS_BYTES, stream, p);
    return hipPeekAtLastError() == hipSuccess ? 0 : -1;
}
}
#ifndef DBG_STAGE
#define DBG_STAGE 0
#endif
extern "C" void kernel_launch(void* const* d_in, const int* in_sizes, int n_in, void* d_out, int out_size, void* d_ws, size_t ws_size, hipStream_t stream) {
    if (n_in != 23 || out_size != fk::M * fk::D || ws_size < fk::WS_END) { fprintf(stderr, "kernel_launch: unexpected shapes / workspace (%d inputs, out %d, ws %zu)\n", n_in, out_size, ws_size); return; }
    unsigned char* ws = (unsigned char*)d_ws; float* out = (float*)d_out;
#if DBG_STAGE == 0
    fk::launch_fast(d_in, out, ws, stream, -1);
#else
    constexpr int S = DBG_STAGE; constexpr size_t MiB = 1u << 20;
    float* ckf = (float*)(ws + 390 * MiB); float* acc = (float*)(ws + 389 * MiB);
    int stop = -1; size_t off = 0, n = 0; float scale = 1.f; bool isf32 = false;
    const size_t NM = (size_t)fk::M;
    switch (S) {
        case 1: stop = 1; off = fk::WS_H; n = NM * 1024; break;
        case 2: stop = 2; off = fk::WS_Z; n = NM * 512; break;
        case 3: stop = 2; off = fk::WS_Q; n = NM * 512; scale = 1.f / fk::QSCALE; break;
        case 4: stop = 2; off = fk::WS_K; n = NM * 512; break;
        case 5: stop = 3; off = fk::WS_YC; n = NM * 1024; break;
        case 6: stop = 4; isf32 = true; n = NM * 1024; break;
        case 7: stop = 5; off = fk::WS_H; n = NM * 1024; break;
        case 8: stop = 6; off = fk::WS_ACT; n = NM * 1024; break;
        case 9: stop = 7; isf32 = true; n = NM * 1024; break;
        case 11: stop = 8; off = fk::WS_H; n = NM * 1024; break;
        case 12: stop = 9; off = fk::WS_Z; n = NM * 512; break;
        case 13: stop = 9; off = fk::WS_Q; n = NM * 512; scale = 1.f / fk::QSCALE; break;
        case 14: stop = 9; off = fk::WS_K; n = NM * 512; break;
        case 15: stop = 10; off = fk::WS_YC; n = NM * 1024; break;
        case 16: stop = 11; isf32 = true; n = NM * 1024; break;
        default: stop = -1; isf32 = true; n = NM * 1024; break;
    }
    fk::launch_fast(d_in, out, ws, stream, stop);
    if (isf32) nv::k_copy<<<(unsigned)((n + 255) / 256), 256, 0, stream>>>(out, ckf, n);
    else nv::k_cvt<<<(unsigned)((n + 255) / 256), 256, 0, stream>>>((const unsigned short*)(ws + off), ckf, n, scale);
    hipMemsetAsync(acc, 0, 256, stream);
    nv::forward(d_in, out, ws, stream, S, ckf, acc);
    if (S == 99) nv::k_cmp<<<1024, 256, 0, stream>>>(ckf, out, n, acc);
    nv::k_scale<<<(unsigned)((NM * 1024 + 255) / 256), 256, 0, stream>>>(out, NM * 1024, acc);
#endif
}
```

```cpp
#include <hip/hip_runtime.h>
#include <cstdio>
#include <cstdint>
#define DBG_STAGE 0
#define REPMASK 0
namespace pg8 {
#define PG8_LAS __attribute__((address_space(3)))
typedef unsigned short bf16_t;
typedef short bf16x8 __attribute__((ext_vector_type(8)));
typedef float f32x4 __attribute__((ext_vector_type(4)));
typedef unsigned u32x4 __attribute__((ext_vector_type(4)));
constexpr int BM = 256, BK = 64, HALF = 128, HTB = HALF * BK * 2  , STAGE_BYTES = 8 * HTB, NXCD = 8, WGM = 8;

__host__ __device__ __forceinline__ int lds_byte(int r, int c) { const int st = (r >> 4) * 2 + (c >> 5), rr = r & 15, cc = c & 31, ob = rr * 64 + cc * 2; return st * 1024 + (ob ^ (((ob >> 9) & 1) << 5)); }
__host__ __device__ __forceinline__ void stage_rc(int b, int& R, int& C) { const int st = b / 1024, sb = b % 1024, swz = sb ^ (((sb >> 9) & 1) << 5); R = (st >> 1) * 16 + swz / 64; C = (st & 1) * 32 + (swz % 64) / 2; }
__host__ __device__ __forceinline__ int perm32(int rho) { const int n = rho >> 4, i = rho & 15; return 8 * (i >> 2) + 4 * n + (i & 3); }

struct Unit { int pm, pn, e, pa; };
struct Gemm { const bf16_t* A; const bf16_t* Bt; int M, N, K; unsigned bstride; };

struct StaticOrder {
    int nM, nN, nwg, G, c;
    __device__ void init(int M, int N, int G_, int c_) { nM = M / BM; nN = N / BM; nwg = nM * nN; G = G_; c = c_; }
    __device__ bool next(int i, Unit& u) const {
        const long L = (long)i * G + c; if (L >= nwg) return false;
        int wgid = (int)L; { const int q = nwg / NXCD, r = nwg % NXCD, xcd = wgid % NXCD, off = wgid / NXCD; wgid = (xcd < r ? xcd * (q + 1) : r * (q + 1) + (xcd - r) * q) + off; }
        const int nig = WGM * nN, gid = wgid / nig, fm = gid * WGM, gsz = (nM - fm) < WGM ? (nM - fm) : WGM;
        u.pm = fm + ((wgid % nig) % gsz); u.pn = (wgid % nig) / gsz; u.e = 0; u.pa = u.pm; return true;
    }
    __device__ __forceinline__ void a_ready(const Unit&) const {}
    __device__ __forceinline__ void done(const Unit&) const {}
};
struct MoeOrder {
    int nM, nN, nwg, G, c; int t1, t2, t3, t4, t5, t6, t7; bool capA;
    __device__ bool next(int i, Unit& u) const {
        const long L = (long)i * G + c; if (L >= nwg) return false;
        int wgid = (int)L; { const int q = nwg / NXCD, r = nwg % NXCD, xcd = wgid % NXCD, off = wgid / NXCD; wgid = (xcd < r ? xcd * (q + 1) : r * (q + 1) + (xcd - r) * q) + off; }
        const int nig = WGM * nN, gid = wgid / nig, fm = gid * WGM, gsz = (nM - fm) < WGM ? (nM - fm) : WGM;
        u.pm = fm + ((wgid % nig) % gsz); u.pn = (wgid % nig) / gsz;
        const int p = u.pm; u.e = (p >= t1) + (p >= t2) + (p >= t3) + (p >= t4) + (p >= t5) + (p >= t6) + (p >= t7);
        if (capA) { int ts = 0; ts = p >= t1 ? t1 : ts; ts = p >= t2 ? t2 : ts; ts = p >= t3 ? t3 : ts; ts = p >= t4 ? t4 : ts; ts = p >= t5 ? t5 : ts; ts = p >= t6 ? t6 : ts; ts = p >= t7 ? t7 : ts; u.pa = u.e * 64 + (p - ts); }
        else u.pa = p;
        return true;
    }
    __device__ __forceinline__ void a_ready(const Unit&) const {}
    __device__ __forceinline__ void done(const Unit&) const {}
};

__device__ __forceinline__ unsigned cvt_pk_bf16(float lo, float hi) { unsigned r; asm volatile("v_cvt_pk_bf16_f32 %0, %1, %2" : "=v"(r) : "v"(lo), "v"(hi)); return r; }
typedef int v8i __attribute__((ext_vector_type(8))); typedef int v4i __attribute__((ext_vector_type(4)));
__device__ __forceinline__ v8i cat8(bf16x8 lo, bf16x8 hi) { const v4i a = __builtin_bit_cast(v4i, lo), b = __builtin_bit_cast(v4i, hi); return __builtin_shufflevector(a, b, 0, 1, 2, 3, 4, 5, 6, 7); }
__device__ __forceinline__ unsigned pk4_fp8(float a, float b, float c, float d) { int w = __builtin_amdgcn_cvt_pk_fp8_f32(a, b, 0, false); w = __builtin_amdgcn_cvt_pk_fp8_f32(c, d, w, true); return (unsigned)w; }
__device__ __forceinline__ float sigm(float x) { return __builtin_amdgcn_rcpf(1.f + __builtin_amdgcn_exp2f(-1.4426950408889634f * x)); }
__device__ __forceinline__ u32x4 pack8(f32x4 v0, f32x4 v1) { u32x4 w; w.x = cvt_pk_bf16(v0[0], v0[1]); w.y = cvt_pk_bf16(v0[2], v0[3]); w.z = cvt_pk_bf16(v1[0], v1[1]); w.w = cvt_pk_bf16(v1[2], v1[3]); return w; }

struct EpiBf16 {
    static constexpr bool PERM = true, AFTER_DRAIN = false;
    bf16_t* O; int ldc; float scale;
    __device__ __forceinline__ void operator()(const f32x4 (&acc)[2][2][4][2], const Unit& u, int wr, int wc, int fr, int fq) const {
        const int row0 = u.pm * BM + wr * 64 + fr; const int col0 = u.pn * BM + wc * 32 + 8 * fq;
#pragma unroll
        for (int ai = 0; ai < 2; ++ai)
#pragma unroll
            for (int m = 0; m < 4; ++m) { bf16_t* rowp = O + (size_t)(row0 + ai * HALF + m * 16) * ldc + col0;
#pragma unroll
                for (int bj = 0; bj < 2; ++bj) *(u32x4*)(rowp + bj * HALF) = pack8(acc[ai][bj][m][0] * scale, acc[ai][bj][m][1] * scale); }
    }
};
struct EpiInProj {
    static constexpr bool PERM = true, AFTER_DRAIN = false;
    bf16_t *Z, *Q, *Kt; const float *qg, *kg; float qscale;
    __device__ __forceinline__ void operator()(const f32x4 (&acc)[2][2][4][2], const Unit& u, int wr, int wc, int fr, int fq) const {
        const int row0 = u.pm * BM + wr * 64 + fr;
        if (u.pn < 4) {
            const int col0 = u.pn * 128 + wc * 32 + 8 * fq;
#pragma unroll
            for (int ai = 0; ai < 2; ++ai)
#pragma unroll
                for (int m = 0; m < 4; ++m) { f32x4 z0, z1;
#pragma unroll
                    for (int i = 0; i < 4; ++i) { z0[i] = acc[ai][0][m][0][i] * sigm(acc[ai][1][m][0][i]); z1[i] = acc[ai][0][m][1][i] * sigm(acc[ai][1][m][1][i]); }
                    *(u32x4*)(Z + (size_t)(row0 + ai * HALF + m * 16) * 512 + col0) = pack8(z0, z1); }
        } else {
            const bool isq = u.pn < 6; bf16_t* O = isq ? Q : Kt; const float* gv = isq ? qg : kg; const float sc = isq ? qscale : 1.f;
            const int head = 4 * (u.pn & 1) + wc;
            f32x4 gw[2][2];
#pragma unroll
            for (int bj = 0; bj < 2; ++bj)
#pragma unroll
                for (int n = 0; n < 2; ++n) gw[bj][n] = *(const f32x4*)(gv + 32 * bj + 8 * fq + 4 * n) * sc;
#pragma unroll
            for (int ai = 0; ai < 2; ++ai)
#pragma unroll
                for (int m = 0; m < 4; ++m) { float ss = 0.f;
#pragma unroll
                    for (int bj = 0; bj < 2; ++bj)
#pragma unroll
                        for (int n = 0; n < 2; ++n) { const f32x4 x = acc[ai][bj][m][n]; ss += (x[0] * x[0] + x[1] * x[1]) + (x[2] * x[2] + x[3] * x[3]); }
                    ss += __shfl_xor(ss, 16); ss += __shfl_xor(ss, 32);
                    const float r = __builtin_amdgcn_rsqf(ss * (1.f / 64.f) + 1e-6f);
                    bf16_t* rowp = O + (size_t)(row0 + ai * HALF + m * 16) * 512 + head * 64 + 8 * fq;
#pragma unroll
                    for (int bj = 0; bj < 2; ++bj) *(u32x4*)(rowp + 32 * bj) = pack8(acc[ai][bj][m][0] * r * gw[bj][0], acc[ai][bj][m][1] * r * gw[bj][1]); }
        }
    }
};
struct EpiResGate {
    static constexpr bool PERM = false, AFTER_DRAIN = false;
    const float* xin; float* out; const float* gate;
    __device__ __forceinline__ void operator()(const f32x4 (&acc)[2][2][4][2], const Unit& u, int wr, int wc, int fr, int fq) const {
        const int row0 = u.pm * BM + wr * 64 + fr, col0 = u.pn * BM + wc * 32 + 4 * fq; const float* gp = gate + (size_t)(u.pm >> 3) * 6144 + col0;
        f32x4 gv[2][2];
#pragma unroll
        for (int bj = 0; bj < 2; ++bj)
#pragma unroll
            for (int n = 0; n < 2; ++n) gv[bj][n] = *(const f32x4*)(gp + bj * HALF + n * 16);
#pragma unroll
        for (int ai = 0; ai < 2; ++ai)
#pragma unroll
            for (int m = 0; m < 4; ++m) { const size_t off = (size_t)(row0 + ai * HALF + m * 16) * 1024 + col0;
#pragma unroll
                for (int bj = 0; bj < 2; ++bj)
#pragma unroll
                    for (int n = 0; n < 2; ++n) { const f32x4 xv = *(const f32x4*)(xin + off + bj * HALF + n * 16); *(f32x4*)(out + off + bj * HALF + n * 16) = xv + gv[bj][n] * acc[ai][bj][m][n]; } }
    }
};
template <bool F8OUT> struct EpiSwiGLU {
    static constexpr bool PERM = true, AFTER_DRAIN = false;
    bf16_t* O; int ldc; const float* rowscale; float oscale, iscale;
    __device__ __forceinline__ void operator()(const f32x4 (&acc)[2][2][4][2], const Unit& u, int wr, int wc, int fr, int fq) const {
        const int row0 = u.pm * BM + wr * 64 + fr; const int col0 = u.pn * 128 + wc * 32 + 8 * fq;
#pragma unroll
        for (int ai = 0; ai < 2; ++ai)
#pragma unroll
            for (int m = 0; m < 4; ++m) { const int row = row0 + ai * HALF + m * 16; const float rs = (rowscale ? rowscale[row + (u.pa - u.pm) * BM] : 1.f) * oscale;   f32x4 z0, z1;
#pragma unroll
                for (int i = 0; i < 4; ++i) { const float g0 = acc[ai][0][m][0][i] * iscale, g1 = acc[ai][0][m][1][i] * iscale;
                    z0[i] = g0 * sigm(g0) * acc[ai][1][m][0][i] * rs; z1[i] = g1 * sigm(g1) * acc[ai][1][m][1][i] * rs; }
                if constexpr (F8OUT) { typedef unsigned u32x2 __attribute__((ext_vector_type(2))); u32x2 w; w.x = pk4_fp8(z0[0], z0[1], z0[2], z0[3]); w.y = pk4_fp8(z1[0], z1[1], z1[2], z1[3]);
                    *(u32x2*)((unsigned char*)O + (size_t)row * ldc + col0) = w; }
                else *(u32x4*)(O + (size_t)row * ldc + col0) = pack8(z0, z1); }
    }
};
struct EpiNone {
    static constexpr bool PERM = true, AFTER_DRAIN = false;
    __device__ __forceinline__ void operator()(const f32x4 (&acc)[2][2][4][2], const Unit& u, int wr, int wc, int fr, int fq) const {
#pragma unroll
        for (int ai = 0; ai < 2; ++ai)
#pragma unroll
            for (int bj = 0; bj < 2; ++bj)
#pragma unroll
                for (int m = 0; m < 4; ++m)
#pragma unroll
                    for (int n = 0; n < 2; ++n) asm volatile("" :: "v"(acc[ai][bj][m][n]));
    }
};
__device__ __forceinline__ const char* uptr(const char* p) { unsigned long long v = (unsigned long long)p; const unsigned lo = __builtin_amdgcn_readfirstlane((unsigned)v), hi = __builtin_amdgcn_readfirstlane((unsigned)(v >> 32)); unsigned long long r = ((unsigned long long)hi << 32) | lo; asm volatile("" : "+s"(r)); return (const char*)r; }
template <class Epi, class Sched, bool ALIGN_EPI = false, bool SP2 = false, bool FP8 = false>
__device__ __forceinline__ void gemm_phase(PG8_LAS unsigned char* lds, const Gemm g, const Sched& S, const Epi& E) {
    int tid_ = threadIdx.x; asm volatile("" : "+v"(tid_)); const int tid = tid_, wid = __builtin_amdgcn_readfirstlane(tid >> 6), lane = tid & 63, wr = wid >> 2, wc = wid & 3, fr = lane & 15, fq = lane >> 4;
    const int KB = FP8 ? g.K : g.K * 2, nt = KB / (BK * 2);
    unsigned voffA, voffB;
    { int R, C; stage_rc(tid * 16, R, C); const int Rb = Epi::PERM ? ((R & ~31) + perm32(R & 31)) : R;
        voffA = (unsigned)(R * KB + C * 2); voffB = (unsigned)(Rb * KB + C * 2); }
    const unsigned pstep = 64u * KB;
    constexpr unsigned kstep = BK * 2;
    const unsigned hstep = (unsigned)HALF * KB;
    const unsigned tstep = 2 * hstep;
    const unsigned ldsw = (unsigned)wid * 1024u;
    const int aoff = lds_byte(wr * 64 + fr, fq * 8), boff = lds_byte(wc * 32 + fr, fq * 8);
#define PG8_SA(b, h) (((b) * 2 + (h)) * HTB)
#define PG8_SB(b, h) ((4 + (b) * 2 + (h)) * HTB)
#define PG8_STAGE(bufoff, gbase, voff) do { unsigned vo_ = (voff); asm volatile("" : "+v"(vo_));   \
        _Pragma("unroll") for (int _i = 0; _i < 2; ++_i) \
        __builtin_amdgcn_global_load_lds((const unsigned*)((const char*)(gbase) + _i * pstep + vo_), (PG8_LAS unsigned*)(lds + (bufoff) + ldsw + _i * 8192), 16, 0, 0); } while (0)
#define PG8_LDA(dst, b, h) do { _Pragma("unroll") for (int m = 0; m < 4; ++m) { if constexpr (FP8) { const v4i lo_ = *(const PG8_LAS v4i*)(lds + PG8_SA(b, h) + aoff + m * 2048), hi_ = *(const PG8_LAS v4i*)(lds + PG8_SA(b, h) + aoff + m * 2048 + 1024); dst##8[m] = __builtin_shufflevector(lo_, hi_, 0, 1, 2, 3, 4, 5, 6, 7); } \
        else { _Pragma("unroll") for (int k = 0; k < 2; ++k) dst[m][k] = *(const PG8_LAS bf16x8*)(lds + PG8_SA(b, h) + aoff + m * 2048 + k * 1024); } } } while (0)
#define PG8_LDB(dst, b, h) do { _Pragma("unroll") for (int n = 0; n < 2; ++n) { if constexpr (FP8) { const v4i lo_ = *(const PG8_LAS v4i*)(lds + PG8_SB(b, h) + boff + n * 2048), hi_ = *(const PG8_LAS v4i*)(lds + PG8_SB(b, h) + boff + n * 2048 + 1024); dst##8[n] = __builtin_shufflevector(lo_, hi_, 0, 1, 2, 3, 4, 5, 6, 7); } \
        else { _Pragma("unroll") for (int k = 0; k < 2; ++k) dst[n][k] = *(const PG8_LAS bf16x8*)(lds + PG8_SB(b, h) + boff + n * 2048 + k * 1024); } } } while (0)
#define PG8_MMA(ai, bj, At, Bt) do { __builtin_amdgcn_s_setprio(1); _Pragma("unroll") for (int m = 0; m < 4; ++m) _Pragma("unroll") for (int n = 0; n < 2; ++n) { \
        if constexpr (FP8) asm volatile("v_mfma_f32_16x16x128_f8f6f4 %0, %1, %2, %0" : "+v"(acc[ai][bj][m][n]) : "v"(Bt##8[n]), "v"(At##8[m]));   \
        else { _Pragma("unroll") for (int k = 0; k < 2; ++k) acc[ai][bj][m][n] = __builtin_amdgcn_mfma_f32_16x16x32_bf16(Bt[n][k], At[m][k], acc[ai][bj][m][n], 0, 0, 0); } } \
        __builtin_amdgcn_s_setprio(0); } while (0)
#define PG8_WAIT_V(n) asm volatile("s_waitcnt vmcnt(" #n ")" ::: "memory")
#define PG8_WAIT_L(n) asm volatile("s_waitcnt lgkmcnt(" #n ")" ::: "memory")
#define PG8_BAR __builtin_amdgcn_s_barrier()
#define PG8_SCHED __builtin_amdgcn_sched_barrier(0)
    Unit cur, nxt; int ui = 0;
    if (!S.next(0, cur)) return;
    f32x4 acc[2][2][4][2];
#pragma unroll
    for (int a = 0; a < 2; ++a)
#pragma unroll
        for (int b = 0; b < 2; ++b)
#pragma unroll
            for (int m = 0; m < 4; ++m)
#pragma unroll
                for (int n = 0; n < 2; ++n) acc[a][b][m][n] = (f32x4){0.f, 0.f, 0.f, 0.f};
    bf16x8 At[4][2], B0[2][2], B1[2][2]; v8i At8[4], B08[2], B18[2];
    const char* cA = (const char*)g.A + (unsigned)cur.pa * tstep; const char* cB = (const char*)g.Bt + (unsigned)cur.e * g.bstride + (unsigned)cur.pn * tstep;
    S.a_ready(cur);
    if constexpr (SP2) {
        PG8_STAGE(PG8_SB(0, 0), cB, voffB); PG8_STAGE(PG8_SB(0, 1), cB + hstep, voffB); PG8_STAGE(PG8_SA(0, 0), cA, voffA); PG8_STAGE(PG8_SA(0, 1), cA + hstep, voffA);
        if (wr == 1) PG8_BAR;
        PG8_WAIT_V(2); PG8_BAR;
        PG8_STAGE(PG8_SB(1, 0), cB + kstep, voffB); PG8_STAGE(PG8_SA(1, 0), cA + kstep, voffA); PG8_STAGE(PG8_SB(1, 1), cB + hstep + kstep, voffB);
        PG8_WAIT_V(6); PG8_BAR;
    } else {
        PG8_STAGE(PG8_SB(0, 0), cB, voffB); PG8_STAGE(PG8_SA(0, 0), cA, voffA); PG8_STAGE(PG8_SB(0, 1), cB + hstep, voffB); PG8_STAGE(PG8_SA(0, 1), cA + hstep, voffA);
        if (wr == 1) PG8_BAR;
        PG8_WAIT_V(4); PG8_BAR;
        PG8_STAGE(PG8_SB(1, 0), cB + kstep, voffB); PG8_STAGE(PG8_SA(1, 0), cA + kstep, voffA); PG8_STAGE(PG8_SB(1, 1), cB + hstep + kstep, voffB);
        PG8_WAIT_V(6); PG8_BAR;
    }
    for (;;) {
        const bool has_next = S.next(ui + 1, nxt);
        const char* nA = has_next ? (const char*)g.A + (unsigned)nxt.pa * tstep : cA; const char* nB = has_next ? (const char*)g.Bt + (unsigned)nxt.e * g.bstride + (unsigned)nxt.pn * tstep : cB;
#pragma unroll 1
        for (int t = 0; t < nt; t += 2) {
            const bool last = (t == nt - 2);
            const char* a1 = cA + (unsigned)(t + 1) * kstep;
            const char* a2 = last ? nA : cA + (unsigned)(t + 2) * kstep; const char* b2 = last ? nB : cB + (unsigned)(t + 2) * kstep;
            const char* a3 = a2 + kstep; const char* b3 = b2 + kstep;
            a1 = uptr(a1); a2 = uptr(a2); b2 = uptr(b2); a3 = uptr(a3); b3 = uptr(b3);
            if (last && has_next) S.a_ready(nxt);
            if constexpr (SP2) {
            PG8_LDB(B0, 0, 0); PG8_LDB(B1, 0, 1); PG8_SCHED; PG8_LDA(At, 0, 0); PG8_STAGE(PG8_SA(1, 1), a1 + hstep, voffA);
            PG8_WAIT_V(8); PG8_WAIT_L(0); PG8_BAR; PG8_MMA(0, 0, At, B0); PG8_MMA(0, 1, At, B1); PG8_BAR; PG8_SCHED;
            PG8_LDA(At, 0, 1); PG8_STAGE(PG8_SB(0, 0), b2, voffB); PG8_STAGE(PG8_SB(0, 1), b2 + hstep, voffB); PG8_STAGE(PG8_SA(0, 0), a2, voffA);
            PG8_WAIT_V(8); PG8_WAIT_L(0); PG8_BAR; PG8_MMA(1, 0, At, B0); PG8_MMA(1, 1, At, B1); PG8_BAR; PG8_SCHED;
            PG8_LDB(B0, 1, 0); PG8_LDB(B1, 1, 1); PG8_SCHED; PG8_LDA(At, 1, 0); PG8_STAGE(PG8_SA(0, 1), a2 + hstep, voffA);
            PG8_WAIT_V(8); PG8_WAIT_L(0); PG8_BAR; PG8_MMA(0, 0, At, B0); PG8_MMA(0, 1, At, B1); PG8_BAR; PG8_SCHED;
            PG8_LDA(At, 1, 1); PG8_STAGE(PG8_SB(1, 0), b3, voffB); PG8_STAGE(PG8_SB(1, 1), b3 + hstep, voffB); PG8_STAGE(PG8_SA(1, 0), a3, voffA);
            PG8_WAIT_V(8); PG8_WAIT_L(0); PG8_BAR; PG8_MMA(1, 0, At, B0); PG8_MMA(1, 1, At, B1); PG8_BAR; PG8_SCHED;
            } else {
            PG8_LDB(B0, 0, 0); PG8_SCHED; PG8_LDA(At, 0, 0); PG8_STAGE(PG8_SA(1, 1), a1 + hstep, voffA);
            PG8_WAIT_L(8); PG8_BAR; PG8_WAIT_L(0); PG8_MMA(0, 0, At, B0); PG8_BAR; PG8_SCHED;
            PG8_LDB(B1, 0, 1); PG8_STAGE(PG8_SB(0, 0), b2, voffB);
            PG8_BAR; PG8_WAIT_L(0); PG8_MMA(0, 1, At, B1); PG8_BAR;
            PG8_LDA(At, 0, 1); PG8_STAGE(PG8_SA(0, 0), a2, voffA);
            PG8_BAR; PG8_WAIT_L(0); PG8_MMA(1, 0, At, B0); PG8_BAR; PG8_SCHED;
            PG8_STAGE(PG8_SB(0, 1), b2 + hstep, voffB);
            PG8_WAIT_V(6); PG8_BAR; PG8_MMA(1, 1, At, B1); PG8_BAR;
            PG8_LDB(B0, 1, 0); PG8_SCHED; PG8_LDA(At, 1, 0); PG8_STAGE(PG8_SA(0, 1), a2 + hstep, voffA);
            PG8_WAIT_L(8); PG8_BAR; PG8_WAIT_L(0); PG8_MMA(0, 0, At, B0); PG8_BAR; PG8_SCHED;
            PG8_LDB(B1, 1, 1); PG8_STAGE(PG8_SB(1, 0), b3, voffB);
            PG8_BAR; PG8_WAIT_L(0); PG8_MMA(0, 1, At, B1); PG8_BAR;
            PG8_LDA(At, 1, 1); PG8_STAGE(PG8_SA(1, 0), a3, voffA);
            PG8_BAR; PG8_WAIT_L(0); PG8_MMA(1, 0, At, B0); PG8_BAR; PG8_SCHED;
            PG8_STAGE(PG8_SB(1, 1), b3 + hstep, voffB);
            PG8_WAIT_V(6); PG8_BAR; PG8_MMA(1, 1, At, B1); PG8_BAR;
            }
        }
        if constexpr (FP8) asm volatile("s_nop 15\n\ts_nop 15" ::: "memory");
        if constexpr (ALIGN_EPI) { if (wr == 0) PG8_BAR; }
        if constexpr (!Epi::AFTER_DRAIN) { int l_ = threadIdx.x; asm volatile("" : "+v"(l_)); const int fr_ = l_ & 15, fq_ = (l_ >> 4) & 3; E(acc, cur, wr, wc, fr_, fq_); S.done(cur); }
        if (!has_next) break;
#pragma unroll
        for (int a = 0; a < 2; ++a)
#pragma unroll
            for (int b = 0; b < 2; ++b)
#pragma unroll
                for (int m = 0; m < 4; ++m)
#pragma unroll
                    for (int n = 0; n < 2; ++n) acc[a][b][m][n] = (f32x4){0.f, 0.f, 0.f, 0.f};
        cur = nxt; cA = nA; cB = nB; ++ui;
        if constexpr (ALIGN_EPI) { if (wr == 1) PG8_BAR; }
    }
    PG8_WAIT_V(0);
    if constexpr (!ALIGN_EPI) { if (wr == 0) PG8_BAR; }
    PG8_BAR;
    if constexpr (Epi::AFTER_DRAIN) { E.fused(acc, cur, wr, wc, fr, fq, lds, wid, lane); S.done(cur); }
#undef PG8_SA
#undef PG8_SB
#undef PG8_STAGE
#undef PG8_LDA
#undef PG8_LDB
#undef PG8_MMA
#undef PG8_WAIT_V
#undef PG8_WAIT_L
#undef PG8_BAR
#undef PG8_SCHED
}
}

namespace fk {
using pg8::bf16_t; using pg8::bf16x8; using pg8::f32x4; using pg8::u32x4;
constexpr int NWAVES = 8, NTHR = 512, GRID = 256, NGW = GRID * NWAVES;
constexpr int B_ = 8, S_ = 2048, D = 1024, M = B_ * S_, DIN = 2560, DC = 512, FFD = 2816, NE = 8, FFE = 3584, CW = 31, NREL = 257;
constexpr float LOG2E = 1.4426950408889634f, QSCALE = 0.125f * LOG2E, EPS = 1e-6f;
constexpr size_t MiB = 1u << 20;
constexpr size_t WS_CTL = 0, CTL_ZERO_BYTES = 1 * MiB;
constexpr size_t WS_MODP = 1 * MiB;
constexpr size_t WS_MOD = 4 * MiB;
constexpr size_t WS_PAIR = 4 * MiB + 512 * 1024;
constexpr size_t WS_LIST = 5 * MiB;
constexpr size_t WS_WL = 5 * MiB + 512 * 1024;
constexpr size_t WS_WLG = 6 * MiB;
constexpr size_t WS_WMGU = 8 * MiB;
constexpr size_t WS_WMD = 120 * MiB;
constexpr size_t WS_WIN = 176 * MiB;
constexpr size_t WS_WOUT = 186 * MiB;
constexpr size_t WS_WGU = 190 * MiB;
constexpr size_t WS_WD = 201 * MiB;
constexpr size_t WS_H = 207 * MiB;
constexpr size_t WS_Z = 239 * MiB, WS_Q = 255 * MiB, WS_K = 271 * MiB, WS_VT = 287 * MiB;
constexpr size_t WS_YC = 303 * MiB;
constexpr size_t WS_ACT = 239 * MiB;
constexpr size_t WS_HG = 363 * MiB;
constexpr size_t WS_F = 176 * MiB;
constexpr size_t WS_ACTM = 244 * MiB;
constexpr size_t WS_END = 491 * MiB;
constexpr int MAXROWS = 34816;
constexpr int CW_BAR = 4096, CW_CNT = 16384;
constexpr int RING_BYTES = 131072, LDSCTL_OFF = RING_BYTES, MISC_OFF = LDSCTL_OFF + 320, MOETAB_OFF = LDSCTL_OFF + 512;
constexpr int LDS_BYTES = 147456;

#define GAS __attribute__((address_space(1)))
#define LAS __attribute__((address_space(3)))
typedef unsigned short bf16;
typedef unsigned v4u __attribute__((ext_vector_type(4)));
typedef unsigned v2u __attribute__((ext_vector_type(2)));
typedef float f32x16 __attribute__((ext_vector_type(16)));
typedef short s16x4 __attribute__((ext_vector_type(4)));
typedef float f32x2_t __attribute__((ext_vector_type(2))); typedef __bf16 bf16x2_t __attribute__((ext_vector_type(2)));
__device__ __forceinline__ unsigned pk2(float lo, float hi) { f32x2_t v = {lo, hi}; bf16x2_t b = __builtin_convertvector(v, bf16x2_t); return __builtin_bit_cast(unsigned, b); }
__device__ __forceinline__ float bf2f(bf16 v) { return __uint_as_float((unsigned)v << 16); }
__device__ __forceinline__ float wave_sum(float v) {
#pragma unroll
    for (int o = 1; o < 64; o <<= 1) v += __shfl_xor(v, o);
    return v;
}
__device__ __forceinline__ float sigm(float x) { return __builtin_amdgcn_rcpf(1.f + __builtin_amdgcn_exp2f(-LOG2E * x)); }
using pg8::pk4_fp8;
constexpr float W8_SCALE = 64.f, H8_SCALE = 8.f, A8_SCALE = 4.f;
constexpr int E8_W = (127 - 6) * 0x01010101, E8_H = (127 - 3) * 0x01010101, E8_A = (127 - 2) * 0x01010101;
#define LDS_WAIT() asm volatile("s_waitcnt lgkmcnt(0)" ::: "memory")
#define RFL(x) __builtin_amdgcn_readfirstlane(x)

#define XB_TMO      128
#define XB_XCNT(j)  (256  + 64 * (j))
#define XB_XSUB(j)  (1280 + 64 * (j))
#define XB_XGEN(j)  (2304 + 64 * (j))
#define XB_TOP      3328
#define XB_TOPGEN   3392
#define XCD_BAR_WORDS 3456
#define XB_SPIN_CAP (1u << 18)

__device__ __forceinline__ unsigned xb_ld(unsigned* p)              { return __hip_atomic_load(p, __ATOMIC_RELAXED, __HIP_MEMORY_SCOPE_AGENT); }
__device__ __forceinline__ unsigned xb_add(unsigned* p, unsigned v) { return __hip_atomic_fetch_add(p, v, __ATOMIC_RELAXED, __HIP_MEMORY_SCOPE_AGENT); }
__device__ __forceinline__ unsigned xb_xcc_id() { return (unsigned)__builtin_amdgcn_s_getreg((3 << 11) | 20) & 0xFu; }
#define XB_SPIN(cond, bar) do { unsigned _sp = 0; while (cond) { __builtin_amdgcn_s_sleep(1); \
    if ((++_sp & 255u) == 0u) { if (xb_ld(&(bar)[XB_TMO])) break; if (_sp > XB_SPIN_CAP) { atomicAdd(&(bar)[XB_TMO], 1u); break; } } } } while (0)

struct XcdBarrier {
    unsigned* bar; unsigned x;
    volatile LAS unsigned* st;
};

__device__ __forceinline__ XcdBarrier xcd_barrier_post(unsigned* bar, volatile LAS unsigned* st) {
    XcdBarrier b; b.bar = bar; b.x = xb_xcc_id(); b.st = st;
    if (threadIdx.x == 0) (void)xb_add(&bar[XB_XCNT(b.x)], 1u);
    return b;
}
__device__ __forceinline__ void xcd_barrier_complete(unsigned* bar, unsigned x, unsigned& nloc, unsigned& nx) {
    const unsigned G = gridDim.x * gridDim.y * gridDim.z;
    unsigned sum, cnt, mine, sp = 0u;
    for (;;) {
        sum = 0u; cnt = 0u; mine = 0u;
#pragma unroll
        for (unsigned j = 0; j < 16; ++j) { const unsigned c = xb_ld(&bar[XB_XCNT(j)]); sum += c; cnt += (c > 0u) ? 1u : 0u; mine = (j == x) ? c : mine; }
        if (sum == G) break;
        __builtin_amdgcn_s_sleep(1);
        if ((++sp & 255u) == 0u) { if (xb_ld(&bar[XB_TMO])) break; if (sp > XB_SPIN_CAP) { atomicAdd(&bar[XB_TMO], 1u); break; } }
    }
    nloc = mine > 0u ? mine : 1u; nx = cnt > 0u ? cnt : 1u;
}

__device__ __forceinline__ void xcd_barrier(const XcdBarrier& b) {
    asm volatile("s_waitcnt vmcnt(0)" ::: "memory");
    __syncthreads();
    if (threadIdx.x == 0) {
        unsigned* bar = b.bar;
        __builtin_amdgcn_s_waitcnt(0);
        unsigned nloc = b.st[0], nx = b.st[1];
        if (nloc == 0u) { xcd_barrier_complete(bar, b.x, nloc, nx); b.st[0] = nloc; b.st[1] = nx; }
        const unsigned old = xb_add(&bar[XB_XSUB(b.x)], 1u);
        const unsigned gen = old / nloc;
        if (old + 1u == (gen + 1u) * nloc) {
            __builtin_amdgcn_fence(__ATOMIC_RELEASE, "agent");
            asm volatile("s_waitcnt vmcnt(0)" ::: "memory");
            const unsigned og = xb_add(&bar[XB_TOP], 1u);
            const unsigned tg = og / nx;
            if (og + 1u == (tg + 1u) * nx) xb_add(&bar[XB_TOPGEN], 1u);
            else XB_SPIN(xb_ld(&bar[XB_TOPGEN]) == tg, bar);
            __builtin_amdgcn_fence(__ATOMIC_ACQUIRE, "agent");
            xb_add(&bar[XB_XGEN(b.x)], 1u);
            asm volatile("s_waitcnt vmcnt(0)" ::: "memory");
        } else {
            XB_SPIN(xb_ld(&bar[XB_XGEN(b.x)]) == gen, bar);
            __builtin_amdgcn_fence(__ATOMIC_ACQUIRE, "agent");
            asm volatile("s_waitcnt vmcnt(0)" ::: "memory");
        }
    }
    __syncthreads();
}


#ifndef REPMASK
#define REPMASK 0
#endif
struct Params { const float* in[23]; float* out; unsigned char* ws; int stop; int pad; };

__device__ __forceinline__ void tr_item(const float* W, int K, int N, bf16* WT, int kb, int nb, int drow0, LAS float* scr, int lane) {
    const int k0 = 64 * kb, n0 = 32 * nb;
#pragma unroll 8
    for (int i = 0; i < 32; ++i) { const int kk = 2 * i + (lane >> 5); scr[kk * 33 + (lane & 31)] = W[(size_t)(k0 + kk) * N + n0 + (lane & 31)]; }
    LDS_WAIT(); asm volatile("" ::: "memory");
    const int c = lane & 7;
#pragma unroll
    for (int j = 0; j < 4; ++j) { const int n = (lane >> 3) + 8 * j; const LAS float* s = scr + (8 * c) * 33 + n;
        v4u o; o.x = pk2(s[0 * 33], s[1 * 33]); o.y = pk2(s[2 * 33], s[3 * 33]); o.z = pk2(s[4 * 33], s[5 * 33]); o.w = pk2(s[6 * 33], s[7 * 33]);
        *(GAS v4u*)(WT + (size_t)(drow0 + n) * K + k0 + 8 * c) = o; }
    LDS_WAIT(); asm volatile("" ::: "memory");
}
__device__ __forceinline__ void tr_item_f8(const float* W, int K, int N, unsigned char* WT, int kb, int nb, int drow0, LAS float* scr, int lane, float scale) {
    const int k0 = 64 * kb, n0 = 32 * nb;
#pragma unroll 8
    for (int i = 0; i < 32; ++i) { const int kk = 2 * i + (lane >> 5); scr[kk * 33 + (lane & 31)] = W[(size_t)(k0 + kk) * N + n0 + (lane & 31)]; }
    LDS_WAIT(); asm volatile("" ::: "memory");
    const int c = lane & 7;
#pragma unroll
    for (int j = 0; j < 4; ++j) { const int n = (lane >> 3) + 8 * j; const LAS float* s = scr + (8 * c) * 33 + n;
        v2u o; o.x = pk4_fp8(s[0 * 33] * scale, s[1 * 33] * scale, s[2 * 33] * scale, s[3 * 33] * scale); o.y = pk4_fp8(s[4 * 33] * scale, s[5 * 33] * scale, s[6 * 33] * scale, s[7 * 33] * scale);
        *(GAS v2u*)(WT + (size_t)(drow0 + n) * K + k0 + 8 * c) = o; }
    LDS_WAIT(); asm volatile("" ::: "memory");
}
__device__ __forceinline__ int rowmap_win(int n0) {
    if (n0 < 512) return 256 * (n0 >> 7) + (n0 & 127);
    if (n0 < 1024) { const int m = n0 - 512; return 256 * (m >> 7) + 128 + (m & 127); }
    if (n0 < 2048) { const int isk = n0 >= 1536; const int m = n0 - (isk ? 1536 : 1024); const int head = m >> 6, bj = (m >> 5) & 1; return 256 * (4 + 2 * isk + (head >> 2)) + 128 * bj + 32 * (head & 3); }
    return n0;
}
__device__ __forceinline__ int rowmap_gu(int n0, int up) { return 256 * (n0 >> 7) + 128 * up + (n0 & 127); }

__device__ __forceinline__ void phase0(const Params& P, LAS unsigned char* lds, int tid, int lane, int wave, int gw) {
    LAS float* cact = (LAS float*)(lds + 69632);
    { const float* c = P.in[1]; for (int i = tid; i < B_ * D; i += NTHR) { const float v = c[i]; cact[i] = v * sigm(v); } }
    __syncthreads();
    {
        const float* w_ada = P.in[2]; float* modp = (float*)(P.ws + WS_MODP);
        for (int it = gw; it < 1536; it += NGW) {
            const int ks = it & 7, jb = (it >> 3) % 96, l = it / 768;
            const float* wp = w_ada + ((size_t)l * D + ks * 128) * 6144 + jb * 64 + lane;
            float acc[8];
#pragma unroll
            for (int b = 0; b < 8; ++b) acc[b] = 0.f;
#pragma unroll 8
            for (int k = 0; k < 128; ++k) { const float w = wp[(size_t)k * 6144];
#pragma unroll
                for (int b = 0; b < 8; ++b) acc[b] += cact[b * D + ks * 128 + k] * w; }
#pragma unroll
            for (int b = 0; b < 8; ++b) modp[(((size_t)ks * 2 + l) * 8 + b) * 6144 + jb * 64 + lane] = acc[b];
        }
    }
    LAS float* scr = (LAS float*)(lds + wave * 8448);
    constexpr int I_WIN = 16 * 80, I_WOUT = 16 * 32, I_FG = 16 * 88, I_FD = 44 * 32, I_MG = 16 * 112, I_MD = 56 * 32;
    constexpr int NITEMS = 2 * I_WIN + 2 * I_WOUT + 2 * I_FG + I_FD + 16 * I_MG + 8 * I_MD;
    for (int it = gw; it < NITEMS; it += NGW) {
        int r = it;
        if (r < 16 * I_MG) { const int mat = r / I_MG, q = r % I_MG, e = mat >> 1, up = mat & 1; const int kb = q / 112, nb = q % 112;
            tr_item_f8((up ? P.in[21] : P.in[20]) + (size_t)e * D * FFE, D, FFE, (unsigned char*)(P.ws + WS_WMGU) + (size_t)e * 7168 * D, kb, nb, rowmap_gu(32 * nb, up), scr, lane, W8_SCALE); continue; }
        r -= 16 * I_MG;
        if (r < 8 * I_MD) { const int e = r / I_MD, q = r % I_MD; const int kb = q / 32, nb = q % 32;
            tr_item_f8(P.in[22] + (size_t)e * FFE * D, FFE, D, (unsigned char*)(P.ws + WS_WMD) + (size_t)e * D * FFE, kb, nb, 32 * nb, scr, lane, W8_SCALE); continue; }
        r -= 8 * I_MD;
        if (r < 2 * I_WIN) { const int l = r / I_WIN, q = r % I_WIN; const int kb = q / 80, nb = q % 80;
            tr_item(P.in[6] + (size_t)l * D * DIN, D, DIN, (bf16*)(P.ws + WS_WIN) + (size_t)l * DIN * D, kb, nb, rowmap_win(32 * nb), scr, lane); continue; }
        r -= 2 * I_WIN;
        if (r < 2 * I_WOUT) { const int l = r / I_WOUT, q = r % I_WOUT; const int kb = q / 32, nb = q % 32;
            tr_item(P.in[7] + (size_t)l * D * D, D, D, (bf16*)(P.ws + WS_WOUT) + (size_t)l * D * D, kb, nb, 32 * nb, scr, lane); continue; }
        r -= 2 * I_WOUT;
        if (r < 2 * I_FG) { const int up = r / I_FG, q = r % I_FG; const int kb = q / 88, nb = q % 88;
            tr_item((up ? P.in[16] : P.in[15]), D, FFD, (bf16*)(P.ws + WS_WGU), kb, nb, rowmap_gu(32 * nb, up), scr, lane); continue; }
        r -= 2 * I_FG;
        { const int kb = r / 32, nb = r % 32; tr_item(P.in[17], FFD, D, (bf16*)(P.ws + WS_WD), kb, nb, 32 * nb, scr, lane); }
    }
}

__device__ __forceinline__ float modp_sum(const float* modp, const float* b_ada, int l, int b, int j) {
    float s = b_ada[l * 6144 + j];
#pragma unroll
    for (int ks = 0; ks < 8; ++ks) s += modp[(((size_t)ks * 2 + l) * 8 + b) * 6144 + j];
    return s;
}
__device__ __forceinline__ void norm_row(const float* xrow, const LAS float* gm, const LAS float* shv, int lane, f32x4 (&h)[4]) {
    const GAS f32x4* xr = (const GAS f32x4*)xrow + lane; float ss = 0.f;
#pragma unroll
    for (int j = 0; j < 4; ++j) { h[j] = xr[64 * j]; ss += (h[j].x * h[j].x + h[j].y * h[j].y) + (h[j].z * h[j].z + h[j].w * h[j].w); }
    const float r = __builtin_amdgcn_rsqf(wave_sum(ss) * (1.f / D) + EPS);
#pragma unroll
    for (int j = 0; j < 4; ++j) { const f32x4 g4 = *(const LAS f32x4*)(gm + 4 * lane + 256 * j), s4 = *(const LAS f32x4*)(shv + 4 * lane + 256 * j); h[j] = h[j] * r * g4 + s4; }
}
__device__ __forceinline__ void store_row_bf16(bf16* orow, int lane, const f32x4 (&h)[4]) {
    GAS v2u* o8 = (GAS v2u*)orow + lane;
#pragma unroll
    for (int j = 0; j < 4; ++j) { v2u w; w.x = pk2(h[j].x, h[j].y); w.y = pk2(h[j].z, h[j].w); o8[64 * j] = w; }
}
__device__ __forceinline__ void norm_phase(const Params& P, LAS unsigned char* lds, const float* xin, const float* gvec, int l, int sh_off, int sc_off, bool from_partials, int tid, int lane, int wave, int wgi) {
    LAS float* gm = (LAS float*)lds; LAS float* shv = (LAS float*)(lds + 4096);
    const float* modp = (const float*)(P.ws + WS_MODP); float* mod = (float*)(P.ws + WS_MOD); const float* b_ada = P.in[3];
    const int b = wgi >> 5;
    if (from_partials) {
        if (tid < 384) { const int idx = wgi * 384 + tid; const int ll = idx / 49152, rem = idx % 49152, bb = rem / 6144, j = rem % 6144; mod[idx] = modp_sum(modp, b_ada, ll, bb, j); }
        for (int c = tid; c < D; c += NTHR) { gm[c] = gvec[c] * (1.f + modp_sum(modp, b_ada, l, b, sc_off + c)); shv[c] = modp_sum(modp, b_ada, l, b, sh_off + c); }
    } else {
        const float* ml = mod + ((size_t)l * 8 + b) * 6144;
        for (int c = tid; c < D; c += NTHR) { gm[c] = gvec[c] * (1.f + ml[sc_off + c]); shv[c] = ml[sh_off + c]; }
    }
    __syncthreads();
    bf16* H = (bf16*)(P.ws + WS_H);
    for (int i = 0; i < 8; ++i) { const int row = wgi * 64 + wave * 8 + i; f32x4 h[4]; norm_row(xin + (size_t)row * D, gm, shv, lane, h); store_row_bf16(H + (size_t)row * D, lane, h); }
    __syncthreads();
}
__device__ __forceinline__ void router_phase(const Params& P, LAS unsigned char* lds, const float* xin, int tid, int lane, int wave, int wgi) {
    LAS float* gm = (LAS float*)lds; LAS float* shv = (LAS float*)(lds + 4096); LAS float* wrT = (LAS float*)(lds + 8192);
    LAS int* pe = (LAS int*)(lds + 40960); LAS float* pw = (LAS float*)(lds + 41472); LAS int* cw = (LAS int*)(lds + 41984); LAS int* baseL = (LAS int*)(lds + 42048);
    const float* mod = (const float*)(P.ws + WS_MOD); const int b = wgi >> 5; const float* ml = mod + ((size_t)1 * 8 + b) * 6144; const float* gvec = P.in[5] + D;
    for (int c = tid; c < D; c += NTHR) { gm[c] = gvec[c] * (1.f + ml[4096 + c]); shv[c] = ml[3072 + c]; }
    { const float* wr = P.in[18]; for (int i = tid; i < D * NE; i += NTHR) { const int c = i >> 3, e = i & 7; wrT[e * D + c] = wr[i]; } }
    __syncthreads();
    const float* br = P.in[19];
    for (int i = 0; i < 8; ++i) { const int rl = wave * 8 + i, row = wgi * 64 + rl; f32x4 h[4]; norm_row(xin + (size_t)row * D, gm, shv, lane, h);
        float lg[8];
#pragma unroll
        for (int e = 0; e < 8; ++e) { float s = 0.f;
#pragma unroll
            for (int j = 0; j < 4; ++j) { const f32x4 w4 = *(const LAS f32x4*)(wrT + e * D + 4 * lane + 256 * j); s += (h[j].x * w4.x + h[j].y * w4.y) + (h[j].z * w4.z + h[j].w * w4.w); }
            lg[e] = wave_sum(s) + br[e]; }
        int e1 = 0; float v1 = lg[0];
#pragma unroll
        for (int e = 1; e < 8; ++e) if (lg[e] > v1) { v1 = lg[e]; e1 = e; }
        int e2 = -1; float v2 = -3.0e38f;
#pragma unroll
        for (int e = 0; e < 8; ++e) if (e != e1 && lg[e] > v2) { v2 = lg[e]; e2 = e; }
        const float p2 = __expf(v2 - v1), inv = 1.f / (1.f + p2);
        if (lane == 0) { pe[2 * rl] = e1; pe[2 * rl + 1] = e2; pw[2 * rl] = inv; pw[2 * rl + 1] = p2 * inv; }
        { LAS unsigned* r4 = (LAS unsigned*)(lds + 65536 + rl * 1024) + lane;
#pragma unroll
          for (int j = 0; j < 4; ++j) r4[64 * j] = pk4_fp8(h[j].x * H8_SCALE, h[j].y * H8_SCALE, h[j].z * H8_SCALE, h[j].w * H8_SCALE); } }
    __syncthreads();
    int e = 0, rank = 0;
    if (tid < 128) { e = pe[tid];
#pragma unroll
        for (int ee = 0; ee < 8; ++ee) { const unsigned long long mk = __ballot(e == ee); if (e == ee) rank = __popcll(mk & ((1ull << lane) - 1ull)); if (lane == 0) cw[wave * 8 + ee] = __popcll(mk); } }
    __syncthreads();
    if (tid < 8) { const int tot = cw[tid] + cw[8 + tid]; unsigned* cnt = (unsigned*)(P.ws + WS_CTL) + CW_CNT + 64 * tid;
        baseL[tid] = (int)__hip_atomic_fetch_add(cnt, (unsigned)tot, __ATOMIC_RELAXED, __HIP_MEMORY_SCOPE_AGENT); }
    __syncthreads();
    if (tid < 128) { const int slot = baseL[e] + rank + (wave == 1 ? cw[e] : 0); const int token = wgi * 64 + (tid >> 1);
        ((float*)(P.ws + WS_WL))[e * M + slot] = pw[tid]; ((int*)(P.ws + WS_PAIR))[token * 2 + (tid & 1)] = e * M + slot; pe[tid] = e * M + slot; }
    __syncthreads();
    for (int i = 0; i < 16; ++i) { const int p = wave * 16 + i; const int dst = pe[p];
        const v4u v = *(const LAS v4u*)(lds + 65536 + (p >> 1) * 1024 + lane * 16); *(GAS v4u*)(P.ws + WS_HG + (size_t)dst * D + lane * 16) = v; }
    __syncthreads();
}
__device__ __forceinline__ void moe_tables(const Params& P, LAS unsigned char* lds, int tid) {
    LAS int* tab = (LAS int*)(lds + MOETAB_OFF);
    if (tid == 0) { const unsigned* ctl = (const unsigned*)(P.ws + WS_CTL); int rb = 0;
        for (int e = 0; e < 8; ++e) { int c = (int)__hip_atomic_load(ctl + CW_CNT + 64 * e, __ATOMIC_RELAXED, __HIP_MEMORY_SCOPE_AGENT); c = c < 0 ? 0 : (c > M ? M : c); tab[e] = rb; tab[9 + e] = c; rb += (c + 255) & ~255; }
        tab[8] = rb; }
    __syncthreads();
}
__device__ __forceinline__ void gather_phase(const Params& P, LAS unsigned char* lds, const float* xin, int tid, int lane, int wave, int gw) {
    LAS float* gmA = (LAS float*)lds; LAS float* shA = (LAS float*)(lds + 32768); const LAS int* tab = (const LAS int*)(lds + MOETAB_OFF);
    const float* mod1 = (const float*)(P.ws + WS_MOD) + (size_t)8 * 6144; const float* gvec = P.in[5] + D;
    for (int i = tid; i < 8 * D; i += NTHR) { const int b = i >> 10, c = i & 1023; gmA[i] = gvec[c] * (1.f + mod1[b * 6144 + 4096 + c]); shA[i] = mod1[b * 6144 + 3072 + c]; }
    __syncthreads();
    const int ptot = tab[8]; const int* list = (const int*)(P.ws + WS_LIST); const float* wl = (const float*)(P.ws + WS_WL); float* wlg = (float*)(P.ws + WS_WLG); unsigned char* HG = (unsigned char*)(P.ws + WS_HG);
    for (int p = gw; p < ptot; p += NGW) {
        int e = 0;
#pragma unroll
        for (int k = 1; k < 8; ++k) e += (p >= tab[k]);
        const int slot = p - tab[e], cn = tab[9 + e]; const bool valid = slot < cn; const int token = list[e * M + (valid ? slot : cn - 1)]; const int b = token >> 11;
        f32x4 h[4]; norm_row(xin + (size_t)token * D, gmA + b * D, shA + b * D, lane, h);
        { GAS unsigned* o4 = (GAS unsigned*)(HG + (size_t)p * D) + lane;
#pragma unroll
          for (int j = 0; j < 4; ++j) o4[64 * j] = pk4_fp8(h[j].x * H8_SCALE, h[j].y * H8_SCALE, h[j].z * H8_SCALE, h[j].w * H8_SCALE); }
        if (lane == 0) wlg[p] = valid ? wl[e * M + slot] : 0.f;
    }
    __syncthreads();
}
__device__ __forceinline__ void combine_phase(const Params& P, LAS unsigned char* lds, int lane, int gw) {
    const LAS int* tab = (const LAS int*)(lds + MOETAB_OFF); const int* pair = (const int*)(P.ws + WS_PAIR); const bf16* F = (const bf16*)(P.ws + WS_F);
    const float* mod1 = (const float*)(P.ws + WS_MOD) + (size_t)8 * 6144;
    for (int t = gw; t < M; t += NGW) {
        const int pa = pair[2 * t], pb = pair[2 * t + 1]; const int ra = tab[pa >> 14] + (pa & 16383), rb = tab[pb >> 14] + (pb & 16383); const int b = t >> 11;
        const GAS v2u* fa = (const GAS v2u*)(F + (size_t)ra * D) + lane; const GAS v2u* fb = (const GAS v2u*)(F + (size_t)rb * D) + lane;
        GAS f32x4* xo = (GAS f32x4*)(P.out + (size_t)t * D) + lane; const GAS f32x4* g2 = (const GAS f32x4*)(mod1 + b * 6144 + 5120) + lane;
#pragma unroll
        for (int j = 0; j < 4; ++j) { const v2u a = fa[64 * j], c = fb[64 * j]; f32x4 f;
            f.x = __uint_as_float(a.x << 16) + __uint_as_float(c.x << 16); f.y = __uint_as_float(a.x & 0xffff0000u) + __uint_as_float(c.x & 0xffff0000u);
            f.z = __uint_as_float(a.y << 16) + __uint_as_float(c.y << 16); f.w = __uint_as_float(a.y & 0xffff0000u) + __uint_as_float(c.y & 0xffff0000u);
            xo[64 * j] = xo[64 * j] + g2[64 * j] * f; }
    }
}

__device__ __forceinline__ void conv_unit(const bf16* Z, bf16* YC, const float* cw, const float* cb, const float* lg, const float* lb, LAS float* tile, int unit, int tid, int wave, int lane) {
    const int tok0 = unit * 32, tp0 = tok0 & (S_ - 1), c = tid;
    float w[CW];
#pragma unroll
    for (int j = 0; j < CW; ++j) w[j] = cw[j * DC + c];
    const float bias = cb[c];
#pragma unroll
    for (int half = 0; half < 2; ++half) {
        float in[46];
#pragma unroll
        for (int i = 0; i < 46; ++i) { const int dt = 16 * half - 30 + i; const bool ok = tp0 + dt >= 0; const int dtc = ok ? dt : -tp0;
            const float zv = bf2f(Z[(size_t)(tok0 + dtc) * DC + c]); in[i] = ok ? zv : 0.f; }
#pragma unroll
        for (int q = 0; q < 16; ++q) { float a = bias;
#pragma unroll
            for (int j = 0; j < CW; ++j) a += w[j] * in[q + j];
            tile[(16 * half + q) * DC + c] = a; }
    }
    __syncthreads();
    const f32x4 g0 = *(const f32x4*)(lg + lane * 8), g1 = *(const f32x4*)(lg + lane * 8 + 4), b0 = *(const f32x4*)(lb + lane * 8), b1 = *(const f32x4*)(lb + lane * 8 + 4);
#pragma unroll
    for (int tt = 0; tt < 4; ++tt) { const int t = wave * 4 + tt;
        f32x4 v0 = *(const LAS f32x4*)(tile + t * DC + lane * 8), v1 = *(const LAS f32x4*)(tile + t * DC + lane * 8 + 4);
        const float mean = wave_sum((v0.x + v0.y) + (v0.z + v0.w) + (v1.x + v1.y) + (v1.z + v1.w)) * (1.f / DC);
        v0 = v0 - mean; v1 = v1 - mean;
        const float var = wave_sum((v0.x * v0.x + v0.y * v0.y) + (v0.z * v0.z + v0.w * v0.w) + (v1.x * v1.x + v1.y * v1.y) + (v1.z * v1.z + v1.w * v1.w)) * (1.f / DC);
        const float rstd = __builtin_amdgcn_rsqf(var + EPS);
        f32x4 y0 = v0 * rstd * g0 + b0, y1 = v1 * rstd * g1 + b1;
#pragma unroll
        for (int i = 0; i < 4; ++i) { y0[i] = y0[i] * sigm(y0[i]); y1[i] = y1[i] * sigm(y1[i]); }
        v4u o; o.x = pk2(y0.x, y0.y); o.y = pk2(y0.z, y0.w); o.z = pk2(y1.x, y1.y); o.w = pk2(y1.z, y1.w);
        *(GAS v4u*)(YC + (size_t)(tok0 + t) * D + lane * 8) = o; }
    __syncthreads();
}
__device__ __forceinline__ int crow(int r, int hi) { return (r & 3) + 8 * (r >> 2) + 4 * hi; }
#define MFMA32(a, b, c) __builtin_amdgcn_mfma_f32_32x32x16_bf16((a), (b), (c), 0, 0, 0)
__device__ __forceinline__ void attn_unit(const bf16* Q, const bf16* K, const bf16* VT, bf16* YC, const LAS float* btile, float b0, LAS unsigned char* kv, int b, int h, int g, int tid, int wave, int lane) {
    const int r32 = lane & 31, hi = lane >> 5;
    const int n0 = 4 * g, n = n0 + (wave >> 1), qh = wave & 1;
    const size_t rowq = (size_t)b * S_ + n * 64 + qh * 32 + r32;
    bf16x8 qf[4];
#pragma unroll
    for (int d0 = 0; d0 < 4; ++d0) qf[d0] = *(const GAS bf16x8*)(Q + rowq * DC + h * 64 + d0 * 16 + hi * 8);
    float m = -1.0e30f, l = 0.f; f32x16 o0, o1;
#pragma unroll
    for (int r = 0; r < 16; ++r) { o0[r] = 0.f; o1[r] = 0.f; }
    const int kc_lo = n0 - 8 < 0 ? 0 : n0 - 8, ns = n0 + 4 - kc_lo;
    const int lrow = tid >> 3, lc = tid & 7; const int lofs = lrow * 128 + ((lc ^ ((lrow >> 1) & 7)) << 4);
    const bf16* kg = K + ((size_t)b * S_ + lrow) * DC + h * 64 + lc * 8;
    const bf16* vg = VT + (size_t)(h * 64 + lrow) * M + (size_t)b * S_ + lc * 8;
    v4u kreg = *(const GAS v4u*)(kg + (size_t)kc_lo * 64 * DC), vreg = *(const GAS v4u*)(vg + kc_lo * 64);
    *(LAS v4u*)(kv + lofs) = kreg; *(LAS v4u*)(kv + 8192 + lofs) = vreg;
    __syncthreads();
    const int fsw = (r32 >> 1) & 7;
    for (int s = 0; s < ns; ++s) {
        const int kc = kc_lo + s; const LAS unsigned char* buf = kv + (s & 1) * 16384;
        if (s + 1 < ns) { kreg = *(const GAS v4u*)(kg + (size_t)(kc + 1) * 64 * DC); vreg = *(const GAS v4u*)(vg + (kc + 1) * 64); }
        if (kc >= n - 8 && kc <= n) {
#pragma unroll
            for (int kb = 0; kb < 2; ++kb) {
                const int key0 = kc * 64 + kb * 32;
                bf16x8 kf[4];
#pragma unroll
                for (int d0 = 0; d0 < 4; ++d0) kf[d0] = *(const LAS bf16x8*)(buf + (kb * 32 + r32) * 128 + (((2 * d0 + hi) ^ fsw) << 4));
                s16x4 va[2][2][2];
#pragma unroll
                for (int db = 0; db < 2; ++db)
#pragma unroll
                    for (int s2 = 0; s2 < 2; ++s2)
#pragma unroll
                        for (int hf = 0; hf < 2; ++hf) va[db][s2][hf] = *(const LAS s16x4*)(buf + 8192 + (db * 32 + r32) * 128 + (((kb * 4 + 2 * s2 + hf) ^ fsw) << 4) + 8 * hi);
                f32x16 sc; const int jb = (n - kc) * 2 + kb;
                if (n - kc >= 3) {
#pragma unroll
                    for (int r = 0; r < 16; ++r) sc[r] = b0;
                } else { const LAS f32x4* tp = (const LAS f32x4*)(btile + ((qh * 6 + jb) * 4) * 256) + lane;
#pragma unroll
                    for (int q4 = 0; q4 < 4; ++q4) { const f32x4 t4 = tp[q4 * 64]; sc[4 * q4] = t4.x; sc[4 * q4 + 1] = t4.y; sc[4 * q4 + 2] = t4.z; sc[4 * q4 + 3] = t4.w; } }
#pragma unroll
                for (int d0 = 0; d0 < 4; ++d0) sc = MFMA32(kf[d0], qf[d0], sc);
                float mx = sc[0];
#pragma unroll
                for (int r = 1; r < 16; ++r) mx = fmaxf(mx, sc[r]);
                mx = fmaxf(mx, __shfl_xor(mx, 32));
                const float mn = fmaxf(m, mx);
                if (__any(mn > m)) { const float alpha = __builtin_amdgcn_exp2f(m - mn); l *= alpha;
#pragma unroll
                    for (int r = 0; r < 16; ++r) { o0[r] *= alpha; o1[r] *= alpha; } }
                m = mn;
                float ps = 0.f;
#pragma unroll
                for (int r = 0; r < 16; ++r) { sc[r] = __builtin_amdgcn_exp2f(sc[r] - mn); ps += sc[r]; }
                l += ps;
                v4u p0, p1;
                p0.x = pk2(sc[0], sc[1]); p0.y = pk2(sc[2], sc[3]); p0.z = pk2(sc[4], sc[5]); p0.w = pk2(sc[6], sc[7]);
                p1.x = pk2(sc[8], sc[9]); p1.y = pk2(sc[10], sc[11]); p1.z = pk2(sc[12], sc[13]); p1.w = pk2(sc[14], sc[15]);
                const bf16x8 pb0 = __builtin_bit_cast(bf16x8, p0), pb1 = __builtin_bit_cast(bf16x8, p1);
#define VA8(db, s2) (bf16x8){va[db][s2][0][0], va[db][s2][0][1], va[db][s2][0][2], va[db][s2][0][3], va[db][s2][1][0], va[db][s2][1][1], va[db][s2][1][2], va[db][s2][1][3]}
                o0 = MFMA32(VA8(0, 0), pb0, o0); o0 = MFMA32(VA8(0, 1), pb1, o0);
                o1 = MFMA32(VA8(1, 0), pb0, o1); o1 = MFMA32(VA8(1, 1), pb1, o1);
#undef VA8
            }
        }
        if (s + 1 < ns) { LAS unsigned char* nb = kv + ((s + 1) & 1) * 16384; *(LAS v4u*)(nb + lofs) = kreg; *(LAS v4u*)(nb + 8192 + lofs) = vreg; }
        __syncthreads();
    }
    l += __shfl_xor(l, 32); const float il = 1.f / l;
    bf16* yp = YC + rowq * D + DC + h * 64 + 4 * hi;
#pragma unroll
    for (int gq = 0; gq < 4; ++gq) { v2u w0, w1; w0.x = pk2(o0[4 * gq] * il, o0[4 * gq + 1] * il); w0.y = pk2(o0[4 * gq + 2] * il, o0[4 * gq + 3] * il);
        w1.x = pk2(o1[4 * gq] * il, o1[4 * gq + 1] * il); w1.y = pk2(o1[4 * gq + 2] * il, o1[4 * gq + 3] * il);
        *(GAS v2u*)(yp + 8 * gq) = w0; *(GAS v2u*)(yp + 32 + 8 * gq) = w1; }
}
__device__ __forceinline__ void mixer_phase(const Params& P, LAS unsigned char* lds, int l, int tid, int lane, int wave, int wgi) {
    LAS float* tile = (LAS float*)lds; LAS float* biasL = (LAS float*)(lds + 65536); LAS unsigned char* kv = lds + 73728;
    { const float* rb = P.in[14] + l * 8 * NREL; for (int i = tid; i < 8 * NREL; i += NTHR) biasL[i] = rb[i] * LOG2E; }
    __syncthreads();
    const bf16* Z = (const bf16*)(P.ws + WS_Z); const bf16* Q = (const bf16*)(P.ws + WS_Q); const bf16* K = (const bf16*)(P.ws + WS_K); const bf16* VT = (const bf16*)(P.ws + WS_VT); bf16* YC = (bf16*)(P.ws + WS_YC);
    for (int rp = 0; rp < 1 + ((REPMASK >> 20) & 1); ++rp)
    for (int cu = 0; cu < 2; ++cu) conv_unit(Z, YC, P.in[8] + l * CW * DC, P.in[9] + l * DC, P.in[10] + l * DC, P.in[11] + l * DC, tile, wgi * 2 + cu, tid, wave, lane);
    { const int b = wgi >> 5, h = (wgi >> 2) & 7, gp = wgi & 3;
      for (int i = tid; i < 2 * 6 * 16 * 64; i += NTHR) { const int ln = (i >> 2) & 63, r = ((i >> 8) & 3) * 4 + (i & 3), jb = (i >> 10) % 6, qh = i / 6144;
          int rel = -64 * (jb >> 1) + 32 * (jb & 1) - 32 * qh + crow(r, ln >> 5) - (ln & 31); rel = rel < -128 ? -128 : (rel > 128 ? 128 : rel); tile[i] = biasL[h * NREL + rel + 128]; }
      const float b0 = biasL[h * NREL];
      __syncthreads();
      for (int rp = 0; rp < 1 + ((REPMASK >> 21) & 1); ++rp)
      for (int au = 0; au < 2; ++au) attn_unit(Q, K, VT, YC, tile, b0, kv, b, h, au ? 7 - gp : gp, tid, wave, lane); }
    __syncthreads();
}

#define PHASE(k, ...) do { { __VA_ARGS__ } if constexpr ((REPMASK >> (k)) & 1) { xcd_barrier(bar); RETID(); { __VA_ARGS__ } } } while (0)
__global__ void __launch_bounds__(NTHR, 2) fwd(Params P) {
    extern __shared__ __attribute__((aligned(16))) unsigned char lds_raw[];
    LAS unsigned char* lds = (LAS unsigned char*)lds_raw;
    int tid = threadIdx.x, lane = tid & 63, wave = __builtin_amdgcn_readfirstlane(tid >> 6); const int wgi = blockIdx.x; int gw = wgi * NWAVES + wave;
#define RETID() do { tid = threadIdx.x; asm volatile("" : "+v"(tid)); lane = tid & 63; wave = __builtin_amdgcn_readfirstlane(tid >> 6); gw = wgi * NWAVES + wave; } while (0)
    for (int u = tid; u < (LDS_BYTES - LDSCTL_OFF) / 4; u += NTHR) ((LAS unsigned*)(lds + LDSCTL_OFF))[u] = 0u;
    __syncthreads();
    unsigned* ctl = (unsigned*)(P.ws + WS_CTL);
    XcdBarrier bar = xcd_barrier_post(ctl + CW_BAR, (volatile LAS unsigned*)(lds + MISC_OFF) + 8);
    const int stop = P.stop;
#define SEAM(k) do { if (stop == (k)) return; xcd_barrier(bar); RETID(); } while (0)
    bf16* H = (bf16*)(P.ws + WS_H); float* mod = (float*)(P.ws + WS_MOD);

    PHASE(0, phase0(P, lds, tid, lane, wave, gw););                                                      SEAM(0);
    PHASE(1, norm_phase(P, lds, P.in[0], P.in[4], 0, 0, 1024, true, tid, lane, wave, wgi););             SEAM(1);
#define LAYER_COMMON(l, pb, xin) \
    PHASE(2,   \
        const bf16* Wl = (const bf16*)(P.ws + WS_WIN) + (size_t)(l) * DIN * D; \
        { pg8::Gemm g{H, Wl, M, 2048, D, 0}; pg8::StaticOrder S; S.init(M, 2048, GRID, wgi); \
          pg8::EpiInProj E{(bf16*)(P.ws + WS_Z), (bf16*)(P.ws + WS_Q), (bf16*)(P.ws + WS_K), P.in[12] + (l) * 64, P.in[13] + (l) * 64, QSCALE}; \
          pg8::gemm_phase<pg8::EpiInProj, pg8::StaticOrder, true, true>(lds, g, S, E); } \
        { pg8::Gemm g{Wl + (size_t)2048 * D, H, 512, M, D, 0}; pg8::StaticOrder S; S.init(512, M, GRID, wgi); \
          pg8::EpiBf16 E{(bf16*)(P.ws + WS_VT), M, 1.f}; \
          pg8::gemm_phase<pg8::EpiBf16, pg8::StaticOrder, true, true>(lds, g, S, E); } ); \
    SEAM(pb); \
    PHASE(3, mixer_phase(P, lds, (l), tid, lane, wave, wgi);); \
    SEAM((pb) + 1); \
    PHASE(4 + 10 * (l),   \
        pg8::Gemm g{(const bf16*)(P.ws + WS_YC), (const bf16*)(P.ws + WS_WOUT) + (size_t)(l) * D * D, M, D, D, 0}; pg8::StaticOrder S; S.init(M, D, GRID, wgi); \
        pg8::EpiResGate E{(xin), P.out, mod + (size_t)(l) * 8 * 6144 + 2048}; \
        pg8::gemm_phase<pg8::EpiResGate, pg8::StaticOrder, false, true>(lds, g, S, E); ); \
    SEAM((pb) + 2);

    LAYER_COMMON(0, 2, P.in[0])
    PHASE(5, norm_phase(P, lds, P.out, P.in[5], 0, 3072, 4096, false, tid, lane, wave, wgi););          SEAM(5);
    PHASE(6, pg8::Gemm g{H, (const bf16*)(P.ws + WS_WGU), M, 2 * FFD, D, 0}; pg8::StaticOrder S; S.init(M, 2 * FFD, GRID, wgi);
             pg8::EpiSwiGLU<false> E{(bf16*)(P.ws + WS_ACT), FFD, nullptr, 1.f, 1.f};
             pg8::gemm_phase<pg8::EpiSwiGLU<false>, pg8::StaticOrder, true, true>(lds, g, S, E););
    SEAM(6);
    PHASE(30, pg8::Gemm g{(const bf16*)(P.ws + WS_ACT), (const bf16*)(P.ws + WS_WD), M, D, FFD, 0}; pg8::StaticOrder S; S.init(M, D, GRID, wgi);
              pg8::EpiResGate E{P.out, P.out, mod + 5120};
              pg8::gemm_phase<pg8::EpiResGate, pg8::StaticOrder, false, true>(lds, g, S, E););
    SEAM(7);
    PHASE(8, norm_phase(P, lds, P.out, P.in[4] + D, 1, 0, 1024, false, tid, lane, wave, wgi););         SEAM(8);
    LAYER_COMMON(1, 9, P.out)
    PHASE(31, router_phase(P, lds, P.out, tid, lane, wave, wgi););                                       SEAM(12);
    moe_tables(P, lds, tid);
    {
        const LAS int* tab = (const LAS int*)(lds + MOETAB_OFF);
        const int ptot = RFL(tab[8]);
        PHASE(11, pg8::Gemm g{(const bf16*)(P.ws + WS_HG), (const bf16*)(P.ws + WS_WMGU), ptot, 2 * FFE, D, (unsigned)(2 * FFE * D)};
                  pg8::MoeOrder S; S.nM = ptot >> 8; S.nN = 2 * FFE / 256; S.nwg = S.nM * S.nN; S.G = GRID; S.c = wgi; S.capA = true;
                  S.t1 = RFL(tab[1] >> 8); S.t2 = RFL(tab[2] >> 8); S.t3 = RFL(tab[3] >> 8); S.t4 = RFL(tab[4] >> 8); S.t5 = RFL(tab[5] >> 8); S.t6 = RFL(tab[6] >> 8); S.t7 = RFL(tab[7] >> 8);
                  pg8::EpiSwiGLU<true> E{(bf16*)(P.ws + WS_ACTM), FFE, (const float*)(P.ws + WS_WL), A8_SCALE / (H8_SCALE * W8_SCALE), 1.f / (H8_SCALE * W8_SCALE)};
                  pg8::gemm_phase<pg8::EpiSwiGLU<true>, pg8::MoeOrder, true, true, true>(lds, g, S, E););
        if constexpr ((REPMASK >> 22) & 1) { xcd_barrier(bar); RETID();
                  pg8::Gemm g{(const bf16*)(P.ws + WS_HG), (const bf16*)(P.ws + WS_WMGU), ptot, 2 * FFE, D, (unsigned)(2 * FFE * D)};
                  pg8::MoeOrder S; S.nM = ptot >> 8; S.nN = 2 * FFE / 256; S.nwg = S.nM * S.nN; S.G = GRID; S.c = wgi; S.capA = true;
                  S.t1 = RFL(tab[1] >> 8); S.t2 = RFL(tab[2] >> 8); S.t3 = RFL(tab[3] >> 8); S.t4 = RFL(tab[4] >> 8); S.t5 = RFL(tab[5] >> 8); S.t6 = RFL(tab[6] >> 8); S.t7 = RFL(tab[7] >> 8);
                  pg8::EpiNone E{};
                  pg8::gemm_phase<pg8::EpiNone, pg8::MoeOrder, true, true, true>(lds, g, S, E); }
        SEAM(14);
        PHASE(12, pg8::Gemm g{(const bf16*)(P.ws + WS_ACTM), (const bf16*)(P.ws + WS_WMD), ptot, D, FFE, (unsigned)(D * FFE)};
                  pg8::MoeOrder S; S.nM = ptot >> 8; S.nN = D / 256; S.nwg = S.nM * S.nN; S.G = GRID; S.c = wgi; S.capA = false;
                  S.t1 = RFL(tab[1] >> 8); S.t2 = RFL(tab[2] >> 8); S.t3 = RFL(tab[3] >> 8); S.t4 = RFL(tab[4] >> 8); S.t5 = RFL(tab[5] >> 8); S.t6 = RFL(tab[6] >> 8); S.t7 = RFL(tab[7] >> 8);
                  pg8::EpiBf16 E{(bf16*)(P.ws + WS_F), D, 1.f / (A8_SCALE * W8_SCALE)};
                  pg8::gemm_phase<pg8::EpiBf16, pg8::MoeOrder, true, true, true>(lds, g, S, E););
        SEAM(15);
        PHASE(29, combine_phase(P, lds, lane, gw););
    }
#undef SEAM
}
static int launch_fast(void* const* d_in, float* out, unsigned char* ws, hipStream_t stream, int stop) {
    static int ready = 0;
    if (ready == 0) {
        if (hipFuncSetAttribute((const void*)fwd, hipFuncAttributeMaxDynamicSharedMemorySize, LDS_BYTES) != hipSuccess) { fprintf(stderr, "kernel_launch: hipFuncSetAttribute failed\n"); ready = -1; return -1; }
        int per_cu = 0; if (hipOccupancyMaxActiveBlocksPerMultiprocessor(&per_cu, (const void*)fwd, NTHR, LDS_BYTES) != hipSuccess || per_cu < 1) fprintf(stderr, "kernel_launch: occupancy query reports %d blocks per CU\n", per_cu);
        (void)hipGetLastError(); ready = 1;
    }
    if (ready < 0) return -1;
    if (hipMemsetAsync(ws + WS_CTL, 0, CTL_ZERO_BYTES, stream) != hipSuccess) return -1;
    Params p{}; for (int i = 0; i < 23; ++i) p.in[i] = (const float*)d_in[i]; p.out = out; p.ws = ws; p.stop = stop; p.pad = 0;
    hipLaunchKernelGGL(fwd, dim3(GRID), dim3(NTHR), LDS_BYTES, stream, p);
    return hipPeekAtLastError() == hipSuccess ? 0 : -1;
}
}
#ifndef DBG_STAGE
#define DBG_STAGE 0
#endif
extern "C" void kernel_launch(void* const* d_in, const int* in_sizes, int n_in, void* d_out, int out_size, void* d_ws, size_t ws_size, hipStream_t stream) {
    if (n_in != 23 || out_size != fk::M * fk::D || ws_size < fk::WS_END) { fprintf(stderr, "kernel_launch: unexpected shapes / workspace (%d inputs, out %d, ws %zu)\n", n_in, out_size, ws_size); return; }
    unsigned char* ws = (unsigned char*)d_ws; float* out = (float*)d_out;
#if DBG_STAGE == 0
    fk::launch_fast(d_in, out, ws, stream, -1);
#else
    constexpr int S = DBG_STAGE; constexpr size_t MiB = 1u << 20;
    float* ckf = (float*)(ws + 390 * MiB); float* acc = (float*)(ws + 389 * MiB);
    int stop = -1; size_t off = 0, n = 0; float scale = 1.f; bool isf32 = false;
    const size_t NM = (size_t)fk::M;
    switch (S) {
        case 1: stop = 1; off = fk::WS_H; n = NM * 1024; break;
        case 2: stop = 2; off = fk::WS_Z; n = NM * 512; break;
        case 3: stop = 2; off = fk::WS_Q; n = NM * 512; scale = 1.f / fk::QSCALE; break;
        case 4: stop = 2; off = fk::WS_K; n = NM * 512; break;
        case 5: stop = 3; off = fk::WS_YC; n = NM * 1024; break;
        case 6: stop = 4; isf32 = true; n = NM * 1024; break;
        case 7: stop = 5; off = fk::WS_H; n = NM * 1024; break;
        case 8: stop = 6; off = fk::WS_ACT; n = NM * 1024; break;
        case 9: stop = 7; isf32 = true; n = NM * 1024; break;
        case 11: stop = 8; off = fk::WS_H; n = NM * 1024; break;
        case 12: stop = 9; off = fk::WS_Z; n = NM * 512; break;
        case 13: stop = 9; off = fk::WS_Q; n = NM * 512; scale = 1.f / fk::QSCALE; break;
        case 14: stop = 9; off = fk::WS_K; n = NM * 512; break;
        case 15: stop = 10; off = fk::WS_YC; n = NM * 1024; break;
        case 16: stop = 11; isf32 = true; n = NM * 1024; break;
        default: stop = -1; isf32 = true; n = NM * 1024; break;
    }
    fk::launch_fast(d_in, out, ws, stream, stop);
    if (isf32) nv::k_copy<<<(unsigned)((n + 255) / 256), 256, 0, stream>>>(out, ckf, n);
    else nv::k_cvt<<<(unsigned)((n + 255) / 256), 256, 0, stream>>>((const unsigned short*)(ws + off), ckf, n, scale);
    hipMemsetAsync(acc, 0, 256, stream);
    nv::forward(d_in, out, ws, stream, S, ckf, acc);
    if (S == 99) nv::k_cmp<<<1024, 256, 0, stream>>>(ckf, out, n, acc);
    nv::k_scale<<<(unsigned)((NM * 1024 + 255) / 256), 256, 0, stream>>>(out, NM * 1024, acc);
#endif
}
```

```cpp
#include <hip/hip_runtime.h>
#include <cstdio>
#include <cstdint>
#define DBG_STAGE 0
#define REPMASK 0
namespace pg8 {
#define PG8_LAS __attribute__((address_space(3)))
typedef unsigned short bf16_t;
typedef short bf16x8 __attribute__((ext_vector_type(8)));
typedef float f32x4 __attribute__((ext_vector_type(4)));
typedef unsigned u32x4 __attribute__((ext_vector_type(4)));
constexpr int BM = 256, BK = 64, HALF = 128, HTB = HALF * BK * 2  , STAGE_BYTES = 8 * HTB, NXCD = 8, WGM = 8;

__host__ __device__ __forceinline__ int lds_byte(int r, int c) { const int st = (r >> 4) * 2 + (c >> 5), rr = r & 15, cc = c & 31, ob = rr * 64 + cc * 2; return st * 1024 + (ob ^ (((ob >> 9) & 1) << 5)); }
__host__ __device__ __forceinline__ void stage_rc(int b, int& R, int& C) { const int st = b / 1024, sb = b % 1024, swz = sb ^ (((sb >> 9) & 1) << 5); R = (st >> 1) * 16 + swz / 64; C = (st & 1) * 32 + (swz % 64) / 2; }
__host__ __device__ __forceinline__ int perm32(int rho) { const int n = rho >> 4, i = rho & 15; return 8 * (i >> 2) + 4 * n + (i & 3); }

struct Unit { int pm, pn, e, pa, ks; };
struct Gemm { const bf16_t* A; const bf16_t* Bt; int M, N, K; unsigned bstride; int ld; };

struct StaticOrder {
    int nM, nN, nwg, G, c;
    __device__ void init(int M, int N, int G_, int c_) { nM = M / BM; nN = N / BM; nwg = nM * nN; G = G_; c = c_; }
    __device__ bool next(int i, Unit& u) const {
        const long L = (long)i * G + c; if (L >= nwg) return false;
        int wgid = (int)L; { const int q = nwg / NXCD, r = nwg % NXCD, xcd = wgid % NXCD, off = wgid / NXCD; wgid = (xcd < r ? xcd * (q + 1) : r * (q + 1) + (xcd - r) * q) + off; }
        const int nig = WGM * nN, gid = wgid / nig, fm = gid * WGM, gsz = (nM - fm) < WGM ? (nM - fm) : WGM;
        u.pm = fm + ((wgid % nig) % gsz); u.pn = (wgid % nig) / gsz; u.e = 0; u.pa = u.pm; u.ks = 0; return true;
    }
    __device__ __forceinline__ void a_ready(const Unit&) const {}
    __device__ __forceinline__ void done(const Unit&) const {}
};
struct MoeOrder {
    int nM, nN, nwg, G, c; int t1, t2, t3, t4, t5, t6, t7; bool capA;
    __device__ bool next(int i, Unit& u) const {
        const long L = (long)i * G + c; if (L >= nwg) return false;
        int wgid = (int)L; { const int q = nwg / NXCD, r = nwg % NXCD, xcd = wgid % NXCD, off = wgid / NXCD; wgid = (xcd < r ? xcd * (q + 1) : r * (q + 1) + (xcd - r) * q) + off; }
        const int nig = WGM * nN, gid = wgid / nig, fm = gid * WGM, gsz = (nM - fm) < WGM ? (nM - fm) : WGM;
        u.pm = fm + ((wgid % nig) % gsz); u.pn = (wgid % nig) / gsz;
        const int p = u.pm; u.e = (p >= t1) + (p >= t2) + (p >= t3) + (p >= t4) + (p >= t5) + (p >= t6) + (p >= t7);
        if (capA) { int ts = 0; ts = p >= t1 ? t1 : ts; ts = p >= t2 ? t2 : ts; ts = p >= t3 ? t3 : ts; ts = p >= t4 ? t4 : ts; ts = p >= t5 ? t5 : ts; ts = p >= t6 ? t6 : ts; ts = p >= t7 ? t7 : ts; u.pa = u.e * 64 + (p - ts); }
        else u.pa = p;
        u.ks = 0; return true;
    }
    __device__ __forceinline__ void a_ready(const Unit&) const {}
    __device__ __forceinline__ void done(const Unit&) const {}
};

struct RemOrder {
    int tm0, nrem, G, c; int t1, t2, t3, t4, t5, t6, t7; static constexpr int NSPLIT = 7;
    __device__ bool next(int i, Unit& u) const {
        const int L = i * G + c; if (L >= nrem * 4 * NSPLIT) return false;
        u.ks = L % NSPLIT; u.pn = (L / NSPLIT) & 3; u.pm = tm0 + L / (4 * NSPLIT); u.pa = u.pm;
        const int p = u.pm; u.e = (p >= t1) + (p >= t2) + (p >= t3) + (p >= t4) + (p >= t5) + (p >= t6) + (p >= t7); return true;
    }
    __device__ __forceinline__ void a_ready(const Unit&) const {}
    __device__ __forceinline__ void done(const Unit&) const {}
};
__device__ __forceinline__ unsigned cvt_pk_bf16(float lo, float hi) { unsigned r; asm volatile("v_cvt_pk_bf16_f32 %0, %1, %2" : "=v"(r) : "v"(lo), "v"(hi)); return r; }
typedef int v8i __attribute__((ext_vector_type(8))); typedef int v4i __attribute__((ext_vector_type(4)));
__device__ __forceinline__ v8i cat8(bf16x8 lo, bf16x8 hi) { const v4i a = __builtin_bit_cast(v4i, lo), b = __builtin_bit_cast(v4i, hi); return __builtin_shufflevector(a, b, 0, 1, 2, 3, 4, 5, 6, 7); }
__device__ __forceinline__ unsigned pk4_fp8(float a, float b, float c, float d) { int w = __builtin_amdgcn_cvt_pk_fp8_f32(a, b, 0, false); w = __builtin_amdgcn_cvt_pk_fp8_f32(c, d, w, true); return (unsigned)w; }
__device__ __forceinline__ float sigm(float x) { return __builtin_amdgcn_rcpf(1.f + __builtin_amdgcn_exp2f(-1.4426950408889634f * x)); }
__device__ __forceinline__ u32x4 pack8(f32x4 v0, f32x4 v1) { u32x4 w; w.x = cvt_pk_bf16(v0[0], v0[1]); w.y = cvt_pk_bf16(v0[2], v0[3]); w.z = cvt_pk_bf16(v1[0], v1[1]); w.w = cvt_pk_bf16(v1[2], v1[3]); return w; }

template <bool NORM> struct EpiBf16 {
    static constexpr bool PERM = true, AFTER_DRAIN = false;
    bf16_t* O; int ldc; float scale; size_t slab;
    const float* ss; const float* cvec;
    __device__ __forceinline__ void operator()(const f32x4 (&acc)[2][2][4][2], const Unit& u, int wr, int wc, int fr, int fq) const {
        const int row0 = u.pm * BM + wr * 64 + fr; const int col0 = u.pn * BM + wc * 32 + 8 * fq;
        f32x4 rc[2][2];
        if constexpr (NORM) {
#pragma unroll
            for (int bj = 0; bj < 2; ++bj)
#pragma unroll
                for (int n = 0; n < 2; ++n) { const f32x4 q = *(const f32x4*)(ss + col0 + bj * HALF + 4 * n);
#pragma unroll
                    for (int i = 0; i < 4; ++i) rc[bj][n][i] = __builtin_amdgcn_rsqf(q[i] * (1.f / 1024.f) + 1e-6f); } }
#pragma unroll
        for (int ai = 0; ai < 2; ++ai)
#pragma unroll
            for (int m = 0; m < 4; ++m) { bf16_t* rowp = O + (size_t)u.ks * slab + (size_t)(row0 + ai * HALF + m * 16) * ldc + col0;
#pragma unroll
                for (int bj = 0; bj < 2; ++bj) { f32x4 v0 = acc[ai][bj][m][0] * scale, v1 = acc[ai][bj][m][1] * scale;
                    if constexpr (NORM) { const float cb = cvec[(size_t)(u.pn >> 3) * 2560 + row0 + ai * HALF + m * 16]; v0 = v0 * rc[bj][0] + cb; v1 = v1 * rc[bj][1] + cb; }
                    *(u32x4*)(rowp + bj * HALF) = pack8(v0, v1); } }
    }
};
template <bool NORM> struct EpiInProj {
    static constexpr bool PERM = true, AFTER_DRAIN = false;
    bf16_t *Z, *Q, *Kt; const float *qg, *kg; float qscale;
    const float* ss; const float* cvec;
    __device__ __forceinline__ void operator()(const f32x4 (&acc)[2][2][4][2], const Unit& u, int wr, int wc, int fr, int fq) const {
        const int row0 = u.pm * BM + wr * 64 + fr;
        f32x4 cv[2][2]; float rr[2][4];
#pragma unroll
        for (int bj = 0; bj < 2; ++bj)
#pragma unroll
            for (int n = 0; n < 2; ++n) { if constexpr (NORM) cv[bj][n] = *(const f32x4*)(cvec + (size_t)(u.pm >> 3) * 2560 + u.pn * BM + bj * HALF + wc * 32 + 8 * fq + 4 * n); else cv[bj][n] = (f32x4){0.f, 0.f, 0.f, 0.f}; }
#pragma unroll
        for (int ai = 0; ai < 2; ++ai)
#pragma unroll
            for (int m = 0; m < 4; ++m) { if constexpr (NORM) rr[ai][m] = __builtin_amdgcn_rsqf(ss[row0 + ai * HALF + m * 16] * (1.f / 1024.f) + 1e-6f); else rr[ai][m] = 1.f; }
#define VAL(ai, bj, m, n) (NORM ? acc[ai][bj][m][n] * rr[ai][m] + cv[bj][n] : acc[ai][bj][m][n])
        if (u.pn < 4) {
            const int col0 = u.pn * 128 + wc * 32 + 8 * fq;
#pragma unroll
            for (int ai = 0; ai < 2; ++ai)
#pragma unroll
                for (int m = 0; m < 4; ++m) { f32x4 z0, z1;
                    const f32x4 a0 = VAL(ai, 0, m, 0), a1 = VAL(ai, 0, m, 1), g0 = VAL(ai, 1, m, 0), g1 = VAL(ai, 1, m, 1);
#pragma unroll
                    for (int i = 0; i < 4; ++i) { z0[i] = a0[i] * sigm(g0[i]); z1[i] = a1[i] * sigm(g1[i]); }
                    *(u32x4*)(Z + (size_t)(row0 + ai * HALF + m * 16) * 512 + col0) = pack8(z0, z1); }
        } else {
            const bool isq = u.pn < 6; bf16_t* O = isq ? Q : Kt; const float* gv = isq ? qg : kg; const float sc = isq ? qscale : 1.f;
            const int head = 4 * (u.pn & 1) + wc;
            f32x4 gw[2][2];
#pragma unroll
            for (int bj = 0; bj < 2; ++bj)
#pragma unroll
                for (int n = 0; n < 2; ++n) gw[bj][n] = *(const f32x4*)(gv + 32 * bj + 8 * fq + 4 * n) * sc;
#pragma unroll
            for (int ai = 0; ai < 2; ++ai)
#pragma unroll
                for (int m = 0; m < 4; ++m) { float hs = 0.f; f32x4 xv[2][2];
#pragma unroll
                    for (int bj = 0; bj < 2; ++bj)
#pragma unroll
                        for (int n = 0; n < 2; ++n) { const f32x4 x = VAL(ai, bj, m, n); xv[bj][n] = x; hs += (x[0] * x[0] + x[1] * x[1]) + (x[2] * x[2] + x[3] * x[3]); }
                    hs += __shfl_xor(hs, 16); hs += __shfl_xor(hs, 32);
                    const float r = __builtin_amdgcn_rsqf(hs * (1.f / 64.f) + 1e-6f);
                    bf16_t* rowp = O + (size_t)(row0 + ai * HALF + m * 16) * 512 + head * 64 + 8 * fq;
#pragma unroll
                    for (int bj = 0; bj < 2; ++bj) *(u32x4*)(rowp + 32 * bj) = pack8(xv[bj][0] * r * gw[bj][0], xv[bj][1] * r * gw[bj][1]); }
        }
#undef VAL
    }
};
template <bool NORM, bool INBF = false, bool OUTBF = false> struct EpiResGate {
    static constexpr bool PERM = false, AFTER_DRAIN = false;
    const float* xin; float* out; const float* gate;
    bf16_t* xg; float* ss; const float* gnext; const float* scnext;
    __device__ __forceinline__ void operator()(const f32x4 (&acc)[2][2][4][2], const Unit& u, int wr, int wc, int fr, int fq) const {
        const int row0 = u.pm * BM + wr * 64 + fr, col0 = u.pn * BM + wc * 32 + 4 * fq; const float* gp = gate + (size_t)(u.pm >> 3) * 6144 + col0;
        f32x4 gv[2][2], gm[2][2];
#pragma unroll
        for (int bj = 0; bj < 2; ++bj)
#pragma unroll
            for (int n = 0; n < 2; ++n) { gv[bj][n] = *(const f32x4*)(gp + bj * HALF + n * 16);
                if constexpr (NORM) gm[bj][n] = *(const f32x4*)(gnext + col0 + bj * HALF + n * 16) * (*(const f32x4*)(scnext + (size_t)(u.pm >> 3) * 6144 + col0 + bj * HALF + n * 16) + 1.f); }
#pragma unroll
        for (int ai = 0; ai < 2; ++ai)
#pragma unroll
            for (int m = 0; m < 4; ++m) { const int row = row0 + ai * HALF + m * 16; const size_t off = (size_t)row * 1024 + col0; float sq = 0.f;
#pragma unroll
                for (int bj = 0; bj < 2; ++bj)
#pragma unroll
                    for (int n = 0; n < 2; ++n) { typedef unsigned u32x2b __attribute__((ext_vector_type(2))); f32x4 xv;
                        if constexpr (INBF) { const u32x2b q = *(const u32x2b*)((const bf16_t*)xin + off + bj * HALF + n * 16); xv = (f32x4){__uint_as_float(q.x << 16), __uint_as_float(q.x & 0xffff0000u), __uint_as_float(q.y << 16), __uint_as_float(q.y & 0xffff0000u)}; }
                        else xv = *(const f32x4*)(xin + off + bj * HALF + n * 16);
                        const f32x4 xn = xv + gv[bj][n] * acc[ai][bj][m][n];
                        if constexpr (OUTBF) { u32x2b w; w.x = cvt_pk_bf16(xn[0], xn[1]); w.y = cvt_pk_bf16(xn[2], xn[3]); *(u32x2b*)((bf16_t*)out + off + bj * HALF + n * 16) = w; }
                        else *(f32x4*)(out + off + bj * HALF + n * 16) = xn;
                        if constexpr (NORM) { sq += (xn[0] * xn[0] + xn[1] * xn[1]) + (xn[2] * xn[2] + xn[3] * xn[3]); const f32x4 t = xn * gm[bj][n];
                            typedef unsigned u32x2 __attribute__((ext_vector_type(2))); u32x2 w; w.x = cvt_pk_bf16(t[0], t[1]); w.y = cvt_pk_bf16(t[2], t[3]); *(u32x2*)(xg + off + bj * HALF + n * 16) = w; } }
                if constexpr (NORM) { sq += __shfl_xor(sq, 16); sq += __shfl_xor(sq, 32); if (fq == 0) atomicAdd(ss + row, sq); } }
    }
};
template <bool F8OUT, bool NORM> struct EpiSwiGLU {
    static constexpr bool PERM = true, AFTER_DRAIN = false;
    bf16_t* O; int ldc; const float* rowscale; float oscale, iscale;
    const float* ss; const float* cvec;
    int ncv;
    __device__ __forceinline__ void operator()(const f32x4 (&acc)[2][2][4][2], const Unit& u, int wr, int wc, int fr, int fq) const {
        const int row0 = u.pm * BM + wr * 64 + fr; const int col0 = u.pn * 128 + wc * 32 + 8 * fq;
        f32x4 cg[2], cu[2];
        if constexpr (NORM) { const float* cp = cvec + (size_t)(u.pm >> 3) * ncv + u.pn * BM + wc * 32 + 8 * fq; cg[0] = *(const f32x4*)cp; cg[1] = *(const f32x4*)(cp + 4); cu[0] = *(const f32x4*)(cp + HALF); cu[1] = *(const f32x4*)(cp + HALF + 4); }
#pragma unroll
        for (int ai = 0; ai < 2; ++ai)
#pragma unroll
            for (int m = 0; m < 4; ++m) { const int row = row0 + ai * HALF + m * 16; const float rs = (rowscale ? rowscale[row + (u.pa - u.pm) * BM] : 1.f) * oscale;   f32x4 z0, z1;
                if constexpr (NORM) { const float r = __builtin_amdgcn_rsqf(ss[row] * (1.f / 1024.f) + 1e-6f);
#pragma unroll
                    for (int i = 0; i < 4; ++i) { const float g0 = r * acc[ai][0][m][0][i] + cg[0][i], g1 = r * acc[ai][0][m][1][i] + cg[1][i], u0 = r * acc[ai][1][m][0][i] + cu[0][i], u1 = r * acc[ai][1][m][1][i] + cu[1][i];
                        z0[i] = g0 * sigm(g0) * u0 * rs; z1[i] = g1 * sigm(g1) * u1 * rs; } }
                else {
#pragma unroll
                for (int i = 0; i < 4; ++i) { const float g0 = acc[ai][0][m][0][i] * iscale, g1 = acc[ai][0][m][1][i] * iscale;
                    z0[i] = g0 * sigm(g0) * acc[ai][1][m][0][i] * rs; z1[i] = g1 * sigm(g1) * acc[ai][1][m][1][i] * rs; } }
                if constexpr (F8OUT) { typedef unsigned u32x2 __attribute__((ext_vector_type(2))); u32x2 w; w.x = pk4_fp8(z0[0], z0[1], z0[2], z0[3]); w.y = pk4_fp8(z1[0], z1[1], z1[2], z1[3]);
                    *(u32x2*)((unsigned char*)O + (size_t)row * ldc + col0) = w; }
                else *(u32x4*)(O + (size_t)row * ldc + col0) = pack8(z0, z1); }
    }
};
struct EpiNone {
    static constexpr bool PERM = true, AFTER_DRAIN = false;
    __device__ __forceinline__ void operator()(const f32x4 (&acc)[2][2][4][2], const Unit& u, int wr, int wc, int fr, int fq) const {
#pragma unroll
        for (int ai = 0; ai < 2; ++ai)
#pragma unroll
            for (int bj = 0; bj < 2; ++bj)
#pragma unroll
                for (int m = 0; m < 4; ++m)
#pragma unroll
                    for (int n = 0; n < 2; ++n) asm volatile("" :: "v"(acc[ai][bj][m][n]));
    }
};
__device__ __forceinline__ const char* uptr(const char* p) { unsigned long long v = (unsigned long long)p; const unsigned lo = __builtin_amdgcn_readfirstlane((unsigned)v), hi = __builtin_amdgcn_readfirstlane((unsigned)(v >> 32)); unsigned long long r = ((unsigned long long)hi << 32) | lo; asm volatile("" : "+s"(r)); return (const char*)r; }
template <class Epi, class Sched, bool ALIGN_EPI = false, bool SP2 = false, bool FP8 = false>
__device__ __forceinline__ void gemm_phase(PG8_LAS unsigned char* lds, const Gemm g, const Sched& S, const Epi& E) {
    int tid_ = threadIdx.x; asm volatile("" : "+v"(tid_)); const int tid = tid_, wid = __builtin_amdgcn_readfirstlane(tid >> 6), lane = tid & 63, wr = wid >> 2, wc = wid & 3, fr = lane & 15, fq = lane >> 4;
    const int KB0 = FP8 ? g.K : g.K * 2, nt = KB0 / (BK * 2), KB = g.ld ? (FP8 ? g.ld : g.ld * 2) : KB0;
    unsigned voffA, voffB;
    { int R, C; stage_rc(tid * 16, R, C); const int Rb = Epi::PERM ? ((R & ~31) + perm32(R & 31)) : R;
        voffA = (unsigned)(R * KB + C * 2); voffB = (unsigned)(Rb * KB + C * 2); }
    const unsigned pstep = 64u * KB;
    constexpr unsigned kstep = BK * 2;
    const unsigned hstep = (unsigned)HALF * KB;
    const unsigned tstep = 2 * hstep;
    const unsigned ldsw = (unsigned)wid * 1024u;
    const int aoff = lds_byte(wr * 64 + fr, fq * 8), boff = lds_byte(wc * 32 + fr, fq * 8);
#define PG8_SA(b, h) (((b) * 2 + (h)) * HTB)
#define PG8_SB(b, h) ((4 + (b) * 2 + (h)) * HTB)
#define PG8_STAGE(bufoff, gbase, voff) do { unsigned vo_ = (voff); asm volatile("" : "+v"(vo_));   \
        _Pragma("unroll") for (int _i = 0; _i < 2; ++_i) \
        __builtin_amdgcn_global_load_lds((const unsigned*)((const char*)(gbase) + _i * pstep + vo_), (PG8_LAS unsigned*)(lds + (bufoff) + ldsw + _i * 8192), 16, 0, 0); } while (0)
#define PG8_LDA(dst, b, h) do { _Pragma("unroll") for (int m = 0; m < 4; ++m) { if constexpr (FP8) { const v4i lo_ = *(const PG8_LAS v4i*)(lds + PG8_SA(b, h) + aoff + m * 2048), hi_ = *(const PG8_LAS v4i*)(lds + PG8_SA(b, h) + aoff + m * 2048 + 1024); dst##8[m] = __builtin_shufflevector(lo_, hi_, 0, 1, 2, 3, 4, 5, 6, 7); } \
        else { _Pragma("unroll") for (int k = 0; k < 2; ++k) dst[m][k] = *(const PG8_LAS bf16x8*)(lds + PG8_SA(b, h) + aoff + m * 2048 + k * 1024); } } } while (0)
#define PG8_LDB(dst, b, h) do { _Pragma("unroll") for (int n = 0; n < 2; ++n) { if constexpr (FP8) { const v4i lo_ = *(const PG8_LAS v4i*)(lds + PG8_SB(b, h) + boff + n * 2048), hi_ = *(const PG8_LAS v4i*)(lds + PG8_SB(b, h) + boff + n * 2048 + 1024); dst##8[n] = __builtin_shufflevector(lo_, hi_, 0, 1, 2, 3, 4, 5, 6, 7); } \
        else { _Pragma("unroll") for (int k = 0; k < 2; ++k) dst[n][k] = *(const PG8_LAS bf16x8*)(lds + PG8_SB(b, h) + boff + n * 2048 + k * 1024); } } } while (0)
#define PG8_MMA(ai, bj, At, Bt) do { __builtin_amdgcn_s_setprio(1); _Pragma("unroll") for (int m = 0; m < 4; ++m) _Pragma("unroll") for (int n = 0; n < 2; ++n) { \
        if constexpr (FP8) asm volatile("v_mfma_f32_16x16x128_f8f6f4 %0, %1, %2, %0" : "+v"(acc[ai][bj][m][n]) : "v"(Bt##8[n]), "v"(At##8[m]));   \
        else { _Pragma("unroll") for (int k = 0; k < 2; ++k) acc[ai][bj][m][n] = __builtin_amdgcn_mfma_f32_16x16x32_bf16(Bt[n][k], At[m][k], acc[ai][bj][m][n], 0, 0, 0); } } \
        __builtin_amdgcn_s_setprio(0); } while (0)
#define PG8_WAIT_V(n) asm volatile("s_waitcnt vmcnt(" #n ")" ::: "memory")
#define PG8_WAIT_L(n) asm volatile("s_waitcnt lgkmcnt(" #n ")" ::: "memory")
#define PG8_BAR __builtin_amdgcn_s_barrier()
#define PG8_SCHED __builtin_amdgcn_sched_barrier(0)
    Unit cur, nxt; int ui = 0;
    if (!S.next(0, cur)) return;
    f32x4 acc[2][2][4][2];
#pragma unroll
    for (int a = 0; a < 2; ++a)
#pragma unroll
        for (int b = 0; b < 2; ++b)
#pragma unroll
            for (int m = 0; m < 4; ++m)
#pragma unroll
                for (int n = 0; n < 2; ++n) acc[a][b][m][n] = (f32x4){0.f, 0.f, 0.f, 0.f};
    bf16x8 At[4][2], B0[2][2], B1[2][2]; v8i At8[4], B08[2], B18[2];
    const char* cA = (const char*)g.A + (unsigned)cur.pa * tstep + (unsigned)cur.ks * (unsigned)KB0; const char* cB = (const char*)g.Bt + (unsigned)cur.e * g.bstride + (unsigned)cur.pn * tstep + (unsigned)cur.ks * (unsigned)KB0;
    S.a_ready(cur);
    if constexpr (SP2) {
        PG8_STAGE(PG8_SB(0, 0), cB, voffB); PG8_STAGE(PG8_SB(0, 1), cB + hstep, voffB); PG8_STAGE(PG8_SA(0, 0), cA, voffA); PG8_STAGE(PG8_SA(0, 1), cA + hstep, voffA);
        if (wr == 1) PG8_BAR;
        PG8_WAIT_V(2); PG8_BAR;
        PG8_STAGE(PG8_SB(1, 0), cB + kstep, voffB); PG8_STAGE(PG8_SA(1, 0), cA + kstep, voffA); PG8_STAGE(PG8_SB(1, 1), cB + hstep + kstep, voffB);
        PG8_WAIT_V(6); PG8_BAR;
    } else {
        PG8_STAGE(PG8_SB(0, 0), cB, voffB); PG8_STAGE(PG8_SA(0, 0), cA, voffA); PG8_STAGE(PG8_SB(0, 1), cB + hstep, voffB); PG8_STAGE(PG8_SA(0, 1), cA + hstep, voffA);
        if (wr == 1) PG8_BAR;
        PG8_WAIT_V(4); PG8_BAR;
        PG8_STAGE(PG8_SB(1, 0), cB + kstep, voffB); PG8_STAGE(PG8_SA(1, 0), cA + kstep, voffA); PG8_STAGE(PG8_SB(1, 1), cB + hstep + kstep, voffB);
        PG8_WAIT_V(6); PG8_BAR;
    }
    for (;;) {
        const bool has_next = S.next(ui + 1, nxt);
        const char* nA = has_next ? (const char*)g.A + (unsigned)nxt.pa * tstep + (unsigned)nxt.ks * (unsigned)KB0 : cA; const char* nB = has_next ? (const char*)g.Bt + (unsigned)nxt.e * g.bstride + (unsigned)nxt.pn * tstep + (unsigned)nxt.ks * (unsigned)KB0 : cB;
#pragma unroll 1
        for (int t = 0; t < nt; t += 2) {
            const bool last = (t == nt - 2);
            const char* a1 = cA + (unsigned)(t + 1) * kstep;
            const char* a2 = last ? nA : cA + (unsigned)(t + 2) * kstep; const char* b2 = last ? nB : cB + (unsigned)(t + 2) * kstep;
            const char* a3 = a2 + kstep; const char* b3 = b2 + kstep;
            a1 = uptr(a1); a2 = uptr(a2); b2 = uptr(b2); a3 = uptr(a3); b3 = uptr(b3);
            if (last && has_next) S.a_ready(nxt);
            if constexpr (SP2) {
            PG8_LDB(B0, 0, 0); PG8_LDB(B1, 0, 1); PG8_SCHED; PG8_LDA(At, 0, 0); PG8_STAGE(PG8_SA(1, 1), a1 + hstep, voffA);
            PG8_WAIT_V(8); PG8_WAIT_L(0); PG8_BAR; PG8_MMA(0, 0, At, B0); PG8_MMA(0, 1, At, B1); PG8_BAR; PG8_SCHED;
            PG8_LDA(At, 0, 1); PG8_STAGE(PG8_SB(0, 0), b2, voffB); PG8_STAGE(PG8_SB(0, 1), b2 + hstep, voffB); PG8_STAGE(PG8_SA(0, 0), a2, voffA);
            PG8_WAIT_V(8); PG8_WAIT_L(0); PG8_BAR; PG8_MMA(1, 0, At, B0); PG8_MMA(1, 1, At, B1); PG8_BAR; PG8_SCHED;
            PG8_LDB(B0, 1, 0); PG8_LDB(B1, 1, 1); PG8_SCHED; PG8_LDA(At, 1, 0); PG8_STAGE(PG8_SA(0, 1), a2 + hstep, voffA);
            PG8_WAIT_V(8); PG8_WAIT_L(0); PG8_BAR; PG8_MMA(0, 0, At, B0); PG8_MMA(0, 1, At, B1); PG8_BAR; PG8_SCHED;
            PG8_LDA(At, 1, 1); PG8_STAGE(PG8_SB(1, 0), b3, voffB); PG8_STAGE(PG8_SB(1, 1), b3 + hstep, voffB); PG8_STAGE(PG8_SA(1, 0), a3, voffA);
            PG8_WAIT_V(8); PG8_WAIT_L(0); PG8_BAR; PG8_MMA(1, 0, At, B0); PG8_MMA(1, 1, At, B1); PG8_BAR; PG8_SCHED;
            } else {
            PG8_LDB(B0, 0, 0); PG8_SCHED; PG8_LDA(At, 0, 0); PG8_STAGE(PG8_SA(1, 1), a1 + hstep, voffA);
            PG8_WAIT_L(8); PG8_BAR; PG8_WAIT_L(0); PG8_MMA(0, 0, At, B0); PG8_BAR; PG8_SCHED;
            PG8_LDB(B1, 0, 1); PG8_STAGE(PG8_SB(0, 0), b2, voffB);
            PG8_BAR; PG8_WAIT_L(0); PG8_MMA(0, 1, At, B1); PG8_BAR;
            PG8_LDA(At, 0, 1); PG8_STAGE(PG8_SA(0, 0), a2, voffA);
            PG8_BAR; PG8_WAIT_L(0); PG8_MMA(1, 0, At, B0); PG8_BAR; PG8_SCHED;
            PG8_STAGE(PG8_SB(0, 1), b2 + hstep, voffB);
            PG8_WAIT_V(6); PG8_BAR; PG8_MMA(1, 1, At, B1); PG8_BAR;
            PG8_LDB(B0, 1, 0); PG8_SCHED; PG8_LDA(At, 1, 0); PG8_STAGE(PG8_SA(0, 1), a2 + hstep, voffA);
            PG8_WAIT_L(8); PG8_BAR; PG8_WAIT_L(0); PG8_MMA(0, 0, At, B0); PG8_BAR; PG8_SCHED;
            PG8_LDB(B1, 1, 1); PG8_STAGE(PG8_SB(1, 0), b3, voffB);
            PG8_BAR; PG8_WAIT_L(0); PG8_MMA(0, 1, At, B1); PG8_BAR;
            PG8_LDA(At, 1, 1); PG8_STAGE(PG8_SA(1, 0), a3, voffA);
            PG8_BAR; PG8_WAIT_L(0); PG8_MMA(1, 0, At, B0); PG8_BAR; PG8_SCHED;
            PG8_STAGE(PG8_SB(1, 1), b3 + hstep, voffB);
            PG8_WAIT_V(6); PG8_BAR; PG8_MMA(1, 1, At, B1); PG8_BAR;
            }
        }
        if constexpr (FP8) asm volatile("s_nop 15\n\ts_nop 15" ::: "memory");
        if constexpr (ALIGN_EPI) { if (wr == 0) PG8_BAR; }
        if constexpr (!Epi::AFTER_DRAIN) { int l_ = threadIdx.x; asm volatile("" : "+v"(l_)); const int fr_ = l_ & 15, fq_ = (l_ >> 4) & 3; E(acc, cur, wr, wc, fr_, fq_); S.done(cur); }
        if (!has_next) break;
#pragma unroll
        for (int a = 0; a < 2; ++a)
#pragma unroll
            for (int b = 0; b < 2; ++b)
#pragma unroll
                for (int m = 0; m < 4; ++m)
#pragma unroll
                    for (int n = 0; n < 2; ++n) acc[a][b][m][n] = (f32x4){0.f, 0.f, 0.f, 0.f};
        cur = nxt; cA = nA; cB = nB; ++ui;
        if constexpr (ALIGN_EPI) { if (wr == 1) PG8_BAR; }
    }
    PG8_WAIT_V(0);
    if constexpr (!ALIGN_EPI) { if (wr == 0) PG8_BAR; }
    PG8_BAR;
    if constexpr (Epi::AFTER_DRAIN) { E.fused(acc, cur, wr, wc, fr, fq, lds, wid, lane); S.done(cur); }
#undef PG8_SA
#undef PG8_SB
#undef PG8_STAGE
#undef PG8_LDA
#undef PG8_LDB
#undef PG8_MMA
#undef PG8_WAIT_V
#undef PG8_WAIT_L
#undef PG8_BAR
#undef PG8_SCHED
}
}

namespace fk {
using pg8::bf16_t; using pg8::bf16x8; using pg8::f32x4; using pg8::u32x4;
constexpr int NWAVES = 8, NTHR = 512, GRID = 256, NGW = GRID * NWAVES;
constexpr int B_ = 8, S_ = 2048, D = 1024, M = B_ * S_, DIN = 2560, DC = 512, FFD = 2816, NE = 8, FFE = 3584, CW = 31, NREL = 257;
constexpr float LOG2E = 1.4426950408889634f, QSCALE = 0.125f * LOG2E, EPS = 1e-6f;
constexpr size_t MiB = 1u << 20;
constexpr size_t WS_CTL = 0, CTL_ZERO_BYTES = 1 * MiB;
constexpr size_t WS_SS1 = 256 * 1024, WS_SS2 = 320 * 1024;
constexpr size_t WS_MODP = 1 * MiB;
constexpr size_t WS_CFF = 1 * MiB, WS_CIN = 1 * MiB + 256 * 1024;
constexpr size_t WS_MOD = 4 * MiB;
constexpr size_t WS_PAIR = 4 * MiB + 512 * 1024;
constexpr size_t WS_LIST = 5 * MiB;
constexpr size_t WS_WL = 5 * MiB + 512 * 1024;
constexpr size_t WS_WLG = 6 * MiB;
constexpr size_t WS_WMGU = 8 * MiB;
constexpr size_t WS_WMD = 120 * MiB;
constexpr size_t WS_XB = 64 * MiB;
constexpr size_t WS_FP = 148 * MiB;
constexpr size_t WS_WIN = 176 * MiB;
constexpr size_t WS_WOUT = 186 * MiB;
constexpr size_t WS_WGU = 190 * MiB;
constexpr size_t WS_WD = 201 * MiB;
constexpr size_t WS_H = 207 * MiB;
constexpr size_t WS_Z = 239 * MiB, WS_Q = 255 * MiB, WS_K = 271 * MiB, WS_VT = 287 * MiB;
constexpr size_t WS_YC = 303 * MiB;
constexpr size_t WS_ACT = 239 * MiB;
constexpr size_t WS_HG = 363 * MiB;
constexpr size_t WS_F = 176 * MiB;
constexpr size_t WS_ACTM = 244 * MiB;
constexpr size_t WS_END = 491 * MiB;
constexpr int MAXROWS = 34816;
constexpr int CW_BAR = 4096, CW_CNT = 16384;
constexpr int RING_BYTES = 131072, LDSCTL_OFF = RING_BYTES, MISC_OFF = LDSCTL_OFF + 320, MOETAB_OFF = LDSCTL_OFF + 512;
constexpr int LDS_BYTES = 147456;

#define GAS __attribute__((address_space(1)))
#define LAS __attribute__((address_space(3)))
typedef unsigned short bf16;
typedef unsigned v4u __attribute__((ext_vector_type(4)));
typedef unsigned v2u __attribute__((ext_vector_type(2)));
typedef float f32x16 __attribute__((ext_vector_type(16)));
typedef short s16x4 __attribute__((ext_vector_type(4)));
typedef float f32x2_t __attribute__((ext_vector_type(2))); typedef __bf16 bf16x2_t __attribute__((ext_vector_type(2)));
__device__ __forceinline__ unsigned pk2(float lo, float hi) { f32x2_t v = {lo, hi}; bf16x2_t b = __builtin_convertvector(v, bf16x2_t); return __builtin_bit_cast(unsigned, b); }
__device__ __forceinline__ float bf2f(bf16 v) { return __uint_as_float((unsigned)v << 16); }
__device__ __forceinline__ float wave_sum(float v) {
#pragma unroll
    for (int o = 1; o < 64; o <<= 1) v += __shfl_xor(v, o);
    return v;
}
__device__ __forceinline__ float sigm(float x) { return __builtin_amdgcn_rcpf(1.f + __builtin_amdgcn_exp2f(-LOG2E * x)); }
using pg8::pk4_fp8;
constexpr float W8_SCALE = 64.f, H8_SCALE = 8.f, A8_SCALE = 4.f;
constexpr int E8_W = (127 - 6) * 0x01010101, E8_H = (127 - 3) * 0x01010101, E8_A = (127 - 2) * 0x01010101;
#define LDS_WAIT() asm volatile("s_waitcnt lgkmcnt(0)" ::: "memory")
#define RFL(x) __builtin_amdgcn_readfirstlane(x)

#define XB_TMO      128
#define XB_XCNT(j)  (256  + 64 * (j))
#define XB_XSUB(j)  (1280 + 64 * (j))
#define XB_XGEN(j)  (2304 + 64 * (j))
#define XB_TOP      3328
#define XB_TOPGEN   3392
#define XCD_BAR_WORDS 3456
#define XB_SPIN_CAP (1u << 18)

__device__ __forceinline__ unsigned xb_ld(unsigned* p)              { return __hip_atomic_load(p, __ATOMIC_RELAXED, __HIP_MEMORY_SCOPE_AGENT); }
__device__ __forceinline__ unsigned xb_add(unsigned* p, unsigned v) { return __hip_atomic_fetch_add(p, v, __ATOMIC_RELAXED, __HIP_MEMORY_SCOPE_AGENT); }
__device__ __forceinline__ unsigned xb_xcc_id() { return (unsigned)__builtin_amdgcn_s_getreg((3 << 11) | 20) & 0xFu; }
#define XB_SPIN(cond, bar) do { unsigned _sp = 0; while (cond) { __builtin_amdgcn_s_sleep(1); \
    if ((++_sp & 255u) == 0u) { if (xb_ld(&(bar)[XB_TMO])) break; if (_sp > XB_SPIN_CAP) { atomicAdd(&(bar)[XB_TMO], 1u); break; } } } } while (0)

struct XcdBarrier {
    unsigned* bar; unsigned x;
    volatile LAS unsigned* st;
};

__device__ __forceinline__ XcdBarrier xcd_barrier_post(unsigned* bar, volatile LAS unsigned* st) {
    XcdBarrier b; b.bar = bar; b.x = xb_xcc_id(); b.st = st;
    if (threadIdx.x == 0) (void)xb_add(&bar[XB_XCNT(b.x)], 1u);
    return b;
}
__device__ __forceinline__ void xcd_barrier_complete(unsigned* bar, unsigned x, unsigned& nloc, unsigned& nx) {
    const unsigned G = gridDim.x * gridDim.y * gridDim.z;
    unsigned sum, cnt, mine, sp = 0u;
    for (;;) {
        sum = 0u; cnt = 0u; mine = 0u;
#pragma unroll
        for (unsigned j = 0; j < 16; ++j) { const unsigned c = xb_ld(&bar[XB_XCNT(j)]); sum += c; cnt += (c > 0u) ? 1u : 0u; mine = (j == x) ? c : mine; }
        if (sum == G) break;
        __builtin_amdgcn_s_sleep(1);
        if ((++sp & 255u) == 0u) { if (xb_ld(&bar[XB_TMO])) break; if (sp > XB_SPIN_CAP) { atomicAdd(&bar[XB_TMO], 1u); break; } }
    }
    nloc = mine > 0u ? mine : 1u; nx = cnt > 0u ? cnt : 1u;
}

__device__ __forceinline__ void xcd_barrier(const XcdBarrier& b) {
    asm volatile("s_waitcnt vmcnt(0)" ::: "memory");
    __syncthreads();
    if (threadIdx.x == 0) {
        unsigned* bar = b.bar;
        __builtin_amdgcn_s_waitcnt(0);
        unsigned nloc = b.st[0], nx = b.st[1];
        if (nloc == 0u) { xcd_barrier_complete(bar, b.x, nloc, nx); b.st[0] = nloc; b.st[1] = nx; }
        const unsigned old = xb_add(&bar[XB_XSUB(b.x)], 1u);
        const unsigned gen = old / nloc;
        if (old + 1u == (gen + 1u) * nloc) {
            __builtin_amdgcn_fence(__ATOMIC_RELEASE, "agent");
            asm volatile("s_waitcnt vmcnt(0)" ::: "memory");
            const unsigned og = xb_add(&bar[XB_TOP], 1u);
            const unsigned tg = og / nx;
            if (og + 1u == (tg + 1u) * nx) xb_add(&bar[XB_TOPGEN], 1u);
            else XB_SPIN(xb_ld(&bar[XB_TOPGEN]) == tg, bar);
            __builtin_amdgcn_fence(__ATOMIC_ACQUIRE, "agent");
            xb_add(&bar[XB_XGEN(b.x)], 1u);
            asm volatile("s_waitcnt vmcnt(0)" ::: "memory");
        } else {
            XB_SPIN(xb_ld(&bar[XB_XGEN(b.x)]) == gen, bar);
            __builtin_amdgcn_fence(__ATOMIC_ACQUIRE, "agent");
            asm volatile("s_waitcnt vmcnt(0)" ::: "memory");
        }
    }
    __syncthreads();
}


#ifndef FUSE_NORM
#define FUSE_NORM 0
#endif
#ifndef REPMASK
#define REPMASK 0
#endif
struct Params { const float* in[23]; float* out; unsigned char* ws; int stop; int pad; };

__device__ __forceinline__ void tr_item(const float* W, int K, int N, bf16* WT, int kb, int nb, int drow0, LAS float* scr, int lane) {
    const int k0 = 64 * kb, n0 = 32 * nb;
    { f32x4 v[8];
#pragma unroll
      for (int i = 0; i < 8; ++i) v[i] = *(const GAS f32x4*)(W + (size_t)(k0 + 8 * i + (lane >> 3)) * N + n0 + (lane & 7) * 4);
#pragma unroll
      for (int i = 0; i < 8; ++i) { LAS float* d = scr + (8 * i + (lane >> 3)) * 33 + (lane & 7) * 4; d[0] = v[i].x; d[1] = v[i].y; d[2] = v[i].z; d[3] = v[i].w; } }
    LDS_WAIT(); asm volatile("" ::: "memory");
    const int c = lane & 7;
#pragma unroll
    for (int j = 0; j < 4; ++j) { const int n = (lane >> 3) + 8 * j; const LAS float* s = scr + (8 * c) * 33 + n;
        v4u o; o.x = pk2(s[0 * 33], s[1 * 33]); o.y = pk2(s[2 * 33], s[3 * 33]); o.z = pk2(s[4 * 33], s[5 * 33]); o.w = pk2(s[6 * 33], s[7 * 33]);
        *(GAS v4u*)(WT + (size_t)(drow0 + n) * K + k0 + 8 * c) = o; }
    LDS_WAIT(); asm volatile("" ::: "memory");
}
__device__ __forceinline__ void tr_item_f8(const float* W, int K, int N, unsigned char* WT, int kb, int nb, int drow0, LAS float* scr, int lane, float scale) {
    const int k0 = 64 * kb, n0 = 32 * nb;
    { f32x4 v[8];
#pragma unroll
      for (int i = 0; i < 8; ++i) v[i] = __builtin_nontemporal_load((const GAS f32x4*)(W + (size_t)(k0 + 8 * i + (lane >> 3)) * N + n0 + (lane & 7) * 4));
#pragma unroll
      for (int i = 0; i < 8; ++i) { LAS float* d = scr + (8 * i + (lane >> 3)) * 33 + (lane & 7) * 4; d[0] = v[i].x; d[1] = v[i].y; d[2] = v[i].z; d[3] = v[i].w; } }
    LDS_WAIT(); asm volatile("" ::: "memory");
    const int c = lane & 7;
#pragma unroll
    for (int j = 0; j < 4; ++j) { const int n = (lane >> 3) + 8 * j; const LAS float* s = scr + (8 * c) * 33 + n;
        v2u o; o.x = pk4_fp8(s[0 * 33] * scale, s[1 * 33] * scale, s[2 * 33] * scale, s[3 * 33] * scale); o.y = pk4_fp8(s[4 * 33] * scale, s[5 * 33] * scale, s[6 * 33] * scale, s[7 * 33] * scale);
        __builtin_nontemporal_store(o, (GAS v2u*)(WT + (size_t)(drow0 + n) * K + k0 + 8 * c)); }
    LDS_WAIT(); asm volatile("" ::: "memory");
}
__device__ __forceinline__ int rowmap_win(int n0) {
    if (n0 < 512) return 256 * (n0 >> 7) + (n0 & 127);
    if (n0 < 1024) { const int m = n0 - 512; return 256 * (m >> 7) + 128 + (m & 127); }
    if (n0 < 2048) { const int isk = n0 >= 1536; const int m = n0 - (isk ? 1536 : 1024); const int head = m >> 6, bj = (m >> 5) & 1; return 256 * (4 + 2 * isk + (head >> 2)) + 128 * bj + 32 * (head & 3); }
    return n0;
}
__device__ __forceinline__ int rowmap_gu(int n0, int up) { return 256 * (n0 >> 7) + 128 * up + (n0 & 127); }

constexpr int MOE_ITEMS = 16 * (16 * 112) + 8 * (56 * 32);
constexpr int FILL_S0 = 10240, FILL_S1 = 22528, FILL_S2 = 32768, FILL_MIX = 0, FILL_P0 = FILL_S2 + 2 * FILL_MIX;
struct MoeItem { const float* src; unsigned char* dst; int N, K; };
__device__ __forceinline__ MoeItem moe_item_decode(const Params& P, int r, int lane) {
    constexpr int I_MG = 16 * 112, I_MD = 56 * 32; MoeItem m;
    if (r < 16 * I_MG) { const int mat = r / I_MG, q = r % I_MG, e = mat >> 1, up = mat & 1; const int kb = q / 112, nb = q % 112;
        m.N = FFE; m.K = D; m.src = (up ? P.in[21] : P.in[20]) + (size_t)e * D * FFE + (size_t)(64 * kb + (lane >> 3)) * FFE + 32 * nb + (lane & 7) * 4;
        m.dst = (unsigned char*)(P.ws + WS_WMGU) + (size_t)e * 7168 * D + (size_t)rowmap_gu(32 * nb, up) * D + 64 * kb; }
    else { r -= 16 * I_MG; const int e = r / I_MD, q = r % I_MD; const int kb = q / 32, nb = q % 32;
        m.N = D; m.K = FFE; m.src = P.in[22] + (size_t)e * FFE * D + (size_t)(64 * kb + (lane >> 3)) * D + 32 * nb + (lane & 7) * 4;
        m.dst = (unsigned char*)(P.ws + WS_WMD) + (size_t)e * D * FFE + (size_t)(32 * nb) * FFE + 64 * kb; }
    return m;
}
__device__ __forceinline__ void moe_item_load(const MoeItem& m, f32x4 (&v)[8]) {
#pragma unroll
    for (int i = 0; i < 8; ++i) v[i] = __builtin_nontemporal_load((const GAS f32x4*)(m.src + (size_t)(8 * i) * m.N));
}
__device__ __forceinline__ void moe_item_finish(const MoeItem& m, const f32x4 (&v)[8], LAS float* scr, int lane) {
#pragma unroll
    for (int i = 0; i < 8; ++i) { LAS float* d = scr + (8 * i + (lane >> 3)) * 33 + (lane & 7) * 4; d[0] = v[i].x; d[1] = v[i].y; d[2] = v[i].z; d[3] = v[i].w; }
    LDS_WAIT(); asm volatile("" ::: "memory");
    const int c = lane & 7;
#pragma unroll
    for (int j = 0; j < 4; ++j) { const int n = (lane >> 3) + 8 * j; const LAS float* s = scr + (8 * c) * 33 + n;
        v2u o; o.x = pk4_fp8(s[0 * 33] * W8_SCALE, s[1 * 33] * W8_SCALE, s[2 * 33] * W8_SCALE, s[3 * 33] * W8_SCALE); o.y = pk4_fp8(s[4 * 33] * W8_SCALE, s[5 * 33] * W8_SCALE, s[6 * 33] * W8_SCALE, s[7 * 33] * W8_SCALE);
        __builtin_nontemporal_store(o, (GAS v2u*)(m.dst + (size_t)n * m.K + 8 * c)); }
    LDS_WAIT(); asm volatile("" ::: "memory");
}
__device__ __forceinline__ void moe_fill_run(const Params& P, LAS unsigned char* lds, int first, int stride, int hi, int lane, int wave);
__device__ __forceinline__ void moe_filler(const Params& P, LAS unsigned char* lds, int lo, int hi, int lane, int wave, int wgi) {
    if (wgi < 128) return;
    moe_fill_run(P, lds, lo + (wgi - 128) * NWAVES + wave, 128 * NWAVES, hi, lane, wave);
}
__device__ __forceinline__ void moe_fill_run(const Params& P, LAS unsigned char* lds, int first, int stride, int hi, int lane, int wave) {
    LAS float* scr = (LAS float*)(lds + wave * 8448);
    int it = first; if (it >= hi) return;
    MoeItem cur = moe_item_decode(P, it, lane); f32x4 v[8]; moe_item_load(cur, v);
    for (;;) { const int nx = it + stride; const bool more = nx < hi;
        MoeItem nxt = cur; f32x4 vn[8];
        if (more) { nxt = moe_item_decode(P, nx, lane); moe_item_load(nxt, vn); }
        moe_item_finish(cur, v, scr, lane);
        if (!more) break;
        cur = nxt; it = nx;
#pragma unroll
        for (int i = 0; i < 8; ++i) v[i] = vn[i];
    }
}

__device__ __forceinline__ void phase0(const Params& P, LAS unsigned char* lds, int tid, int lane, int wave, int gw) {
    LAS float* cact = (LAS float*)(lds + 69632);
    { const float* c = P.in[1]; for (int i = tid; i < B_ * D; i += NTHR) { const float v = c[i]; cact[i] = v * sigm(v); } }
    __syncthreads();
    {
        const float* w_ada = P.in[2]; float* modp = (float*)(P.ws + WS_MODP);
        for (int it = gw; it < 1536; it += NGW) {
            const int ks = it & 7, jb = (it >> 3) % 96, l = it / 768;
            const float* wp = w_ada + ((size_t)l * D + ks * 128) * 6144 + jb * 64 + lane;
            float acc[8];
#pragma unroll
            for (int b = 0; b < 8; ++b) acc[b] = 0.f;
#pragma unroll 32
            for (int k = 0; k < 128; ++k) { const float w = wp[(size_t)k * 6144];
#pragma unroll
                for (int b = 0; b < 8; ++b) acc[b] += cact[b * D + ks * 128 + k] * w; }
#pragma unroll
            for (int b = 0; b < 8; ++b) modp[(((size_t)ks * 2 + l) * 8 + b) * 6144 + jb * 64 + lane] = acc[b];
        }
    }
    LAS float* scr = (LAS float*)(lds + wave * 8448);
    constexpr int I_WIN = 16 * 80, I_WOUT = 16 * 32, I_FG = 16 * 88, I_FD = 44 * 32, I_MG = 16 * 112, I_MD = 56 * 32;
    constexpr int NITEMS = 2 * I_WIN + 2 * I_WOUT + 2 * I_FG + I_FD + 16 * I_MG + 8 * I_MD; static_assert(16 * I_MG + 8 * I_MD == MOE_ITEMS, "item counts");
    for (int it = gw; it < NITEMS - MOE_ITEMS; it += NGW) {
        int r = it;
        if (r < 2 * I_WIN) { const int l = r / I_WIN, q = r % I_WIN; const int kb = q / 80, nb = q % 80;
            tr_item(P.in[6] + (size_t)l * D * DIN, D, DIN, (bf16*)(P.ws + WS_WIN) + (size_t)l * DIN * D, kb, nb, rowmap_win(32 * nb), scr, lane); continue; }
        r -= 2 * I_WIN;
        if (r < 2 * I_WOUT) { const int l = r / I_WOUT, q = r % I_WOUT; const int kb = q / 32, nb = q % 32;
            tr_item(P.in[7] + (size_t)l * D * D, D, D, (bf16*)(P.ws + WS_WOUT) + (size_t)l * D * D, kb, nb, 32 * nb, scr, lane); continue; }
        r -= 2 * I_WOUT;
        if (r < 2 * I_FG) { const int up = r / I_FG, q = r % I_FG; const int kb = q / 88, nb = q % 88;
            tr_item((up ? P.in[16] : P.in[15]), D, FFD, (bf16*)(P.ws + WS_WGU), kb, nb, rowmap_gu(32 * nb, up), scr, lane); continue; }
        r -= 2 * I_FG;
        { const int kb = r / 32, nb = r % 32; tr_item(P.in[17], FFD, D, (bf16*)(P.ws + WS_WD), kb, nb, 32 * nb, scr, lane); }
    }    moe_fill_run(P, lds, FILL_P0 + gw, NGW, MOE_ITEMS, lane, wave);
}

__device__ __forceinline__ void cvec_fill(const Params& P, LAS unsigned char* lds, int tid, int lane, int wave, int wgi) {
    if (wgi < 128) return;
    LAS float* shL = (LAS float*)lds;
    const float* mod = (const float*)(P.ws + WS_MOD);
    for (int i = tid; i < 2 * 8 * D; i += NTHR) { const int which = i >> 13, b = (i >> 10) & 7, k = i & 1023; shL[i] = which ? mod[((size_t)8 + b) * 6144 + k] : mod[(size_t)b * 6144 + 3072 + k]; }
    __syncthreads();
    const bf16* Wgu = (const bf16*)(P.ws + WS_WGU); const bf16* Win1 = (const bf16*)(P.ws + WS_WIN) + (size_t)DIN * D;
    float* cff = (float*)(P.ws + WS_CFF); float* cin = (float*)(P.ws + WS_CIN);
    for (int r = (wgi - 128) * NWAVES + wave; r < 2 * FFD + DIN; r += 128 * NWAVES) {
        const bool ff = r < 2 * FFD; const int n = ff ? r : r - 2 * FFD; const bf16* wr = (ff ? Wgu : Win1) + (size_t)n * D + 16 * lane;
        const v4u w0 = *(const GAS v4u*)wr, w1 = *(const GAS v4u*)(wr + 8); float wv[16];
#pragma unroll
        for (int j = 0; j < 4; ++j) { wv[2 * j] = __uint_as_float(w0[j] << 16); wv[2 * j + 1] = __uint_as_float(w0[j] & 0xffff0000u); wv[8 + 2 * j] = __uint_as_float(w1[j] << 16); wv[8 + 2 * j + 1] = __uint_as_float(w1[j] & 0xffff0000u); }
        const LAS float* sp = shL + (ff ? 0 : 8 * D) + 16 * lane; float mine = 0.f;
#pragma unroll
        for (int b = 0; b < 8; ++b) { float s = 0.f;
#pragma unroll
            for (int j = 0; j < 4; ++j) { const f32x4 s4 = *(const LAS f32x4*)(sp + b * D + 4 * j); s += (s4.x * wv[4 * j] + s4.y * wv[4 * j + 1]) + (s4.z * wv[4 * j + 2] + s4.w * wv[4 * j + 3]); }
            s = wave_sum(s); if (lane == b) mine = s; }
        if (lane < 8) (ff ? cff + (size_t)lane * (2 * FFD) : cin + (size_t)lane * DIN)[n] = mine;
    }
    __syncthreads();
}

__device__ __forceinline__ float modp_sum(const float* modp, const float* b_ada, int l, int b, int j) {
    float s = b_ada[l * 6144 + j];
#pragma unroll
    for (int ks = 0; ks < 8; ++ks) s += modp[(((size_t)ks * 2 + l) * 8 + b) * 6144 + j];
    return s;
}
template <bool INBF> __device__ __forceinline__ void row_load(const float* xrow, int lane, f32x4 (&h)[4]) {
    if constexpr (INBF) { const GAS v2u* xr = (const GAS v2u*)xrow + lane;
#pragma unroll
        for (int j = 0; j < 4; ++j) { const v2u q = xr[64 * j]; h[j] = (f32x4){__uint_as_float(q.x << 16), __uint_as_float(q.x & 0xffff0000u), __uint_as_float(q.y << 16), __uint_as_float(q.y & 0xffff0000u)}; } }
    else { const GAS f32x4* xr = (const GAS f32x4*)xrow + lane;
#pragma unroll
        for (int j = 0; j < 4; ++j) h[j] = xr[64 * j]; }
}
__device__ __forceinline__ void row_finish(const LAS float* gm, const LAS float* shv, int lane, f32x4 (&h)[4]) {
    float ss = 0.f;
#pragma unroll
    for (int j = 0; j < 4; ++j) ss += (h[j].x * h[j].x + h[j].y * h[j].y) + (h[j].z * h[j].z + h[j].w * h[j].w);
    const float r = __builtin_amdgcn_rsqf(wave_sum(ss) * (1.f / D) + EPS);
#pragma unroll
    for (int j = 0; j < 4; ++j) { const f32x4 g4 = *(const LAS f32x4*)(gm + 4 * lane + 256 * j), s4 = *(const LAS f32x4*)(shv + 4 * lane + 256 * j); h[j] = h[j] * r * g4 + s4; }
}
__device__ __forceinline__ void norm_row(const float* xrow, const LAS float* gm, const LAS float* shv, int lane, f32x4 (&h)[4]) { row_load<false>(xrow, lane, h); row_finish(gm, shv, lane, h); }
__device__ __forceinline__ void store_row_bf16(bf16* orow, int lane, const f32x4 (&h)[4]) {
    GAS v2u* o8 = (GAS v2u*)orow + lane;
#pragma unroll
    for (int j = 0; j < 4; ++j) { v2u w; w.x = pk2(h[j].x, h[j].y); w.y = pk2(h[j].z, h[j].w); o8[64 * j] = w; }
}
template <bool INBF> __device__ __forceinline__ void norm_phase(const Params& P, LAS unsigned char* lds, const float* xin, const float* gvec, int l, int sh_off, int sc_off, bool from_partials, int tid, int lane, int wave, int wgi) {
    LAS float* gm = (LAS float*)lds; LAS float* shv = (LAS float*)(lds + 4096);
    const float* modp = (const float*)(P.ws + WS_MODP); float* mod = (float*)(P.ws + WS_MOD); const float* b_ada = P.in[3];
    const int b = wgi >> 5;
    if (from_partials) {
        if (tid < 384) { const int idx = wgi * 384 + tid; const int ll = idx / 49152, rem = idx % 49152, bb = rem / 6144, j = rem % 6144; mod[idx] = modp_sum(modp, b_ada, ll, bb, j); }
        for (int c = tid; c < D; c += NTHR) { gm[c] = gvec[c] * (1.f + modp_sum(modp, b_ada, l, b, sc_off + c)); shv[c] = modp_sum(modp, b_ada, l, b, sh_off + c); }
    } else {
        const float* ml = mod + ((size_t)l * 8 + b) * 6144;
        for (int c = tid; c < D; c += NTHR) { gm[c] = gvec[c] * (1.f + ml[sc_off + c]); shv[c] = ml[sh_off + c]; }
    }
    __syncthreads();
    bf16* H = (bf16*)(P.ws + WS_H);
    constexpr int RS = INBF ? D / 2 : D;
    for (int i = 0; i < 8; i += 2) { const int row = wgi * 64 + wave * 8 + i; f32x4 ha[4], hb[4];
        row_load<INBF>(xin + (size_t)row * RS, lane, ha); row_load<INBF>(xin + (size_t)(row + 1) * RS, lane, hb);
        row_finish(gm, shv, lane, ha); store_row_bf16(H + (size_t)row * D, lane, ha);
        row_finish(gm, shv, lane, hb); store_row_bf16(H + (size_t)(row + 1) * D, lane, hb); }
    __syncthreads();
}
__device__ __forceinline__ void router_phase(const Params& P, LAS unsigned char* lds, const float* xin, int tid, int lane, int wave, int wgi) {
    LAS float* gm = (LAS float*)lds; LAS float* shv = (LAS float*)(lds + 4096); LAS float* wrT = (LAS float*)(lds + 8192);
    LAS int* pe = (LAS int*)(lds + 40960); LAS float* pw = (LAS float*)(lds + 41472); LAS int* cw = (LAS int*)(lds + 41984); LAS int* baseL = (LAS int*)(lds + 42048);
    const float* mod = (const float*)(P.ws + WS_MOD); const int b = wgi >> 5; const float* ml = mod + ((size_t)1 * 8 + b) * 6144; const float* gvec = P.in[5] + D;
    for (int c = tid; c < D; c += NTHR) { gm[c] = gvec[c] * (1.f + ml[4096 + c]); shv[c] = ml[3072 + c]; }
    { const float* wr = P.in[18]; for (int i = tid; i < D * NE; i += NTHR) { const int c = i >> 3, e = i & 7; wrT[e * D + c] = wr[i]; } }
    __syncthreads();
#if defined(TSDBG)
    if (wgi == 0 && tid == 0) ((unsigned long long*)(P.ws + WS_CTL) + 16384)[100] = __builtin_amdgcn_s_memrealtime();
#endif
    const float* br = P.in[19];
    f32x4 hn[4]; row_load<false>(xin + (size_t)(wgi * 64 + wave * 8) * D, lane, hn);
    for (int i = 0; i < 8; ++i) { const int rl = wave * 8 + i, row = wgi * 64 + rl; f32x4 h[4];
#pragma unroll
        for (int j = 0; j < 4; ++j) h[j] = hn[j];
        if (i < 7) row_load<false>(xin + (size_t)(row + 1) * D, lane, hn);
        row_finish(gm, shv, lane, h);
        float lg[8];
#pragma unroll
        for (int e = 0; e < 8; ++e) { float s = 0.f;
#pragma unroll
            for (int j = 0; j < 4; ++j) { const f32x4 w4 = *(const LAS f32x4*)(wrT + e * D + 4 * lane + 256 * j); s += (h[j].x * w4.x + h[j].y * w4.y) + (h[j].z * w4.z + h[j].w * w4.w); }
            lg[e] = s; }
        {
            float w4[4], u2[2];
#pragma unroll
            for (int i = 0; i < 4; ++i) { const bool hi1 = lane & 1; const float keep = hi1 ? lg[2 * i + 1] : lg[2 * i], send = hi1 ? lg[2 * i] : lg[2 * i + 1]; w4[i] = keep + __shfl_xor(send, 1); }
#pragma unroll
            for (int i = 0; i < 2; ++i) { const bool hi2 = lane & 2; const float keep = hi2 ? w4[2 * i + 1] : w4[2 * i], send = hi2 ? w4[2 * i] : w4[2 * i + 1]; u2[i] = keep + __shfl_xor(send, 2); }
            const bool hi4 = lane & 4; float z = (hi4 ? u2[1] : u2[0]) + __shfl_xor(hi4 ? u2[0] : u2[1], 4);
            z += __shfl_xor(z, 8); z += __shfl_xor(z, 16); z += __shfl_xor(z, 32);
#pragma unroll
            for (int e = 0; e < 8; ++e) lg[e] = __uint_as_float((unsigned)__builtin_amdgcn_readlane((int)__float_as_uint(z), e)) + br[e];
        }
        int e1 = 0; float v1 = lg[0];
#pragma unroll
        for (int e = 1; e < 8; ++e) if (lg[e] > v1) { v1 = lg[e]; e1 = e; }
        int e2 = -1; float v2 = -3.0e38f;
#pragma unroll
        for (int e = 0; e < 8; ++e) if (e != e1 && lg[e] > v2) { v2 = lg[e]; e2 = e; }
        const float p2 = __expf(v2 - v1), inv = 1.f / (1.f + p2);
        if (lane == 0) { pe[2 * rl] = e1; pe[2 * rl + 1] = e2; pw[2 * rl] = inv; pw[2 * rl + 1] = p2 * inv; }
        { LAS unsigned* r4 = (LAS unsigned*)(lds + 65536 + rl * 1024) + lane;
#pragma unroll
          for (int j = 0; j < 4; ++j) r4[64 * j] = pk4_fp8(h[j].x * H8_SCALE, h[j].y * H8_SCALE, h[j].z * H8_SCALE, h[j].w * H8_SCALE); } }
    __syncthreads();
#if defined(TSDBG)
    if (wgi == 0 && tid == 0) ((unsigned long long*)(P.ws + WS_CTL) + 16384)[101] = __builtin_amdgcn_s_memrealtime();
#endif
    int e = 0, rank = 0;
    if (tid < 128) { e = pe[tid];
#pragma unroll
        for (int ee = 0; ee < 8; ++ee) { const unsigned long long mk = __ballot(e == ee); if (e == ee) rank = __popcll(mk & ((1ull << lane) - 1ull)); if (lane == 0) cw[wave * 8 + ee] = __popcll(mk); } }
    __syncthreads();
    if (tid < 8) { const int tot = cw[tid] + cw[8 + tid]; unsigned* cnt = (unsigned*)(P.ws + WS_CTL) + CW_CNT + 64 * tid;
        baseL[tid] = (int)__hip_atomic_fetch_add(cnt, (unsigned)tot, __ATOMIC_RELAXED, __HIP_MEMORY_SCOPE_AGENT); }
    __syncthreads();
    if (tid < 128) { const int slot = baseL[e] + rank + (wave == 1 ? cw[e] : 0); const int token = wgi * 64 + (tid >> 1);
        ((float*)(P.ws + WS_WL))[e * M + slot] = pw[tid]; ((int*)(P.ws + WS_PAIR))[token * 2 + (tid & 1)] = e * M + slot; pe[tid] = e * M + slot; }
    __syncthreads();
#if defined(TSDBG)
    if (wgi == 0 && tid == 0) ((unsigned long long*)(P.ws + WS_CTL) + 16384)[102] = __builtin_amdgcn_s_memrealtime();
#endif
    for (int i = 0; i < 16; ++i) { const int p = wave * 16 + i; const int dst = pe[p];
        const v4u v = *(const LAS v4u*)(lds + 65536 + (p >> 1) * 1024 + lane * 16); *(GAS v4u*)(P.ws + WS_HG + (size_t)dst * D + lane * 16) = v; }
    __syncthreads();
}
__device__ __forceinline__ void moe_tables(const Params& P, LAS unsigned char* lds, int tid) {
    LAS int* tab = (LAS int*)(lds + MOETAB_OFF);
    if (tid == 0) { const unsigned* ctl = (const unsigned*)(P.ws + WS_CTL); int rb = 0;
        for (int e = 0; e < 8; ++e) { int c = (int)__hip_atomic_load(ctl + CW_CNT + 64 * e, __ATOMIC_RELAXED, __HIP_MEMORY_SCOPE_AGENT); c = c < 0 ? 0 : (c > M ? M : c); tab[e] = rb; tab[9 + e] = c; rb += (c + 255) & ~255; }
        tab[8] = rb; }
    __syncthreads();
}
__device__ __forceinline__ void gather_phase(const Params& P, LAS unsigned char* lds, const float* xin, int tid, int lane, int wave, int gw) {
    LAS float* gmA = (LAS float*)lds; LAS float* shA = (LAS float*)(lds + 32768); const LAS int* tab = (const LAS int*)(lds + MOETAB_OFF);
    const float* mod1 = (const float*)(P.ws + WS_MOD) + (size_t)8 * 6144; const float* gvec = P.in[5] + D;
    for (int i = tid; i < 8 * D; i += NTHR) { const int b = i >> 10, c = i & 1023; gmA[i] = gvec[c] * (1.f + mod1[b * 6144 + 4096 + c]); shA[i] = mod1[b * 6144 + 3072 + c]; }
    __syncthreads();
    const int ptot = tab[8]; const int* list = (const int*)(P.ws + WS_LIST); const float* wl = (const float*)(P.ws + WS_WL); float* wlg = (float*)(P.ws + WS_WLG); unsigned char* HG = (unsigned char*)(P.ws + WS_HG);
    for (int p = gw; p < ptot; p += NGW) {
        int e = 0;
#pragma unroll
        for (int k = 1; k < 8; ++k) e += (p >= tab[k]);
        const int slot = p - tab[e], cn = tab[9 + e]; const bool valid = slot < cn; const int token = list[e * M + (valid ? slot : cn - 1)]; const int b = token >> 11;
        f32x4 h[4]; norm_row(xin + (size_t)token * D, gmA + b * D, shA + b * D, lane, h);
        { GAS unsigned* o4 = (GAS unsigned*)(HG + (size_t)p * D) + lane;
#pragma unroll
          for (int j = 0; j < 4; ++j) o4[64 * j] = pk4_fp8(h[j].x * H8_SCALE, h[j].y * H8_SCALE, h[j].z * H8_SCALE, h[j].w * H8_SCALE); }
        if (lane == 0) wlg[p] = valid ? wl[e * M + slot] : 0.f;
    }
    __syncthreads();
}
__device__ __forceinline__ void combine_phase(const Params& P, LAS unsigned char* lds, int lane, int gw) {
    const LAS int* tab = (const LAS int*)(lds + MOETAB_OFF); const int* pair = (const int*)(P.ws + WS_PAIR); const bf16* F = (const bf16*)(P.ws + WS_F);
    const float* mod1 = (const float*)(P.ws + WS_MOD) + (size_t)8 * 6144;
    for (int t = gw; t < M; t += NGW) {
        const int pa = pair[2 * t], pb = pair[2 * t + 1]; const int ra = tab[pa >> 14] + (pa & 16383), rb = tab[pb >> 14] + (pb & 16383); const int b = t >> 11;
        const bf16* FP = (const bf16*)(P.ws + WS_FP);
        f32x4 fs[4];
#pragma unroll
        for (int j = 0; j < 4; ++j) fs[j] = (f32x4){0.f, 0.f, 0.f, 0.f};
#pragma unroll
        for (int side = 0; side < 2; ++side) { const int r = side ? rb : ra;
            if (r < 32768) { const GAS v2u* fp = (const GAS v2u*)(F + (size_t)r * D) + lane;
#pragma unroll
                for (int j = 0; j < 4; ++j) { const v2u a = fp[64 * j]; fs[j] = fs[j] + (f32x4){__uint_as_float(a.x << 16), __uint_as_float(a.x & 0xffff0000u), __uint_as_float(a.y << 16), __uint_as_float(a.y & 0xffff0000u)}; } }
            else for (int ks = 0; ks < 7; ++ks) { const GAS v2u* fp = (const GAS v2u*)(FP + ((size_t)ks * 2048 + (r - 32768)) * D) + lane;
#pragma unroll
                for (int j = 0; j < 4; ++j) { const v2u a = fp[64 * j]; fs[j] = fs[j] + (f32x4){__uint_as_float(a.x << 16), __uint_as_float(a.x & 0xffff0000u), __uint_as_float(a.y << 16), __uint_as_float(a.y & 0xffff0000u)}; } } }
        GAS f32x4* xo = (GAS f32x4*)(P.out + (size_t)t * D) + lane; const GAS f32x4* g2 = (const GAS f32x4*)(mod1 + b * 6144 + 5120) + lane;
#pragma unroll
        for (int j = 0; j < 4; ++j) xo[64 * j] = xo[64 * j] + g2[64 * j] * fs[j];
    }
}

__device__ __forceinline__ void conv_stage(const bf16* Z, LAS unsigned char* zt, int unit, int tid) {
    const int tok0 = unit * 32, tp0 = tok0 & (S_ - 1);
#pragma unroll
    for (int i = 0; i < 8; ++i) { const int idx = i * NTHR + tid;
        if (idx < 62 * 64) { const int row = idx >> 6, pc = idx & 63; const bool ok = tp0 + row - 30 >= 0;
            v4u v = *(const GAS v4u*)(Z + (size_t)(tok0 + (ok ? row - 30 : -tp0)) * DC + pc * 8); if (!ok) v = (v4u){0u, 0u, 0u, 0u};
            *(LAS v4u*)(zt + idx * 16) = v; } }
}
__device__ __forceinline__ void conv_unit(const LAS unsigned char* zt, const float (&w)[CW], float bias, bf16* YC, const float* lg, const float* lb, LAS float* tile, int unit, int tid, int wave, int lane) {
    const int tok0 = unit * 32, c = tid;
    const LAS bf16* zc = (const LAS bf16*)zt + c;
#pragma unroll
    for (int half = 0; half < 2; ++half) {
        float in[46];
#pragma unroll
        for (int i = 0; i < 46; ++i) in[i] = bf2f(zc[(16 * half + i) * DC]);
#pragma unroll
        for (int q = 0; q < 16; ++q) { float a = bias;
#pragma unroll
            for (int j = 0; j < CW; ++j) a += w[j] * in[q + j];
            tile[(16 * half + q) * DC + c] = a; }
    }
    __syncthreads();
    const f32x4 g0 = *(const f32x4*)(lg + lane * 8), g1 = *(const f32x4*)(lg + lane * 8 + 4), b0 = *(const f32x4*)(lb + lane * 8), b1 = *(const f32x4*)(lb + lane * 8 + 4);
#pragma unroll
    for (int tt = 0; tt < 4; ++tt) { const int t = wave * 4 + tt;
        f32x4 v0 = *(const LAS f32x4*)(tile + t * DC + lane * 8), v1 = *(const LAS f32x4*)(tile + t * DC + lane * 8 + 4);
        const float mean = wave_sum((v0.x + v0.y) + (v0.z + v0.w) + (v1.x + v1.y) + (v1.z + v1.w)) * (1.f / DC);
        v0 = v0 - mean; v1 = v1 - mean;
        const float var = wave_sum((v0.x * v0.x + v0.y * v0.y) + (v0.z * v0.z + v0.w * v0.w) + (v1.x * v1.x + v1.y * v1.y) + (v1.z * v1.z + v1.w * v1.w)) * (1.f / DC);
        const float rstd = __builtin_amdgcn_rsqf(var + EPS);
        f32x4 y0 = v0 * rstd * g0 + b0, y1 = v1 * rstd * g1 + b1;
#pragma unroll
        for (int i = 0; i < 4; ++i) { y0[i] = y0[i] * sigm(y0[i]); y1[i] = y1[i] * sigm(y1[i]); }
        v4u o; o.x = pk2(y0.x, y0.y); o.y = pk2(y0.z, y0.w); o.z = pk2(y1.x, y1.y); o.w = pk2(y1.z, y1.w);
        *(GAS v4u*)(YC + (size_t)(tok0 + t) * D + lane * 8) = o; }
    __syncthreads();
}
__device__ __forceinline__ int crow(int r, int hi) { return (r & 3) + 8 * (r >> 2) + 4 * hi; }
#define MFMA32(a, b, c) __builtin_amdgcn_mfma_f32_32x32x16_bf16((a), (b), (c), 0, 0, 0)
__device__ __forceinline__ void attn_stage(const LAS unsigned char* stage, int kc0, int n, int qh, int r32, int hi, int lane, const LAS float* btile, const bf16x8 (&qf)[4], const f32x16& cinit, f32x16& o0, f32x16& o1, float& l) {
    const int fsw = (r32 >> 1) & 7;
#pragma unroll
    for (int sub = 0; sub < 2; ++sub) {
        const int kc = kc0 + sub; const LAS unsigned char* buf = stage + sub * 16384;
        if (kc >= n - 8 && kc <= n) {
            bf16x8 kf[2][4], vf[2][2][2]; f32x16 sc[2];
#pragma unroll
            for (int kb = 0; kb < 2; ++kb)
#pragma unroll
                for (int d0 = 0; d0 < 4; ++d0) kf[kb][d0] = *(const LAS bf16x8*)(buf + (kb * 32 + r32) * 128 + (((2 * d0 + hi) ^ fsw) << 4));
            if (n - kc >= 3) { sc[0] = cinit; sc[1] = cinit; }
            else {
#pragma unroll
                for (int kb = 0; kb < 2; ++kb) { const LAS f32x4* tp = (const LAS f32x4*)(btile + ((qh * 6 + (n - kc) * 2 + kb) * 4) * 256) + lane;
#pragma unroll
                    for (int q4 = 0; q4 < 4; ++q4) { const f32x4 t4 = tp[q4 * 64]; sc[kb][4 * q4] = t4.x; sc[kb][4 * q4 + 1] = t4.y; sc[kb][4 * q4 + 2] = t4.z; sc[kb][4 * q4 + 3] = t4.w; } } }
#pragma unroll
            for (int kb = 0; kb < 2; ++kb)
#pragma unroll
                for (int db = 0; db < 2; ++db)
#pragma unroll
                    for (int s2 = 0; s2 < 2; ++s2) vf[kb][db][s2] = *(const LAS bf16x8*)(buf + 8192 + (db * 32 + r32) * 128 + (((kb * 4 + 2 * s2 + hi) ^ fsw) << 4));
#pragma unroll
            for (int d0 = 0; d0 < 4; ++d0) { sc[0] = MFMA32(kf[0][d0], qf[d0], sc[0]); sc[1] = MFMA32(kf[1][d0], qf[d0], sc[1]); }
            float ps0 = 0.f, ps1 = 0.f;
#pragma unroll
            for (int r = 0; r < 16; ++r) { sc[0][r] = __builtin_amdgcn_exp2f(sc[0][r]); ps0 += sc[0][r]; }
#pragma unroll
            for (int r = 0; r < 16; ++r) { sc[1][r] = __builtin_amdgcn_exp2f(sc[1][r]); ps1 += sc[1][r]; }
            l += ps0 + ps1;
            bf16x8 pb[2][2];
#pragma unroll
            for (int kb = 0; kb < 2; ++kb) { v4u p0, p1;
                p0.x = pk2(sc[kb][0], sc[kb][1]); p0.y = pk2(sc[kb][2], sc[kb][3]); p0.z = pk2(sc[kb][4], sc[kb][5]); p0.w = pk2(sc[kb][6], sc[kb][7]);
                p1.x = pk2(sc[kb][8], sc[kb][9]); p1.y = pk2(sc[kb][10], sc[kb][11]); p1.z = pk2(sc[kb][12], sc[kb][13]); p1.w = pk2(sc[kb][14], sc[kb][15]);
                pb[kb][0] = __builtin_bit_cast(bf16x8, p0); pb[kb][1] = __builtin_bit_cast(bf16x8, p1); }
#pragma unroll
            for (int kb = 0; kb < 2; ++kb)
#pragma unroll
                for (int s2 = 0; s2 < 2; ++s2) { o0 = MFMA32(vf[kb][0][s2], pb[kb][s2], o0); o1 = MFMA32(vf[kb][1][s2], pb[kb][s2], o1); }
        }
    }
}
__device__ __forceinline__ void attn_unit(const bf16* Q, const bf16* K, const bf16* VT, bf16* YC, const LAS float* btile, float c0, LAS unsigned char* kv, int b, int h, int g, int tid, int wave, int lane) {
    const int r32 = lane & 31, hi = lane >> 5;
    const int n0 = 4 * g, n = n0 + (wave >> 1), qh = wave & 1;
    const size_t rowq = (size_t)b * S_ + n * 64 + qh * 32 + r32;
    bf16x8 qf[4];
#pragma unroll
    for (int d0 = 0; d0 < 4; ++d0) qf[d0] = *(const GAS bf16x8*)(Q + rowq * DC + h * 64 + d0 * 16 + hi * 8);
    float l = 0.f; f32x16 o0, o1, cinit;
#pragma unroll
    for (int r = 0; r < 16; ++r) { o0[r] = 0.f; o1[r] = 0.f; cinit[r] = c0; }
    const int kc_lo = n0 - 8 < 0 ? 0 : n0 - 8, nt = (n0 + 4 - kc_lo) >> 1;
    const int lrow = tid >> 3, lc = tid & 7, lsw = (lrow >> 1) & 7; const int kofs = lrow * 128 + ((lc ^ lsw) << 4);
    const int vofs0 = lrow * 128 + ((((lc & 6) | 0) ^ lsw) << 4) + (lc & 1) * 8, vofs1 = lrow * 128 + ((((lc & 6) | 1) ^ lsw) << 4) + (lc & 1) * 8;
    const bf16* kg = K + ((size_t)b * S_ + lrow) * DC + h * 64 + lc * 8 + (size_t)kc_lo * 64 * DC;
    const bf16* vg = VT + (size_t)(h * 64 + lrow) * M + (size_t)b * S_ + lc * 8 + kc_lo * 64;
#define ATT_GET(t, R) do { R[0] = *(const GAS v4u*)(kg + (size_t)(2 * (t)) * 64 * DC); R[1] = *(const GAS v4u*)(vg + (2 * (t)) * 64); R[2] = *(const GAS v4u*)(kg + (size_t)(2 * (t) + 1) * 64 * DC); R[3] = *(const GAS v4u*)(vg + (2 * (t) + 1) * 64); } while (0)
#define ATT_PUT(base, R) do { *(LAS v4u*)((base) + kofs) = R[0]; *(LAS v2u*)((base) + 8192 + vofs0) = (v2u){R[1].x, R[1].y}; *(LAS v2u*)((base) + 8192 + vofs1) = (v2u){R[1].z, R[1].w}; \
        *(LAS v4u*)((base) + 16384 + kofs) = R[2]; *(LAS v2u*)((base) + 24576 + vofs0) = (v2u){R[3].x, R[3].y}; *(LAS v2u*)((base) + 24576 + vofs1) = (v2u){R[3].z, R[3].w}; } while (0)
    v4u RA[4], RB[4];
    ATT_GET(0, RA); ATT_GET(1, RB);
    ATT_PUT(kv, RA);
    __syncthreads();
    asm volatile("" : "+v"(qf[0]), "+v"(qf[1]), "+v"(qf[2]), "+v"(qf[3]));
    for (int t = 0; t < nt; t += 2) {
        { const int tg = t + 2 < nt ? t + 2 : nt - 1; ATT_GET(tg, RA); }
        attn_stage(kv, kc_lo + 2 * t, n, qh, r32, hi, lane, btile, qf, cinit, o0, o1, l);
        ATT_PUT(kv + 32768, RB);
        __syncthreads();
        { const int tg = t + 3 < nt ? t + 3 : nt - 1; ATT_GET(tg, RB); }
        attn_stage(kv + 32768, kc_lo + 2 * t + 2, n, qh, r32, hi, lane, btile, qf, cinit, o0, o1, l);
        if (t + 2 < nt) ATT_PUT(kv, RA);
        __syncthreads();
    }
#undef ATT_PUT
#undef ATT_GET
    l += __shfl_xor(l, 32); const float il = 1.f / l;
    bf16* yp = YC + rowq * D + DC + h * 64 + 4 * hi;
#pragma unroll
    for (int gq = 0; gq < 4; ++gq) { v2u w0, w1; w0.x = pk2(o0[4 * gq] * il, o0[4 * gq + 1] * il); w0.y = pk2(o0[4 * gq + 2] * il, o0[4 * gq + 3] * il);
        w1.x = pk2(o1[4 * gq] * il, o1[4 * gq + 1] * il); w1.y = pk2(o1[4 * gq + 2] * il, o1[4 * gq + 3] * il);
        *(GAS v2u*)(yp + 8 * gq) = w0; *(GAS v2u*)(yp + 32 + 8 * gq) = w1; }
}
__device__ __forceinline__ void mixer_phase(const Params& P, LAS unsigned char* lds, int l, int tid, int lane, int wave, int wgi) {
#if defined(TSDBG)
    if (wgi == 0 && tid == 0) ((unsigned long long*)(P.ws + WS_CTL) + 16384)[40 + 4 * l] = __builtin_amdgcn_s_memrealtime();
#endif
    LAS unsigned char* zt = lds; LAS float* tile = (LAS float*)(lds + 63488); LAS float* biasL = (LAS float*)(lds + LDSCTL_OFF + 1024); LAS unsigned char* kv = lds + 49152;
    { const float* rb = P.in[14] + l * 8 * NREL; for (int i = tid; i < 8 * NREL; i += NTHR) biasL[i] = rb[i] * LOG2E; }
    __syncthreads();
    const bf16* Z = (const bf16*)(P.ws + WS_Z); const bf16* Q = (const bf16*)(P.ws + WS_Q); const bf16* K = (const bf16*)(P.ws + WS_K); const bf16* VT = (const bf16*)(P.ws + WS_VT); bf16* YC = (bf16*)(P.ws + WS_YC);
    {   float w[CW]; const float* cw = P.in[8] + l * CW * DC;
#pragma unroll
        for (int j = 0; j < CW; ++j) w[j] = cw[j * DC + tid];
        const float cbias = P.in[9][l * DC + tid];
        for (int cu = 0; cu < 2; ++cu) { conv_stage(Z, zt, wgi * 2 + cu, tid); __syncthreads();
            conv_unit(zt, w, cbias, YC, P.in[10] + l * DC, P.in[11] + l * DC, tile, wgi * 2 + cu, tid, wave, lane); } }
#if defined(TSDBG)
    if (wgi == 0 && tid == 0) ((unsigned long long*)(P.ws + WS_CTL) + 16384)[40 + 4 * l + 1] = __builtin_amdgcn_s_memrealtime();
#endif
#if defined(TSDBG)
    if (tid == 0) atomicMax((unsigned long long*)(P.ws + WS_CTL) + 16384 + 74 + l, (unsigned long long)__builtin_amdgcn_s_memrealtime());
#endif
    { const int b = wgi >> 5, h = (wgi >> 2) & 7, gp = wgi & 3;
      LAS float* btl = (LAS float*)lds;
      float Bref; { LAS float* red = (LAS float*)(lds + 49152);
          float gq = 0.f, gk = 0.f, bm = 0.f;
          if (tid < 64) { gq = fabsf(P.in[12][l * 64 + tid]); gk = fabsf(P.in[13][l * 64 + tid]); }
          if (tid < NREL) bm = fabsf(biasL[h * NREL + tid]);
#pragma unroll
          for (int o = 1; o < 64; o <<= 1) { gq = fmaxf(gq, __shfl_xor(gq, o)); gk = fmaxf(gk, __shfl_xor(gk, o)); bm = fmaxf(bm, __shfl_xor(bm, o)); }
          if (lane == 0) { red[wave] = gq; red[8 + wave] = gk; red[16 + wave] = bm; }
          __syncthreads();
          gq = red[0]; gk = red[8]; bm = fmaxf(fmaxf(fmaxf(red[16], red[17]), fmaxf(red[18], red[19])), red[20]);
          Bref = 1.02f * (LOG2E * 8.f * gq * gk + bm); }
#pragma unroll
      for (int k = 0; k < 24; ++k) { const int i = tid + NTHR * k; const int jbq = k >> 1, qh = jbq / 6, jb = jbq % 6;
          const int ln = (i >> 2) & 63, r = ((i >> 8) & 3) * 4 + (i & 3);
          int rel = -64 * (jb >> 1) + 32 * (jb & 1) - 32 * qh + crow(r, ln >> 5) - (ln & 31); rel = rel < -128 ? -128 : (rel > 128 ? 128 : rel); btl[i] = biasL[h * NREL + rel + 128] - Bref; }
      const float b0 = biasL[h * NREL] - Bref;
      __syncthreads();
      for (int rp = 0; rp < 1 + ((REPMASK >> 21) & 1); ++rp)
#if defined(TSDBG)
      if ((wgi == 0 || wgi == 3) && tid == 0) ((unsigned long long*)(P.ws + WS_CTL) + 16384)[60 + 8 * l + (wgi ? 4 : 0)] = __builtin_amdgcn_s_memrealtime();
#endif
#if defined(TSDBG)
      const unsigned long long att_t0 = __builtin_amdgcn_s_memrealtime();
#endif
      for (int au = 0; au < 2; ++au) attn_unit(Q, K, VT, YC, btl, b0, kv, b, h, au ? 7 - gp : gp, tid, wave, lane);
      __syncthreads();
#if defined(TSDBG)
      if ((wgi == 0 || wgi == 3) && tid == 0) ((unsigned long long*)(P.ws + WS_CTL) + 16384)[61 + 8 * l + (wgi ? 4 : 0)] = __builtin_amdgcn_s_memrealtime();
#endif
#if defined(TSDBG)
      if (tid == 0) { const unsigned long long dt = __builtin_amdgcn_s_memrealtime() - att_t0; atomicMax((unsigned long long*)(P.ws + WS_CTL) + 16384 + 80 + 4 * l + gp, dt); }
#endif
      const int mlo = FILL_S2 + l * FILL_MIX;
      if constexpr (FILL_MIX > 0) {
      if (gp == 0) moe_fill_run(P, lds, mlo + (wgi >> 2) * NWAVES + wave, 64 * NWAVES, mlo + (FILL_MIX * 3) / 4, lane, wave);
      else if (gp == 1) moe_fill_run(P, lds, mlo + (FILL_MIX * 3) / 4 + (wgi >> 2) * NWAVES + wave, 64 * NWAVES, mlo + FILL_MIX, lane, wave); } }
    __syncthreads();
#if defined(TSDBG)
    if (wgi == 0 && tid == 0) ((unsigned long long*)(P.ws + WS_CTL) + 16384)[40 + 4 * l + 2] = __builtin_amdgcn_s_memrealtime();
    if (tid == 0) atomicMax((unsigned long long*)(P.ws + WS_CTL) + 16384 + 70 + l, (unsigned long long)__builtin_amdgcn_s_memrealtime());
#endif
}

#define PHASE(k, ...) do { { __VA_ARGS__ } if constexpr ((REPMASK >> (k)) & 1) { xcd_barrier(bar); RETID(); { __VA_ARGS__ } } } while (0)
__global__ void __launch_bounds__(NTHR, 2) fwd(Params P) {
    extern __shared__ __attribute__((aligned(16))) unsigned char lds_raw[];
    LAS unsigned char* lds = (LAS unsigned char*)lds_raw;
    int tid = threadIdx.x, lane = tid & 63, wave = __builtin_amdgcn_readfirstlane(tid >> 6); const int wgi = blockIdx.x; int gw = wgi * NWAVES + wave;
#define RETID() do { tid = threadIdx.x; asm volatile("" : "+v"(tid)); lane = tid & 63; wave = __builtin_amdgcn_readfirstlane(tid >> 6); gw = wgi * NWAVES + wave; } while (0)
    for (int u = tid; u < (LDS_BYTES - LDSCTL_OFF) / 4; u += NTHR) ((LAS unsigned*)(lds + LDSCTL_OFF))[u] = 0u;
    __syncthreads();
    unsigned* ctl = (unsigned*)(P.ws + WS_CTL);
    XcdBarrier bar = xcd_barrier_post(ctl + CW_BAR, (volatile LAS unsigned*)(lds + MISC_OFF) + 8);
    const int stop = P.stop;
#if defined(TSDBG)
    unsigned long long* tsbuf = (unsigned long long*)(P.ws + WS_CTL) + 16384;
    int tsn = 0;
#define STAMP() do { if (wgi == 0 && tid == 0) tsbuf[tsn] = __builtin_amdgcn_s_memrealtime(); ++tsn; } while (0)
#else
#define STAMP() do {} while (0)
#endif
    STAMP();
#define SEAM(k) do { if (stop == (k)) return; xcd_barrier(bar); RETID(); STAMP(); } while (0)
    bf16* H = (bf16*)(P.ws + WS_H); float* mod = (float*)(P.ws + WS_MOD); const float* XB = (const float*)(P.ws + WS_XB);

    PHASE(0, phase0(P, lds, tid, lane, wave, gw););                                                      SEAM(0);
    PHASE(1, norm_phase<false>(P, lds, P.in[0], P.in[4], 0, 0, 1024, true, tid, lane, wave, wgi););             SEAM(1);
#define LAYER_COMMON(l, pb, xin) \
    PHASE(2,   \
        const bf16* Wl = (const bf16*)(P.ws + WS_WIN) + (size_t)(l) * DIN * D; \
        { pg8::Gemm g{H, Wl, M, 2048, D, 0}; pg8::StaticOrder S; S.init(M, 2048, GRID, wgi); \
          pg8::EpiInProj<FUSE_NORM && (l) != 0> E{(bf16*)(P.ws + WS_Z), (bf16*)(P.ws + WS_Q), (bf16*)(P.ws + WS_K), P.in[12] + (l) * 64, P.in[13] + (l) * 64, QSCALE, (const float*)(P.ws + WS_SS2), (const float*)(P.ws + WS_CIN)}; \
          pg8::gemm_phase<pg8::EpiInProj<FUSE_NORM && (l) != 0>, pg8::StaticOrder, true, true>(lds, g, S, E); } \
        { pg8::Gemm g{Wl + (size_t)2048 * D, H, 512, M, D, 0}; pg8::StaticOrder S; S.init(512, M, GRID, wgi); \
          pg8::EpiBf16<FUSE_NORM && (l) != 0> E{(bf16*)(P.ws + WS_VT), M, 1.f, 0, (const float*)(P.ws + WS_SS2), (const float*)(P.ws + WS_CIN) + 2048}; \
          pg8::gemm_phase<pg8::EpiBf16<FUSE_NORM && (l) != 0>, pg8::StaticOrder, true, true>(lds, g, S, E); } \
        if (FUSE_NORM && (l) == 0) cvec_fill(P, lds, tid, lane, wave, wgi); \
        moe_filler(P, lds, (l) == 0 ? 0 : FILL_S1, (l) == 0 ? FILL_S0 : FILL_S2, lane, wave, wgi); ); \
    SEAM(pb); \
    PHASE(3, mixer_phase(P, lds, (l), tid, lane, wave, wgi);); \
    SEAM((pb) + 1); \
    PHASE(4 + 10 * (l),   \
        pg8::Gemm g{(const bf16*)(P.ws + WS_YC), (const bf16*)(P.ws + WS_WOUT) + (size_t)(l) * D * D, M, D, D, 0}; pg8::StaticOrder S; S.init(M, D, GRID, wgi); \
        pg8::EpiResGate<FUSE_NORM && (l) == 0, (l) != 0, (l) == 0> E{(l) == 0 ? P.in[0] : XB, (l) == 0 ? (float*)XB : P.out, mod + (size_t)(l) * 8 * 6144 + 2048, H, (float*)(P.ws + WS_SS1), P.in[5], mod + 4096};   \
        pg8::gemm_phase<pg8::EpiResGate<FUSE_NORM && (l) == 0, (l) != 0, (l) == 0>, pg8::StaticOrder, true, true>(lds, g, S, E); ); \
    SEAM((pb) + 2);

    LAYER_COMMON(0, 2, P.in[0])
    if constexpr (!FUSE_NORM) { PHASE(5, norm_phase<true>(P, lds, XB, P.in[5], 0, 3072, 4096, false, tid, lane, wave, wgi);); SEAM(5); }
    PHASE(6, pg8::Gemm g{H, (const bf16*)(P.ws + WS_WGU), M, 2 * FFD, D, 0}; pg8::StaticOrder S; S.init(M, 2 * FFD, GRID, wgi);
             pg8::EpiSwiGLU<false, FUSE_NORM != 0> E{(bf16*)(P.ws + WS_ACT), FFD, nullptr, 1.f, 1.f, (const float*)(P.ws + WS_SS1), (const float*)(P.ws + WS_CFF), 2 * FFD};
             pg8::gemm_phase<pg8::EpiSwiGLU<false, FUSE_NORM != 0>, pg8::StaticOrder, true, true>(lds, g, S, E);
             moe_filler(P, lds, FILL_S0, FILL_S1, lane, wave, wgi););
    SEAM(6);
    PHASE(30, pg8::Gemm g{(const bf16*)(P.ws + WS_ACT), (const bf16*)(P.ws + WS_WD), M, D, FFD, 0}; pg8::StaticOrder S; S.init(M, D, GRID, wgi);
              pg8::EpiResGate<FUSE_NORM != 0, true, true> E{XB, (float*)XB, mod + 5120, H, (float*)(P.ws + WS_SS2), P.in[4] + D, mod + (size_t)8 * 6144 + 1024};
              pg8::gemm_phase<pg8::EpiResGate<FUSE_NORM != 0, true, true>, pg8::StaticOrder, true, true>(lds, g, S, E););
    SEAM(7);
    if constexpr (!FUSE_NORM) { PHASE(8, norm_phase<true>(P, lds, XB, P.in[4] + D, 1, 0, 1024, false, tid, lane, wave, wgi);); SEAM(8); }
    LAYER_COMMON(1, 9, P.out)
    PHASE(31, router_phase(P, lds, P.out, tid, lane, wave, wgi););                                       SEAM(12);
    moe_tables(P, lds, tid);
    {
        const LAS int* tab = (const LAS int*)(lds + MOETAB_OFF);
        const int ptot = RFL(tab[8]);
        PHASE(11, pg8::Gemm g{(const bf16*)(P.ws + WS_HG), (const bf16*)(P.ws + WS_WMGU), ptot, 2 * FFE, D, (unsigned)(2 * FFE * D)};
                  pg8::MoeOrder S; S.nM = ptot >> 8; S.nN = 2 * FFE / 256; S.nwg = S.nM * S.nN; S.G = GRID; S.c = wgi; S.capA = true;
                  S.t1 = RFL(tab[1] >> 8); S.t2 = RFL(tab[2] >> 8); S.t3 = RFL(tab[3] >> 8); S.t4 = RFL(tab[4] >> 8); S.t5 = RFL(tab[5] >> 8); S.t6 = RFL(tab[6] >> 8); S.t7 = RFL(tab[7] >> 8);
                  pg8::EpiSwiGLU<true, false> E{(bf16*)(P.ws + WS_ACTM), FFE, (const float*)(P.ws + WS_WL), A8_SCALE / (H8_SCALE * W8_SCALE), 1.f / (H8_SCALE * W8_SCALE), nullptr, nullptr, 0};
                  pg8::gemm_phase<pg8::EpiSwiGLU<true, false>, pg8::MoeOrder, true, true, true>(lds, g, S, E););
        if constexpr ((REPMASK >> 22) & 1) { xcd_barrier(bar); RETID();
                  pg8::Gemm g{(const bf16*)(P.ws + WS_HG), (const bf16*)(P.ws + WS_WMGU), ptot, 2 * FFE, D, (unsigned)(2 * FFE * D)};
                  pg8::MoeOrder S; S.nM = ptot >> 8; S.nN = 2 * FFE / 256; S.nwg = S.nM * S.nN; S.G = GRID; S.c = wgi; S.capA = true;
                  S.t1 = RFL(tab[1] >> 8); S.t2 = RFL(tab[2] >> 8); S.t3 = RFL(tab[3] >> 8); S.t4 = RFL(tab[4] >> 8); S.t5 = RFL(tab[5] >> 8); S.t6 = RFL(tab[6] >> 8); S.t7 = RFL(tab[7] >> 8);
                  pg8::EpiNone E{};
                  pg8::gemm_phase<pg8::EpiNone, pg8::MoeOrder, true, true, true>(lds, g, S, E); }
        SEAM(14);
        PHASE(12, const int tall = ptot >> 8, tmain = tall < 128 ? tall : 128;
                  { pg8::Gemm g{(const bf16*)(P.ws + WS_ACTM), (const bf16*)(P.ws + WS_WMD), ptot, D, FFE, (unsigned)(D * FFE), 0};
                    pg8::MoeOrder S; S.nM = tmain; S.nN = D / 256; S.nwg = S.nM * S.nN; S.G = GRID; S.c = wgi; S.capA = false;
                    S.t1 = RFL(tab[1] >> 8); S.t2 = RFL(tab[2] >> 8); S.t3 = RFL(tab[3] >> 8); S.t4 = RFL(tab[4] >> 8); S.t5 = RFL(tab[5] >> 8); S.t6 = RFL(tab[6] >> 8); S.t7 = RFL(tab[7] >> 8);
                    pg8::EpiBf16<false> E{(bf16*)(P.ws + WS_F), D, 1.f / (A8_SCALE * W8_SCALE), 0, nullptr, nullptr};
                    pg8::gemm_phase<pg8::EpiBf16<false>, pg8::MoeOrder, true, true, true>(lds, g, S, E); }
                  if (tall > 128) { pg8::Gemm g{(const bf16*)(P.ws + WS_ACTM), (const bf16*)(P.ws + WS_WMD), ptot, D, FFE / pg8::RemOrder::NSPLIT, (unsigned)(D * FFE), FFE};
                    pg8::RemOrder S; S.tm0 = 128; S.nrem = tall - 128; S.G = GRID; S.c = wgi;
                    S.t1 = RFL(tab[1] >> 8); S.t2 = RFL(tab[2] >> 8); S.t3 = RFL(tab[3] >> 8); S.t4 = RFL(tab[4] >> 8); S.t5 = RFL(tab[5] >> 8); S.t6 = RFL(tab[6] >> 8); S.t7 = RFL(tab[7] >> 8);
                    pg8::EpiBf16<false> E{(bf16*)(P.ws + WS_FP) - (size_t)128 * 256 * D, D, 1.f / (A8_SCALE * W8_SCALE), (size_t)2048 * D, nullptr, nullptr};
                    pg8::gemm_phase<pg8::EpiBf16<false>, pg8::RemOrder, true, true, true>(lds, g, S, E); } );
        SEAM(15);
        PHASE(29, combine_phase(P, lds, lane, gw););
        __syncthreads(); STAMP();
    }
#undef SEAM
}
static int launch_fast(void* const* d_in, float* out, unsigned char* ws, hipStream_t stream, int stop) {
    static int ready = 0;
    if (ready == 0) {
        if (hipFuncSetAttribute((const void*)fwd, hipFuncAttributeMaxDynamicSharedMemorySize, LDS_BYTES) != hipSuccess) { fprintf(stderr, "kernel_launch: hipFuncSetAttribute failed\n"); ready = -1; return -1; }
        int per_cu = 0; if (hipOccupancyMaxActiveBlocksPerMultiprocessor(&per_cu, (const void*)fwd, NTHR, LDS_BYTES) != hipSuccess || per_cu < 1) fprintf(stderr, "kernel_launch: occupancy query reports %d blocks per CU\n", per_cu);
        (void)hipGetLastError(); ready = 1;
    }
    if (ready < 0) return -1;
    if (hipMemsetAsync(ws + WS_CTL, 0, CTL_ZERO_BYTES, stream) != hipSuccess) return -1;
    Params p{}; for (int i = 0; i < 23; ++i) p.in[i] = (const float*)d_in[i]; p.out = out; p.ws = ws; p.stop = stop; p.pad = 0;
    hipLaunchKernelGGL(fwd, dim3(GRID), dim3(NTHR), LDS_BYTES, stream, p);
    return hipPeekAtLastError() == hipSuccess ? 0 : -1;
}
}
#ifndef DBG_STAGE
#define DBG_STAGE 0
#endif
extern "C" void kernel_launch(void* const* d_in, const int* in_sizes, int n_in, void* d_out, int out_size, void* d_ws, size_t ws_size, hipStream_t stream) {
    if (n_in != 23 || out_size != fk::M * fk::D || ws_size < fk::WS_END) { fprintf(stderr, "kernel_launch: unexpected shapes / workspace (%d inputs, out %d, ws %zu)\n", n_in, out_size, ws_size); return; }
    unsigned char* ws = (unsigned char*)d_ws; float* out = (float*)d_out;
#if DBG_STAGE == 0
    fk::launch_fast(d_in, out, ws, stream, -1);
#elif defined(TSDBG)
    fk::launch_fast(d_in, out, ws, stream, -1);
    nv::k_savets<<<1, 64, 0, stream>>>((const unsigned long long*)ws + 16384, (float*)(ws + 389 * ((size_t)1 << 20)), TS_A0, TS_A1, TS_B0, TS_B1);
    nv::forward(d_in, out, ws, stream);
    nv::k_encode<<<(unsigned)(((size_t)fk::M * 1024 + 255) / 256), 256, 0, stream>>>(out, (size_t)fk::M * 1024, (const float*)(ws + 389 * ((size_t)1 << 20)));
#else
    constexpr int S = DBG_STAGE; constexpr size_t MiB = 1u << 20;
    float* ckf = (float*)(ws + 390 * MiB); float* acc = (float*)(ws + 389 * MiB);
    int stop = -1; size_t off = 0, n = 0; float scale = 1.f; bool isf32 = false;
    const size_t NM = (size_t)fk::M;
    switch (S) {
        case 1: stop = 1; off = fk::WS_H; n = NM * 1024; break;
        case 2: stop = 2; off = fk::WS_Z; n = NM * 512; break;
        case 3: stop = 2; off = fk::WS_Q; n = NM * 512; scale = 1.f / fk::QSCALE; break;
        case 4: stop = 2; off = fk::WS_K; n = NM * 512; break;
        case 5: stop = 3; off = fk::WS_YC; n = NM * 1024; break;
        case 6: stop = 4; isf32 = true; n = NM * 1024; break;
        case 7: stop = 5; off = fk::WS_H; n = NM * 1024; break;
        case 8: stop = 6; off = fk::WS_ACT; n = NM * 1024; break;
        case 9: stop = 7; isf32 = true; n = NM * 1024; break;
        case 11: stop = 8; off = fk::WS_H; n = NM * 1024; break;
        case 12: stop = 9; off = fk::WS_Z; n = NM * 512; break;
        case 13: stop = 9; off = fk::WS_Q; n = NM * 512; scale = 1.f / fk::QSCALE; break;
        case 14: stop = 9; off = fk::WS_K; n = NM * 512; break;
        case 15: stop = 10; off = fk::WS_YC; n = NM * 1024; break;
        case 16: stop = 11; isf32 = true; n = NM * 1024; break;
        default: stop = -1; isf32 = true; n = NM * 1024; break;
    }
    fk::launch_fast(d_in, out, ws, stream, stop);
    if (isf32) nv::k_copy<<<(unsigned)((n + 255) / 256), 256, 0, stream>>>(out, ckf, n);
    else nv::k_cvt<<<(unsigned)((n + 255) / 256), 256, 0, stream>>>((const unsigned short*)(ws + off), ckf, n, scale);
    hipMemsetAsync(acc, 0, 256, stream);
    nv::forward(d_in, out, ws, stream, S, ckf, acc);
    if (S == 99) nv::k_cmp<<<1024, 256, 0, stream>>>(ckf, out, n, acc);
    nv::k_scale<<<(unsigned)((NM * 1024 + 255) / 256), 256, 0, stream>>>(out, NM * 1024, acc);
#endif
}
```

```cpp
#include <hip/hip_runtime.h>
#include <cstdio>
#include <cstdint>
#define DBG_STAGE 0
#define REPMASK 0
namespace pg8 {
#define PG8_LAS __attribute__((address_space(3)))
typedef unsigned short bf16_t;
typedef short bf16x8 __attribute__((ext_vector_type(8)));
typedef float f32x4 __attribute__((ext_vector_type(4)));
typedef unsigned u32x4 __attribute__((ext_vector_type(4)));
constexpr int BM = 256, BK = 64, HALF = 128, HTB = HALF * BK * 2  , STAGE_BYTES = 8 * HTB, NXCD = 8, WGM = 8;

__host__ __device__ __forceinline__ int lds_byte(int r, int c) { const int st = (r >> 4) * 2 + (c >> 5), rr = r & 15, cc = c & 31, ob = rr * 64 + cc * 2; return st * 1024 + (ob ^ (((ob >> 9) & 1) << 5)); }
__host__ __device__ __forceinline__ void stage_rc(int b, int& R, int& C) { const int st = b / 1024, sb = b % 1024, swz = sb ^ (((sb >> 9) & 1) << 5); R = (st >> 1) * 16 + swz / 64; C = (st & 1) * 32 + (swz % 64) / 2; }
__host__ __device__ __forceinline__ int perm32(int rho) { const int n = rho >> 4, i = rho & 15; return 8 * (i >> 2) + 4 * n + (i & 3); }

struct Unit { int pm, pn, e, pa, ks; };
struct Gemm { const bf16_t* A; const bf16_t* Bt; int M, N, K; unsigned bstride; int ld; };

struct StaticOrder {
    int nM, nN, nwg, G, c;
    __device__ void init(int M, int N, int G_, int c_) { nM = M / BM; nN = N / BM; nwg = nM * nN; G = G_; c = c_; }
    __device__ bool next(int i, Unit& u) const {
        const long L = (long)i * G + c; if (L >= nwg) return false;
        int wgid = (int)L; { const int q = nwg / NXCD, r = nwg % NXCD, xcd = wgid % NXCD, off = wgid / NXCD; wgid = (xcd < r ? xcd * (q + 1) : r * (q + 1) + (xcd - r) * q) + off; }
        const int nig = WGM * nN, gid = wgid / nig, fm = gid * WGM, gsz = (nM - fm) < WGM ? (nM - fm) : WGM;
        u.pm = fm + ((wgid % nig) % gsz); u.pn = (wgid % nig) / gsz; u.e = 0; u.pa = u.pm; u.ks = 0; return true;
    }
    __device__ __forceinline__ void a_ready(const Unit&) const {}
    __device__ __forceinline__ void done(const Unit&) const {}
};
struct MoeOrder {
    int nM, nN, nwg, G, c; int t1, t2, t3, t4, t5, t6, t7; bool capA;
    __device__ bool next(int i, Unit& u) const {
        const long L = (long)i * G + c; if (L >= nwg) return false;
        int wgid = (int)L; { const int q = nwg / NXCD, r = nwg % NXCD, xcd = wgid % NXCD, off = wgid / NXCD; wgid = (xcd < r ? xcd * (q + 1) : r * (q + 1) + (xcd - r) * q) + off; }
        const int nig = WGM * nN, gid = wgid / nig, fm = gid * WGM, gsz = (nM - fm) < WGM ? (nM - fm) : WGM;
        u.pm = fm + ((wgid % nig) % gsz); u.pn = (wgid % nig) / gsz;
        const int p = u.pm; u.e = (p >= t1) + (p >= t2) + (p >= t3) + (p >= t4) + (p >= t5) + (p >= t6) + (p >= t7);
        if (capA) { int ts = 0; ts = p >= t1 ? t1 : ts; ts = p >= t2 ? t2 : ts; ts = p >= t3 ? t3 : ts; ts = p >= t4 ? t4 : ts; ts = p >= t5 ? t5 : ts; ts = p >= t6 ? t6 : ts; ts = p >= t7 ? t7 : ts; u.pa = u.e * 64 + (p - ts); }
        else u.pa = p;
        u.ks = 0; return true;
    }
    __device__ __forceinline__ void a_ready(const Unit&) const {}
    __device__ __forceinline__ void done(const Unit&) const {}
};

struct RemOrder {
    int tm0, nrem, G, c; int t1, t2, t3, t4, t5, t6, t7; static constexpr int NSPLIT = 7;
    __device__ bool next(int i, Unit& u) const {
        const int L = i * G + c; if (L >= nrem * 4 * NSPLIT) return false;
        u.ks = L % NSPLIT; u.pn = (L / NSPLIT) & 3; u.pm = tm0 + L / (4 * NSPLIT); u.pa = u.pm;
        const int p = u.pm; u.e = (p >= t1) + (p >= t2) + (p >= t3) + (p >= t4) + (p >= t5) + (p >= t6) + (p >= t7); return true;
    }
    __device__ __forceinline__ void a_ready(const Unit&) const {}
    __device__ __forceinline__ void done(const Unit&) const {}
};
__device__ __forceinline__ unsigned cvt_pk_bf16(float lo, float hi) { unsigned r; asm volatile("v_cvt_pk_bf16_f32 %0, %1, %2" : "=v"(r) : "v"(lo), "v"(hi)); return r; }
typedef int v8i __attribute__((ext_vector_type(8))); typedef int v4i __attribute__((ext_vector_type(4)));
__device__ __forceinline__ v8i cat8(bf16x8 lo, bf16x8 hi) { const v4i a = __builtin_bit_cast(v4i, lo), b = __builtin_bit_cast(v4i, hi); return __builtin_shufflevector(a, b, 0, 1, 2, 3, 4, 5, 6, 7); }
__device__ __forceinline__ unsigned pk4_fp8(float a, float b, float c, float d) { int w = __builtin_amdgcn_cvt_pk_fp8_f32(a, b, 0, false); w = __builtin_amdgcn_cvt_pk_fp8_f32(c, d, w, true); return (unsigned)w; }
__device__ __forceinline__ float sigm(float x) { return __builtin_amdgcn_rcpf(1.f + __builtin_amdgcn_exp2f(-1.4426950408889634f * x)); }
__device__ __forceinline__ u32x4 pack8(f32x4 v0, f32x4 v1) { u32x4 w; w.x = cvt_pk_bf16(v0[0], v0[1]); w.y = cvt_pk_bf16(v0[2], v0[3]); w.z = cvt_pk_bf16(v1[0], v1[1]); w.w = cvt_pk_bf16(v1[2], v1[3]); return w; }

template <bool NORM> struct EpiBf16 {
    static constexpr bool PERM = true, AFTER_DRAIN = false;
    bf16_t* O; int ldc; float scale; size_t slab;
    const float* ss; const float* cvec;
    __device__ __forceinline__ void operator()(const f32x4 (&acc)[2][2][4][2], const Unit& u, int wr, int wc, int fr, int fq) const {
        const int row0 = u.pm * BM + wr * 64 + fr; const int col0 = u.pn * BM + wc * 32 + 8 * fq;
        f32x4 rc[2][2];
        if constexpr (NORM) {
#pragma unroll
            for (int bj = 0; bj < 2; ++bj)
#pragma unroll
                for (int n = 0; n < 2; ++n) { const f32x4 q = *(const f32x4*)(ss + col0 + bj * HALF + 4 * n);
#pragma unroll
                    for (int i = 0; i < 4; ++i) rc[bj][n][i] = __builtin_amdgcn_rsqf(q[i] * (1.f / 1024.f) + 1e-6f); } }
#pragma unroll
        for (int ai = 0; ai < 2; ++ai)
#pragma unroll
            for (int m = 0; m < 4; ++m) { bf16_t* rowp = O + (size_t)u.ks * slab + (size_t)(row0 + ai * HALF + m * 16) * ldc + col0;
#pragma unroll
                for (int bj = 0; bj < 2; ++bj) { f32x4 v0 = acc[ai][bj][m][0] * scale, v1 = acc[ai][bj][m][1] * scale;
                    if constexpr (NORM) { const float cb = cvec[(size_t)(u.pn >> 3) * 2560 + row0 + ai * HALF + m * 16]; v0 = v0 * rc[bj][0] + cb; v1 = v1 * rc[bj][1] + cb; }
                    *(u32x4*)(rowp + bj * HALF) = pack8(v0, v1); } }
    }
};
template <bool NORM> struct EpiInProj {
    static constexpr bool PERM = true, AFTER_DRAIN = false;
    bf16_t *Z, *Q, *Kt; const float *qg, *kg; float qscale;
    const float* ss; const float* cvec;
    __device__ __forceinline__ void operator()(const f32x4 (&acc)[2][2][4][2], const Unit& u, int wr, int wc, int fr, int fq) const {
        const int row0 = u.pm * BM + wr * 64 + fr;
        f32x4 cv[2][2]; float rr[2][4];
#pragma unroll
        for (int bj = 0; bj < 2; ++bj)
#pragma unroll
            for (int n = 0; n < 2; ++n) { if constexpr (NORM) cv[bj][n] = *(const f32x4*)(cvec + (size_t)(u.pm >> 3) * 2560 + u.pn * BM + bj * HALF + wc * 32 + 8 * fq + 4 * n); else cv[bj][n] = (f32x4){0.f, 0.f, 0.f, 0.f}; }
#pragma unroll
        for (int ai = 0; ai < 2; ++ai)
#pragma unroll
            for (int m = 0; m < 4; ++m) { if constexpr (NORM) rr[ai][m] = __builtin_amdgcn_rsqf(ss[row0 + ai * HALF + m * 16] * (1.f / 1024.f) + 1e-6f); else rr[ai][m] = 1.f; }
#define VAL(ai, bj, m, n) (NORM ? acc[ai][bj][m][n] * rr[ai][m] + cv[bj][n] : acc[ai][bj][m][n])
        if (u.pn < 4) {
            const int col0 = u.pn * 128 + wc * 32 + 8 * fq;
#pragma unroll
            for (int ai = 0; ai < 2; ++ai)
#pragma unroll
                for (int m = 0; m < 4; ++m) { f32x4 z0, z1;
                    const f32x4 a0 = VAL(ai, 0, m, 0), a1 = VAL(ai, 0, m, 1), g0 = VAL(ai, 1, m, 0), g1 = VAL(ai, 1, m, 1);
#pragma unroll
                    for (int i = 0; i < 4; ++i) { z0[i] = a0[i] * sigm(g0[i]); z1[i] = a1[i] * sigm(g1[i]); }
                    *(u32x4*)(Z + (size_t)(row0 + ai * HALF + m * 16) * 512 + col0) = pack8(z0, z1); }
        } else {
            const bool isq = u.pn < 6; bf16_t* O = isq ? Q : Kt; const float* gv = isq ? qg : kg; const float sc = isq ? qscale : 1.f;
            const int head = 4 * (u.pn & 1) + wc;
            f32x4 gw[2][2];
#pragma unroll
            for (int bj = 0; bj < 2; ++bj)
#pragma unroll
                for (int n = 0; n < 2; ++n) gw[bj][n] = *(const f32x4*)(gv + 32 * bj + 8 * fq + 4 * n) * sc;
#pragma unroll
            for (int ai = 0; ai < 2; ++ai)
#pragma unroll
                for (int m = 0; m < 4; ++m) { float hs = 0.f; f32x4 xv[2][2];
#pragma unroll
                    for (int bj = 0; bj < 2; ++bj)
#pragma unroll
                        for (int n = 0; n < 2; ++n) { const f32x4 x = VAL(ai, bj, m, n); xv[bj][n] = x; hs += (x[0] * x[0] + x[1] * x[1]) + (x[2] * x[2] + x[3] * x[3]); }
                    hs += __shfl_xor(hs, 16); hs += __shfl_xor(hs, 32);
                    const float r = __builtin_amdgcn_rsqf(hs * (1.f / 64.f) + 1e-6f);
                    bf16_t* rowp = O + (size_t)(row0 + ai * HALF + m * 16) * 512 + head * 64 + 8 * fq;
#pragma unroll
                    for (int bj = 0; bj < 2; ++bj) *(u32x4*)(rowp + 32 * bj) = pack8(xv[bj][0] * r * gw[bj][0], xv[bj][1] * r * gw[bj][1]); }
        }
#undef VAL
    }
};
template <bool NORM, bool INBF = false, bool OUTBF = false> struct EpiResGate {
    static constexpr bool PERM = false, AFTER_DRAIN = false;
    const float* xin; float* out; const float* gate;
    bf16_t* xg; float* ss; const float* gnext; const float* scnext;
    __device__ __forceinline__ void operator()(const f32x4 (&acc)[2][2][4][2], const Unit& u, int wr, int wc, int fr, int fq) const {
        const int row0 = u.pm * BM + wr * 64 + fr, col0 = u.pn * BM + wc * 32 + 4 * fq; const float* gp = gate + (size_t)(u.pm >> 3) * 6144 + col0;
        f32x4 gv[2][2], gm[2][2];
#pragma unroll
        for (int bj = 0; bj < 2; ++bj)
#pragma unroll
            for (int n = 0; n < 2; ++n) { gv[bj][n] = *(const f32x4*)(gp + bj * HALF + n * 16);
                if constexpr (NORM) gm[bj][n] = *(const f32x4*)(gnext + col0 + bj * HALF + n * 16) * (*(const f32x4*)(scnext + (size_t)(u.pm >> 3) * 6144 + col0 + bj * HALF + n * 16) + 1.f); }
#pragma unroll
        for (int ai = 0; ai < 2; ++ai)
#pragma unroll
            for (int m = 0; m < 4; ++m) { const int row = row0 + ai * HALF + m * 16; const size_t off = (size_t)row * 1024 + col0; float sq = 0.f;
#pragma unroll
                for (int bj = 0; bj < 2; ++bj)
#pragma unroll
                    for (int n = 0; n < 2; ++n) { typedef unsigned u32x2b __attribute__((ext_vector_type(2))); f32x4 xv;
                        if constexpr (INBF) { const u32x2b q = *(const u32x2b*)((const bf16_t*)xin + off + bj * HALF + n * 16); xv = (f32x4){__uint_as_float(q.x << 16), __uint_as_float(q.x & 0xffff0000u), __uint_as_float(q.y << 16), __uint_as_float(q.y & 0xffff0000u)}; }
                        else xv = *(const f32x4*)(xin + off + bj * HALF + n * 16);
                        const f32x4 xn = xv + gv[bj][n] * acc[ai][bj][m][n];
                        if constexpr (OUTBF) { u32x2b w; w.x = cvt_pk_bf16(xn[0], xn[1]); w.y = cvt_pk_bf16(xn[2], xn[3]); *(u32x2b*)((bf16_t*)out + off + bj * HALF + n * 16) = w; }
                        else *(f32x4*)(out + off + bj * HALF + n * 16) = xn;
                        if constexpr (NORM) { sq += (xn[0] * xn[0] + xn[1] * xn[1]) + (xn[2] * xn[2] + xn[3] * xn[3]); const f32x4 t = xn * gm[bj][n];
                            typedef unsigned u32x2 __attribute__((ext_vector_type(2))); u32x2 w; w.x = cvt_pk_bf16(t[0], t[1]); w.y = cvt_pk_bf16(t[2], t[3]); *(u32x2*)(xg + off + bj * HALF + n * 16) = w; } }
                if constexpr (NORM) { sq += __shfl_xor(sq, 16); sq += __shfl_xor(sq, 32); if (fq == 0) atomicAdd(ss + row, sq); } }
    }
};
template <bool F8OUT, bool NORM> struct EpiSwiGLU {
    static constexpr bool PERM = true, AFTER_DRAIN = false;
    bf16_t* O; int ldc; const float* rowscale; float oscale, iscale;
    const float* ss; const float* cvec;
    int ncv;
    __device__ __forceinline__ void operator()(const f32x4 (&acc)[2][2][4][2], const Unit& u, int wr, int wc, int fr, int fq) const {
        const int row0 = u.pm * BM + wr * 64 + fr; const int col0 = u.pn * 128 + wc * 32 + 8 * fq;
        f32x4 cg[2], cu[2];
        if constexpr (NORM) { const float* cp = cvec + (size_t)(u.pm >> 3) * ncv + u.pn * BM + wc * 32 + 8 * fq; cg[0] = *(const f32x4*)cp; cg[1] = *(const f32x4*)(cp + 4); cu[0] = *(const f32x4*)(cp + HALF); cu[1] = *(const f32x4*)(cp + HALF + 4); }
#pragma unroll
        for (int ai = 0; ai < 2; ++ai)
#pragma unroll
            for (int m = 0; m < 4; ++m) { const int row = row0 + ai * HALF + m * 16; const float rs = (rowscale ? rowscale[row + (u.pa - u.pm) * BM] : 1.f) * oscale;   f32x4 z0, z1;
                if constexpr (NORM) { const float r = __builtin_amdgcn_rsqf(ss[row] * (1.f / 1024.f) + 1e-6f);
#pragma unroll
                    for (int i = 0; i < 4; ++i) { const float g0 = r * acc[ai][0][m][0][i] + cg[0][i], g1 = r * acc[ai][0][m][1][i] + cg[1][i], u0 = r * acc[ai][1][m][0][i] + cu[0][i], u1 = r * acc[ai][1][m][1][i] + cu[1][i];
                        z0[i] = g0 * sigm(g0) * u0 * rs; z1[i] = g1 * sigm(g1) * u1 * rs; } }
                else {
#pragma unroll
                for (int i = 0; i < 4; ++i) { const float g0 = acc[ai][0][m][0][i] * iscale, g1 = acc[ai][0][m][1][i] * iscale;
                    z0[i] = g0 * sigm(g0) * acc[ai][1][m][0][i] * rs; z1[i] = g1 * sigm(g1) * acc[ai][1][m][1][i] * rs; } }
                if constexpr (F8OUT) { typedef unsigned u32x2 __attribute__((ext_vector_type(2))); u32x2 w; w.x = pk4_fp8(z0[0], z0[1], z0[2], z0[3]); w.y = pk4_fp8(z1[0], z1[1], z1[2], z1[3]);
                    *(u32x2*)((unsigned char*)O + (size_t)row * ldc + col0) = w; }
                else *(u32x4*)(O + (size_t)row * ldc + col0) = pack8(z0, z1); }
    }
};
struct EpiNone {
    static constexpr bool PERM = true, AFTER_DRAIN = false;
    __device__ __forceinline__ void operator()(const f32x4 (&acc)[2][2][4][2], const Unit& u, int wr, int wc, int fr, int fq) const {
#pragma unroll
        for (int ai = 0; ai < 2; ++ai)
#pragma unroll
            for (int bj = 0; bj < 2; ++bj)
#pragma unroll
                for (int m = 0; m < 4; ++m)
#pragma unroll
                    for (int n = 0; n < 2; ++n) asm volatile("" :: "v"(acc[ai][bj][m][n]));
    }
};
__device__ __forceinline__ const char* uptr(const char* p) { unsigned long long v = (unsigned long long)p; const unsigned lo = __builtin_amdgcn_readfirstlane((unsigned)v), hi = __builtin_amdgcn_readfirstlane((unsigned)(v >> 32)); unsigned long long r = ((unsigned long long)hi << 32) | lo; asm volatile("" : "+s"(r)); return (const char*)r; }
template <class Epi, class Sched, bool ALIGN_EPI = false, bool SP2 = false, bool FP8 = false>
__device__ __forceinline__ void gemm_phase(PG8_LAS unsigned char* lds, const Gemm g, const Sched& S, const Epi& E) {
    int tid_ = threadIdx.x; asm volatile("" : "+v"(tid_)); const int tid = tid_, wid = __builtin_amdgcn_readfirstlane(tid >> 6), lane = tid & 63, wr = wid >> 2, wc = wid & 3, fr = lane & 15, fq = lane >> 4;
    const int KB0 = FP8 ? g.K : g.K * 2, nt = KB0 / (BK * 2), KB = g.ld ? (FP8 ? g.ld : g.ld * 2) : KB0;
    unsigned voffA, voffB;
    { int R, C; stage_rc(tid * 16, R, C); const int Rb = Epi::PERM ? ((R & ~31) + perm32(R & 31)) : R;
        voffA = (unsigned)(R * KB + C * 2); voffB = (unsigned)(Rb * KB + C * 2); }
    const unsigned pstep = 64u * KB;
    constexpr unsigned kstep = BK * 2;
    const unsigned hstep = (unsigned)HALF * KB;
    const unsigned tstep = 2 * hstep;
    const unsigned ldsw = (unsigned)wid * 1024u;
    const int aoff = lds_byte(wr * 64 + fr, fq * 8), boff = lds_byte(wc * 32 + fr, fq * 8);
#define PG8_SA(b, h) (((b) * 2 + (h)) * HTB)
#define PG8_SB(b, h) ((4 + (b) * 2 + (h)) * HTB)
#define PG8_STAGE(bufoff, gbase, voff) do { unsigned vo_ = (voff); asm volatile("" : "+v"(vo_));   \
        _Pragma("unroll") for (int _i = 0; _i < 2; ++_i) \
        __builtin_amdgcn_global_load_lds((const unsigned*)((const char*)(gbase) + _i * pstep + vo_), (PG8_LAS unsigned*)(lds + (bufoff) + ldsw + _i * 8192), 16, 0, 0); } while (0)
#define PG8_LDA(dst, b, h) do { _Pragma("unroll") for (int m = 0; m < 4; ++m) { if constexpr (FP8) { const v4i lo_ = *(const PG8_LAS v4i*)(lds + PG8_SA(b, h) + aoff + m * 2048), hi_ = *(const PG8_LAS v4i*)(lds + PG8_SA(b, h) + aoff + m * 2048 + 1024); dst##8[m] = __builtin_shufflevector(lo_, hi_, 0, 1, 2, 3, 4, 5, 6, 7); } \
        else { _Pragma("unroll") for (int k = 0; k < 2; ++k) dst[m][k] = *(const PG8_LAS bf16x8*)(lds + PG8_SA(b, h) + aoff + m * 2048 + k * 1024); } } } while (0)
#define PG8_LDB(dst, b, h) do { _Pragma("unroll") for (int n = 0; n < 2; ++n) { if constexpr (FP8) { const v4i lo_ = *(const PG8_LAS v4i*)(lds + PG8_SB(b, h) + boff + n * 2048), hi_ = *(const PG8_LAS v4i*)(lds + PG8_SB(b, h) + boff + n * 2048 + 1024); dst##8[n] = __builtin_shufflevector(lo_, hi_, 0, 1, 2, 3, 4, 5, 6, 7); } \
        else { _Pragma("unroll") for (int k = 0; k < 2; ++k) dst[n][k] = *(const PG8_LAS bf16x8*)(lds + PG8_SB(b, h) + boff + n * 2048 + k * 1024); } } } while (0)
#define PG8_MMA(ai, bj, At, Bt) do { __builtin_amdgcn_s_setprio(1); _Pragma("unroll") for (int m = 0; m < 4; ++m) _Pragma("unroll") for (int n = 0; n < 2; ++n) { \
        if constexpr (FP8) asm volatile("v_mfma_f32_16x16x128_f8f6f4 %0, %1, %2, %0" : "+v"(acc[ai][bj][m][n]) : "v"(Bt##8[n]), "v"(At##8[m]));   \
        else { _Pragma("unroll") for (int k = 0; k < 2; ++k) acc[ai][bj][m][n] = __builtin_amdgcn_mfma_f32_16x16x32_bf16(Bt[n][k], At[m][k], acc[ai][bj][m][n], 0, 0, 0); } } \
        __builtin_amdgcn_s_setprio(0); } while (0)
#define PG8_WAIT_V(n) asm volatile("s_waitcnt vmcnt(" #n ")" ::: "memory")
#define PG8_WAIT_L(n) asm volatile("s_waitcnt lgkmcnt(" #n ")" ::: "memory")
#define PG8_BAR __builtin_amdgcn_s_barrier()
#define PG8_SCHED __builtin_amdgcn_sched_barrier(0)
    Unit cur, nxt; int ui = 0;
    if (!S.next(0, cur)) return;
    f32x4 acc[2][2][4][2];
#pragma unroll
    for (int a = 0; a < 2; ++a)
#pragma unroll
        for (int b = 0; b < 2; ++b)
#pragma unroll
            for (int m = 0; m < 4; ++m)
#pragma unroll
                for (int n = 0; n < 2; ++n) acc[a][b][m][n] = (f32x4){0.f, 0.f, 0.f, 0.f};
    bf16x8 At[4][2], B0[2][2], B1[2][2]; v8i At8[4], B08[2], B18[2];
    const char* cA = (const char*)g.A + (unsigned)cur.pa * tstep + (unsigned)cur.ks * (unsigned)KB0; const char* cB = (const char*)g.Bt + (unsigned)cur.e * g.bstride + (unsigned)cur.pn * tstep + (unsigned)cur.ks * (unsigned)KB0;
    S.a_ready(cur);
    if constexpr (SP2) {
        PG8_STAGE(PG8_SB(0, 0), cB, voffB); PG8_STAGE(PG8_SB(0, 1), cB + hstep, voffB); PG8_STAGE(PG8_SA(0, 0), cA, voffA); PG8_STAGE(PG8_SA(0, 1), cA + hstep, voffA);
        if (wr == 1) PG8_BAR;
        PG8_WAIT_V(2); PG8_BAR;
        PG8_STAGE(PG8_SB(1, 0), cB + kstep, voffB); PG8_STAGE(PG8_SA(1, 0), cA + kstep, voffA); PG8_STAGE(PG8_SB(1, 1), cB + hstep + kstep, voffB);
        PG8_WAIT_V(6); PG8_BAR;
    } else {
        PG8_STAGE(PG8_SB(0, 0), cB, voffB); PG8_STAGE(PG8_SA(0, 0), cA, voffA); PG8_STAGE(PG8_SB(0, 1), cB + hstep, voffB); PG8_STAGE(PG8_SA(0, 1), cA + hstep, voffA);
        if (wr == 1) PG8_BAR;
        PG8_WAIT_V(4); PG8_BAR;
        PG8_STAGE(PG8_SB(1, 0), cB + kstep, voffB); PG8_STAGE(PG8_SA(1, 0), cA + kstep, voffA); PG8_STAGE(PG8_SB(1, 1), cB + hstep + kstep, voffB);
        PG8_WAIT_V(6); PG8_BAR;
    }
    for (;;) {
        const bool has_next = S.next(ui + 1, nxt);
        const char* nA = has_next ? (const char*)g.A + (unsigned)nxt.pa * tstep + (unsigned)nxt.ks * (unsigned)KB0 : cA; const char* nB = has_next ? (const char*)g.Bt + (unsigned)nxt.e * g.bstride + (unsigned)nxt.pn * tstep + (unsigned)nxt.ks * (unsigned)KB0 : cB;
#pragma unroll 1
        for (int t = 0; t < nt; t += 2) {
            const bool last = (t == nt - 2);
            const char* a1 = cA + (unsigned)(t + 1) * kstep;
            const char* a2 = last ? nA : cA + (unsigned)(t + 2) * kstep; const char* b2 = last ? nB : cB + (unsigned)(t + 2) * kstep;
            const char* a3 = a2 + kstep; const char* b3 = b2 + kstep;
            a1 = uptr(a1); a2 = uptr(a2); b2 = uptr(b2); a3 = uptr(a3); b3 = uptr(b3);
            if (last && has_next) S.a_ready(nxt);
            if constexpr (SP2) {
            PG8_LDB(B0, 0, 0); PG8_LDB(B1, 0, 1); PG8_SCHED; PG8_LDA(At, 0, 0); PG8_STAGE(PG8_SA(1, 1), a1 + hstep, voffA);
            PG8_WAIT_V(8); PG8_WAIT_L(0); PG8_BAR; PG8_MMA(0, 0, At, B0); PG8_MMA(0, 1, At, B1); PG8_BAR; PG8_SCHED;
            PG8_LDA(At, 0, 1); PG8_STAGE(PG8_SB(0, 0), b2, voffB); PG8_STAGE(PG8_SB(0, 1), b2 + hstep, voffB); PG8_STAGE(PG8_SA(0, 0), a2, voffA);
            PG8_WAIT_V(8); PG8_WAIT_L(0); PG8_BAR; PG8_MMA(1, 0, At, B0); PG8_MMA(1, 1, At, B1); PG8_BAR; PG8_SCHED;
            PG8_LDB(B0, 1, 0); PG8_LDB(B1, 1, 1); PG8_SCHED; PG8_LDA(At, 1, 0); PG8_STAGE(PG8_SA(0, 1), a2 + hstep, voffA);
            PG8_WAIT_V(8); PG8_WAIT_L(0); PG8_BAR; PG8_MMA(0, 0, At, B0); PG8_MMA(0, 1, At, B1); PG8_BAR; PG8_SCHED;
            PG8_LDA(At, 1, 1); PG8_STAGE(PG8_SB(1, 0), b3, voffB); PG8_STAGE(PG8_SB(1, 1), b3 + hstep, voffB); PG8_STAGE(PG8_SA(1, 0), a3, voffA);
            PG8_WAIT_V(8); PG8_WAIT_L(0); PG8_BAR; PG8_MMA(1, 0, At, B0); PG8_MMA(1, 1, At, B1); PG8_BAR; PG8_SCHED;
            } else {
            PG8_LDB(B0, 0, 0); PG8_SCHED; PG8_LDA(At, 0, 0); PG8_STAGE(PG8_SA(1, 1), a1 + hstep, voffA);
            PG8_WAIT_L(8); PG8_BAR; PG8_WAIT_L(0); PG8_MMA(0, 0, At, B0); PG8_BAR; PG8_SCHED;
            PG8_LDB(B1, 0, 1); PG8_STAGE(PG8_SB(0, 0), b2, voffB);
            PG8_BAR; PG8_WAIT_L(0); PG8_MMA(0, 1, At, B1); PG8_BAR;
            PG8_LDA(At, 0, 1); PG8_STAGE(PG8_SA(0, 0), a2, voffA);
            PG8_BAR; PG8_WAIT_L(0); PG8_MMA(1, 0, At, B0); PG8_BAR; PG8_SCHED;
            PG8_STAGE(PG8_SB(0, 1), b2 + hstep, voffB);
            PG8_WAIT_V(6); PG8_BAR; PG8_MMA(1, 1, At, B1); PG8_BAR;
            PG8_LDB(B0, 1, 0); PG8_SCHED; PG8_LDA(At, 1, 0); PG8_STAGE(PG8_SA(0, 1), a2 + hstep, voffA);
            PG8_WAIT_L(8); PG8_BAR; PG8_WAIT_L(0); PG8_MMA(0, 0, At, B0); PG8_BAR; PG8_SCHED;
            PG8_LDB(B1, 1, 1); PG8_STAGE(PG8_SB(1, 0), b3, voffB);
            PG8_BAR; PG8_WAIT_L(0); PG8_MMA(0, 1, At, B1); PG8_BAR;
            PG8_LDA(At, 1, 1); PG8_STAGE(PG8_SA(1, 0), a3, voffA);
            PG8_BAR; PG8_WAIT_L(0); PG8_MMA(1, 0, At, B0); PG8_BAR; PG8_SCHED;
            PG8_STAGE(PG8_SB(1, 1), b3 + hstep, voffB);
            PG8_WAIT_V(6); PG8_BAR; PG8_MMA(1, 1, At, B1); PG8_BAR;
            }
        }
        if constexpr (FP8) asm volatile("s_nop 15\n\ts_nop 15" ::: "memory");
        if constexpr (ALIGN_EPI) { if (wr == 0) PG8_BAR; }
        if constexpr (!Epi::AFTER_DRAIN) { int l_ = threadIdx.x; asm volatile("" : "+v"(l_)); const int fr_ = l_ & 15, fq_ = (l_ >> 4) & 3; E(acc, cur, wr, wc, fr_, fq_); S.done(cur); }
        if (!has_next) break;
#pragma unroll
        for (int a = 0; a < 2; ++a)
#pragma unroll
            for (int b = 0; b < 2; ++b)
#pragma unroll
                for (int m = 0; m < 4; ++m)
#pragma unroll
                    for (int n = 0; n < 2; ++n) acc[a][b][m][n] = (f32x4){0.f, 0.f, 0.f, 0.f};
        cur = nxt; cA = nA; cB = nB; ++ui;
        if constexpr (ALIGN_EPI) { if (wr == 1) PG8_BAR; }
    }
    PG8_WAIT_V(0);
    if constexpr (!ALIGN_EPI) { if (wr == 0) PG8_BAR; }
    PG8_BAR;
    if constexpr (Epi::AFTER_DRAIN) { E.fused(acc, cur, wr, wc, fr, fq, lds, wid, lane); S.done(cur); }
#undef PG8_SA
#undef PG8_SB
#undef PG8_STAGE
#undef PG8_LDA
#undef PG8_LDB
#undef PG8_MMA
#undef PG8_WAIT_V
#undef PG8_WAIT_L
#undef PG8_BAR
#undef PG8_SCHED
}
}

namespace fk {
using pg8::bf16_t; using pg8::bf16x8; using pg8::f32x4; using pg8::u32x4;
constexpr int NWAVES = 8, NTHR = 512, GRID = 256, NGW = GRID * NWAVES;
constexpr int B_ = 8, S_ = 2048, D = 1024, M = B_ * S_, DIN = 2560, DC = 512, FFD = 2816, NE = 8, FFE = 3584, CW = 31, NREL = 257;
constexpr float LOG2E = 1.4426950408889634f, QSCALE = 0.125f * LOG2E, EPS = 1e-6f;
constexpr size_t MiB = 1u << 20;
constexpr size_t WS_CTL = 0, CTL_ZERO_BYTES = 1 * MiB;
constexpr size_t WS_SS1 = 256 * 1024, WS_SS2 = 320 * 1024;
constexpr size_t WS_MODP = 1 * MiB;
constexpr size_t WS_CFF = 1 * MiB, WS_CIN = 1 * MiB + 256 * 1024;
constexpr size_t WS_MOD = 4 * MiB;
constexpr size_t WS_PAIR = 4 * MiB + 512 * 1024;
constexpr size_t WS_LIST = 5 * MiB;
constexpr size_t WS_WL = 5 * MiB + 512 * 1024;
constexpr size_t WS_WLG = 6 * MiB;
constexpr size_t WS_WMGU = 8 * MiB;
constexpr size_t WS_WMD = 120 * MiB;
constexpr size_t WS_XB = 64 * MiB;
constexpr size_t WS_FP = 148 * MiB;
constexpr size_t WS_WIN = 176 * MiB;
constexpr size_t WS_WOUT = 186 * MiB;
constexpr size_t WS_WGU = 190 * MiB;
constexpr size_t WS_WD = 201 * MiB;
constexpr size_t WS_H = 207 * MiB;
constexpr size_t WS_Z = 239 * MiB, WS_Q = 255 * MiB, WS_K = 271 * MiB, WS_VT = 287 * MiB;
constexpr size_t WS_YC = 303 * MiB;
constexpr size_t WS_ACT = 239 * MiB;
constexpr size_t WS_HG = 363 * MiB;
constexpr size_t WS_F = 176 * MiB;
constexpr size_t WS_ACTM = 244 * MiB;
constexpr size_t WS_END = 491 * MiB;
constexpr int MAXROWS = 34816;
constexpr int CW_BAR = 4096, CW_CNT = 16384;
constexpr int RING_BYTES = 131072, LDSCTL_OFF = RING_BYTES, MISC_OFF = LDSCTL_OFF + 320, MOETAB_OFF = LDSCTL_OFF + 512;
constexpr int LDS_BYTES = 147456;

#define GAS __attribute__((address_space(1)))
#define LAS __attribute__((address_space(3)))
typedef unsigned short bf16;
typedef unsigned v4u __attribute__((ext_vector_type(4)));
typedef unsigned v2u __attribute__((ext_vector_type(2)));
typedef float f32x16 __attribute__((ext_vector_type(16)));
typedef short s16x4 __attribute__((ext_vector_type(4)));
typedef float f32x2_t __attribute__((ext_vector_type(2))); typedef __bf16 bf16x2_t __attribute__((ext_vector_type(2)));
__device__ __forceinline__ unsigned pk2(float lo, float hi) { f32x2_t v = {lo, hi}; bf16x2_t b = __builtin_convertvector(v, bf16x2_t); return __builtin_bit_cast(unsigned, b); }
__device__ __forceinline__ float bf2f(bf16 v) { return __uint_as_float((unsigned)v << 16); }
__device__ __forceinline__ float wave_sum(float v) {
#pragma unroll
    for (int o = 1; o < 64; o <<= 1) v += __shfl_xor(v, o);
    return v;
}
__device__ __forceinline__ float sigm(float x) { return __builtin_amdgcn_rcpf(1.f + __builtin_amdgcn_exp2f(-LOG2E * x)); }
using pg8::pk4_fp8;
constexpr float W8_SCALE = 64.f, H8_SCALE = 8.f, A8_SCALE = 4.f;
constexpr int E8_W = (127 - 6) * 0x01010101, E8_H = (127 - 3) * 0x01010101, E8_A = (127 - 2) * 0x01010101;
#define LDS_WAIT() asm volatile("s_waitcnt lgkmcnt(0)" ::: "memory")
#define RFL(x) __builtin_amdgcn_readfirstlane(x)

#define XB_TMO      128
#define XB_XCNT(j)  (256  + 64 * (j))
#define XB_XSUB(j)  (1280 + 64 * (j))
#define XB_XGEN(j)  (2304 + 64 * (j))
#define XB_TOP      3328
#define XB_TOPGEN   3392
#define XCD_BAR_WORDS 3456
#define XB_SPIN_CAP (1u << 18)

__device__ __forceinline__ unsigned xb_ld(unsigned* p)              { return __hip_atomic_load(p, __ATOMIC_RELAXED, __HIP_MEMORY_SCOPE_AGENT); }
__device__ __forceinline__ unsigned xb_add(unsigned* p, unsigned v) { return __hip_atomic_fetch_add(p, v, __ATOMIC_RELAXED, __HIP_MEMORY_SCOPE_AGENT); }
__device__ __forceinline__ unsigned xb_xcc_id() { return (unsigned)__builtin_amdgcn_s_getreg((3 << 11) | 20) & 0xFu; }
#define XB_SPIN(cond, bar) do { unsigned _sp = 0; while (cond) { __builtin_amdgcn_s_sleep(1); \
    if ((++_sp & 255u) == 0u) { if (xb_ld(&(bar)[XB_TMO])) break; if (_sp > XB_SPIN_CAP) { atomicAdd(&(bar)[XB_TMO], 1u); break; } } } } while (0)

struct XcdBarrier {
    unsigned* bar; unsigned x;
    volatile LAS unsigned* st;
};

__device__ __forceinline__ XcdBarrier xcd_barrier_post(unsigned* bar, volatile LAS unsigned* st) {
    XcdBarrier b; b.bar = bar; b.x = xb_xcc_id(); b.st = st;
    if (threadIdx.x == 0) (void)xb_add(&bar[XB_XCNT(b.x)], 1u);
    return b;
}
__device__ __forceinline__ void xcd_barrier_complete(unsigned* bar, unsigned x, unsigned& nloc, unsigned& nx) {
    const unsigned G = gridDim.x * gridDim.y * gridDim.z;
    unsigned sum, cnt, mine, sp = 0u;
    for (;;) {
        sum = 0u; cnt = 0u; mine = 0u;
#pragma unroll
        for (unsigned j = 0; j < 16; ++j) { const unsigned c = xb_ld(&bar[XB_XCNT(j)]); sum += c; cnt += (c > 0u) ? 1u : 0u; mine = (j == x) ? c : mine; }
        if (sum == G) break;
        __builtin_amdgcn_s_sleep(1);
        if ((++sp & 255u) == 0u) { if (xb_ld(&bar[XB_TMO])) break; if (sp > XB_SPIN_CAP) { atomicAdd(&bar[XB_TMO], 1u); break; } }
    }
    nloc = mine > 0u ? mine : 1u; nx = cnt > 0u ? cnt : 1u;
}

__device__ __forceinline__ void xcd_barrier(const XcdBarrier& b) {
    asm volatile("s_waitcnt vmcnt(0)" ::: "memory");
    __syncthreads();
    if (threadIdx.x == 0) {
        unsigned* bar = b.bar;
        __builtin_amdgcn_s_waitcnt(0);
        unsigned nloc = b.st[0], nx = b.st[1];
        if (nloc == 0u) { xcd_barrier_complete(bar, b.x, nloc, nx); b.st[0] = nloc; b.st[1] = nx; }
        const unsigned old = xb_add(&bar[XB_XSUB(b.x)], 1u);
        const unsigned gen = old / nloc;
        if (old + 1u == (gen + 1u) * nloc) {
            __builtin_amdgcn_fence(__ATOMIC_RELEASE, "agent");
            asm volatile("s_waitcnt vmcnt(0)" ::: "memory");
            const unsigned og = xb_add(&bar[XB_TOP], 1u);
            const unsigned tg = og / nx;
            if (og + 1u == (tg + 1u) * nx) xb_add(&bar[XB_TOPGEN], 1u);
            else XB_SPIN(xb_ld(&bar[XB_TOPGEN]) == tg, bar);
            __builtin_amdgcn_fence(__ATOMIC_ACQUIRE, "agent");
            xb_add(&bar[XB_XGEN(b.x)], 1u);
            asm volatile("s_waitcnt vmcnt(0)" ::: "memory");
        } else {
            XB_SPIN(xb_ld(&bar[XB_XGEN(b.x)]) == gen, bar);
            __builtin_amdgcn_fence(__ATOMIC_ACQUIRE, "agent");
            asm volatile("s_waitcnt vmcnt(0)" ::: "memory");
        }
    }
    __syncthreads();
}


#ifndef FUSE_NORM
#define FUSE_NORM 0
#endif
#ifndef REPMASK
#define REPMASK 0
#endif
struct Params { const float* in[23]; float* out; unsigned char* ws; int stop; int pad; };

__device__ __forceinline__ void tr_item(const float* W, int K, int N, bf16* WT, int kb, int nb, int drow0, LAS float* scr, int lane) {
    const int k0 = 64 * kb, n0 = 32 * nb;
    { f32x4 v[8];
#pragma unroll
      for (int i = 0; i < 8; ++i) v[i] = *(const GAS f32x4*)(W + (size_t)(k0 + 8 * i + (lane >> 3)) * N + n0 + (lane & 7) * 4);
#pragma unroll
      for (int i = 0; i < 8; ++i) { LAS float* d = scr + (8 * i + (lane >> 3)) * 33 + (lane & 7) * 4; d[0] = v[i].x; d[1] = v[i].y; d[2] = v[i].z; d[3] = v[i].w; } }
    LDS_WAIT(); asm volatile("" ::: "memory");
    const int c = lane & 7;
#pragma unroll
    for (int j = 0; j < 4; ++j) { const int n = (lane >> 3) + 8 * j; const LAS float* s = scr + (8 * c) * 33 + n;
        v4u o; o.x = pk2(s[0 * 33], s[1 * 33]); o.y = pk2(s[2 * 33], s[3 * 33]); o.z = pk2(s[4 * 33], s[5 * 33]); o.w = pk2(s[6 * 33], s[7 * 33]);
        *(GAS v4u*)(WT + (size_t)(drow0 + n) * K + k0 + 8 * c) = o; }
    LDS_WAIT(); asm volatile("" ::: "memory");
}
__device__ __forceinline__ void tr_item_f8(const float* W, int K, int N, unsigned char* WT, int kb, int nb, int drow0, LAS float* scr, int lane, float scale) {
    const int k0 = 64 * kb, n0 = 32 * nb;
    { f32x4 v[8];
#pragma unroll
      for (int i = 0; i < 8; ++i) v[i] = __builtin_nontemporal_load((const GAS f32x4*)(W + (size_t)(k0 + 8 * i + (lane >> 3)) * N + n0 + (lane & 7) * 4));
#pragma unroll
      for (int i = 0; i < 8; ++i) { LAS float* d = scr + (8 * i + (lane >> 3)) * 33 + (lane & 7) * 4; d[0] = v[i].x; d[1] = v[i].y; d[2] = v[i].z; d[3] = v[i].w; } }
    LDS_WAIT(); asm volatile("" ::: "memory");
    const int c = lane & 7;
#pragma unroll
    for (int j = 0; j < 4; ++j) { const int n = (lane >> 3) + 8 * j; const LAS float* s = scr + (8 * c) * 33 + n;
        v2u o; o.x = pk4_fp8(s[0 * 33] * scale, s[1 * 33] * scale, s[2 * 33] * scale, s[3 * 33] * scale); o.y = pk4_fp8(s[4 * 33] * scale, s[5 * 33] * scale, s[6 * 33] * scale, s[7 * 33] * scale);
        __builtin_nontemporal_store(o, (GAS v2u*)(WT + (size_t)(drow0 + n) * K + k0 + 8 * c)); }
    LDS_WAIT(); asm volatile("" ::: "memory");
}
__device__ __forceinline__ int rowmap_win(int n0) {
    if (n0 < 512) return 256 * (n0 >> 7) + (n0 & 127);
    if (n0 < 1024) { const int m = n0 - 512; return 256 * (m >> 7) + 128 + (m & 127); }
    if (n0 < 2048) { const int isk = n0 >= 1536; const int m = n0 - (isk ? 1536 : 1024); const int head = m >> 6, bj = (m >> 5) & 1; return 256 * (4 + 2 * isk + (head >> 2)) + 128 * bj + 32 * (head & 3); }
    return n0;
}
__device__ __forceinline__ int rowmap_gu(int n0, int up) { return 256 * (n0 >> 7) + 128 * up + (n0 & 127); }

constexpr int MOE_ITEMS = 16 * (16 * 112) + 8 * (56 * 32);
constexpr int FILL_S0 = 10240, FILL_S1 = 22528, FILL_S2 = 32768, FILL_MIX = 0, FILL_P0 = FILL_S2 + 2 * FILL_MIX;
struct MoeItem { const float* src; unsigned char* dst; int N, K; };
__device__ __forceinline__ MoeItem moe_item_decode(const Params& P, int r, int lane) {
    constexpr int I_MG = 16 * 112, I_MD = 56 * 32; MoeItem m;
    if (r < 16 * I_MG) { const int mat = r / I_MG, q = r % I_MG, e = mat >> 1, up = mat & 1; const int kb = q / 112, nb = q % 112;
        m.N = FFE; m.K = D; m.src = (up ? P.in[21] : P.in[20]) + (size_t)e * D * FFE + (size_t)(64 * kb + (lane >> 3)) * FFE + 32 * nb + (lane & 7) * 4;
        m.dst = (unsigned char*)(P.ws + WS_WMGU) + (size_t)e * 7168 * D + (size_t)rowmap_gu(32 * nb, up) * D + 64 * kb; }
    else { r -= 16 * I_MG; const int e = r / I_MD, q = r % I_MD; const int kb = q / 32, nb = q % 32;
        m.N = D; m.K = FFE; m.src = P.in[22] + (size_t)e * FFE * D + (size_t)(64 * kb + (lane >> 3)) * D + 32 * nb + (lane & 7) * 4;
        m.dst = (unsigned char*)(P.ws + WS_WMD) + (size_t)e * D * FFE + (size_t)(32 * nb) * FFE + 64 * kb; }
    return m;
}
__device__ __forceinline__ void moe_item_load(const MoeItem& m, f32x4 (&v)[8]) {
#pragma unroll
    for (int i = 0; i < 8; ++i) v[i] = __builtin_nontemporal_load((const GAS f32x4*)(m.src + (size_t)(8 * i) * m.N));
}
__device__ __forceinline__ void moe_item_finish(const MoeItem& m, const f32x4 (&v)[8], LAS float* scr, int lane) {
#pragma unroll
    for (int i = 0; i < 8; ++i) { LAS float* d = scr + (8 * i + (lane >> 3)) * 33 + (lane & 7) * 4; d[0] = v[i].x; d[1] = v[i].y; d[2] = v[i].z; d[3] = v[i].w; }
    LDS_WAIT(); asm volatile("" ::: "memory");
    const int c = lane & 7;
#pragma unroll
    for (int j = 0; j < 4; ++j) { const int n = (lane >> 3) + 8 * j; const LAS float* s = scr + (8 * c) * 33 + n;
        v2u o; o.x = pk4_fp8(s[0 * 33] * W8_SCALE, s[1 * 33] * W8_SCALE, s[2 * 33] * W8_SCALE, s[3 * 33] * W8_SCALE); o.y = pk4_fp8(s[4 * 33] * W8_SCALE, s[5 * 33] * W8_SCALE, s[6 * 33] * W8_SCALE, s[7 * 33] * W8_SCALE);
        __builtin_nontemporal_store(o, (GAS v2u*)(m.dst + (size_t)n * m.K + 8 * c)); }
    LDS_WAIT(); asm volatile("" ::: "memory");
}
__device__ __forceinline__ void moe_fill_run(const Params& P, LAS unsigned char* lds, int first, int stride, int hi, int lane, int wave);
__device__ __forceinline__ void moe_filler(const Params& P, LAS unsigned char* lds, int lo, int hi, int lane, int wave, int wgi) {
    if (wgi < 128) return;
    moe_fill_run(P, lds, lo + (wgi - 128) * NWAVES + wave, 128 * NWAVES, hi, lane, wave);
}
__device__ __forceinline__ void moe_fill_run(const Params& P, LAS unsigned char* lds, int first, int stride, int hi, int lane, int wave) {
    LAS float* scr = (LAS float*)(lds + wave * 8448);
    int it = first; if (it >= hi) return;
    MoeItem cur = moe_item_decode(P, it, lane); f32x4 v[8]; moe_item_load(cur, v);
    for (;;) { const int nx = it + stride; const bool more = nx < hi;
        MoeItem nxt = cur; f32x4 vn[8];
        if (more) { nxt = moe_item_decode(P, nx, lane); moe_item_load(nxt, vn); }
        moe_item_finish(cur, v, scr, lane);
        if (!more) break;
        cur = nxt; it = nx;
#pragma unroll
        for (int i = 0; i < 8; ++i) v[i] = vn[i];
    }
}

__device__ __forceinline__ void phase0(const Params& P, LAS unsigned char* lds, int tid, int lane, int wave, int gw) {
    LAS float* cact = (LAS float*)(lds + 69632);
    { const float* c = P.in[1]; for (int i = tid; i < B_ * D; i += NTHR) { const float v = c[i]; cact[i] = v * sigm(v); } }
    __syncthreads();
    {
        const float* w_ada = P.in[2]; float* modp = (float*)(P.ws + WS_MODP);
        for (int it = gw; it < 1536; it += NGW) {
            const int ks = it & 7, jb = (it >> 3) % 96, l = it / 768;
            const float* wp = w_ada + ((size_t)l * D + ks * 128) * 6144 + jb * 64 + lane;
            float acc[8];
#pragma unroll
            for (int b = 0; b < 8; ++b) acc[b] = 0.f;
#pragma unroll 8
            for (int k = 0; k < 128; ++k) { const float w = wp[(size_t)k * 6144];
#pragma unroll
                for (int b = 0; b < 8; ++b) acc[b] += cact[b * D + ks * 128 + k] * w; }
#pragma unroll
            for (int b = 0; b < 8; ++b) modp[(((size_t)ks * 2 + l) * 8 + b) * 6144 + jb * 64 + lane] = acc[b];
        }
    }
    LAS float* scr = (LAS float*)(lds + wave * 8448);
    constexpr int I_WIN = 16 * 80, I_WOUT = 16 * 32, I_FG = 16 * 88, I_FD = 44 * 32, I_MG = 16 * 112, I_MD = 56 * 32;
    constexpr int NITEMS = 2 * I_WIN + 2 * I_WOUT + 2 * I_FG + I_FD + 16 * I_MG + 8 * I_MD; static_assert(16 * I_MG + 8 * I_MD == MOE_ITEMS, "item counts");
    for (int it = gw; it < NITEMS - MOE_ITEMS; it += NGW) {
        int r = it;
        if (r < 2 * I_WIN) { const int l = r / I_WIN, q = r % I_WIN; const int kb = q / 80, nb = q % 80;
            tr_item(P.in[6] + (size_t)l * D * DIN, D, DIN, (bf16*)(P.ws + WS_WIN) + (size_t)l * DIN * D, kb, nb, rowmap_win(32 * nb), scr, lane); continue; }
        r -= 2 * I_WIN;
        if (r < 2 * I_WOUT) { const int l = r / I_WOUT, q = r % I_WOUT; const int kb = q / 32, nb = q % 32;
            tr_item(P.in[7] + (size_t)l * D * D, D, D, (bf16*)(P.ws + WS_WOUT) + (size_t)l * D * D, kb, nb, 32 * nb, scr, lane); continue; }
        r -= 2 * I_WOUT;
        if (r < 2 * I_FG) { const int up = r / I_FG, q = r % I_FG; const int kb = q / 88, nb = q % 88;
            tr_item((up ? P.in[16] : P.in[15]), D, FFD, (bf16*)(P.ws + WS_WGU), kb, nb, rowmap_gu(32 * nb, up), scr, lane); continue; }
        r -= 2 * I_FG;
        { const int kb = r / 32, nb = r % 32; tr_item(P.in[17], FFD, D, (bf16*)(P.ws + WS_WD), kb, nb, 32 * nb, scr, lane); }
    }    moe_fill_run(P, lds, FILL_P0 + gw, NGW, MOE_ITEMS, lane, wave);
}

__device__ __forceinline__ void cvec_fill(const Params& P, LAS unsigned char* lds, int tid, int lane, int wave, int wgi) {
    if (wgi < 128) return;
    LAS float* shL = (LAS float*)lds;
    const float* mod = (const float*)(P.ws + WS_MOD);
    for (int i = tid; i < 2 * 8 * D; i += NTHR) { const int which = i >> 13, b = (i >> 10) & 7, k = i & 1023; shL[i] = which ? mod[((size_t)8 + b) * 6144 + k] : mod[(size_t)b * 6144 + 3072 + k]; }
    __syncthreads();
    const bf16* Wgu = (const bf16*)(P.ws + WS_WGU); const bf16* Win1 = (const bf16*)(P.ws + WS_WIN) + (size_t)DIN * D;
    float* cff = (float*)(P.ws + WS_CFF); float* cin = (float*)(P.ws + WS_CIN);
    for (int r = (wgi - 128) * NWAVES + wave; r < 2 * FFD + DIN; r += 128 * NWAVES) {
        const bool ff = r < 2 * FFD; const int n = ff ? r : r - 2 * FFD; const bf16* wr = (ff ? Wgu : Win1) + (size_t)n * D + 16 * lane;
        const v4u w0 = *(const GAS v4u*)wr, w1 = *(const GAS v4u*)(wr + 8); float wv[16];
#pragma unroll
        for (int j = 0; j < 4; ++j) { wv[2 * j] = __uint_as_float(w0[j] << 16); wv[2 * j + 1] = __uint_as_float(w0[j] & 0xffff0000u); wv[8 + 2 * j] = __uint_as_float(w1[j] << 16); wv[8 + 2 * j + 1] = __uint_as_float(w1[j] & 0xffff0000u); }
        const LAS float* sp = shL + (ff ? 0 : 8 * D) + 16 * lane; float mine = 0.f;
#pragma unroll
        for (int b = 0; b < 8; ++b) { float s = 0.f;
#pragma unroll
            for (int j = 0; j < 4; ++j) { const f32x4 s4 = *(const LAS f32x4*)(sp + b * D + 4 * j); s += (s4.x * wv[4 * j] + s4.y * wv[4 * j + 1]) + (s4.z * wv[4 * j + 2] + s4.w * wv[4 * j + 3]); }
            s = wave_sum(s); if (lane == b) mine = s; }
        if (lane < 8) (ff ? cff + (size_t)lane * (2 * FFD) : cin + (size_t)lane * DIN)[n] = mine;
    }
    __syncthreads();
}

__device__ __forceinline__ float modp_sum(const float* modp, const float* b_ada, int l, int b, int j) {
    float s = b_ada[l * 6144 + j];
#pragma unroll
    for (int ks = 0; ks < 8; ++ks) s += modp[(((size_t)ks * 2 + l) * 8 + b) * 6144 + j];
    return s;
}
template <bool INBF> __device__ __forceinline__ void row_load(const float* xrow, int lane, f32x4 (&h)[4]) {
    if constexpr (INBF) { const GAS v2u* xr = (const GAS v2u*)xrow + lane;
#pragma unroll
        for (int j = 0; j < 4; ++j) { const v2u q = xr[64 * j]; h[j] = (f32x4){__uint_as_float(q.x << 16), __uint_as_float(q.x & 0xffff0000u), __uint_as_float(q.y << 16), __uint_as_float(q.y & 0xffff0000u)}; } }
    else { const GAS f32x4* xr = (const GAS f32x4*)xrow + lane;
#pragma unroll
        for (int j = 0; j < 4; ++j) h[j] = xr[64 * j]; }
}
__device__ __forceinline__ void row_finish(const LAS float* gm, const LAS float* shv, int lane, f32x4 (&h)[4]) {
    float ss = 0.f;
#pragma unroll
    for (int j = 0; j < 4; ++j) ss += (h[j].x * h[j].x + h[j].y * h[j].y) + (h[j].z * h[j].z + h[j].w * h[j].w);
    const float r = __builtin_amdgcn_rsqf(wave_sum(ss) * (1.f / D) + EPS);
#pragma unroll
    for (int j = 0; j < 4; ++j) { const f32x4 g4 = *(const LAS f32x4*)(gm + 4 * lane + 256 * j), s4 = *(const LAS f32x4*)(shv + 4 * lane + 256 * j); h[j] = h[j] * r * g4 + s4; }
}
__device__ __forceinline__ void norm_row(const float* xrow, const LAS float* gm, const LAS float* shv, int lane, f32x4 (&h)[4]) { row_load<false>(xrow, lane, h); row_finish(gm, shv, lane, h); }
__device__ __forceinline__ void store_row_bf16(bf16* orow, int lane, const f32x4 (&h)[4]) {
    GAS v2u* o8 = (GAS v2u*)orow + lane;
#pragma unroll
    for (int j = 0; j < 4; ++j) { v2u w; w.x = pk2(h[j].x, h[j].y); w.y = pk2(h[j].z, h[j].w); o8[64 * j] = w; }
}
template <bool INBF> __device__ __forceinline__ void norm_phase(const Params& P, LAS unsigned char* lds, const float* xin, const float* gvec, int l, int sh_off, int sc_off, bool from_partials, int tid, int lane, int wave, int wgi) {
    LAS float* gm = (LAS float*)lds; LAS float* shv = (LAS float*)(lds + 4096);
    const float* modp = (const float*)(P.ws + WS_MODP); float* mod = (float*)(P.ws + WS_MOD); const float* b_ada = P.in[3];
    const int b = wgi >> 5;
    if (from_partials) {
        if (tid < 384) { const int idx = wgi * 384 + tid; const int ll = idx / 49152, rem = idx % 49152, bb = rem / 6144, j = rem % 6144; mod[idx] = modp_sum(modp, b_ada, ll, bb, j); }
        for (int c = tid; c < D; c += NTHR) { gm[c] = gvec[c] * (1.f + modp_sum(modp, b_ada, l, b, sc_off + c)); shv[c] = modp_sum(modp, b_ada, l, b, sh_off + c); }
    } else {
        const float* ml = mod + ((size_t)l * 8 + b) * 6144;
        for (int c = tid; c < D; c += NTHR) { gm[c] = gvec[c] * (1.f + ml[sc_off + c]); shv[c] = ml[sh_off + c]; }
    }
    __syncthreads();
    bf16* H = (bf16*)(P.ws + WS_H);
    constexpr int RS = INBF ? D / 2 : D;
    for (int i = 0; i < 8; i += 4) { const int row = wgi * 64 + wave * 8 + i; f32x4 h[4][4];
#pragma unroll
        for (int q = 0; q < 4; ++q) row_load<INBF>(xin + (size_t)(row + q) * RS, lane, h[q]);
#pragma unroll
        for (int q = 0; q < 4; ++q) { row_finish(gm, shv, lane, h[q]); store_row_bf16(H + (size_t)(row + q) * D, lane, h[q]); } }
    __syncthreads();
}
__device__ __forceinline__ void router_phase(const Params& P, LAS unsigned char* lds, const float* xin, int tid, int lane, int wave, int wgi) {
    LAS float* gm = (LAS float*)lds; LAS float* shv = (LAS float*)(lds + 4096); LAS float* wrT = (LAS float*)(lds + 8192);
    LAS int* pe = (LAS int*)(lds + 40960); LAS float* pw = (LAS float*)(lds + 41472); LAS int* cw = (LAS int*)(lds + 41984); LAS int* baseL = (LAS int*)(lds + 42048);
    const float* mod = (const float*)(P.ws + WS_MOD); const int b = wgi >> 5; const float* ml = mod + ((size_t)1 * 8 + b) * 6144; const float* gvec = P.in[5] + D;
    for (int c = tid; c < D; c += NTHR) { gm[c] = gvec[c] * (1.f + ml[4096 + c]); shv[c] = ml[3072 + c]; }
    { const float* wr = P.in[18]; for (int i = tid; i < D * NE; i += NTHR) { const int c = i >> 3, e = i & 7; wrT[e * D + c] = wr[i]; } }
    __syncthreads();
#if defined(TSDBG)
    if (wgi == 0 && tid == 0) ((unsigned long long*)(P.ws + WS_CTL) + 16384)[100] = __builtin_amdgcn_s_memrealtime();
#endif
    const float* br = P.in[19];
    f32x4 hq[3][4];
    row_load<false>(xin + (size_t)(wgi * 64 + wave * 8) * D, lane, hq[0]); row_load<false>(xin + (size_t)(wgi * 64 + wave * 8 + 1) * D, lane, hq[1]);
#pragma unroll
    for (int i = 0; i < 8; ++i) { const int rl = wave * 8 + i, row = wgi * 64 + rl; f32x4 h[4];
        if (i < 6) row_load<false>(xin + (size_t)(row + 2) * D, lane, hq[(i + 2) % 3]);
#pragma unroll
        for (int j = 0; j < 4; ++j) h[j] = hq[i % 3][j];
        row_finish(gm, shv, lane, h);
        float lg[8];
#pragma unroll
        for (int e = 0; e < 8; ++e) { float s = 0.f;
#pragma unroll
            for (int j = 0; j < 4; ++j) { const f32x4 w4 = *(const LAS f32x4*)(wrT + e * D + 4 * lane + 256 * j); s += (h[j].x * w4.x + h[j].y * w4.y) + (h[j].z * w4.z + h[j].w * w4.w); }
            lg[e] = s; }
        {
            float w4[4], u2[2];
#pragma unroll
            for (int i = 0; i < 4; ++i) { const bool hi1 = lane & 1; const float keep = hi1 ? lg[2 * i + 1] : lg[2 * i], send = hi1 ? lg[2 * i] : lg[2 * i + 1]; w4[i] = keep + __shfl_xor(send, 1); }
#pragma unroll
            for (int i = 0; i < 2; ++i) { const bool hi2 = lane & 2; const float keep = hi2 ? w4[2 * i + 1] : w4[2 * i], send = hi2 ? w4[2 * i] : w4[2 * i + 1]; u2[i] = keep + __shfl_xor(send, 2); }
            const bool hi4 = lane & 4; float z = (hi4 ? u2[1] : u2[0]) + __shfl_xor(hi4 ? u2[0] : u2[1], 4);
            z += __shfl_xor(z, 8); z += __shfl_xor(z, 16); z += __shfl_xor(z, 32);
#pragma unroll
            for (int e = 0; e < 8; ++e) lg[e] = __uint_as_float((unsigned)__builtin_amdgcn_readlane((int)__float_as_uint(z), e)) + br[e];
        }
        int e1 = 0; float v1 = lg[0];
#pragma unroll
        for (int e = 1; e < 8; ++e) if (lg[e] > v1) { v1 = lg[e]; e1 = e; }
        int e2 = -1; float v2 = -3.0e38f;
#pragma unroll
        for (int e = 0; e < 8; ++e) if (e != e1 && lg[e] > v2) { v2 = lg[e]; e2 = e; }
        const float p2 = __expf(v2 - v1), inv = 1.f / (1.f + p2);
        if (lane == 0) { pe[2 * rl] = e1; pe[2 * rl + 1] = e2; pw[2 * rl] = inv; pw[2 * rl + 1] = p2 * inv; }
        { LAS unsigned* r4 = (LAS unsigned*)(lds + 65536 + rl * 1024) + lane;
#pragma unroll
          for (int j = 0; j < 4; ++j) r4[64 * j] = pk4_fp8(h[j].x * H8_SCALE, h[j].y * H8_SCALE, h[j].z * H8_SCALE, h[j].w * H8_SCALE); } }
    __syncthreads();
#if defined(TSDBG)
    if (wgi == 0 && tid == 0) ((unsigned long long*)(P.ws + WS_CTL) + 16384)[101] = __builtin_amdgcn_s_memrealtime();
#endif
    int e = 0, rank = 0;
    if (tid < 128) { e = pe[tid];
#pragma unroll
        for (int ee = 0; ee < 8; ++ee) { const unsigned long long mk = __ballot(e == ee); if (e == ee) rank = __popcll(mk & ((1ull << lane) - 1ull)); if (lane == 0) cw[wave * 8 + ee] = __popcll(mk); } }
    __syncthreads();
    if (tid < 8) { const int tot = cw[tid] + cw[8 + tid]; unsigned* cnt = (unsigned*)(P.ws + WS_CTL) + CW_CNT + 64 * tid;
        baseL[tid] = (int)__hip_atomic_fetch_add(cnt, (unsigned)tot, __ATOMIC_RELAXED, __HIP_MEMORY_SCOPE_AGENT); }
    __syncthreads();
    if (tid < 128) { const int slot = baseL[e] + rank + (wave == 1 ? cw[e] : 0); const int token = wgi * 64 + (tid >> 1);
        ((float*)(P.ws + WS_WL))[e * M + slot] = pw[tid]; ((int*)(P.ws + WS_PAIR))[token * 2 + (tid & 1)] = e * M + slot; pe[tid] = e * M + slot; }
    __syncthreads();
#if defined(TSDBG)
    if (wgi == 0 && tid == 0) ((unsigned long long*)(P.ws + WS_CTL) + 16384)[102] = __builtin_amdgcn_s_memrealtime();
#endif
    for (int i = 0; i < 16; ++i) { const int p = wave * 16 + i; const int dst = pe[p];
        const v4u v = *(const LAS v4u*)(lds + 65536 + (p >> 1) * 1024 + lane * 16); *(GAS v4u*)(P.ws + WS_HG + (size_t)dst * D + lane * 16) = v; }
    __syncthreads();
}
__device__ __forceinline__ void moe_tables(const Params& P, LAS unsigned char* lds, int tid) {
    LAS int* tab = (LAS int*)(lds + MOETAB_OFF);
    if (tid == 0) { const unsigned* ctl = (const unsigned*)(P.ws + WS_CTL); int rb = 0;
        for (int e = 0; e < 8; ++e) { int c = (int)__hip_atomic_load(ctl + CW_CNT + 64 * e, __ATOMIC_RELAXED, __HIP_MEMORY_SCOPE_AGENT); c = c < 0 ? 0 : (c > M ? M : c); tab[e] = rb; tab[9 + e] = c; rb += (c + 255) & ~255; }
        tab[8] = rb; }
    __syncthreads();
}
__device__ __forceinline__ void gather_phase(const Params& P, LAS unsigned char* lds, const float* xin, int tid, int lane, int wave, int gw) {
    LAS float* gmA = (LAS float*)lds; LAS float* shA = (LAS float*)(lds + 32768); const LAS int* tab = (const LAS int*)(lds + MOETAB_OFF);
    const float* mod1 = (const float*)(P.ws + WS_MOD) + (size_t)8 * 6144; const float* gvec = P.in[5] + D;
    for (int i = tid; i < 8 * D; i += NTHR) { const int b = i >> 10, c = i & 1023; gmA[i] = gvec[c] * (1.f + mod1[b * 6144 + 4096 + c]); shA[i] = mod1[b * 6144 + 3072 + c]; }
    __syncthreads();
    const int ptot = tab[8]; const int* list = (const int*)(P.ws + WS_LIST); const float* wl = (const float*)(P.ws + WS_WL); float* wlg = (float*)(P.ws + WS_WLG); unsigned char* HG = (unsigned char*)(P.ws + WS_HG);
    for (int p = gw; p < ptot; p += NGW) {
        int e = 0;
#pragma unroll
        for (int k = 1; k < 8; ++k) e += (p >= tab[k]);
        const int slot = p - tab[e], cn = tab[9 + e]; const bool valid = slot < cn; const int token = list[e * M + (valid ? slot : cn - 1)]; const int b = token >> 11;
        f32x4 h[4]; norm_row(xin + (size_t)token * D, gmA + b * D, shA + b * D, lane, h);
        { GAS unsigned* o4 = (GAS unsigned*)(HG + (size_t)p * D) + lane;
#pragma unroll
          for (int j = 0; j < 4; ++j) o4[64 * j] = pk4_fp8(h[j].x * H8_SCALE, h[j].y * H8_SCALE, h[j].z * H8_SCALE, h[j].w * H8_SCALE); }
        if (lane == 0) wlg[p] = valid ? wl[e * M + slot] : 0.f;
    }
    __syncthreads();
}
__device__ __forceinline__ void combine_phase(const Params& P, LAS unsigned char* lds, int lane, int gw) {
    const LAS int* tab = (const LAS int*)(lds + MOETAB_OFF); const int* pair = (const int*)(P.ws + WS_PAIR); const bf16* F = (const bf16*)(P.ws + WS_F);
    const float* mod1 = (const float*)(P.ws + WS_MOD) + (size_t)8 * 6144;
    for (int t = gw; t < M; t += NGW) {
        const int pa = pair[2 * t], pb = pair[2 * t + 1]; const int ra = tab[pa >> 14] + (pa & 16383), rb = tab[pb >> 14] + (pb & 16383); const int b = t >> 11;
        const bf16* FP = (const bf16*)(P.ws + WS_FP);
        f32x4 fs[4];
#pragma unroll
        for (int j = 0; j < 4; ++j) fs[j] = (f32x4){0.f, 0.f, 0.f, 0.f};
#pragma unroll
        for (int side = 0; side < 2; ++side) { const int r = side ? rb : ra;
            if (r < 32768) { const GAS v2u* fp = (const GAS v2u*)(F + (size_t)r * D) + lane;
#pragma unroll
                for (int j = 0; j < 4; ++j) { const v2u a = fp[64 * j]; fs[j] = fs[j] + (f32x4){__uint_as_float(a.x << 16), __uint_as_float(a.x & 0xffff0000u), __uint_as_float(a.y << 16), __uint_as_float(a.y & 0xffff0000u)}; } }
            else for (int ks = 0; ks < 7; ++ks) { const GAS v2u* fp = (const GAS v2u*)(FP + ((size_t)ks * 2048 + (r - 32768)) * D) + lane;
#pragma unroll
                for (int j = 0; j < 4; ++j) { const v2u a = fp[64 * j]; fs[j] = fs[j] + (f32x4){__uint_as_float(a.x << 16), __uint_as_float(a.x & 0xffff0000u), __uint_as_float(a.y << 16), __uint_as_float(a.y & 0xffff0000u)}; } } }
        GAS f32x4* xo = (GAS f32x4*)(P.out + (size_t)t * D) + lane; const GAS f32x4* g2 = (const GAS f32x4*)(mod1 + b * 6144 + 5120) + lane;
#pragma unroll
        for (int j = 0; j < 4; ++j) xo[64 * j] = xo[64 * j] + g2[64 * j] * fs[j];
    }
}

__device__ __forceinline__ void conv_stage(const bf16* Z, LAS unsigned char* zt, int unit, int tid) {
    const int tok0 = unit * 32, tp0 = tok0 & (S_ - 1);
#pragma unroll
    for (int i = 0; i < 8; ++i) { const int idx = i * NTHR + tid;
        if (idx < 62 * 64) { const int row = idx >> 6, pc = idx & 63; const bool ok = tp0 + row - 30 >= 0;
            v4u v = *(const GAS v4u*)(Z + (size_t)(tok0 + (ok ? row - 30 : -tp0)) * DC + pc * 8); if (!ok) v = (v4u){0u, 0u, 0u, 0u};
            *(LAS v4u*)(zt + idx * 16) = v; } }
}
__device__ __forceinline__ void conv_unit(const LAS unsigned char* zt, const float (&w)[CW], float bias, bf16* YC, const float* lg, const float* lb, LAS float* tile, int unit, int tid, int wave, int lane) {
    const int tok0 = unit * 32, c = tid;
    const LAS bf16* zc = (const LAS bf16*)zt + c;
#pragma unroll
    for (int half = 0; half < 2; ++half) {
        float in[46];
#pragma unroll
        for (int i = 0; i < 46; ++i) in[i] = bf2f(zc[(16 * half + i) * DC]);
#pragma unroll
        for (int q = 0; q < 16; ++q) { float a = bias;
#pragma unroll
            for (int j = 0; j < CW; ++j) a += w[j] * in[q + j];
            tile[(16 * half + q) * DC + c] = a; }
    }
    __syncthreads();
    const f32x4 g0 = *(const f32x4*)(lg + lane * 8), g1 = *(const f32x4*)(lg + lane * 8 + 4), b0 = *(const f32x4*)(lb + lane * 8), b1 = *(const f32x4*)(lb + lane * 8 + 4);
#pragma unroll
    for (int tt = 0; tt < 4; ++tt) { const int t = wave * 4 + tt;
        f32x4 v0 = *(const LAS f32x4*)(tile + t * DC + lane * 8), v1 = *(const LAS f32x4*)(tile + t * DC + lane * 8 + 4);
        const float mean = wave_sum((v0.x + v0.y) + (v0.z + v0.w) + (v1.x + v1.y) + (v1.z + v1.w)) * (1.f / DC);
        v0 = v0 - mean; v1 = v1 - mean;
        const float var = wave_sum((v0.x * v0.x + v0.y * v0.y) + (v0.z * v0.z + v0.w * v0.w) + (v1.x * v1.x + v1.y * v1.y) + (v1.z * v1.z + v1.w * v1.w)) * (1.f / DC);
        const float rstd = __builtin_amdgcn_rsqf(var + EPS);
        f32x4 y0 = v0 * rstd * g0 + b0, y1 = v1 * rstd * g1 + b1;
#pragma unroll
        for (int i = 0; i < 4; ++i) { y0[i] = y0[i] * sigm(y0[i]); y1[i] = y1[i] * sigm(y1[i]); }
        v4u o; o.x = pk2(y0.x, y0.y); o.y = pk2(y0.z, y0.w); o.z = pk2(y1.x, y1.y); o.w = pk2(y1.z, y1.w);
        *(GAS v4u*)(YC + (size_t)(tok0 + t) * D + lane * 8) = o; }
    __syncthreads();
}
__device__ __forceinline__ int crow(int r, int hi) { return (r & 3) + 8 * (r >> 2) + 4 * hi; }
#define MFMA32(a, b, c) __builtin_amdgcn_mfma_f32_32x32x16_bf16((a), (b), (c), 0, 0, 0)
__device__ __forceinline__ void attn_stage(const LAS unsigned char* stage, int kc0, int n, int qh, int r32, int hi, int lane, const LAS float* btile, const bf16x8 (&qf)[4], const f32x16& cinit, f32x16& o0, f32x16& o1, float& l) {
    const int fsw = (r32 >> 1) & 7;
#pragma unroll
    for (int sub = 0; sub < 2; ++sub) {
        const int kc = kc0 + sub; const LAS unsigned char* buf = stage + sub * 16384;
        if (kc >= n - 8 && kc <= n) {
            bf16x8 kf[2][4], vf[2][2][2]; f32x16 sc[2];
#pragma unroll
            for (int kb = 0; kb < 2; ++kb)
#pragma unroll
                for (int d0 = 0; d0 < 4; ++d0) kf[kb][d0] = *(const LAS bf16x8*)(buf + (kb * 32 + r32) * 128 + (((2 * d0 + hi) ^ fsw) << 4));
            if (n - kc >= 3) { sc[0] = cinit; sc[1] = cinit; }
            else {
#pragma unroll
                for (int kb = 0; kb < 2; ++kb) { const LAS f32x4* tp = (const LAS f32x4*)(btile + ((qh * 6 + (n - kc) * 2 + kb) * 4) * 256) + lane;
#pragma unroll
                    for (int q4 = 0; q4 < 4; ++q4) { const f32x4 t4 = tp[q4 * 64]; sc[kb][4 * q4] = t4.x; sc[kb][4 * q4 + 1] = t4.y; sc[kb][4 * q4 + 2] = t4.z; sc[kb][4 * q4 + 3] = t4.w; } } }
#pragma unroll
            for (int kb = 0; kb < 2; ++kb)
#pragma unroll
                for (int db = 0; db < 2; ++db)
#pragma unroll
                    for (int s2 = 0; s2 < 2; ++s2) vf[kb][db][s2] = *(const LAS bf16x8*)(buf + 8192 + (db * 32 + r32) * 128 + (((kb * 4 + 2 * s2 + hi) ^ fsw) << 4));
#pragma unroll
            for (int d0 = 0; d0 < 4; ++d0) { sc[0] = MFMA32(kf[0][d0], qf[d0], sc[0]); sc[1] = MFMA32(kf[1][d0], qf[d0], sc[1]); }
            float ps0 = 0.f, ps1 = 0.f;
#pragma unroll
            for (int r = 0; r < 16; ++r) { sc[0][r] = __builtin_amdgcn_exp2f(sc[0][r]); ps0 += sc[0][r]; }
#pragma unroll
            for (int r = 0; r < 16; ++r) { sc[1][r] = __builtin_amdgcn_exp2f(sc[1][r]); ps1 += sc[1][r]; }
            l += ps0 + ps1;
            bf16x8 pb[2][2];
#pragma unroll
            for (int kb = 0; kb < 2; ++kb) { v4u p0, p1;
                p0.x = pk2(sc[kb][0], sc[kb][1]); p0.y = pk2(sc[kb][2], sc[kb][3]); p0.z = pk2(sc[kb][4], sc[kb][5]); p0.w = pk2(sc[kb][6], sc[kb][7]);
                p1.x = pk2(sc[kb][8], sc[kb][9]); p1.y = pk2(sc[kb][10], sc[kb][11]); p1.z = pk2(sc[kb][12], sc[kb][13]); p1.w = pk2(sc[kb][14], sc[kb][15]);
                pb[kb][0] = __builtin_bit_cast(bf16x8, p0); pb[kb][1] = __builtin_bit_cast(bf16x8, p1); }
#pragma unroll
            for (int kb = 0; kb < 2; ++kb)
#pragma unroll
                for (int s2 = 0; s2 < 2; ++s2) { o0 = MFMA32(vf[kb][0][s2], pb[kb][s2], o0); o1 = MFMA32(vf[kb][1][s2], pb[kb][s2], o1); }
        }
    }
}
__device__ __forceinline__ void attn_unit(const bf16* Q, const bf16* K, const bf16* VT, bf16* YC, const LAS float* btile, float c0, LAS unsigned char* kv, int b, int h, int g, int tid, int wave, int lane) {
    const int r32 = lane & 31, hi = lane >> 5;
    const int n0 = 4 * g, n = n0 + (wave >> 1), qh = wave & 1;
    const size_t rowq = (size_t)b * S_ + n * 64 + qh * 32 + r32;
    bf16x8 qf[4];
#pragma unroll
    for (int d0 = 0; d0 < 4; ++d0) qf[d0] = *(const GAS bf16x8*)(Q + rowq * DC + h * 64 + d0 * 16 + hi * 8);
    float l = 0.f; f32x16 o0, o1, cinit;
#pragma unroll
    for (int r = 0; r < 16; ++r) { o0[r] = 0.f; o1[r] = 0.f; cinit[r] = c0; }
    const int kc_lo = n0 - 8 < 0 ? 0 : n0 - 8, nt = (n0 + 4 - kc_lo) >> 1;
    const int lrow = tid >> 3, lc = tid & 7, lsw = (lrow >> 1) & 7; const int kofs = lrow * 128 + ((lc ^ lsw) << 4);
    const int vofs0 = lrow * 128 + ((((lc & 6) | 0) ^ lsw) << 4) + (lc & 1) * 8, vofs1 = lrow * 128 + ((((lc & 6) | 1) ^ lsw) << 4) + (lc & 1) * 8;
    const bf16* kg = K + ((size_t)b * S_ + lrow) * DC + h * 64 + lc * 8 + (size_t)kc_lo * 64 * DC;
    const bf16* vg = VT + (size_t)(h * 64 + lrow) * M + (size_t)b * S_ + lc * 8 + kc_lo * 64;
#define ATT_GET(t, R) do { R[0] = *(const GAS v4u*)(kg + (size_t)(2 * (t)) * 64 * DC); R[1] = *(const GAS v4u*)(vg + (2 * (t)) * 64); R[2] = *(const GAS v4u*)(kg + (size_t)(2 * (t) + 1) * 64 * DC); R[3] = *(const GAS v4u*)(vg + (2 * (t) + 1) * 64); } while (0)
#define ATT_PUT(base, R) do { *(LAS v4u*)((base) + kofs) = R[0]; *(LAS v2u*)((base) + 8192 + vofs0) = (v2u){R[1].x, R[1].y}; *(LAS v2u*)((base) + 8192 + vofs1) = (v2u){R[1].z, R[1].w}; \
        *(LAS v4u*)((base) + 16384 + kofs) = R[2]; *(LAS v2u*)((base) + 24576 + vofs0) = (v2u){R[3].x, R[3].y}; *(LAS v2u*)((base) + 24576 + vofs1) = (v2u){R[3].z, R[3].w}; } while (0)
    v4u RA[4], RB[4];
    ATT_GET(0, RA); ATT_GET(1, RB);
    ATT_PUT(kv, RA);
    __syncthreads();
    asm volatile("" : "+v"(qf[0]), "+v"(qf[1]), "+v"(qf[2]), "+v"(qf[3]));
    for (int t = 0; t < nt; t += 2) {
        { const int tg = t + 2 < nt ? t + 2 : nt - 1; ATT_GET(tg, RA); }
        attn_stage(kv, kc_lo + 2 * t, n, qh, r32, hi, lane, btile, qf, cinit, o0, o1, l);
        ATT_PUT(kv + 32768, RB);
        __syncthreads();
        { const int tg = t + 3 < nt ? t + 3 : nt - 1; ATT_GET(tg, RB); }
        attn_stage(kv + 32768, kc_lo + 2 * t + 2, n, qh, r32, hi, lane, btile, qf, cinit, o0, o1, l);
        if (t + 2 < nt) ATT_PUT(kv, RA);
        __syncthreads();
    }
#undef ATT_PUT
#undef ATT_GET
    l += __shfl_xor(l, 32); const float il = 1.f / l;
    bf16* yp = YC + rowq * D + DC + h * 64 + 4 * hi;
#pragma unroll
    for (int gq = 0; gq < 4; ++gq) { v2u w0, w1; w0.x = pk2(o0[4 * gq] * il, o0[4 * gq + 1] * il); w0.y = pk2(o0[4 * gq + 2] * il, o0[4 * gq + 3] * il);
        w1.x = pk2(o1[4 * gq] * il, o1[4 * gq + 1] * il); w1.y = pk2(o1[4 * gq + 2] * il, o1[4 * gq + 3] * il);
        *(GAS v2u*)(yp + 8 * gq) = w0; *(GAS v2u*)(yp + 32 + 8 * gq) = w1; }
}
__device__ __forceinline__ void mixer_phase(const Params& P, LAS unsigned char* lds, int l, int tid, int lane, int wave, int wgi) {
#if defined(TSDBG)
    if (wgi == 0 && tid == 0) ((unsigned long long*)(P.ws + WS_CTL) + 16384)[40 + 4 * l] = __builtin_amdgcn_s_memrealtime();
#endif
    LAS unsigned char* zt = lds; LAS float* tile = (LAS float*)(lds + 63488); LAS float* biasL = (LAS float*)(lds + LDSCTL_OFF + 1024); LAS unsigned char* kv = lds + 49152;
    { const float* rb = P.in[14] + l * 8 * NREL; for (int i = tid; i < 8 * NREL; i += NTHR) biasL[i] = rb[i] * LOG2E; }
    __syncthreads();
    const bf16* Z = (const bf16*)(P.ws + WS_Z); const bf16* Q = (const bf16*)(P.ws + WS_Q); const bf16* K = (const bf16*)(P.ws + WS_K); const bf16* VT = (const bf16*)(P.ws + WS_VT); bf16* YC = (bf16*)(P.ws + WS_YC);
    {   float w[CW]; const float* cw = P.in[8] + l * CW * DC;
#pragma unroll
        for (int j = 0; j < CW; ++j) w[j] = cw[j * DC + tid];
        const float cbias = P.in[9][l * DC + tid];
        for (int cu = 0; cu < 2; ++cu) { conv_stage(Z, zt, wgi * 2 + cu, tid); __syncthreads();
            conv_unit(zt, w, cbias, YC, P.in[10] + l * DC, P.in[11] + l * DC, tile, wgi * 2 + cu, tid, wave, lane); } }
#if defined(TSDBG)
    if (wgi == 0 && tid == 0) ((unsigned long long*)(P.ws + WS_CTL) + 16384)[40 + 4 * l + 1] = __builtin_amdgcn_s_memrealtime();
#endif
#if defined(TSDBG)
    if (tid == 0) atomicMax((unsigned long long*)(P.ws + WS_CTL) + 16384 + 74 + l, (unsigned long long)__builtin_amdgcn_s_memrealtime());
#endif
    { const int b = wgi >> 5, h = (wgi >> 2) & 7, gp = wgi & 3;
      LAS float* btl = (LAS float*)lds;
      float Bref; { LAS float* red = (LAS float*)(lds + 49152);
          float gq = 0.f, gk = 0.f, bm = 0.f;
          if (tid < 64) { gq = fabsf(P.in[12][l * 64 + tid]); gk = fabsf(P.in[13][l * 64 + tid]); }
          if (tid < NREL) bm = fabsf(biasL[h * NREL + tid]);
#pragma unroll
          for (int o = 1; o < 64; o <<= 1) { gq = fmaxf(gq, __shfl_xor(gq, o)); gk = fmaxf(gk, __shfl_xor(gk, o)); bm = fmaxf(bm, __shfl_xor(bm, o)); }
          if (lane == 0) { red[wave] = gq; red[8 + wave] = gk; red[16 + wave] = bm; }
          __syncthreads();
          gq = red[0]; gk = red[8]; bm = fmaxf(fmaxf(fmaxf(red[16], red[17]), fmaxf(red[18], red[19])), red[20]);
          Bref = 1.02f * (LOG2E * 8.f * gq * gk + bm); }
#pragma unroll
      for (int k = 0; k < 24; ++k) { const int i = tid + NTHR * k; const int jbq = k >> 1, qh = jbq / 6, jb = jbq % 6;
          const int ln = (i >> 2) & 63, r = ((i >> 8) & 3) * 4 + (i & 3);
          int rel = -64 * (jb >> 1) + 32 * (jb & 1) - 32 * qh + crow(r, ln >> 5) - (ln & 31); rel = rel < -128 ? -128 : (rel > 128 ? 128 : rel); btl[i] = biasL[h * NREL + rel + 128] - Bref; }
      const float b0 = biasL[h * NREL] - Bref;
      __syncthreads();
      for (int rp = 0; rp < 1 + ((REPMASK >> 21) & 1); ++rp)
#if defined(TSDBG)
      if ((wgi == 0 || wgi == 3) && tid == 0) ((unsigned long long*)(P.ws + WS_CTL) + 16384)[60 + 8 * l + (wgi ? 4 : 0)] = __builtin_amdgcn_s_memrealtime();
#endif
#if defined(TSDBG)
      const unsigned long long att_t0 = __builtin_amdgcn_s_memrealtime();
#endif
      for (int au = 0; au < 2; ++au) attn_unit(Q, K, VT, YC, btl, b0, kv, b, h, au ? 7 - gp : gp, tid, wave, lane);
      __syncthreads();
#if defined(TSDBG)
      if ((wgi == 0 || wgi == 3) && tid == 0) ((unsigned long long*)(P.ws + WS_CTL) + 16384)[61 + 8 * l + (wgi ? 4 : 0)] = __builtin_amdgcn_s_memrealtime();
#endif
#if defined(TSDBG)
      if (tid == 0) { const unsigned long long dt = __builtin_amdgcn_s_memrealtime() - att_t0; atomicMax((unsigned long long*)(P.ws + WS_CTL) + 16384 + 80 + 4 * l + gp, dt); }
#endif
      const int mlo = FILL_S2 + l * FILL_MIX;
      if constexpr (FILL_MIX > 0) {
      if (gp == 0) moe_fill_run(P, lds, mlo + (wgi >> 2) * NWAVES + wave, 64 * NWAVES, mlo + (FILL_MIX * 3) / 4, lane, wave);
      else if (gp == 1) moe_fill_run(P, lds, mlo + (FILL_MIX * 3) / 4 + (wgi >> 2) * NWAVES + wave, 64 * NWAVES, mlo + FILL_MIX, lane, wave); } }
    __syncthreads();
#if defined(TSDBG)
    if (wgi == 0 && tid == 0) ((unsigned long long*)(P.ws + WS_CTL) + 16384)[40 + 4 * l + 2] = __builtin_amdgcn_s_memrealtime();
    if (tid == 0) atomicMax((unsigned long long*)(P.ws + WS_CTL) + 16384 + 70 + l, (unsigned long long)__builtin_amdgcn_s_memrealtime());
#endif
}

#define PHASE(k, ...) do { { __VA_ARGS__ } if constexpr ((REPMASK >> (k)) & 1) { xcd_barrier(bar); RETID(); { __VA_ARGS__ } } } while (0)
__global__ void __launch_bounds__(NTHR, 2) fwd(Params P) {
    extern __shared__ __attribute__((aligned(16))) unsigned char lds_raw[];
    LAS unsigned char* lds = (LAS unsigned char*)lds_raw;
    int tid = threadIdx.x, lane = tid & 63, wave = __builtin_amdgcn_readfirstlane(tid >> 6); const int wgi = blockIdx.x; int gw = wgi * NWAVES + wave;
#define RETID() do { tid = threadIdx.x; asm volatile("" : "+v"(tid)); lane = tid & 63; wave = __builtin_amdgcn_readfirstlane(tid >> 6); gw = wgi * NWAVES + wave; } while (0)
    for (int u = tid; u < (LDS_BYTES - LDSCTL_OFF) / 4; u += NTHR) ((LAS unsigned*)(lds + LDSCTL_OFF))[u] = 0u;
    __syncthreads();
    unsigned* ctl = (unsigned*)(P.ws + WS_CTL);
    XcdBarrier bar = xcd_barrier_post(ctl + CW_BAR, (volatile LAS unsigned*)(lds + MISC_OFF) + 8);
    const int stop = P.stop;
#if defined(TSDBG)
    unsigned long long* tsbuf = (unsigned long long*)(P.ws + WS_CTL) + 16384;
    int tsn = 0;
#define STAMP() do { if (wgi == 0 && tid == 0) tsbuf[tsn] = __builtin_amdgcn_s_memrealtime(); ++tsn; } while (0)
#else
#define STAMP() do {} while (0)
#endif
    STAMP();
#define SEAM(k) do { if (stop == (k)) return; xcd_barrier(bar); RETID(); STAMP(); } while (0)
    bf16* H = (bf16*)(P.ws + WS_H); float* mod = (float*)(P.ws + WS_MOD); const float* XB = (const float*)(P.ws + WS_XB);

    PHASE(0, phase0(P, lds, tid, lane, wave, gw););                                                      SEAM(0);
    PHASE(1, norm_phase<false>(P, lds, P.in[0], P.in[4], 0, 0, 1024, true, tid, lane, wave, wgi););             SEAM(1);
#define LAYER_COMMON(l, pb, xin) \
    PHASE(2,   \
        const bf16* Wl = (const bf16*)(P.ws + WS_WIN) + (size_t)(l) * DIN * D; \
        { pg8::Gemm g{H, Wl, M, 2048, D, 0}; pg8::StaticOrder S; S.init(M, 2048, GRID, wgi); \
          pg8::EpiInProj<FUSE_NORM && (l) != 0> E{(bf16*)(P.ws + WS_Z), (bf16*)(P.ws + WS_Q), (bf16*)(P.ws + WS_K), P.in[12] + (l) * 64, P.in[13] + (l) * 64, QSCALE, (const float*)(P.ws + WS_SS2), (const float*)(P.ws + WS_CIN)}; \
          pg8::gemm_phase<pg8::EpiInProj<FUSE_NORM && (l) != 0>, pg8::StaticOrder, true, true>(lds, g, S, E); } \
        { pg8::Gemm g{Wl + (size_t)2048 * D, H, 512, M, D, 0}; pg8::StaticOrder S; S.init(512, M, GRID, wgi); \
          pg8::EpiBf16<FUSE_NORM && (l) != 0> E{(bf16*)(P.ws + WS_VT), M, 1.f, 0, (const float*)(P.ws + WS_SS2), (const float*)(P.ws + WS_CIN) + 2048}; \
          pg8::gemm_phase<pg8::EpiBf16<FUSE_NORM && (l) != 0>, pg8::StaticOrder, true, true>(lds, g, S, E); } \
        if (FUSE_NORM && (l) == 0) cvec_fill(P, lds, tid, lane, wave, wgi); \
        moe_filler(P, lds, (l) == 0 ? 0 : FILL_S1, (l) == 0 ? FILL_S0 : FILL_S2, lane, wave, wgi); ); \
    SEAM(pb); \
    PHASE(3, mixer_phase(P, lds, (l), tid, lane, wave, wgi);); \
    SEAM((pb) + 1); \
    PHASE(4 + 10 * (l),   \
        pg8::Gemm g{(const bf16*)(P.ws + WS_YC), (const bf16*)(P.ws + WS_WOUT) + (size_t)(l) * D * D, M, D, D, 0}; pg8::StaticOrder S; S.init(M, D, GRID, wgi); \
        pg8::EpiResGate<FUSE_NORM && (l) == 0, (l) != 0, (l) == 0> E{(l) == 0 ? P.in[0] : XB, (l) == 0 ? (float*)XB : P.out, mod + (size_t)(l) * 8 * 6144 + 2048, H, (float*)(P.ws + WS_SS1), P.in[5], mod + 4096};   \
        pg8::gemm_phase<pg8::EpiResGate<FUSE_NORM && (l) == 0, (l) != 0, (l) == 0>, pg8::StaticOrder, true, true>(lds, g, S, E); ); \
    SEAM((pb) + 2);

    LAYER_COMMON(0, 2, P.in[0])
    if constexpr (!FUSE_NORM) { PHASE(5, norm_phase<true>(P, lds, XB, P.in[5], 0, 3072, 4096, false, tid, lane, wave, wgi);); SEAM(5); }
    PHASE(6, pg8::Gemm g{H, (const bf16*)(P.ws + WS_WGU), M, 2 * FFD, D, 0}; pg8::StaticOrder S; S.init(M, 2 * FFD, GRID, wgi);
             pg8::EpiSwiGLU<false, FUSE_NORM != 0> E{(bf16*)(P.ws + WS_ACT), FFD, nullptr, 1.f, 1.f, (const float*)(P.ws + WS_SS1), (const float*)(P.ws + WS_CFF), 2 * FFD};
             pg8::gemm_phase<pg8::EpiSwiGLU<false, FUSE_NORM != 0>, pg8::StaticOrder, true, true>(lds, g, S, E);
             moe_filler(P, lds, FILL_S0, FILL_S1, lane, wave, wgi););
    SEAM(6);
    PHASE(30, pg8::Gemm g{(const bf16*)(P.ws + WS_ACT), (const bf16*)(P.ws + WS_WD), M, D, FFD, 0}; pg8::StaticOrder S; S.init(M, D, GRID, wgi);
              pg8::EpiResGate<FUSE_NORM != 0, true, true> E{XB, (float*)XB, mod + 5120, H, (float*)(P.ws + WS_SS2), P.in[4] + D, mod + (size_t)8 * 6144 + 1024};
              pg8::gemm_phase<pg8::EpiResGate<FUSE_NORM != 0, true, true>, pg8::StaticOrder, true, true>(lds, g, S, E););
    SEAM(7);
    if constexpr (!FUSE_NORM) { PHASE(8, norm_phase<true>(P, lds, XB, P.in[4] + D, 1, 0, 1024, false, tid, lane, wave, wgi);); SEAM(8); }
    LAYER_COMMON(1, 9, P.out)
    PHASE(31, router_phase(P, lds, P.out, tid, lane, wave, wgi););                                       SEAM(12);
    moe_tables(P, lds, tid);
    {
        const LAS int* tab = (const LAS int*)(lds + MOETAB_OFF);
        const int ptot = RFL(tab[8]);
        PHASE(11, pg8::Gemm g{(const bf16*)(P.ws + WS_HG), (const bf16*)(P.ws + WS_WMGU), ptot, 2 * FFE, D, (unsigned)(2 * FFE * D)};
                  pg8::MoeOrder S; S.nM = ptot >> 8; S.nN = 2 * FFE / 256; S.nwg = S.nM * S.nN; S.G = GRID; S.c = wgi; S.capA = true;
                  S.t1 = RFL(tab[1] >> 8); S.t2 = RFL(tab[2] >> 8); S.t3 = RFL(tab[3] >> 8); S.t4 = RFL(tab[4] >> 8); S.t5 = RFL(tab[5] >> 8); S.t6 = RFL(tab[6] >> 8); S.t7 = RFL(tab[7] >> 8);
                  pg8::EpiSwiGLU<true, false> E{(bf16*)(P.ws + WS_ACTM), FFE, (const float*)(P.ws + WS_WL), A8_SCALE / (H8_SCALE * W8_SCALE), 1.f / (H8_SCALE * W8_SCALE), nullptr, nullptr, 0};
                  pg8::gemm_phase<pg8::EpiSwiGLU<true, false>, pg8::MoeOrder, true, true, true>(lds, g, S, E););
        if constexpr ((REPMASK >> 22) & 1) { xcd_barrier(bar); RETID();
                  pg8::Gemm g{(const bf16*)(P.ws + WS_HG), (const bf16*)(P.ws + WS_WMGU), ptot, 2 * FFE, D, (unsigned)(2 * FFE * D)};
                  pg8::MoeOrder S; S.nM = ptot >> 8; S.nN = 2 * FFE / 256; S.nwg = S.nM * S.nN; S.G = GRID; S.c = wgi; S.capA = true;
                  S.t1 = RFL(tab[1] >> 8); S.t2 = RFL(tab[2] >> 8); S.t3 = RFL(tab[3] >> 8); S.t4 = RFL(tab[4] >> 8); S.t5 = RFL(tab[5] >> 8); S.t6 = RFL(tab[6] >> 8); S.t7 = RFL(tab[7] >> 8);
                  pg8::EpiNone E{};
                  pg8::gemm_phase<pg8::EpiNone, pg8::MoeOrder, true, true, true>(lds, g, S, E); }
        SEAM(14);
        PHASE(12, const int tall = ptot >> 8, tmain = tall < 128 ? tall : 128;
                  { pg8::Gemm g{(const bf16*)(P.ws + WS_ACTM), (const bf16*)(P.ws + WS_WMD), ptot, D, FFE, (unsigned)(D * FFE), 0};
                    pg8::MoeOrder S; S.nM = tmain; S.nN = D / 256; S.nwg = S.nM * S.nN; S.G = GRID; S.c = wgi; S.capA = false;
                    S.t1 = RFL(tab[1] >> 8); S.t2 = RFL(tab[2] >> 8); S.t3 = RFL(tab[3] >> 8); S.t4 = RFL(tab[4] >> 8); S.t5 = RFL(tab[5] >> 8); S.t6 = RFL(tab[6] >> 8); S.t7 = RFL(tab[7] >> 8);
                    pg8::EpiBf16<false> E{(bf16*)(P.ws + WS_F), D, 1.f / (A8_SCALE * W8_SCALE), 0, nullptr, nullptr};
                    pg8::gemm_phase<pg8::EpiBf16<false>, pg8::MoeOrder, true, true, true>(lds, g, S, E); }
                  if (tall > 128) { pg8::Gemm g{(const bf16*)(P.ws + WS_ACTM), (const bf16*)(P.ws + WS_WMD), ptot, D, FFE / pg8::RemOrder::NSPLIT, (unsigned)(D * FFE), FFE};
                    pg8::RemOrder S; S.tm0 = 128; S.nrem = tall - 128; S.G = GRID; S.c = wgi;
                    S.t1 = RFL(tab[1] >> 8); S.t2 = RFL(tab[2] >> 8); S.t3 = RFL(tab[3] >> 8); S.t4 = RFL(tab[4] >> 8); S.t5 = RFL(tab[5] >> 8); S.t6 = RFL(tab[6] >> 8); S.t7 = RFL(tab[7] >> 8);
                    pg8::EpiBf16<false> E{(bf16*)(P.ws + WS_FP) - (size_t)128 * 256 * D, D, 1.f / (A8_SCALE * W8_SCALE), (size_t)2048 * D, nullptr, nullptr};
                    pg8::gemm_phase<pg8::EpiBf16<false>, pg8::RemOrder, true, true, true>(lds, g, S, E); } );
        SEAM(15);
        PHASE(29, combine_phase(P, lds, lane, gw););
        __syncthreads(); STAMP();
    }
#undef SEAM
}
static int launch_fast(void* const* d_in, float* out, unsigned char* ws, hipStream_t stream, int stop) {
    static int ready = 0;
    if (ready == 0) {
        if (hipFuncSetAttribute((const void*)fwd, hipFuncAttributeMaxDynamicSharedMemorySize, LDS_BYTES) != hipSuccess) { fprintf(stderr, "kernel_launch: hipFuncSetAttribute failed\n"); ready = -1; return -1; }
        int per_cu = 0; if (hipOccupancyMaxActiveBlocksPerMultiprocessor(&per_cu, (const void*)fwd, NTHR, LDS_BYTES) != hipSuccess || per_cu < 1) fprintf(stderr, "kernel_launch: occupancy query reports %d blocks per CU\n", per_cu);
        (void)hipGetLastError(); ready = 1;
    }
    if (ready < 0) return -1;
    if (hipMemsetAsync(ws + WS_CTL, 0, CTL_ZERO_BYTES, stream) != hipSuccess) return -1;
    Params p{}; for (int i = 0; i < 23; ++i) p.in[i] = (const float*)d_in[i]; p.out = out; p.ws = ws; p.stop = stop; p.pad = 0;
    hipLaunchKernelGGL(fwd, dim3(GRID), dim3(NTHR), LDS_BYTES, stream, p);
    return hipPeekAtLastError() == hipSuccess ? 0 : -1;
}
}
#ifndef DBG_STAGE
#define DBG_STAGE 0
#endif
extern "C" void kernel_launch(void* const* d_in, const int* in_sizes, int n_in, void* d_out, int out_size, void* d_ws, size_t ws_size, hipStream_t stream) {
    if (n_in != 23 || out_size != fk::M * fk::D || ws_size < fk::WS_END) { fprintf(stderr, "kernel_launch: unexpected shapes / workspace (%d inputs, out %d, ws %zu)\n", n_in, out_size, ws_size); return; }
    unsigned char* ws = (unsigned char*)d_ws; float* out = (float*)d_out;
#if DBG_STAGE == 0
    fk::launch_fast(d_in, out, ws, stream, -1);
#elif defined(TSDBG)
    fk::launch_fast(d_in, out, ws, stream, -1);
    nv::k_savets<<<1, 64, 0, stream>>>((const unsigned long long*)ws + 16384, (float*)(ws + 389 * ((size_t)1 << 20)), TS_A0, TS_A1, TS_B0, TS_B1);
    nv::forward(d_in, out, ws, stream);
    nv::k_encode<<<(unsigned)(((size_t)fk::M * 1024 + 255) / 256), 256, 0, stream>>>(out, (size_t)fk::M * 1024, (const float*)(ws + 389 * ((size_t)1 << 20)));
#else
    constexpr int S = DBG_STAGE; constexpr size_t MiB = 1u << 20;
    float* ckf = (float*)(ws + 390 * MiB); float* acc = (float*)(ws + 389 * MiB);
    int stop = -1; size_t off = 0, n = 0; float scale = 1.f; bool isf32 = false;
    const size_t NM = (size_t)fk::M;
    switch (S) {
        case 1: stop = 1; off = fk::WS_H; n = NM * 1024; break;
        case 2: stop = 2; off = fk::WS_Z; n = NM * 512; break;
        case 3: stop = 2; off = fk::WS_Q; n = NM * 512; scale = 1.f / fk::QSCALE; break;
        case 4: stop = 2; off = fk::WS_K; n = NM * 512; break;
        case 5: stop = 3; off = fk::WS_YC; n = NM * 1024; break;
        case 6: stop = 4; isf32 = true; n = NM * 1024; break;
        case 7: stop = 5; off = fk::WS_H; n = NM * 1024; break;
        case 8: stop = 6; off = fk::WS_ACT; n = NM * 1024; break;
        case 9: stop = 7; isf32 = true; n = NM * 1024; break;
        case 11: stop = 8; off = fk::WS_H; n = NM * 1024; break;
        case 12: stop = 9; off = fk::WS_Z; n = NM * 512; break;
        case 13: stop = 9; off = fk::WS_Q; n = NM * 512; scale = 1.f / fk::QSCALE; break;
        case 14: stop = 9; off = fk::WS_K; n = NM * 512; break;
        case 15: stop = 10; off = fk::WS_YC; n = NM * 1024; break;
        case 16: stop = 11; isf32 = true; n = NM * 1024; break;
        default: stop = -1; isf32 = true; n = NM * 1024; break;
    }
    fk::launch_fast(d_in, out, ws, stream, stop);
    if (isf32) nv::k_copy<<<(unsigned)((n + 255) / 256), 256, 0, stream>>>(out, ckf, n);
    else nv::k_cvt<<<(unsigned)((n + 255) / 256), 256, 0, stream>>>((const unsigned short*)(ws + off), ckf, n, scale);
    hipMemsetAsync(acc, 0, 256, stream);
    nv::forward(d_in, out, ws, stream, S, ckf, acc);
    if (S == 99) nv::k_cmp<<<1024, 256, 0, stream>>>(ckf, out, n, acc);
    nv::k_scale<<<(unsigned)((NM * 1024 + 255) / 256), 256, 0, stream>>>(out, NM * 1024, acc);
#endif
}
```

```cpp
#include <hip/hip_runtime.h>
#include <cstdio>
#include <cstdint>
#define DBG_STAGE 0
#define REPMASK 0
namespace pg8 {
#define PG8_LAS __attribute__((address_space(3)))
typedef unsigned short bf16_t;
typedef short bf16x8 __attribute__((ext_vector_type(8)));
typedef float f32x4 __attribute__((ext_vector_type(4)));
typedef unsigned u32x4 __attribute__((ext_vector_type(4)));
constexpr int BM = 256, BK = 64, HALF = 128, HTB = HALF * BK * 2  , STAGE_BYTES = 8 * HTB, NXCD = 8, WGM = 8;

__host__ __device__ __forceinline__ int lds_byte(int r, int c) { const int st = (r >> 4) * 2 + (c >> 5), rr = r & 15, cc = c & 31, ob = rr * 64 + cc * 2; return st * 1024 + (ob ^ (((ob >> 9) & 1) << 5)); }
__host__ __device__ __forceinline__ void stage_rc(int b, int& R, int& C) { const int st = b / 1024, sb = b % 1024, swz = sb ^ (((sb >> 9) & 1) << 5); R = (st >> 1) * 16 + swz / 64; C = (st & 1) * 32 + (swz % 64) / 2; }
__host__ __device__ __forceinline__ int perm32(int rho) { const int n = rho >> 4, i = rho & 15; return 8 * (i >> 2) + 4 * n + (i & 3); }

struct Unit { int pm, pn, e, pa, ks; };
struct Gemm { const bf16_t* A; const bf16_t* Bt; int M, N, K; unsigned bstride; int ld; };

struct StaticOrder {
    int nM, nN, nwg, G, c;
    __device__ void init(int M, int N, int G_, int c_) { nM = M / BM; nN = N / BM; nwg = nM * nN; G = G_; c = c_; }
    __device__ bool next(int i, Unit& u) const {
        const long L = (long)i * G + c; if (L >= nwg) return false;
        int wgid = (int)L; { const int q = nwg / NXCD, r = nwg % NXCD, xcd = wgid % NXCD, off = wgid / NXCD; wgid = (xcd < r ? xcd * (q + 1) : r * (q + 1) + (xcd - r) * q) + off; }
        const int nig = WGM * nN, gid = wgid / nig, fm = gid * WGM, gsz = (nM - fm) < WGM ? (nM - fm) : WGM;
        u.pm = fm + ((wgid % nig) % gsz); u.pn = (wgid % nig) / gsz; u.e = 0; u.pa = u.pm; u.ks = 0; return true;
    }
    __device__ __forceinline__ void a_ready(const Unit&) const {}
    __device__ __forceinline__ void done(const Unit&) const {}
};
struct MoeOrder {
    int nM, nN, nwg, G, c; int t1, t2, t3, t4, t5, t6, t7; bool capA;
    __device__ bool next(int i, Unit& u) const {
        const long L = (long)i * G + c; if (L >= nwg) return false;
        int wgid = (int)L; { const int q = nwg / NXCD, r = nwg % NXCD, xcd = wgid % NXCD, off = wgid / NXCD; wgid = (xcd < r ? xcd * (q + 1) : r * (q + 1) + (xcd - r) * q) + off; }
        const int nig = WGM * nN, gid = wgid / nig, fm = gid * WGM, gsz = (nM - fm) < WGM ? (nM - fm) : WGM;
        u.pm = fm + ((wgid % nig) % gsz); u.pn = (wgid % nig) / gsz;
        const int p = u.pm; u.e = (p >= t1) + (p >= t2) + (p >= t3) + (p >= t4) + (p >= t5) + (p >= t6) + (p >= t7);
        if (capA) { int ts = 0; ts = p >= t1 ? t1 : ts; ts = p >= t2 ? t2 : ts; ts = p >= t3 ? t3 : ts; ts = p >= t4 ? t4 : ts; ts = p >= t5 ? t5 : ts; ts = p >= t6 ? t6 : ts; ts = p >= t7 ? t7 : ts; u.pa = u.e * 64 + (p - ts); }
        else u.pa = p;
        u.ks = 0; return true;
    }
    __device__ __forceinline__ void a_ready(const Unit&) const {}
    __device__ __forceinline__ void done(const Unit&) const {}
};

struct RemOrder {
    int tm0, nrem, G, c; int t1, t2, t3, t4, t5, t6, t7; static constexpr int NSPLIT = 7;
    __device__ bool next(int i, Unit& u) const {
        const int L = i * G + c; if (L >= nrem * 4 * NSPLIT) return false;
        u.ks = L % NSPLIT; u.pn = (L / NSPLIT) & 3; u.pm = tm0 + L / (4 * NSPLIT); u.pa = u.pm;
        const int p = u.pm; u.e = (p >= t1) + (p >= t2) + (p >= t3) + (p >= t4) + (p >= t5) + (p >= t6) + (p >= t7); return true;
    }
    __device__ __forceinline__ void a_ready(const Unit&) const {}
    __device__ __forceinline__ void done(const Unit&) const {}
};
__device__ __forceinline__ unsigned cvt_pk_bf16(float lo, float hi) { unsigned r; asm volatile("v_cvt_pk_bf16_f32 %0, %1, %2" : "=v"(r) : "v"(lo), "v"(hi)); return r; }
typedef int v8i __attribute__((ext_vector_type(8))); typedef int v4i __attribute__((ext_vector_type(4)));
__device__ __forceinline__ v8i cat8(bf16x8 lo, bf16x8 hi) { const v4i a = __builtin_bit_cast(v4i, lo), b = __builtin_bit_cast(v4i, hi); return __builtin_shufflevector(a, b, 0, 1, 2, 3, 4, 5, 6, 7); }
__device__ __forceinline__ unsigned pk4_fp8(float a, float b, float c, float d) { int w = __builtin_amdgcn_cvt_pk_fp8_f32(a, b, 0, false); w = __builtin_amdgcn_cvt_pk_fp8_f32(c, d, w, true); return (unsigned)w; }
__device__ __forceinline__ float sigm(float x) { return __builtin_amdgcn_rcpf(1.f + __builtin_amdgcn_exp2f(-1.4426950408889634f * x)); }
__device__ __forceinline__ u32x4 pack8(f32x4 v0, f32x4 v1) { u32x4 w; w.x = cvt_pk_bf16(v0[0], v0[1]); w.y = cvt_pk_bf16(v0[2], v0[3]); w.z = cvt_pk_bf16(v1[0], v1[1]); w.w = cvt_pk_bf16(v1[2], v1[3]); return w; }

template <bool NORM> struct EpiBf16 {
    static constexpr bool PERM = true, AFTER_DRAIN = false;
    bf16_t* O; int ldc; float scale; size_t slab;
    const float* ss; const float* cvec;
    __device__ __forceinline__ void operator()(const f32x4 (&acc)[2][2][4][2], const Unit& u, int wr, int wc, int fr, int fq) const {
        const int row0 = u.pm * BM + wr * 64 + fr; const int col0 = u.pn * BM + wc * 32 + 8 * fq;
        f32x4 rc[2][2];
        if constexpr (NORM) {
#pragma unroll
            for (int bj = 0; bj < 2; ++bj)
#pragma unroll
                for (int n = 0; n < 2; ++n) { const f32x4 q = *(const f32x4*)(ss + col0 + bj * HALF + 4 * n);
#pragma unroll
                    for (int i = 0; i < 4; ++i) rc[bj][n][i] = __builtin_amdgcn_rsqf(q[i] * (1.f / 1024.f) + 1e-6f); } }
#pragma unroll
        for (int ai = 0; ai < 2; ++ai)
#pragma unroll
            for (int m = 0; m < 4; ++m) { bf16_t* rowp = O + (size_t)u.ks * slab + (size_t)(row0 + ai * HALF + m * 16) * ldc + col0;
#pragma unroll
                for (int bj = 0; bj < 2; ++bj) { f32x4 v0 = acc[ai][bj][m][0] * scale, v1 = acc[ai][bj][m][1] * scale;
                    if constexpr (NORM) { const float cb = cvec[(size_t)(u.pn >> 3) * 2560 + row0 + ai * HALF + m * 16]; v0 = v0 * rc[bj][0] + cb; v1 = v1 * rc[bj][1] + cb; }
                    *(u32x4*)(rowp + bj * HALF) = pack8(v0, v1); } }
    }
};
template <bool NORM> struct EpiInProj {
    static constexpr bool PERM = true, AFTER_DRAIN = false;
    bf16_t *Z, *Q, *Kt; const float *qg, *kg; float qscale;
    const float* ss; const float* cvec;
    __device__ __forceinline__ void operator()(const f32x4 (&acc)[2][2][4][2], const Unit& u, int wr, int wc, int fr, int fq) const {
        const int row0 = u.pm * BM + wr * 64 + fr;
        f32x4 cv[2][2]; float rr[2][4];
#pragma unroll
        for (int bj = 0; bj < 2; ++bj)
#pragma unroll
            for (int n = 0; n < 2; ++n) { if constexpr (NORM) cv[bj][n] = *(const f32x4*)(cvec + (size_t)(u.pm >> 3) * 2560 + u.pn * BM + bj * HALF + wc * 32 + 8 * fq + 4 * n); else cv[bj][n] = (f32x4){0.f, 0.f, 0.f, 0.f}; }
#pragma unroll
        for (int ai = 0; ai < 2; ++ai)
#pragma unroll
            for (int m = 0; m < 4; ++m) { if constexpr (NORM) rr[ai][m] = __builtin_amdgcn_rsqf(ss[row0 + ai * HALF + m * 16] * (1.f / 1024.f) + 1e-6f); else rr[ai][m] = 1.f; }
#define VAL(ai, bj, m, n) (NORM ? acc[ai][bj][m][n] * rr[ai][m] + cv[bj][n] : acc[ai][bj][m][n])
        if (u.pn < 4) {
            const int col0 = u.pn * 128 + wc * 32 + 8 * fq;
#pragma unroll
            for (int ai = 0; ai < 2; ++ai)
#pragma unroll
                for (int m = 0; m < 4; ++m) { f32x4 z0, z1;
                    const f32x4 a0 = VAL(ai, 0, m, 0), a1 = VAL(ai, 0, m, 1), g0 = VAL(ai, 1, m, 0), g1 = VAL(ai, 1, m, 1);
#pragma unroll
                    for (int i = 0; i < 4; ++i) { z0[i] = a0[i] * sigm(g0[i]); z1[i] = a1[i] * sigm(g1[i]); }
                    *(u32x4*)(Z + (size_t)(row0 + ai * HALF + m * 16) * 512 + col0) = pack8(z0, z1); }
        } else {
            const bool isq = u.pn < 6; bf16_t* O = isq ? Q : Kt; const float* gv = isq ? qg : kg; const float sc = isq ? qscale : 1.f;
            const int head = 4 * (u.pn & 1) + wc;
            f32x4 gw[2][2];
#pragma unroll
            for (int bj = 0; bj < 2; ++bj)
#pragma unroll
                for (int n = 0; n < 2; ++n) gw[bj][n] = *(const f32x4*)(gv + 32 * bj + 8 * fq + 4 * n) * sc;
#pragma unroll
            for (int ai = 0; ai < 2; ++ai)
#pragma unroll
                for (int m = 0; m < 4; ++m) { float hs = 0.f; f32x4 xv[2][2];
#pragma unroll
                    for (int bj = 0; bj < 2; ++bj)
#pragma unroll
                        for (int n = 0; n < 2; ++n) { const f32x4 x = VAL(ai, bj, m, n); xv[bj][n] = x; hs += (x[0] * x[0] + x[1] * x[1]) + (x[2] * x[2] + x[3] * x[3]); }
                    hs += __shfl_xor(hs, 16); hs += __shfl_xor(hs, 32);
                    const float r = __builtin_amdgcn_rsqf(hs * (1.f / 64.f) + 1e-6f);
                    bf16_t* rowp = O + (size_t)(row0 + ai * HALF + m * 16) * 512 + head * 64 + 8 * fq;
#pragma unroll
                    for (int bj = 0; bj < 2; ++bj) *(u32x4*)(rowp + 32 * bj) = pack8(xv[bj][0] * r * gw[bj][0], xv[bj][1] * r * gw[bj][1]); }
        }
#undef VAL
    }
};
template <bool NORM, bool INBF = false, bool OUTBF = false> struct EpiResGate {
    static constexpr bool PERM = false, AFTER_DRAIN = false;
    const float* xin; float* out; const float* gate;
    bf16_t* xg; float* ss; const float* gnext; const float* scnext;
    __device__ __forceinline__ void operator()(const f32x4 (&acc)[2][2][4][2], const Unit& u, int wr, int wc, int fr, int fq) const {
        const int row0 = u.pm * BM + wr * 64 + fr, col0 = u.pn * BM + wc * 32 + 4 * fq; const float* gp = gate + (size_t)(u.pm >> 3) * 6144 + col0;
        f32x4 gv[2][2], gm[2][2];
#pragma unroll
        for (int bj = 0; bj < 2; ++bj)
#pragma unroll
            for (int n = 0; n < 2; ++n) { gv[bj][n] = *(const f32x4*)(gp + bj * HALF + n * 16);
                if constexpr (NORM) gm[bj][n] = *(const f32x4*)(gnext + col0 + bj * HALF + n * 16) * (*(const f32x4*)(scnext + (size_t)(u.pm >> 3) * 6144 + col0 + bj * HALF + n * 16) + 1.f); }
#pragma unroll
        for (int ai = 0; ai < 2; ++ai)
#pragma unroll
            for (int m = 0; m < 4; ++m) { const int row = row0 + ai * HALF + m * 16; const size_t off = (size_t)row * 1024 + col0; float sq = 0.f;
#pragma unroll
                for (int bj = 0; bj < 2; ++bj)
#pragma unroll
                    for (int n = 0; n < 2; ++n) { typedef unsigned u32x2b __attribute__((ext_vector_type(2))); f32x4 xv;
                        if constexpr (INBF) { const u32x2b q = *(const u32x2b*)((const bf16_t*)xin + off + bj * HALF + n * 16); xv = (f32x4){__uint_as_float(q.x << 16), __uint_as_float(q.x & 0xffff0000u), __uint_as_float(q.y << 16), __uint_as_float(q.y & 0xffff0000u)}; }
                        else xv = *(const f32x4*)(xin + off + bj * HALF + n * 16);
                        const f32x4 xn = xv + gv[bj][n] * acc[ai][bj][m][n];
                        if constexpr (OUTBF) { u32x2b w; w.x = cvt_pk_bf16(xn[0], xn[1]); w.y = cvt_pk_bf16(xn[2], xn[3]); *(u32x2b*)((bf16_t*)out + off + bj * HALF + n * 16) = w; }
                        else *(f32x4*)(out + off + bj * HALF + n * 16) = xn;
                        if constexpr (NORM) { sq += (xn[0] * xn[0] + xn[1] * xn[1]) + (xn[2] * xn[2] + xn[3] * xn[3]); const f32x4 t = xn * gm[bj][n];
                            typedef unsigned u32x2 __attribute__((ext_vector_type(2))); u32x2 w; w.x = cvt_pk_bf16(t[0], t[1]); w.y = cvt_pk_bf16(t[2], t[3]); *(u32x2*)(xg + off + bj * HALF + n * 16) = w; } }
                if constexpr (NORM) { sq += __shfl_xor(sq, 16); sq += __shfl_xor(sq, 32); if (fq == 0) atomicAdd(ss + row, sq); } }
    }
};
template <bool F8OUT, bool NORM> struct EpiSwiGLU {
    static constexpr bool PERM = true, AFTER_DRAIN = false;
    bf16_t* O; int ldc; const float* rowscale; float oscale, iscale;
    const float* ss; const float* cvec;
    int ncv;
    __device__ __forceinline__ void operator()(const f32x4 (&acc)[2][2][4][2], const Unit& u, int wr, int wc, int fr, int fq) const {
        const int row0 = u.pm * BM + wr * 64 + fr; const int col0 = u.pn * 128 + wc * 32 + 8 * fq;
        f32x4 cg[2], cu[2];
        if constexpr (NORM) { const float* cp = cvec + (size_t)(u.pm >> 3) * ncv + u.pn * BM + wc * 32 + 8 * fq; cg[0] = *(const f32x4*)cp; cg[1] = *(const f32x4*)(cp + 4); cu[0] = *(const f32x4*)(cp + HALF); cu[1] = *(const f32x4*)(cp + HALF + 4); }
#pragma unroll
        for (int ai = 0; ai < 2; ++ai)
#pragma unroll
            for (int m = 0; m < 4; ++m) { const int row = row0 + ai * HALF + m * 16; const float rs = (rowscale ? rowscale[row + (u.pa - u.pm) * BM] : 1.f) * oscale;   f32x4 z0, z1;
                if constexpr (NORM) { const float r = __builtin_amdgcn_rsqf(ss[row] * (1.f / 1024.f) + 1e-6f);
#pragma unroll
                    for (int i = 0; i < 4; ++i) { const float g0 = r * acc[ai][0][m][0][i] + cg[0][i], g1 = r * acc[ai][0][m][1][i] + cg[1][i], u0 = r * acc[ai][1][m][0][i] + cu[0][i], u1 = r * acc[ai][1][m][1][i] + cu[1][i];
                        z0[i] = g0 * sigm(g0) * u0 * rs; z1[i] = g1 * sigm(g1) * u1 * rs; } }
                else {
#pragma unroll
                for (int i = 0; i < 4; ++i) { const float g0 = acc[ai][0][m][0][i] * iscale, g1 = acc[ai][0][m][1][i] * iscale;
                    z0[i] = g0 * sigm(g0) * acc[ai][1][m][0][i] * rs; z1[i] = g1 * sigm(g1) * acc[ai][1][m][1][i] * rs; } }
                if constexpr (F8OUT) { typedef unsigned u32x2 __attribute__((ext_vector_type(2))); u32x2 w; w.x = pk4_fp8(z0[0], z0[1], z0[2], z0[3]); w.y = pk4_fp8(z1[0], z1[1], z1[2], z1[3]);
                    *(u32x2*)((unsigned char*)O + (size_t)row * ldc + col0) = w; }
                else *(u32x4*)(O + (size_t)row * ldc + col0) = pack8(z0, z1); }
    }
};
struct EpiNone {
    static constexpr bool PERM = true, AFTER_DRAIN = false;
    __device__ __forceinline__ void operator()(const f32x4 (&acc)[2][2][4][2], const Unit& u, int wr, int wc, int fr, int fq) const {
#pragma unroll
        for (int ai = 0; ai < 2; ++ai)
#pragma unroll
            for (int bj = 0; bj < 2; ++bj)
#pragma unroll
                for (int m = 0; m < 4; ++m)
#pragma unroll
                    for (int n = 0; n < 2; ++n) asm volatile("" :: "v"(acc[ai][bj][m][n]));
    }
};
__device__ __forceinline__ const char* uptr(const char* p) { unsigned long long v = (unsigned long long)p; const unsigned lo = __builtin_amdgcn_readfirstlane((unsigned)v), hi = __builtin_amdgcn_readfirstlane((unsigned)(v >> 32)); unsigned long long r = ((unsigned long long)hi << 32) | lo; asm volatile("" : "+s"(r)); return (const char*)r; }
template <class Epi, class Sched, bool ALIGN_EPI = false, bool SP2 = false, bool FP8 = false>
__device__ __forceinline__ void gemm_phase(PG8_LAS unsigned char* lds, const Gemm g, const Sched& S, const Epi& E) {
    int tid_ = threadIdx.x; asm volatile("" : "+v"(tid_)); const int tid = tid_, wid = __builtin_amdgcn_readfirstlane(tid >> 6), lane = tid & 63, wr = wid >> 2, wc = wid & 3, fr = lane & 15, fq = lane >> 4;
    const int KB0 = FP8 ? g.K : g.K * 2, nt = KB0 / (BK * 2), KB = g.ld ? (FP8 ? g.ld : g.ld * 2) : KB0;
    unsigned voffA, voffB;
    { int R, C; stage_rc(tid * 16, R, C); const int Rb = Epi::PERM ? ((R & ~31) + perm32(R & 31)) : R;
        voffA = (unsigned)(R * KB + C * 2); voffB = (unsigned)(Rb * KB + C * 2); }
    const unsigned pstep = 64u * KB;
    constexpr unsigned kstep = BK * 2;
    const unsigned hstep = (unsigned)HALF * KB;
    const unsigned tstep = 2 * hstep;
    const unsigned ldsw = (unsigned)wid * 1024u;
    const int aoff = lds_byte(wr * 64 + fr, fq * 8), boff = lds_byte(wc * 32 + fr, fq * 8);
#define PG8_SA(b, h) (((b) * 2 + (h)) * HTB)
#define PG8_SB(b, h) ((4 + (b) * 2 + (h)) * HTB)
#define PG8_STAGE(bufoff, gbase, voff) do { unsigned vo_ = (voff); asm volatile("" : "+v"(vo_));   \
        _Pragma("unroll") for (int _i = 0; _i < 2; ++_i) \
        __builtin_amdgcn_global_load_lds((const unsigned*)((const char*)(gbase) + _i * pstep + vo_), (PG8_LAS unsigned*)(lds + (bufoff) + ldsw + _i * 8192), 16, 0, 0); } while (0)
#define PG8_LDA(dst, b, h) do { _Pragma("unroll") for (int m = 0; m < 4; ++m) { if constexpr (FP8) { const v4i lo_ = *(const PG8_LAS v4i*)(lds + PG8_SA(b, h) + aoff + m * 2048), hi_ = *(const PG8_LAS v4i*)(lds + PG8_SA(b, h) + aoff + m * 2048 + 1024); dst##8[m] = __builtin_shufflevector(lo_, hi_, 0, 1, 2, 3, 4, 5, 6, 7); } \
        else { _Pragma("unroll") for (int k = 0; k < 2; ++k) dst[m][k] = *(const PG8_LAS bf16x8*)(lds + PG8_SA(b, h) + aoff + m * 2048 + k * 1024); } } } while (0)
#define PG8_LDB(dst, b, h) do { _Pragma("unroll") for (int n = 0; n < 2; ++n) { if constexpr (FP8) { const v4i lo_ = *(const PG8_LAS v4i*)(lds + PG8_SB(b, h) + boff + n * 2048), hi_ = *(const PG8_LAS v4i*)(lds + PG8_SB(b, h) + boff + n * 2048 + 1024); dst##8[n] = __builtin_shufflevector(lo_, hi_, 0, 1, 2, 3, 4, 5, 6, 7); } \
        else { _Pragma("unroll") for (int k = 0; k < 2; ++k) dst[n][k] = *(const PG8_LAS bf16x8*)(lds + PG8_SB(b, h) + boff + n * 2048 + k * 1024); } } } while (0)
#define PG8_MMA(ai, bj, At, Bt) do { __builtin_amdgcn_s_setprio(1); _Pragma("unroll") for (int m = 0; m < 4; ++m) _Pragma("unroll") for (int n = 0; n < 2; ++n) { \
        if constexpr (FP8) asm volatile("v_mfma_f32_16x16x128_f8f6f4 %0, %1, %2, %0" : "+v"(acc[ai][bj][m][n]) : "v"(Bt##8[n]), "v"(At##8[m]));   \
        else { _Pragma("unroll") for (int k = 0; k < 2; ++k) acc[ai][bj][m][n] = __builtin_amdgcn_mfma_f32_16x16x32_bf16(Bt[n][k], At[m][k], acc[ai][bj][m][n], 0, 0, 0); } } \
        __builtin_amdgcn_s_setprio(0); } while (0)
#define PG8_WAIT_V(n) asm volatile("s_waitcnt vmcnt(" #n ")" ::: "memory")
#define PG8_WAIT_L(n) asm volatile("s_waitcnt lgkmcnt(" #n ")" ::: "memory")
#define PG8_BAR __builtin_amdgcn_s_barrier()
#define PG8_SCHED __builtin_amdgcn_sched_barrier(0)
    Unit cur, nxt; int ui = 0;
    if (!S.next(0, cur)) return;
    f32x4 acc[2][2][4][2];
#pragma unroll
    for (int a = 0; a < 2; ++a)
#pragma unroll
        for (int b = 0; b < 2; ++b)
#pragma unroll
            for (int m = 0; m < 4; ++m)
#pragma unroll
                for (int n = 0; n < 2; ++n) acc[a][b][m][n] = (f32x4){0.f, 0.f, 0.f, 0.f};
    bf16x8 At[4][2], B0[2][2], B1[2][2]; v8i At8[4], B08[2], B18[2];
    const char* cA = (const char*)g.A + (unsigned)cur.pa * tstep + (unsigned)cur.ks * (unsigned)KB0; const char* cB = (const char*)g.Bt + (unsigned)cur.e * g.bstride + (unsigned)cur.pn * tstep + (unsigned)cur.ks * (unsigned)KB0;
    S.a_ready(cur);
    if constexpr (SP2) {
        PG8_STAGE(PG8_SB(0, 0), cB, voffB); PG8_STAGE(PG8_SB(0, 1), cB + hstep, voffB); PG8_STAGE(PG8_SA(0, 0), cA, voffA); PG8_STAGE(PG8_SA(0, 1), cA + hstep, voffA);
        if (wr == 1) PG8_BAR;
        PG8_WAIT_V(2); PG8_BAR;
        PG8_STAGE(PG8_SB(1, 0), cB + kstep, voffB); PG8_STAGE(PG8_SA(1, 0), cA + kstep, voffA); PG8_STAGE(PG8_SB(1, 1), cB + hstep + kstep, voffB);
        PG8_WAIT_V(6); PG8_BAR;
    } else {
        PG8_STAGE(PG8_SB(0, 0), cB, voffB); PG8_STAGE(PG8_SA(0, 0), cA, voffA); PG8_STAGE(PG8_SB(0, 1), cB + hstep, voffB); PG8_STAGE(PG8_SA(0, 1), cA + hstep, voffA);
        if (wr == 1) PG8_BAR;
        PG8_WAIT_V(4); PG8_BAR;
        PG8_STAGE(PG8_SB(1, 0), cB + kstep, voffB); PG8_STAGE(PG8_SA(1, 0), cA + kstep, voffA); PG8_STAGE(PG8_SB(1, 1), cB + hstep + kstep, voffB);
        PG8_WAIT_V(6); PG8_BAR;
    }
    for (;;) {
        const bool has_next = S.next(ui + 1, nxt);
        const char* nA = has_next ? (const char*)g.A + (unsigned)nxt.pa * tstep + (unsigned)nxt.ks * (unsigned)KB0 : cA; const char* nB = has_next ? (const char*)g.Bt + (unsigned)nxt.e * g.bstride + (unsigned)nxt.pn * tstep + (unsigned)nxt.ks * (unsigned)KB0 : cB;
#pragma unroll 1
        for (int t = 0; t < nt; t += 2) {
            const bool last = (t == nt - 2);
            const char* a1 = cA + (unsigned)(t + 1) * kstep;
            const char* a2 = last ? nA : cA + (unsigned)(t + 2) * kstep; const char* b2 = last ? nB : cB + (unsigned)(t + 2) * kstep;
            const char* a3 = a2 + kstep; const char* b3 = b2 + kstep;
            a1 = uptr(a1); a2 = uptr(a2); b2 = uptr(b2); a3 = uptr(a3); b3 = uptr(b3);
            if (last && has_next) S.a_ready(nxt);
            if constexpr (SP2) {
            PG8_LDB(B0, 0, 0); PG8_LDB(B1, 0, 1); PG8_SCHED; PG8_LDA(At, 0, 0); PG8_STAGE(PG8_SA(1, 1), a1 + hstep, voffA);
            PG8_WAIT_V(8); PG8_WAIT_L(0); PG8_BAR; PG8_MMA(0, 0, At, B0); PG8_MMA(0, 1, At, B1); PG8_BAR; PG8_SCHED;
            PG8_LDA(At, 0, 1); PG8_STAGE(PG8_SB(0, 0), b2, voffB); PG8_STAGE(PG8_SB(0, 1), b2 + hstep, voffB); PG8_STAGE(PG8_SA(0, 0), a2, voffA);
            PG8_WAIT_V(8); PG8_WAIT_L(0); PG8_BAR; PG8_MMA(1, 0, At, B0); PG8_MMA(1, 1, At, B1); PG8_BAR; PG8_SCHED;
            PG8_LDB(B0, 1, 0); PG8_LDB(B1, 1, 1); PG8_SCHED; PG8_LDA(At, 1, 0); PG8_STAGE(PG8_SA(0, 1), a2 + hstep, voffA);
            PG8_WAIT_V(8); PG8_WAIT_L(0); PG8_BAR; PG8_MMA(0, 0, At, B0); PG8_MMA(0, 1, At, B1); PG8_BAR; PG8_SCHED;
            PG8_LDA(At, 1, 1); PG8_STAGE(PG8_SB(1, 0), b3, voffB); PG8_STAGE(PG8_SB(1, 1), b3 + hstep, voffB); PG8_STAGE(PG8_SA(1, 0), a3, voffA);
            PG8_WAIT_V(8); PG8_WAIT_L(0); PG8_BAR; PG8_MMA(1, 0, At, B0); PG8_MMA(1, 1, At, B1); PG8_BAR; PG8_SCHED;
            } else {
            PG8_LDB(B0, 0, 0); PG8_SCHED; PG8_LDA(At, 0, 0); PG8_STAGE(PG8_SA(1, 1), a1 + hstep, voffA);
            PG8_WAIT_L(8); PG8_BAR; PG8_WAIT_L(0); PG8_MMA(0, 0, At, B0); PG8_BAR; PG8_SCHED;
            PG8_LDB(B1, 0, 1); PG8_STAGE(PG8_SB(0, 0), b2, voffB);
            PG8_BAR; PG8_WAIT_L(0); PG8_MMA(0, 1, At, B1); PG8_BAR;
            PG8_LDA(At, 0, 1); PG8_STAGE(PG8_SA(0, 0), a2, voffA);
            PG8_BAR; PG8_WAIT_L(0); PG8_MMA(1, 0, At, B0); PG8_BAR; PG8_SCHED;
            PG8_STAGE(PG8_SB(0, 1), b2 + hstep, voffB);
            PG8_WAIT_V(6); PG8_BAR; PG8_MMA(1, 1, At, B1); PG8_BAR;
            PG8_LDB(B0, 1, 0); PG8_SCHED; PG8_LDA(At, 1, 0); PG8_STAGE(PG8_SA(0, 1), a2 + hstep, voffA);
            PG8_WAIT_L(8); PG8_BAR; PG8_WAIT_L(0); PG8_MMA(0, 0, At, B0); PG8_BAR; PG8_SCHED;
            PG8_LDB(B1, 1, 1); PG8_STAGE(PG8_SB(1, 0), b3, voffB);
            PG8_BAR; PG8_WAIT_L(0); PG8_MMA(0, 1, At, B1); PG8_BAR;
            PG8_LDA(At, 1, 1); PG8_STAGE(PG8_SA(1, 0), a3, voffA);
            PG8_BAR; PG8_WAIT_L(0); PG8_MMA(1, 0, At, B0); PG8_BAR; PG8_SCHED;
            PG8_STAGE(PG8_SB(1, 1), b3 + hstep, voffB);
            PG8_WAIT_V(6); PG8_BAR; PG8_MMA(1, 1, At, B1); PG8_BAR;
            }
        }
        if constexpr (FP8) asm volatile("s_nop 15\n\ts_nop 15" ::: "memory");
        if constexpr (ALIGN_EPI) { if (wr == 0) PG8_BAR; }
        if constexpr (!Epi::AFTER_DRAIN) { int l_ = threadIdx.x; asm volatile("" : "+v"(l_)); const int fr_ = l_ & 15, fq_ = (l_ >> 4) & 3; E(acc, cur, wr, wc, fr_, fq_); S.done(cur); }
        if (!has_next) break;
#pragma unroll
        for (int a = 0; a < 2; ++a)
#pragma unroll
            for (int b = 0; b < 2; ++b)
#pragma unroll
                for (int m = 0; m < 4; ++m)
#pragma unroll
                    for (int n = 0; n < 2; ++n) acc[a][b][m][n] = (f32x4){0.f, 0.f, 0.f, 0.f};
        cur = nxt; cA = nA; cB = nB; ++ui;
        if constexpr (ALIGN_EPI) { if (wr == 1) PG8_BAR; }
    }
    PG8_WAIT_V(0);
    if constexpr (!ALIGN_EPI) { if (wr == 0) PG8_BAR; }
    PG8_BAR;
    if constexpr (Epi::AFTER_DRAIN) { E.fused(acc, cur, wr, wc, fr, fq, lds, wid, lane); S.done(cur); }
#undef PG8_SA
#undef PG8_SB
#undef PG8_STAGE
#undef PG8_LDA
#undef PG8_LDB
#undef PG8_MMA
#undef PG8_WAIT_V
#undef PG8_WAIT_L
#undef PG8_BAR
#undef PG8_SCHED
}
}

namespace fk {
using pg8::bf16_t; using pg8::bf16x8; using pg8::f32x4; using pg8::u32x4;
constexpr int NWAVES = 8, NTHR = 512, GRID = 256, NGW = GRID * NWAVES;
constexpr int B_ = 8, S_ = 2048, D = 1024, M = B_ * S_, DIN = 2560, DC = 512, FFD = 2816, NE = 8, FFE = 3584, CW = 31, NREL = 257;
constexpr float LOG2E = 1.4426950408889634f, QSCALE = 0.125f * LOG2E, EPS = 1e-6f;
constexpr size_t MiB = 1u << 20;
constexpr size_t WS_CTL = 0, CTL_ZERO_BYTES = 1 * MiB;
constexpr size_t WS_SS1 = 256 * 1024, WS_SS2 = 320 * 1024;
constexpr size_t WS_MODP = 1 * MiB;
constexpr size_t WS_CFF = 1 * MiB, WS_CIN = 1 * MiB + 256 * 1024;
constexpr size_t WS_MOD = 4 * MiB;
constexpr size_t WS_PAIR = 4 * MiB + 512 * 1024;
constexpr size_t WS_LIST = 5 * MiB;
constexpr size_t WS_WL = 5 * MiB + 512 * 1024;
constexpr size_t WS_WLG = 6 * MiB;
constexpr size_t WS_WMGU = 8 * MiB;
constexpr size_t WS_WMD = 120 * MiB;
constexpr size_t WS_XB = 64 * MiB;
constexpr size_t WS_FP = 148 * MiB;
constexpr size_t WS_WIN = 176 * MiB;
constexpr size_t WS_WOUT = 186 * MiB;
constexpr size_t WS_WGU = 190 * MiB;
constexpr size_t WS_WD = 201 * MiB;
constexpr size_t WS_H = 207 * MiB;
constexpr size_t WS_Z = 239 * MiB, WS_Q = 255 * MiB, WS_K = 271 * MiB, WS_VT = 287 * MiB;
constexpr size_t WS_YC = 303 * MiB;
constexpr size_t WS_ACT = 239 * MiB;
constexpr size_t WS_HG = 363 * MiB;
constexpr size_t WS_F = 176 * MiB;
constexpr size_t WS_ACTM = 244 * MiB;
constexpr size_t WS_END = 491 * MiB;
constexpr int MAXROWS = 34816;
constexpr int CW_BAR = 4096, CW_CNT = 16384;
constexpr int RING_BYTES = 131072, LDSCTL_OFF = RING_BYTES, MISC_OFF = LDSCTL_OFF + 320, MOETAB_OFF = LDSCTL_OFF + 512;
constexpr int LDS_BYTES = 147456;

#define GAS __attribute__((address_space(1)))
#define LAS __attribute__((address_space(3)))
typedef unsigned short bf16;
typedef unsigned v4u __attribute__((ext_vector_type(4)));
typedef unsigned v2u __attribute__((ext_vector_type(2)));
typedef float f32x16 __attribute__((ext_vector_type(16)));
typedef short s16x4 __attribute__((ext_vector_type(4)));
typedef float f32x2_t __attribute__((ext_vector_type(2))); typedef __bf16 bf16x2_t __attribute__((ext_vector_type(2)));
__device__ __forceinline__ unsigned pk2(float lo, float hi) { f32x2_t v = {lo, hi}; bf16x2_t b = __builtin_convertvector(v, bf16x2_t); return __builtin_bit_cast(unsigned, b); }
__device__ __forceinline__ float bf2f(bf16 v) { return __uint_as_float((unsigned)v << 16); }
__device__ __forceinline__ float wave_sum(float v) {
#pragma unroll
    for (int o = 1; o < 64; o <<= 1) v += __shfl_xor(v, o);
    return v;
}
__device__ __forceinline__ float sigm(float x) { return __builtin_amdgcn_rcpf(1.f + __builtin_amdgcn_exp2f(-LOG2E * x)); }
using pg8::pk4_fp8;
constexpr float W8_SCALE = 64.f, H8_SCALE = 8.f, A8_SCALE = 4.f;
constexpr int E8_W = (127 - 6) * 0x01010101, E8_H = (127 - 3) * 0x01010101, E8_A = (127 - 2) * 0x01010101;
#define LDS_WAIT() asm volatile("s_waitcnt lgkmcnt(0)" ::: "memory")
#define RFL(x) __builtin_amdgcn_readfirstlane(x)

#define XB_TMO      128
#define XB_XCNT(j)  (256  + 64 * (j))
#define XB_XSUB(j)  (1280 + 64 * (j))
#define XB_XGEN(j)  (2304 + 64 * (j))
#define XB_TOP      3328
#define XB_TOPGEN   3392
#define XCD_BAR_WORDS 3456
#define XB_SPIN_CAP (1u << 18)

__device__ __forceinline__ unsigned xb_ld(unsigned* p)              { return __hip_atomic_load(p, __ATOMIC_RELAXED, __HIP_MEMORY_SCOPE_AGENT); }
__device__ __forceinline__ unsigned xb_add(unsigned* p, unsigned v) { return __hip_atomic_fetch_add(p, v, __ATOMIC_RELAXED, __HIP_MEMORY_SCOPE_AGENT); }
__device__ __forceinline__ unsigned xb_xcc_id() { return (unsigned)__builtin_amdgcn_s_getreg((3 << 11) | 20) & 0xFu; }
#define XB_SPIN(cond, bar) do { unsigned _sp = 0; while (cond) { __builtin_amdgcn_s_sleep(1); \
    if ((++_sp & 255u) == 0u) { if (xb_ld(&(bar)[XB_TMO])) break; if (_sp > XB_SPIN_CAP) { atomicAdd(&(bar)[XB_TMO], 1u); break; } } } } while (0)

struct XcdBarrier {
    unsigned* bar; unsigned x;
    volatile LAS unsigned* st;
};

__device__ __forceinline__ XcdBarrier xcd_barrier_post(unsigned* bar, volatile LAS unsigned* st) {
    XcdBarrier b; b.bar = bar; b.x = xb_xcc_id(); b.st = st;
    if (threadIdx.x == 0) (void)xb_add(&bar[XB_XCNT(b.x)], 1u);
    return b;
}
__device__ __forceinline__ void xcd_barrier_complete(unsigned* bar, unsigned x, unsigned& nloc, unsigned& nx) {
    const unsigned G = gridDim.x * gridDim.y * gridDim.z;
    unsigned sum, cnt, mine, sp = 0u;
    for (;;) {
        sum = 0u; cnt = 0u; mine = 0u;
#pragma unroll
        for (unsigned j = 0; j < 16; ++j) { const unsigned c = xb_ld(&bar[XB_XCNT(j)]); sum += c; cnt += (c > 0u) ? 1u : 0u; mine = (j == x) ? c : mine; }
        if (sum == G) break;
        __builtin_amdgcn_s_sleep(1);
        if ((++sp & 255u) == 0u) { if (xb_ld(&bar[XB_TMO])) break; if (sp > XB_SPIN_CAP) { atomicAdd(&bar[XB_TMO], 1u); break; } }
    }
    nloc = mine > 0u ? mine : 1u; nx = cnt > 0u ? cnt : 1u;
}

__device__ __forceinline__ void xcd_barrier(const XcdBarrier& b) {
    asm volatile("s_waitcnt vmcnt(0)" ::: "memory");
    __syncthreads();
    if (threadIdx.x == 0) {
        unsigned* bar = b.bar;
        __builtin_amdgcn_s_waitcnt(0);
        unsigned nloc = b.st[0], nx = b.st[1];
        if (nloc == 0u) { xcd_barrier_complete(bar, b.x, nloc, nx); b.st[0] = nloc; b.st[1] = nx; }
        const unsigned old = xb_add(&bar[XB_XSUB(b.x)], 1u);
        const unsigned gen = old / nloc;
        if (old + 1u == (gen + 1u) * nloc) {
            __builtin_amdgcn_fence(__ATOMIC_RELEASE, "agent");
            asm volatile("s_waitcnt vmcnt(0)" ::: "memory");
            const unsigned og = xb_add(&bar[XB_TOP], 1u);
            const unsigned tg = og / nx;
            if (og + 1u == (tg + 1u) * nx) xb_add(&bar[XB_TOPGEN], 1u);
            else XB_SPIN(xb_ld(&bar[XB_TOPGEN]) == tg, bar);
            __builtin_amdgcn_fence(__ATOMIC_ACQUIRE, "agent");
            xb_add(&bar[XB_XGEN(b.x)], 1u);
            asm volatile("s_waitcnt vmcnt(0)" ::: "memory");
        } else {
            XB_SPIN(xb_ld(&bar[XB_XGEN(b.x)]) == gen, bar);
            __builtin_amdgcn_fence(__ATOMIC_ACQUIRE, "agent");
            asm volatile("s_waitcnt vmcnt(0)" ::: "memory");
        }
    }
    __syncthreads();
}


#ifndef FUSE_NORM
#define FUSE_NORM 0
#endif
#ifndef REPMASK
#define REPMASK 0
#endif
struct Params { const float* in[23]; float* out; unsigned char* ws; int stop; int pad; };

__device__ __forceinline__ void tr_item(const float* W, int K, int N, bf16* WT, int kb, int nb, int drow0, LAS float* scr, int lane) {
    const int k0 = 64 * kb, n0 = 32 * nb;
    { f32x4 v[8];
#pragma unroll
      for (int i = 0; i < 8; ++i) v[i] = *(const GAS f32x4*)(W + (size_t)(k0 + 8 * i + (lane >> 3)) * N + n0 + (lane & 7) * 4);
#pragma unroll
      for (int i = 0; i < 8; ++i) { LAS float* d = scr + (8 * i + (lane >> 3)) * 33 + (lane & 7) * 4; d[0] = v[i].x; d[1] = v[i].y; d[2] = v[i].z; d[3] = v[i].w; } }
    LDS_WAIT(); asm volatile("" ::: "memory");
    const int c = lane & 7;
#pragma unroll
    for (int j = 0; j < 4; ++j) { const int n = (lane >> 3) + 8 * j; const LAS float* s = scr + (8 * c) * 33 + n;
        v4u o; o.x = pk2(s[0 * 33], s[1 * 33]); o.y = pk2(s[2 * 33], s[3 * 33]); o.z = pk2(s[4 * 33], s[5 * 33]); o.w = pk2(s[6 * 33], s[7 * 33]);
        *(GAS v4u*)(WT + (size_t)(drow0 + n) * K + k0 + 8 * c) = o; }
    LDS_WAIT(); asm volatile("" ::: "memory");
}
__device__ __forceinline__ void tr_item_f8(const float* W, int K, int N, unsigned char* WT, int kb, int nb, int drow0, LAS float* scr, int lane, float scale) {
    const int k0 = 64 * kb, n0 = 32 * nb;
    { f32x4 v[8];
#pragma unroll
      for (int i = 0; i < 8; ++i) v[i] = __builtin_nontemporal_load((const GAS f32x4*)(W + (size_t)(k0 + 8 * i + (lane >> 3)) * N + n0 + (lane & 7) * 4));
#pragma unroll
      for (int i = 0; i < 8; ++i) { LAS float* d = scr + (8 * i + (lane >> 3)) * 33 + (lane & 7) * 4; d[0] = v[i].x; d[1] = v[i].y; d[2] = v[i].z; d[3] = v[i].w; } }
    LDS_WAIT(); asm volatile("" ::: "memory");
    const int c = lane & 7;
#pragma unroll
    for (int j = 0; j < 4; ++j) { const int n = (lane >> 3) + 8 * j; const LAS float* s = scr + (8 * c) * 33 + n;
        v2u o; o.x = pk4_fp8(s[0 * 33] * scale, s[1 * 33] * scale, s[2 * 33] * scale, s[3 * 33] * scale); o.y = pk4_fp8(s[4 * 33] * scale, s[5 * 33] * scale, s[6 * 33] * scale, s[7 * 33] * scale);
        __builtin_nontemporal_store(o, (GAS v2u*)(WT + (size_t)(drow0 + n) * K + k0 + 8 * c)); }
    LDS_WAIT(); asm volatile("" ::: "memory");
}
__device__ __forceinline__ int rowmap_win(int n0) {
    if (n0 < 512) return 256 * (n0 >> 7) + (n0 & 127);
    if (n0 < 1024) { const int m = n0 - 512; return 256 * (m >> 7) + 128 + (m & 127); }
    if (n0 < 2048) { const int isk = n0 >= 1536; const int m = n0 - (isk ? 1536 : 1024); const int head = m >> 6, bj = (m >> 5) & 1; return 256 * (4 + 2 * isk + (head >> 2)) + 128 * bj + 32 * (head & 3); }
    return n0;
}
__device__ __forceinline__ int rowmap_gu(int n0, int up) { return 256 * (n0 >> 7) + 128 * up + (n0 & 127); }

constexpr int MOE_ITEMS = 16 * (16 * 112) + 8 * (56 * 32);
constexpr int FILL_S0 = 10240, FILL_S1 = 22528, FILL_S2 = 32768, FILL_MIX = 0, FILL_P0 = FILL_S2 + 2 * FILL_MIX;
struct MoeItem { const float* src; unsigned char* dst; int N, K; };
__device__ __forceinline__ MoeItem moe_item_decode(const Params& P, int r, int lane) {
    constexpr int I_MG = 16 * 112, I_MD = 56 * 32; MoeItem m;
    if (r < 16 * I_MG) { const int mat = r / I_MG, q = r % I_MG, e = mat >> 1, up = mat & 1; const int kb = q / 112, nb = q % 112;
        m.N = FFE; m.K = D; m.src = (up ? P.in[21] : P.in[20]) + (size_t)e * D * FFE + (size_t)(64 * kb + (lane >> 3)) * FFE + 32 * nb + (lane & 7) * 4;
        m.dst = (unsigned char*)(P.ws + WS_WMGU) + (size_t)e * 7168 * D + (size_t)rowmap_gu(32 * nb, up) * D + 64 * kb; }
    else { r -= 16 * I_MG; const int e = r / I_MD, q = r % I_MD; const int kb = q / 32, nb = q % 32;
        m.N = D; m.K = FFE; m.src = P.in[22] + (size_t)e * FFE * D + (size_t)(64 * kb + (lane >> 3)) * D + 32 * nb + (lane & 7) * 4;
        m.dst = (unsigned char*)(P.ws + WS_WMD) + (size_t)e * D * FFE + (size_t)(32 * nb) * FFE + 64 * kb; }
    return m;
}
__device__ __forceinline__ void moe_item_load(const MoeItem& m, f32x4 (&v)[8]) {
#pragma unroll
    for (int i = 0; i < 8; ++i) v[i] = __builtin_nontemporal_load((const GAS f32x4*)(m.src + (size_t)(8 * i) * m.N));
}
__device__ __forceinline__ void moe_item_finish(const MoeItem& m, const f32x4 (&v)[8], LAS float* scr, int lane) {
#pragma unroll
    for (int i = 0; i < 8; ++i) { LAS float* d = scr + (8 * i + (lane >> 3)) * 33 + (lane & 7) * 4; d[0] = v[i].x; d[1] = v[i].y; d[2] = v[i].z; d[3] = v[i].w; }
    LDS_WAIT(); asm volatile("" ::: "memory");
    const int c = lane & 7;
#pragma unroll
    for (int j = 0; j < 4; ++j) { const int n = (lane >> 3) + 8 * j; const LAS float* s = scr + (8 * c) * 33 + n;
        v2u o; o.x = pk4_fp8(s[0 * 33] * W8_SCALE, s[1 * 33] * W8_SCALE, s[2 * 33] * W8_SCALE, s[3 * 33] * W8_SCALE); o.y = pk4_fp8(s[4 * 33] * W8_SCALE, s[5 * 33] * W8_SCALE, s[6 * 33] * W8_SCALE, s[7 * 33] * W8_SCALE);
        __builtin_nontemporal_store(o, (GAS v2u*)(m.dst + (size_t)n * m.K + 8 * c)); }
    LDS_WAIT(); asm volatile("" ::: "memory");
}
__device__ __forceinline__ void moe_fill_run(const Params& P, LAS unsigned char* lds, int first, int stride, int hi, int lane, int wave);
__device__ __forceinline__ void moe_filler(const Params& P, LAS unsigned char* lds, int lo, int hi, int lane, int wave, int wgi) {
    if (wgi < 128) return;
    moe_fill_run(P, lds, lo + (wgi - 128) * NWAVES + wave, 128 * NWAVES, hi, lane, wave);
}
__device__ __forceinline__ void moe_fill_run(const Params& P, LAS unsigned char* lds, int first, int stride, int hi, int lane, int wave) {
    LAS float* scr = (LAS float*)(lds + wave * 8448);
    int it = first; if (it >= hi) return;
    MoeItem cur = moe_item_decode(P, it, lane); f32x4 v[8]; moe_item_load(cur, v);
    for (;;) { const int nx = it + stride; const bool more = nx < hi;
        MoeItem nxt = cur; f32x4 vn[8];
        if (more) { nxt = moe_item_decode(P, nx, lane); moe_item_load(nxt, vn); }
        moe_item_finish(cur, v, scr, lane);
        if (!more) break;
        cur = nxt; it = nx;
#pragma unroll
        for (int i = 0; i < 8; ++i) v[i] = vn[i];
    }
}

__device__ __forceinline__ void phase0(const Params& P, LAS unsigned char* lds, int tid, int lane, int wave, int gw) {
    LAS float* cact = (LAS float*)(lds + 69632);
    { const float* c = P.in[1]; for (int i = tid; i < B_ * D; i += NTHR) { const float v = c[i]; cact[i] = v * sigm(v); } }
    __syncthreads();
    {
        const float* w_ada = P.in[2]; float* modp = (float*)(P.ws + WS_MODP);
        for (int it = gw; it < 1536; it += NGW) {
            const int ks = it & 7, jb = (it >> 3) % 96, l = it / 768;
            const float* wp = w_ada + ((size_t)l * D + ks * 128) * 6144 + jb * 64 + lane;
            float acc[8];
#pragma unroll
            for (int b = 0; b < 8; ++b) acc[b] = 0.f;
#pragma unroll 8
            for (int k = 0; k < 128; ++k) { const float w = wp[(size_t)k * 6144];
#pragma unroll
                for (int b = 0; b < 8; ++b) acc[b] += cact[b * D + ks * 128 + k] * w; }
#pragma unroll
            for (int b = 0; b < 8; ++b) modp[(((size_t)ks * 2 + l) * 8 + b) * 6144 + jb * 64 + lane] = acc[b];
        }
    }
    LAS float* scr = (LAS float*)(lds + wave * 8448);
    constexpr int I_WIN = 16 * 80, I_WOUT = 16 * 32, I_FG = 16 * 88, I_FD = 44 * 32, I_MG = 16 * 112, I_MD = 56 * 32;
    constexpr int NITEMS = 2 * I_WIN + 2 * I_WOUT + 2 * I_FG + I_FD + 16 * I_MG + 8 * I_MD; static_assert(16 * I_MG + 8 * I_MD == MOE_ITEMS, "item counts");
    for (int it = gw; it < NITEMS - MOE_ITEMS; it += NGW) {
        int r = it;
        if (r < 2 * I_WIN) { const int l = r / I_WIN, q = r % I_WIN; const int kb = q / 80, nb = q % 80;
            tr_item(P.in[6] + (size_t)l * D * DIN, D, DIN, (bf16*)(P.ws + WS_WIN) + (size_t)l * DIN * D, kb, nb, rowmap_win(32 * nb), scr, lane); continue; }
        r -= 2 * I_WIN;
        if (r < 2 * I_WOUT) { const int l = r / I_WOUT, q = r % I_WOUT; const int kb = q / 32, nb = q % 32;
            tr_item(P.in[7] + (size_t)l * D * D, D, D, (bf16*)(P.ws + WS_WOUT) + (size_t)l * D * D, kb, nb, 32 * nb, scr, lane); continue; }
        r -= 2 * I_WOUT;
        if (r < 2 * I_FG) { const int up = r / I_FG, q = r % I_FG; const int kb = q / 88, nb = q % 88;
            tr_item((up ? P.in[16] : P.in[15]), D, FFD, (bf16*)(P.ws + WS_WGU), kb, nb, rowmap_gu(32 * nb, up), scr, lane); continue; }
        r -= 2 * I_FG;
        { const int kb = r / 32, nb = r % 32; tr_item(P.in[17], FFD, D, (bf16*)(P.ws + WS_WD), kb, nb, 32 * nb, scr, lane); }
    }    moe_fill_run(P, lds, FILL_P0 + gw, NGW, MOE_ITEMS, lane, wave);
}

__device__ __forceinline__ void cvec_fill(const Params& P, LAS unsigned char* lds, int tid, int lane, int wave, int wgi) {
    if (wgi < 128) return;
    LAS float* shL = (LAS float*)lds;
    const float* mod = (const float*)(P.ws + WS_MOD);
    for (int i = tid; i < 2 * 8 * D; i += NTHR) { const int which = i >> 13, b = (i >> 10) & 7, k = i & 1023; shL[i] = which ? mod[((size_t)8 + b) * 6144 + k] : mod[(size_t)b * 6144 + 3072 + k]; }
    __syncthreads();
    const bf16* Wgu = (const bf16*)(P.ws + WS_WGU); const bf16* Win1 = (const bf16*)(P.ws + WS_WIN) + (size_t)DIN * D;
    float* cff = (float*)(P.ws + WS_CFF); float* cin = (float*)(P.ws + WS_CIN);
    for (int r = (wgi - 128) * NWAVES + wave; r < 2 * FFD + DIN; r += 128 * NWAVES) {
        const bool ff = r < 2 * FFD; const int n = ff ? r : r - 2 * FFD; const bf16* wr = (ff ? Wgu : Win1) + (size_t)n * D + 16 * lane;
        const v4u w0 = *(const GAS v4u*)wr, w1 = *(const GAS v4u*)(wr + 8); float wv[16];
#pragma unroll
        for (int j = 0; j < 4; ++j) { wv[2 * j] = __uint_as_float(w0[j] << 16); wv[2 * j + 1] = __uint_as_float(w0[j] & 0xffff0000u); wv[8 + 2 * j] = __uint_as_float(w1[j] << 16); wv[8 + 2 * j + 1] = __uint_as_float(w1[j] & 0xffff0000u); }
        const LAS float* sp = shL + (ff ? 0 : 8 * D) + 16 * lane; float mine = 0.f;
#pragma unroll
        for (int b = 0; b < 8; ++b) { float s = 0.f;
#pragma unroll
            for (int j = 0; j < 4; ++j) { const f32x4 s4 = *(const LAS f32x4*)(sp + b * D + 4 * j); s += (s4.x * wv[4 * j] + s4.y * wv[4 * j + 1]) + (s4.z * wv[4 * j + 2] + s4.w * wv[4 * j + 3]); }
            s = wave_sum(s); if (lane == b) mine = s; }
        if (lane < 8) (ff ? cff + (size_t)lane * (2 * FFD) : cin + (size_t)lane * DIN)[n] = mine;
    }
    __syncthreads();
}

__device__ __forceinline__ float modp_sum(const float* modp, const float* b_ada, int l, int b, int j) {
    float s = b_ada[l * 6144 + j];
#pragma unroll
    for (int ks = 0; ks < 8; ++ks) s += modp[(((size_t)ks * 2 + l) * 8 + b) * 6144 + j];
    return s;
}
template <bool INBF> __device__ __forceinline__ void row_load(const float* xrow, int lane, f32x4 (&h)[4]) {
    if constexpr (INBF) { const GAS v2u* xr = (const GAS v2u*)xrow + lane;
#pragma unroll
        for (int j = 0; j < 4; ++j) { const v2u q = xr[64 * j]; h[j] = (f32x4){__uint_as_float(q.x << 16), __uint_as_float(q.x & 0xffff0000u), __uint_as_float(q.y << 16), __uint_as_float(q.y & 0xffff0000u)}; } }
    else { const GAS f32x4* xr = (const GAS f32x4*)xrow + lane;
#pragma unroll
        for (int j = 0; j < 4; ++j) h[j] = xr[64 * j]; }
}
__device__ __forceinline__ void row_finish(const LAS float* gm, const LAS float* shv, int lane, f32x4 (&h)[4]) {
    float ss = 0.f;
#pragma unroll
    for (int j = 0; j < 4; ++j) ss += (h[j].x * h[j].x + h[j].y * h[j].y) + (h[j].z * h[j].z + h[j].w * h[j].w);
    const float r = __builtin_amdgcn_rsqf(wave_sum(ss) * (1.f / D) + EPS);
#pragma unroll
    for (int j = 0; j < 4; ++j) { const f32x4 g4 = *(const LAS f32x4*)(gm + 4 * lane + 256 * j), s4 = *(const LAS f32x4*)(shv + 4 * lane + 256 * j); h[j] = h[j] * r * g4 + s4; }
}
__device__ __forceinline__ void norm_row(const float* xrow, const LAS float* gm, const LAS float* shv, int lane, f32x4 (&h)[4]) { row_load<false>(xrow, lane, h); row_finish(gm, shv, lane, h); }
__device__ __forceinline__ void store_row_bf16(bf16* orow, int lane, const f32x4 (&h)[4]) {
    GAS v2u* o8 = (GAS v2u*)orow + lane;
#pragma unroll
    for (int j = 0; j < 4; ++j) { v2u w; w.x = pk2(h[j].x, h[j].y); w.y = pk2(h[j].z, h[j].w); o8[64 * j] = w; }
}
template <bool INBF> __device__ __forceinline__ void norm_phase(const Params& P, LAS unsigned char* lds, const float* xin, const float* gvec, int l, int sh_off, int sc_off, bool from_partials, int tid, int lane, int wave, int wgi) {
    LAS float* gm = (LAS float*)lds; LAS float* shv = (LAS float*)(lds + 4096);
    const float* modp = (const float*)(P.ws + WS_MODP); float* mod = (float*)(P.ws + WS_MOD); const float* b_ada = P.in[3];
    const int b = wgi >> 5;
    if (from_partials) {
        if (tid < 384) { const int idx = wgi * 384 + tid; const int ll = idx / 49152, rem = idx % 49152, bb = rem / 6144, j = rem % 6144; mod[idx] = modp_sum(modp, b_ada, ll, bb, j); }
        for (int c = tid; c < D; c += NTHR) { gm[c] = gvec[c] * (1.f + modp_sum(modp, b_ada, l, b, sc_off + c)); shv[c] = modp_sum(modp, b_ada, l, b, sh_off + c); }
    } else {
        const float* ml = mod + ((size_t)l * 8 + b) * 6144;
        for (int c = tid; c < D; c += NTHR) { gm[c] = gvec[c] * (1.f + ml[sc_off + c]); shv[c] = ml[sh_off + c]; }
    }
    __syncthreads();
    bf16* H = (bf16*)(P.ws + WS_H);
    constexpr int RS = INBF ? D / 2 : D;
    for (int i = 0; i < 8; i += 4) { const int row = wgi * 64 + wave * 8 + i; f32x4 h[4][4];
#pragma unroll
        for (int q = 0; q < 4; ++q) row_load<INBF>(xin + (size_t)(row + q) * RS, lane, h[q]);
#pragma unroll
        for (int q = 0; q < 4; ++q) { row_finish(gm, shv, lane, h[q]); store_row_bf16(H + (size_t)(row + q) * D, lane, h[q]); } }
    __syncthreads();
}
__device__ __forceinline__ void router_phase(const Params& P, LAS unsigned char* lds, const float* xin, int tid, int lane, int wave, int wgi) {
    LAS float* gm = (LAS float*)lds; LAS float* shv = (LAS float*)(lds + 4096); LAS float* wrT = (LAS float*)(lds + 8192);
    LAS int* pe = (LAS int*)(lds + 40960); LAS float* pw = (LAS float*)(lds + 41472); LAS int* cw = (LAS int*)(lds + 41984); LAS int* baseL = (LAS int*)(lds + 42048);
    const float* mod = (const float*)(P.ws + WS_MOD); const int b = wgi >> 5; const float* ml = mod + ((size_t)1 * 8 + b) * 6144; const float* gvec = P.in[5] + D;
    for (int c = tid; c < D; c += NTHR) { gm[c] = gvec[c] * (1.f + ml[4096 + c]); shv[c] = ml[3072 + c]; }
    { const float* wr = P.in[18]; for (int i = tid; i < D * NE; i += NTHR) { const int c = i >> 3, e = i & 7; wrT[e * D + c] = wr[i]; } }
    __syncthreads();
#if defined(TSDBG)
    if (wgi == 0 && tid == 0) ((unsigned long long*)(P.ws + WS_CTL) + 16384)[100] = __builtin_amdgcn_s_memrealtime();
#endif
    f32x4 wreg[8][4];
#pragma unroll
    for (int e = 0; e < 8; ++e)
#pragma unroll
        for (int j = 0; j < 4; ++j) wreg[e][j] = *(const LAS f32x4*)(wrT + e * D + 4 * lane + 256 * j);
    float brv[8];
#pragma unroll
    for (int e = 0; e < 8; ++e) brv[e] = P.in[19][e];
    f32x4 hq[3][4];
    row_load<false>(xin + (size_t)(wgi * 64 + wave * 8) * D, lane, hq[0]); row_load<false>(xin + (size_t)(wgi * 64 + wave * 8 + 1) * D, lane, hq[1]);
#pragma unroll
    for (int i = 0; i < 8; ++i) { const int rl = wave * 8 + i, row = wgi * 64 + rl; f32x4 h[4];
        if (i < 6) row_load<false>(xin + (size_t)(row + 2) * D, lane, hq[(i + 2) % 3]);
#pragma unroll
        for (int j = 0; j < 4; ++j) h[j] = hq[i % 3][j];
        row_finish(gm, shv, lane, h);
        float lg[8];
#pragma unroll
        for (int e = 0; e < 8; ++e) { float s = 0.f;
#pragma unroll
            for (int j = 0; j < 4; ++j) { const f32x4 w4 = wreg[e][j]; s = fmaf(h[j].x, w4.x, s); s = fmaf(h[j].y, w4.y, s); s = fmaf(h[j].z, w4.z, s); s = fmaf(h[j].w, w4.w, s); }
            lg[e] = s; }
        {
            float w4[4], u2[2];
#pragma unroll
            for (int i = 0; i < 4; ++i) { const bool hi1 = lane & 1; const float keep = hi1 ? lg[2 * i + 1] : lg[2 * i], send = hi1 ? lg[2 * i] : lg[2 * i + 1]; w4[i] = keep + __shfl_xor(send, 1); }
#pragma unroll
            for (int i = 0; i < 2; ++i) { const bool hi2 = lane & 2; const float keep = hi2 ? w4[2 * i + 1] : w4[2 * i], send = hi2 ? w4[2 * i] : w4[2 * i + 1]; u2[i] = keep + __shfl_xor(send, 2); }
            const bool hi4 = lane & 4; float z = (hi4 ? u2[1] : u2[0]) + __shfl_xor(hi4 ? u2[0] : u2[1], 4);
            z += __shfl_xor(z, 8); z += __shfl_xor(z, 16); z += __shfl_xor(z, 32);
#pragma unroll
            for (int e = 0; e < 8; ++e) lg[e] = __uint_as_float((unsigned)__builtin_amdgcn_readlane((int)__float_as_uint(z), e)) + brv[e];
        }
        int e1 = 0; float v1 = lg[0];
#pragma unroll
        for (int e = 1; e < 8; ++e) if (lg[e] > v1) { v1 = lg[e]; e1 = e; }
        int e2 = -1; float v2 = -3.0e38f;
#pragma unroll
        for (int e = 0; e < 8; ++e) if (e != e1 && lg[e] > v2) { v2 = lg[e]; e2 = e; }
        const float p2 = __expf(v2 - v1), inv = 1.f / (1.f + p2);
        if (lane == 0) { pe[2 * rl] = e1; pe[2 * rl + 1] = e2; pw[2 * rl] = inv; pw[2 * rl + 1] = p2 * inv; }
        { LAS unsigned* r4 = (LAS unsigned*)(lds + 65536 + rl * 1024) + lane;
#pragma unroll
          for (int j = 0; j < 4; ++j) r4[64 * j] = pk4_fp8(h[j].x * H8_SCALE, h[j].y * H8_SCALE, h[j].z * H8_SCALE, h[j].w * H8_SCALE); } }
    __syncthreads();
#if defined(TSDBG)
    if (wgi == 0 && tid == 0) ((unsigned long long*)(P.ws + WS_CTL) + 16384)[101] = __builtin_amdgcn_s_memrealtime();
#endif
    int e = 0, rank = 0;
    if (tid < 128) { e = pe[tid];
#pragma unroll
        for (int ee = 0; ee < 8; ++ee) { const unsigned long long mk = __ballot(e == ee); if (e == ee) rank = __popcll(mk & ((1ull << lane) - 1ull)); if (lane == 0) cw[wave * 8 + ee] = __popcll(mk); } }
    __syncthreads();
    if (tid < 8) { const int tot = cw[tid] + cw[8 + tid]; unsigned* cnt = (unsigned*)(P.ws + WS_CTL) + CW_CNT + 64 * tid;
        baseL[tid] = (int)__hip_atomic_fetch_add(cnt, (unsigned)tot, __ATOMIC_RELAXED, __HIP_MEMORY_SCOPE_AGENT); }
    __syncthreads();
    if (tid < 128) { const int slot = baseL[e] + rank + (wave == 1 ? cw[e] : 0); const int token = wgi * 64 + (tid >> 1);
        ((float*)(P.ws + WS_WL))[e * M + slot] = pw[tid]; ((int*)(P.ws + WS_PAIR))[token * 2 + (tid & 1)] = e * M + slot; pe[tid] = e * M + slot; }
    __syncthreads();
#if defined(TSDBG)
    if (wgi == 0 && tid == 0) ((unsigned long long*)(P.ws + WS_CTL) + 16384)[102] = __builtin_amdgcn_s_memrealtime();
#endif
    for (int i = 0; i < 16; ++i) { const int p = wave * 16 + i; const int dst = pe[p];
        const v4u v = *(const LAS v4u*)(lds + 65536 + (p >> 1) * 1024 + lane * 16); *(GAS v4u*)(P.ws + WS_HG + (size_t)dst * D + lane * 16) = v; }
    __syncthreads();
}
__device__ __forceinline__ void moe_tables(const Params& P, LAS unsigned char* lds, int tid) {
    LAS int* tab = (LAS int*)(lds + MOETAB_OFF);
    if (tid == 0) { const unsigned* ctl = (const unsigned*)(P.ws + WS_CTL); int rb = 0;
        for (int e = 0; e < 8; ++e) { int c = (int)__hip_atomic_load(ctl + CW_CNT + 64 * e, __ATOMIC_RELAXED, __HIP_MEMORY_SCOPE_AGENT); c = c < 0 ? 0 : (c > M ? M : c); tab[e] = rb; tab[9 + e] = c; rb += (c + 255) & ~255; }
        tab[8] = rb; }
    __syncthreads();
}
__device__ __forceinline__ void gather_phase(const Params& P, LAS unsigned char* lds, const float* xin, int tid, int lane, int wave, int gw) {
    LAS float* gmA = (LAS float*)lds; LAS float* shA = (LAS float*)(lds + 32768); const LAS int* tab = (const LAS int*)(lds + MOETAB_OFF);
    const float* mod1 = (const float*)(P.ws + WS_MOD) + (size_t)8 * 6144; const float* gvec = P.in[5] + D;
    for (int i = tid; i < 8 * D; i += NTHR) { const int b = i >> 10, c = i & 1023; gmA[i] = gvec[c] * (1.f + mod1[b * 6144 + 4096 + c]); shA[i] = mod1[b * 6144 + 3072 + c]; }
    __syncthreads();
    const int ptot = tab[8]; const int* list = (const int*)(P.ws + WS_LIST); const float* wl = (const float*)(P.ws + WS_WL); float* wlg = (float*)(P.ws + WS_WLG); unsigned char* HG = (unsigned char*)(P.ws + WS_HG);
    for (int p = gw; p < ptot; p += NGW) {
        int e = 0;
#pragma unroll
        for (int k = 1; k < 8; ++k) e += (p >= tab[k]);
        const int slot = p - tab[e], cn = tab[9 + e]; const bool valid = slot < cn; const int token = list[e * M + (valid ? slot : cn - 1)]; const int b = token >> 11;
        f32x4 h[4]; norm_row(xin + (size_t)token * D, gmA + b * D, shA + b * D, lane, h);
        { GAS unsigned* o4 = (GAS unsigned*)(HG + (size_t)p * D) + lane;
#pragma unroll
          for (int j = 0; j < 4; ++j) o4[64 * j] = pk4_fp8(h[j].x * H8_SCALE, h[j].y * H8_SCALE, h[j].z * H8_SCALE, h[j].w * H8_SCALE); }
        if (lane == 0) wlg[p] = valid ? wl[e * M + slot] : 0.f;
    }
    __syncthreads();
}
__device__ __forceinline__ void combine_phase(const Params& P, LAS unsigned char* lds, int lane, int gw) {
    const LAS int* tab = (const LAS int*)(lds + MOETAB_OFF); const int* pair = (const int*)(P.ws + WS_PAIR); const bf16* F = (const bf16*)(P.ws + WS_F);
    const float* mod1 = (const float*)(P.ws + WS_MOD) + (size_t)8 * 6144;
    for (int t = gw; t < M; t += NGW) {
        const int pa = pair[2 * t], pb = pair[2 * t + 1]; const int ra = tab[pa >> 14] + (pa & 16383), rb = tab[pb >> 14] + (pb & 16383); const int b = t >> 11;
        const bf16* FP = (const bf16*)(P.ws + WS_FP);
        f32x4 fs[4];
#pragma unroll
        for (int j = 0; j < 4; ++j) fs[j] = (f32x4){0.f, 0.f, 0.f, 0.f};
#pragma unroll
        for (int side = 0; side < 2; ++side) { const int r = side ? rb : ra;
            if (r < 32768) { const GAS v2u* fp = (const GAS v2u*)(F + (size_t)r * D) + lane;
#pragma unroll
                for (int j = 0; j < 4; ++j) { const v2u a = fp[64 * j]; fs[j] = fs[j] + (f32x4){__uint_as_float(a.x << 16), __uint_as_float(a.x & 0xffff0000u), __uint_as_float(a.y << 16), __uint_as_float(a.y & 0xffff0000u)}; } }
            else for (int ks = 0; ks < 7; ++ks) { const GAS v2u* fp = (const GAS v2u*)(FP + ((size_t)ks * 2048 + (r - 32768)) * D) + lane;
#pragma unroll
                for (int j = 0; j < 4; ++j) { const v2u a = fp[64 * j]; fs[j] = fs[j] + (f32x4){__uint_as_float(a.x << 16), __uint_as_float(a.x & 0xffff0000u), __uint_as_float(a.y << 16), __uint_as_float(a.y & 0xffff0000u)}; } } }
        GAS f32x4* xo = (GAS f32x4*)(P.out + (size_t)t * D) + lane; const GAS f32x4* g2 = (const GAS f32x4*)(mod1 + b * 6144 + 5120) + lane;
#pragma unroll
        for (int j = 0; j < 4; ++j) xo[64 * j] = xo[64 * j] + g2[64 * j] * fs[j];
    }
}

__device__ __forceinline__ void conv_stage(const bf16* Z, LAS unsigned char* zt, int unit, int tid) {
    const int tok0 = unit * 32, tp0 = tok0 & (S_ - 1);
#pragma unroll
    for (int i = 0; i < 8; ++i) { const int idx = i * NTHR + tid;
        if (idx < 62 * 64) { const int row = idx >> 6, pc = idx & 63; const bool ok = tp0 + row - 30 >= 0;
            v4u v = *(const GAS v4u*)(Z + (size_t)(tok0 + (ok ? row - 30 : -tp0)) * DC + pc * 8); if (!ok) v = (v4u){0u, 0u, 0u, 0u};
            *(LAS v4u*)(zt + idx * 16) = v; } }
}
__device__ __forceinline__ void conv_unit(const LAS unsigned char* zt, const float (&w)[CW], float bias, bf16* YC, const float* lg, const float* lb, LAS float* tile, int unit, int tid, int wave, int lane) {
    const int tok0 = unit * 32, c = tid;
    const LAS bf16* zc = (const LAS bf16*)zt + c;
#pragma unroll
    for (int half = 0; half < 2; ++half) {
        float in[46];
#pragma unroll
        for (int i = 0; i < 46; ++i) in[i] = bf2f(zc[(16 * half + i) * DC]);
#pragma unroll
        for (int q = 0; q < 16; ++q) { float a = bias;
#pragma unroll
            for (int j = 0; j < CW; ++j) a += w[j] * in[q + j];
            tile[(16 * half + q) * DC + c] = a; }
    }
    __syncthreads();
    const f32x4 g0 = *(const f32x4*)(lg + lane * 8), g1 = *(const f32x4*)(lg + lane * 8 + 4), b0 = *(const f32x4*)(lb + lane * 8), b1 = *(const f32x4*)(lb + lane * 8 + 4);
#pragma unroll
    for (int tt = 0; tt < 4; ++tt) { const int t = wave * 4 + tt;
        f32x4 v0 = *(const LAS f32x4*)(tile + t * DC + lane * 8), v1 = *(const LAS f32x4*)(tile + t * DC + lane * 8 + 4);
        const float mean = wave_sum((v0.x + v0.y) + (v0.z + v0.w) + (v1.x + v1.y) + (v1.z + v1.w)) * (1.f / DC);
        v0 = v0 - mean; v1 = v1 - mean;
        const float var = wave_sum((v0.x * v0.x + v0.y * v0.y) + (v0.z * v0.z + v0.w * v0.w) + (v1.x * v1.x + v1.y * v1.y) + (v1.z * v1.z + v1.w * v1.w)) * (1.f / DC);
        const float rstd = __builtin_amdgcn_rsqf(var + EPS);
        f32x4 y0 = v0 * rstd * g0 + b0, y1 = v1 * rstd * g1 + b1;
#pragma unroll
        for (int i = 0; i < 4; ++i) { y0[i] = y0[i] * sigm(y0[i]); y1[i] = y1[i] * sigm(y1[i]); }
        v4u o; o.x = pk2(y0.x, y0.y); o.y = pk2(y0.z, y0.w); o.z = pk2(y1.x, y1.y); o.w = pk2(y1.z, y1.w);
        *(GAS v4u*)(YC + (size_t)(tok0 + t) * D + lane * 8) = o; }
    __syncthreads();
}
__device__ __forceinline__ int crow(int r, int hi) { return (r & 3) + 8 * (r >> 2) + 4 * hi; }
#define MFMA32(a, b, c) __builtin_amdgcn_mfma_f32_32x32x16_bf16((a), (b), (c), 0, 0, 0)
__device__ __forceinline__ void attn_stage(const LAS unsigned char* stage, int kc0, int n, int qh, int r32, int hi, int lane, const LAS float* btile, const bf16x8 (&qf)[4], const f32x16& cinit, f32x16& o0, f32x16& o1, float& l) {
    const int fsw = (r32 >> 1) & 7;
#pragma unroll
    for (int sub = 0; sub < 2; ++sub) {
        const int kc = kc0 + sub; const LAS unsigned char* buf = stage + sub * 16384;
        if (kc >= n - 8 && kc <= n) {
            bf16x8 kf[2][4], vf[2][2][2]; f32x16 sc[2];
#pragma unroll
            for (int kb = 0; kb < 2; ++kb)
#pragma unroll
                for (int d0 = 0; d0 < 4; ++d0) kf[kb][d0] = *(const LAS bf16x8*)(buf + (kb * 32 + r32) * 128 + (((2 * d0 + hi) ^ fsw) << 4));
            if (n - kc >= 3) { sc[0] = cinit; sc[1] = cinit; }
            else {
#pragma unroll
                for (int kb = 0; kb < 2; ++kb) { const LAS f32x4* tp = (const LAS f32x4*)(btile + ((qh * 6 + (n - kc) * 2 + kb) * 4) * 256) + lane;
#pragma unroll
                    for (int q4 = 0; q4 < 4; ++q4) { const f32x4 t4 = tp[q4 * 64]; sc[kb][4 * q4] = t4.x; sc[kb][4 * q4 + 1] = t4.y; sc[kb][4 * q4 + 2] = t4.z; sc[kb][4 * q4 + 3] = t4.w; } } }
#pragma unroll
            for (int kb = 0; kb < 2; ++kb)
#pragma unroll
                for (int db = 0; db < 2; ++db)
#pragma unroll
                    for (int s2 = 0; s2 < 2; ++s2) vf[kb][db][s2] = *(const LAS bf16x8*)(buf + 8192 + (db * 32 + r32) * 128 + (((kb * 4 + 2 * s2 + hi) ^ fsw) << 4));
#pragma unroll
            for (int d0 = 0; d0 < 4; ++d0) { sc[0] = MFMA32(kf[0][d0], qf[d0], sc[0]); sc[1] = MFMA32(kf[1][d0], qf[d0], sc[1]); }
            float ps0 = 0.f, ps1 = 0.f;
#pragma unroll
            for (int r = 0; r < 16; ++r) { sc[0][r] = __builtin_amdgcn_exp2f(sc[0][r]); ps0 += sc[0][r]; }
#pragma unroll
            for (int r = 0; r < 16; ++r) { sc[1][r] = __builtin_amdgcn_exp2f(sc[1][r]); ps1 += sc[1][r]; }
            l += ps0 + ps1;
            bf16x8 pb[2][2];
#pragma unroll
            for (int kb = 0; kb < 2; ++kb) { v4u p0, p1;
                p0.x = pk2(sc[kb][0], sc[kb][1]); p0.y = pk2(sc[kb][2], sc[kb][3]); p0.z = pk2(sc[kb][4], sc[kb][5]); p0.w = pk2(sc[kb][6], sc[kb][7]);
                p1.x = pk2(sc[kb][8], sc[kb][9]); p1.y = pk2(sc[kb][10], sc[kb][11]); p1.z = pk2(sc[kb][12], sc[kb][13]); p1.w = pk2(sc[kb][14], sc[kb][15]);
                pb[kb][0] = __builtin_bit_cast(bf16x8, p0); pb[kb][1] = __builtin_bit_cast(bf16x8, p1); }
#pragma unroll
            for (int kb = 0; kb < 2; ++kb)
#pragma unroll
                for (int s2 = 0; s2 < 2; ++s2) { o0 = MFMA32(vf[kb][0][s2], pb[kb][s2], o0); o1 = MFMA32(vf[kb][1][s2], pb[kb][s2], o1); }
        }
    }
}
__device__ __forceinline__ void attn_unit(const bf16* Q, const bf16* K, const bf16* VT, bf16* YC, const LAS float* btile, float c0, LAS unsigned char* kv, int b, int h, int g, int tid, int wave, int lane) {
    const int r32 = lane & 31, hi = lane >> 5;
    const int n0 = 4 * g, n = n0 + (wave >> 1), qh = wave & 1;
    const size_t rowq = (size_t)b * S_ + n * 64 + qh * 32 + r32;
    bf16x8 qf[4];
#pragma unroll
    for (int d0 = 0; d0 < 4; ++d0) qf[d0] = *(const GAS bf16x8*)(Q + rowq * DC + h * 64 + d0 * 16 + hi * 8);
    float l = 0.f; f32x16 o0, o1, cinit;
#pragma unroll
    for (int r = 0; r < 16; ++r) { o0[r] = 0.f; o1[r] = 0.f; cinit[r] = c0; }
    const int kc_lo = n0 - 8 < 0 ? 0 : n0 - 8, nt = (n0 + 4 - kc_lo) >> 1;
    const int lrow = tid >> 3, lc = tid & 7, lsw = (lrow >> 1) & 7; const int kofs = lrow * 128 + ((lc ^ lsw) << 4);
    const int vofs0 = lrow * 128 + ((((lc & 6) | 0) ^ lsw) << 4) + (lc & 1) * 8, vofs1 = lrow * 128 + ((((lc & 6) | 1) ^ lsw) << 4) + (lc & 1) * 8;
    const bf16* kg = K + ((size_t)b * S_ + lrow) * DC + h * 64 + lc * 8 + (size_t)kc_lo * 64 * DC;
    const bf16* vg = VT + (size_t)(h * 64 + lrow) * M + (size_t)b * S_ + lc * 8 + kc_lo * 64;
#define ATT_GET(t, R) do { R[0] = *(const GAS v4u*)(kg + (size_t)(2 * (t)) * 64 * DC); R[1] = *(const GAS v4u*)(vg + (2 * (t)) * 64); R[2] = *(const GAS v4u*)(kg + (size_t)(2 * (t) + 1) * 64 * DC); R[3] = *(const GAS v4u*)(vg + (2 * (t) + 1) * 64); } while (0)
#define ATT_PUT(base, R) do { *(LAS v4u*)((base) + kofs) = R[0]; *(LAS v2u*)((base) + 8192 + vofs0) = (v2u){R[1].x, R[1].y}; *(LAS v2u*)((base) + 8192 + vofs1) = (v2u){R[1].z, R[1].w}; \
        *(LAS v4u*)((base) + 16384 + kofs) = R[2]; *(LAS v2u*)((base) + 24576 + vofs0) = (v2u){R[3].x, R[3].y}; *(LAS v2u*)((base) + 24576 + vofs1) = (v2u){R[3].z, R[3].w}; } while (0)
    v4u RA[4], RB[4];
    ATT_GET(0, RA); ATT_GET(1, RB);
    ATT_PUT(kv, RA);
    __syncthreads();
    asm volatile("" : "+v"(qf[0]), "+v"(qf[1]), "+v"(qf[2]), "+v"(qf[3]));
    for (int t = 0; t < nt; t += 2) {
        { const int tg = t + 2 < nt ? t + 2 : nt - 1; ATT_GET(tg, RA); }
        attn_stage(kv, kc_lo + 2 * t, n, qh, r32, hi, lane, btile, qf, cinit, o0, o1, l);
        ATT_PUT(kv + 32768, RB);
        __syncthreads();
        { const int tg = t + 3 < nt ? t + 3 : nt - 1; ATT_GET(tg, RB); }
        attn_stage(kv + 32768, kc_lo + 2 * t + 2, n, qh, r32, hi, lane, btile, qf, cinit, o0, o1, l);
        if (t + 2 < nt) ATT_PUT(kv, RA);
        __syncthreads();
    }
#undef ATT_PUT
#undef ATT_GET
    l += __shfl_xor(l, 32); const float il = 1.f / l;
    bf16* yp = YC + rowq * D + DC + h * 64 + 4 * hi;
#pragma unroll
    for (int gq = 0; gq < 4; ++gq) { v2u w0, w1; w0.x = pk2(o0[4 * gq] * il, o0[4 * gq + 1] * il); w0.y = pk2(o0[4 * gq + 2] * il, o0[4 * gq + 3] * il);
        w1.x = pk2(o1[4 * gq] * il, o1[4 * gq + 1] * il); w1.y = pk2(o1[4 * gq + 2] * il, o1[4 * gq + 3] * il);
        *(GAS v2u*)(yp + 8 * gq) = w0; *(GAS v2u*)(yp + 32 + 8 * gq) = w1; }
}
__device__ __forceinline__ void mixer_phase(const Params& P, LAS unsigned char* lds, int l, int tid, int lane, int wave, int wgi) {
#if defined(TSDBG)
    if (wgi == 0 && tid == 0) ((unsigned long long*)(P.ws + WS_CTL) + 16384)[40 + 4 * l] = __builtin_amdgcn_s_memrealtime();
#endif
    LAS unsigned char* zt = lds; LAS float* tile = (LAS float*)(lds + 63488); LAS float* biasL = (LAS float*)(lds + LDSCTL_OFF + 1024); LAS unsigned char* kv = lds + 49152;
    { const float* rb = P.in[14] + l * 8 * NREL; for (int i = tid; i < 8 * NREL; i += NTHR) biasL[i] = rb[i] * LOG2E; }
    __syncthreads();
    const bf16* Z = (const bf16*)(P.ws + WS_Z); const bf16* Q = (const bf16*)(P.ws + WS_Q); const bf16* K = (const bf16*)(P.ws + WS_K); const bf16* VT = (const bf16*)(P.ws + WS_VT); bf16* YC = (bf16*)(P.ws + WS_YC);
    {   float w[CW]; const float* cw = P.in[8] + l * CW * DC;
#pragma unroll
        for (int j = 0; j < CW; ++j) w[j] = cw[j * DC + tid];
        const float cbias = P.in[9][l * DC + tid];
        for (int cu = 0; cu < 2; ++cu) { conv_stage(Z, zt, wgi * 2 + cu, tid); __syncthreads();
            conv_unit(zt, w, cbias, YC, P.in[10] + l * DC, P.in[11] + l * DC, tile, wgi * 2 + cu, tid, wave, lane); } }
#if defined(TSDBG)
    if (wgi == 0 && tid == 0) ((unsigned long long*)(P.ws + WS_CTL) + 16384)[40 + 4 * l + 1] = __builtin_amdgcn_s_memrealtime();
#endif
#if defined(TSDBG)
    if (tid == 0) atomicMax((unsigned long long*)(P.ws + WS_CTL) + 16384 + 74 + l, (unsigned long long)__builtin_amdgcn_s_memrealtime());
#endif
    { const int b = wgi >> 5, h = (wgi >> 2) & 7, gp = wgi & 3;
      LAS float* btl = (LAS float*)lds;
      float Bref; { LAS float* red = (LAS float*)(lds + 49152);
          float gq = 0.f, gk = 0.f, bm = 0.f;
          if (tid < 64) { gq = fabsf(P.in[12][l * 64 + tid]); gk = fabsf(P.in[13][l * 64 + tid]); }
          if (tid < NREL) bm = fabsf(biasL[h * NREL + tid]);
#pragma unroll
          for (int o = 1; o < 64; o <<= 1) { gq = fmaxf(gq, __shfl_xor(gq, o)); gk = fmaxf(gk, __shfl_xor(gk, o)); bm = fmaxf(bm, __shfl_xor(bm, o)); }
          if (lane == 0) { red[wave] = gq; red[8 + wave] = gk; red[16 + wave] = bm; }
          __syncthreads();
          gq = red[0]; gk = red[8]; bm = fmaxf(fmaxf(fmaxf(red[16], red[17]), fmaxf(red[18], red[19])), red[20]);
          Bref = 1.02f * (LOG2E * 8.f * gq * gk + bm); }
#pragma unroll
      for (int k = 0; k < 24; ++k) { const int i = tid + NTHR * k; const int jbq = k >> 1, qh = jbq / 6, jb = jbq % 6;
          const int ln = (i >> 2) & 63, r = ((i >> 8) & 3) * 4 + (i & 3);
          int rel = -64 * (jb >> 1) + 32 * (jb & 1) - 32 * qh + crow(r, ln >> 5) - (ln & 31); rel = rel < -128 ? -128 : (rel > 128 ? 128 : rel); btl[i] = biasL[h * NREL + rel + 128] - Bref; }
      const float b0 = biasL[h * NREL] - Bref;
      __syncthreads();
      for (int rp = 0; rp < 1 + ((REPMASK >> 21) & 1); ++rp)
#if defined(TSDBG)
      if ((wgi == 0 || wgi == 3) && tid == 0) ((unsigned long long*)(P.ws + WS_CTL) + 16384)[60 + 8 * l + (wgi ? 4 : 0)] = __builtin_amdgcn_s_memrealtime();
#endif
#if defined(TSDBG)
      const unsigned long long att_t0 = __builtin_amdgcn_s_memrealtime();
#endif
      for (int au = 0; au < 2; ++au) attn_unit(Q, K, VT, YC, btl, b0, kv, b, h, au ? 7 - gp : gp, tid, wave, lane);
      __syncthreads();
#if defined(TSDBG)
      if ((wgi == 0 || wgi == 3) && tid == 0) ((unsigned long long*)(P.ws + WS_CTL) + 16384)[61 + 8 * l + (wgi ? 4 : 0)] = __builtin_amdgcn_s_memrealtime();
#endif
#if defined(TSDBG)
      if (tid == 0) { const unsigned long long dt = __builtin_amdgcn_s_memrealtime() - att_t0; atomicMax((unsigned long long*)(P.ws + WS_CTL) + 16384 + 80 + 4 * l + gp, dt); }
#endif
      const int mlo = FILL_S2 + l * FILL_MIX;
      if constexpr (FILL_MIX > 0) {
      if (gp == 0) moe_fill_run(P, lds, mlo + (wgi >> 2) * NWAVES + wave, 64 * NWAVES, mlo + (FILL_MIX * 3) / 4, lane, wave);
      else if (gp == 1) moe_fill_run(P, lds, mlo + (FILL_MIX * 3) / 4 + (wgi >> 2) * NWAVES + wave, 64 * NWAVES, mlo + FILL_MIX, lane, wave); } }
    __syncthreads();
#if defined(TSDBG)
    if (wgi == 0 && tid == 0) ((unsigned long long*)(P.ws + WS_CTL) + 16384)[40 + 4 * l + 2] = __builtin_amdgcn_s_memrealtime();
    if (tid == 0) atomicMax((unsigned long long*)(P.ws + WS_CTL) + 16384 + 70 + l, (unsigned long long)__builtin_amdgcn_s_memrealtime());
#endif
}

#define PHASE(k, ...) do { { __VA_ARGS__ } if constexpr ((REPMASK >> (k)) & 1) { xcd_barrier(bar); RETID(); { __VA_ARGS__ } } } while (0)
__global__ void __launch_bounds__(NTHR, 2) fwd(Params P) {
    extern __shared__ __attribute__((aligned(16))) unsigned char lds_raw[];
    LAS unsigned char* lds = (LAS unsigned char*)lds_raw;
    int tid = threadIdx.x, lane = tid & 63, wave = __builtin_amdgcn_readfirstlane(tid >> 6); const int wgi = blockIdx.x; int gw = wgi * NWAVES + wave;
#define RETID() do { tid = threadIdx.x; asm volatile("" : "+v"(tid)); lane = tid & 63; wave = __builtin_amdgcn_readfirstlane(tid >> 6); gw = wgi * NWAVES + wave; } while (0)
    for (int u = tid; u < (LDS_BYTES - LDSCTL_OFF) / 4; u += NTHR) ((LAS unsigned*)(lds + LDSCTL_OFF))[u] = 0u;
    __syncthreads();
    unsigned* ctl = (unsigned*)(P.ws + WS_CTL);
    XcdBarrier bar = xcd_barrier_post(ctl + CW_BAR, (volatile LAS unsigned*)(lds + MISC_OFF) + 8);
    const int stop = P.stop;
#if defined(TSDBG)
    unsigned long long* tsbuf = (unsigned long long*)(P.ws + WS_CTL) + 16384;
    int tsn = 0;
#define STAMP() do { if (wgi == 0 && tid == 0) tsbuf[tsn] = __builtin_amdgcn_s_memrealtime(); ++tsn; } while (0)
#else
#define STAMP() do {} while (0)
#endif
    STAMP();
#define SEAM(k) do { if (stop == (k)) return; xcd_barrier(bar); RETID(); STAMP(); } while (0)
    bf16* H = (bf16*)(P.ws + WS_H); float* mod = (float*)(P.ws + WS_MOD); const float* XB = (const float*)(P.ws + WS_XB);

    PHASE(0, phase0(P, lds, tid, lane, wave, gw););                                                      SEAM(0);
    PHASE(1, norm_phase<false>(P, lds, P.in[0], P.in[4], 0, 0, 1024, true, tid, lane, wave, wgi););             SEAM(1);
#define LAYER_COMMON(l, pb, xin) \
    PHASE(2,   \
        const bf16* Wl = (const bf16*)(P.ws + WS_WIN) + (size_t)(l) * DIN * D; \
        { pg8::Gemm g{H, Wl, M, 2048, D, 0}; pg8::StaticOrder S; S.init(M, 2048, GRID, wgi); \
          pg8::EpiInProj<FUSE_NORM && (l) != 0> E{(bf16*)(P.ws + WS_Z), (bf16*)(P.ws + WS_Q), (bf16*)(P.ws + WS_K), P.in[12] + (l) * 64, P.in[13] + (l) * 64, QSCALE, (const float*)(P.ws + WS_SS2), (const float*)(P.ws + WS_CIN)}; \
          pg8::gemm_phase<pg8::EpiInProj<FUSE_NORM && (l) != 0>, pg8::StaticOrder, true, true>(lds, g, S, E); } \
        { pg8::Gemm g{Wl + (size_t)2048 * D, H, 512, M, D, 0}; pg8::StaticOrder S; S.init(512, M, GRID, wgi); \
          pg8::EpiBf16<FUSE_NORM && (l) != 0> E{(bf16*)(P.ws + WS_VT), M, 1.f, 0, (const float*)(P.ws + WS_SS2), (const float*)(P.ws + WS_CIN) + 2048}; \
          pg8::gemm_phase<pg8::EpiBf16<FUSE_NORM && (l) != 0>, pg8::StaticOrder, true, true>(lds, g, S, E); } \
        if (FUSE_NORM && (l) == 0) cvec_fill(P, lds, tid, lane, wave, wgi); \
        moe_filler(P, lds, (l) == 0 ? 0 : FILL_S1, (l) == 0 ? FILL_S0 : FILL_S2, lane, wave, wgi); ); \
    SEAM(pb); \
    PHASE(3, mixer_phase(P, lds, (l), tid, lane, wave, wgi);); \
    SEAM((pb) + 1); \
    PHASE(4 + 10 * (l),   \
        pg8::Gemm g{(const bf16*)(P.ws + WS_YC), (const bf16*)(P.ws + WS_WOUT) + (size_t)(l) * D * D, M, D, D, 0}; pg8::StaticOrder S; S.init(M, D, GRID, wgi); \
        pg8::EpiResGate<FUSE_NORM && (l) == 0, (l) != 0, (l) == 0> E{(l) == 0 ? P.in[0] : XB, (l) == 0 ? (float*)XB : P.out, mod + (size_t)(l) * 8 * 6144 + 2048, H, (float*)(P.ws + WS_SS1), P.in[5], mod + 4096};   \
        pg8::gemm_phase<pg8::EpiResGate<FUSE_NORM && (l) == 0, (l) != 0, (l) == 0>, pg8::StaticOrder, true, true>(lds, g, S, E); ); \
    SEAM((pb) + 2);

    LAYER_COMMON(0, 2, P.in[0])
    if constexpr (!FUSE_NORM) { PHASE(5, norm_phase<true>(P, lds, XB, P.in[5], 0, 3072, 4096, false, tid, lane, wave, wgi);); SEAM(5); }
    PHASE(6, pg8::Gemm g{H, (const bf16*)(P.ws + WS_WGU), M, 2 * FFD, D, 0}; pg8::StaticOrder S; S.init(M, 2 * FFD, GRID, wgi);
             pg8::EpiSwiGLU<false, FUSE_NORM != 0> E{(bf16*)(P.ws + WS_ACT), FFD, nullptr, 1.f, 1.f, (const float*)(P.ws + WS_SS1), (const float*)(P.ws + WS_CFF), 2 * FFD};
             pg8::gemm_phase<pg8::EpiSwiGLU<false, FUSE_NORM != 0>, pg8::StaticOrder, true, true>(lds, g, S, E);
             moe_filler(P, lds, FILL_S0, FILL_S1, lane, wave, wgi););
    SEAM(6);
    PHASE(30, pg8::Gemm g{(const bf16*)(P.ws + WS_ACT), (const bf16*)(P.ws + WS_WD), M, D, FFD, 0}; pg8::StaticOrder S; S.init(M, D, GRID, wgi);
              pg8::EpiResGate<FUSE_NORM != 0, true, true> E{XB, (float*)XB, mod + 5120, H, (float*)(P.ws + WS_SS2), P.in[4] + D, mod + (size_t)8 * 6144 + 1024};
              pg8::gemm_phase<pg8::EpiResGate<FUSE_NORM != 0, true, true>, pg8::StaticOrder, true, true>(lds, g, S, E););
    SEAM(7);
    if constexpr (!FUSE_NORM) { PHASE(8, norm_phase<true>(P, lds, XB, P.in[4] + D, 1, 0, 1024, false, tid, lane, wave, wgi);); SEAM(8); }
    LAYER_COMMON(1, 9, P.out)
    PHASE(31, router_phase(P, lds, P.out, tid, lane, wave, wgi););                                       SEAM(12);
    moe_tables(P, lds, tid);
    {
        const LAS int* tab = (const LAS int*)(lds + MOETAB_OFF);
        const int ptot = RFL(tab[8]);
        PHASE(11, pg8::Gemm g{(const bf16*)(P.ws + WS_HG), (const bf16*)(P.ws + WS_WMGU), ptot, 2 * FFE, D, (unsigned)(2 * FFE * D)};
                  pg8::MoeOrder S; S.nM = ptot >> 8; S.nN = 2 * FFE / 256; S.nwg = S.nM * S.nN; S.G = GRID; S.c = wgi; S.capA = true;
                  S.t1 = RFL(tab[1] >> 8); S.t2 = RFL(tab[2] >> 8); S.t3 = RFL(tab[3] >> 8); S.t4 = RFL(tab[4] >> 8); S.t5 = RFL(tab[5] >> 8); S.t6 = RFL(tab[6] >> 8); S.t7 = RFL(tab[7] >> 8);
                  pg8::EpiSwiGLU<true, false> E{(bf16*)(P.ws + WS_ACTM), FFE, (const float*)(P.ws + WS_WL), A8_SCALE / (H8_SCALE * W8_SCALE), 1.f / (H8_SCALE * W8_SCALE), nullptr, nullptr, 0};
                  pg8::gemm_phase<pg8::EpiSwiGLU<true, false>, pg8::MoeOrder, true, true, true>(lds, g, S, E););
        if constexpr ((REPMASK >> 22) & 1) { xcd_barrier(bar); RETID();
                  pg8::Gemm g{(const bf16*)(P.ws + WS_HG), (const bf16*)(P.ws + WS_WMGU), ptot, 2 * FFE, D, (unsigned)(2 * FFE * D)};
                  pg8::MoeOrder S; S.nM = ptot >> 8; S.nN = 2 * FFE / 256; S.nwg = S.nM * S.nN; S.G = GRID; S.c = wgi; S.capA = true;
                  S.t1 = RFL(tab[1] >> 8); S.t2 = RFL(tab[2] >> 8); S.t3 = RFL(tab[3] >> 8); S.t4 = RFL(tab[4] >> 8); S.t5 = RFL(tab[5] >> 8); S.t6 = RFL(tab[6] >> 8); S.t7 = RFL(tab[7] >> 8);
                  pg8::EpiNone E{};
                  pg8::gemm_phase<pg8::EpiNone, pg8::MoeOrder, true, true, true>(lds, g, S, E); }
        SEAM(14);
        PHASE(12, const int tall = ptot >> 8, tmain = tall < 128 ? tall : 128;
                  { pg8::Gemm g{(const bf16*)(P.ws + WS_ACTM), (const bf16*)(P.ws + WS_WMD), ptot, D, FFE, (unsigned)(D * FFE), 0};
                    pg8::MoeOrder S; S.nM = tmain; S.nN = D / 256; S.nwg = S.nM * S.nN; S.G = GRID; S.c = wgi; S.capA = false;
                    S.t1 = RFL(tab[1] >> 8); S.t2 = RFL(tab[2] >> 8); S.t3 = RFL(tab[3] >> 8); S.t4 = RFL(tab[4] >> 8); S.t5 = RFL(tab[5] >> 8); S.t6 = RFL(tab[6] >> 8); S.t7 = RFL(tab[7] >> 8);
                    pg8::EpiBf16<false> E{(bf16*)(P.ws + WS_F), D, 1.f / (A8_SCALE * W8_SCALE), 0, nullptr, nullptr};
                    pg8::gemm_phase<pg8::EpiBf16<false>, pg8::MoeOrder, true, true, true>(lds, g, S, E); }
                  if (tall > 128) { pg8::Gemm g{(const bf16*)(P.ws + WS_ACTM), (const bf16*)(P.ws + WS_WMD), ptot, D, FFE / pg8::RemOrder::NSPLIT, (unsigned)(D * FFE), FFE};
                    pg8::RemOrder S; S.tm0 = 128; S.nrem = tall - 128; S.G = GRID; S.c = wgi;
                    S.t1 = RFL(tab[1] >> 8); S.t2 = RFL(tab[2] >> 8); S.t3 = RFL(tab[3] >> 8); S.t4 = RFL(tab[4] >> 8); S.t5 = RFL(tab[5] >> 8); S.t6 = RFL(tab[6] >> 8); S.t7 = RFL(tab[7] >> 8);
                    pg8::EpiBf16<false> E{(bf16*)(P.ws + WS_FP) - (size_t)128 * 256 * D, D, 1.f / (A8_SCALE * W8_SCALE), (size_t)2048 * D, nullptr, nullptr};
                    pg8::gemm_phase<pg8::EpiBf16<false>, pg8::RemOrder, true, true, true>(lds, g, S, E); } );
        SEAM(15);
        PHASE(29, combine_phase(P, lds, lane, gw););
        __syncthreads(); STAMP();
    }
#undef SEAM
}
static int launch_fast(void* const* d_in, float* out, unsigned char* ws, hipStream_t stream, int stop) {
    static int ready = 0;
    if (ready == 0) {
        if (hipFuncSetAttribute((const void*)fwd, hipFuncAttributeMaxDynamicSharedMemorySize, LDS_BYTES) != hipSuccess) { fprintf(stderr, "kernel_launch: hipFuncSetAttribute failed\n"); ready = -1; return -1; }
        int per_cu = 0; if (hipOccupancyMaxActiveBlocksPerMultiprocessor(&per_cu, (const void*)fwd, NTHR, LDS_BYTES) != hipSuccess || per_cu < 1) fprintf(stderr, "kernel_launch: occupancy query reports %d blocks per CU\n", per_cu);
        (void)hipGetLastError(); ready = 1;
    }
    if (ready < 0) return -1;
    if (hipMemsetAsync(ws + WS_CTL, 0, CTL_ZERO_BYTES, stream) != hipSuccess) return -1;
    Params p{}; for (int i = 0; i < 23; ++i) p.in[i] = (const float*)d_in[i]; p.out = out; p.ws = ws; p.stop = stop; p.pad = 0;
    hipLaunchKernelGGL(fwd, dim3(GRID), dim3(NTHR), LDS_BYTES, stream, p);
    return hipPeekAtLastError() == hipSuccess ? 0 : -1;
}
}
#ifndef DBG_STAGE
#define DBG_STAGE 0
#endif
extern "C" void kernel_launch(void* const* d_in, const int* in_sizes, int n_in, void* d_out, int out_size, void* d_ws, size_t ws_size, hipStream_t stream) {
    if (n_in != 23 || out_size != fk::M * fk::D || ws_size < fk::WS_END) { fprintf(stderr, "kernel_launch: unexpected shapes / workspace (%d inputs, out %d, ws %zu)\n", n_in, out_size, ws_size); return; }
    unsigned char* ws = (unsigned char*)d_ws; float* out = (float*)d_out;
#if DBG_STAGE == 0
    fk::launch_fast(d_in, out, ws, stream, -1);
#elif defined(TSDBG)
    fk::launch_fast(d_in, out, ws, stream, -1);
    nv::k_savets<<<1, 64, 0, stream>>>((const unsigned long long*)ws + 16384, (float*)(ws + 389 * ((size_t)1 << 20)), TS_A0, TS_A1, TS_B0, TS_B1);
    nv::forward(d_in, out, ws, stream);
    nv::k_encode<<<(unsigned)(((size_t)fk::M * 1024 + 255) / 256), 256, 0, stream>>>(out, (size_t)fk::M * 1024, (const float*)(ws + 389 * ((size_t)1 << 20)));
#else
    constexpr int S = DBG_STAGE; constexpr size_t MiB = 1u << 20;
    float* ckf = (float*)(ws + 390 * MiB); float* acc = (float*)(ws + 389 * MiB);
    int stop = -1; size_t off = 0, n = 0; float scale = 1.f; bool isf32 = false;
    const size_t NM = (size_t)fk::M;
    switch (S) {
        case 1: stop = 1; off = fk::WS_H; n = NM * 1024; break;
        case 2: stop = 2; off = fk::WS_Z; n = NM * 512; break;
        case 3: stop = 2; off = fk::WS_Q; n = NM * 512; scale = 1.f / fk::QSCALE; break;
        case 4: stop = 2; off = fk::WS_K; n = NM * 512; break;
        case 5: stop = 3; off = fk::WS_YC; n = NM * 1024; break;
        case 6: stop = 4; isf32 = true; n = NM * 1024; break;
        case 7: stop = 5; off = fk::WS_H; n = NM * 1024; break;
        case 8: stop = 6; off = fk::WS_ACT; n = NM * 1024; break;
        case 9: stop = 7; isf32 = true; n = NM * 1024; break;
        case 11: stop = 8; off = fk::WS_H; n = NM * 1024; break;
        case 12: stop = 9; off = fk::WS_Z; n = NM * 512; break;
        case 13: stop = 9; off = fk::WS_Q; n = NM * 512; scale = 1.f / fk::QSCALE; break;
        case 14: stop = 9; off = fk::WS_K; n = NM * 512; break;
        case 15: stop = 10; off = fk::WS_YC; n = NM * 1024; break;
        case 16: stop = 11; isf32 = true; n = NM * 1024; break;
        default: stop = -1; isf32 = true; n = NM * 1024; break;
    }
    fk::launch_fast(d_in, out, ws, stream, stop);
    if (isf32) nv::k_copy<<<(unsigned)((n + 255) / 256), 256, 0, stream>>>(out, ckf, n);
    else nv::k_cvt<<<(unsigned)((n + 255) / 256), 256, 0, stream>>>((const unsigned short*)(ws + off), ckf, n, scale);
    hipMemsetAsync(acc, 0, 256, stream);
    nv::forward(d_in, out, ws, stream, S, ckf, acc);
    if (S == 99) nv::k_cmp<<<1024, 256, 0, stream>>>(ckf, out, n, acc);
    nv::k_scale<<<(unsigned)((NM * 1024 + 255) / 256), 256, 0, stream>>>(out, NM * 1024, acc);
#endif
}
```

```cpp
#include <hip/hip_runtime.h>
#include <cstdio>
#include <cstdint>
#define DBG_STAGE 0
#define REPMASK 0
namespace pg8 {
#define PG8_LAS __attribute__((address_space(3)))
typedef unsigned short bf16_t;
typedef short bf16x8 __attribute__((ext_vector_type(8)));
typedef float f32x4 __attribute__((ext_vector_type(4)));
typedef unsigned u32x4 __attribute__((ext_vector_type(4)));
constexpr int BM = 256, BK = 64, HALF = 128, HTB = HALF * BK * 2  , STAGE_BYTES = 8 * HTB, NXCD = 8, WGM = 8;

__host__ __device__ __forceinline__ int lds_byte(int r, int c) { const int st = (r >> 4) * 2 + (c >> 5), rr = r & 15, cc = c & 31, ob = rr * 64 + cc * 2; return st * 1024 + (ob ^ (((ob >> 9) & 1) << 5)); }
__host__ __device__ __forceinline__ void stage_rc(int b, int& R, int& C) { const int st = b / 1024, sb = b % 1024, swz = sb ^ (((sb >> 9) & 1) << 5); R = (st >> 1) * 16 + swz / 64; C = (st & 1) * 32 + (swz % 64) / 2; }
__host__ __device__ __forceinline__ int perm32(int rho) { const int n = rho >> 4, i = rho & 15; return 8 * (i >> 2) + 4 * n + (i & 3); }

struct Unit { int pm, pn, e, pa, ks; };
struct Gemm { const bf16_t* A; const bf16_t* Bt; int M, N, K; unsigned bstride; int ld; };

struct StaticOrder {
    int nM, nN, nwg, G, c;
    __device__ void init(int M, int N, int G_, int c_) { nM = M / BM; nN = N / BM; nwg = nM * nN; G = G_; c = c_; }
    __device__ bool next(int i, Unit& u) const {
        const long L = (long)i * G + c; if (L >= nwg) return false;
        int wgid = (int)L; { const int q = nwg / NXCD, r = nwg % NXCD, xcd = wgid % NXCD, off = wgid / NXCD; wgid = (xcd < r ? xcd * (q + 1) : r * (q + 1) + (xcd - r) * q) + off; }
        const int nig = WGM * nN, gid = wgid / nig, fm = gid * WGM, gsz = (nM - fm) < WGM ? (nM - fm) : WGM;
        u.pm = fm + ((wgid % nig) % gsz); u.pn = (wgid % nig) / gsz; u.e = 0; u.pa = u.pm; u.ks = 0; return true;
    }
    __device__ __forceinline__ void a_ready(const Unit&) const {}
    __device__ __forceinline__ void done(const Unit&) const {}
};
struct MoeOrder {
    int nM, nN, nwg, G, c; int t1, t2, t3, t4, t5, t6, t7; bool capA;
    __device__ bool next(int i, Unit& u) const {
        const long L = (long)i * G + c; if (L >= nwg) return false;
        int wgid = (int)L; { const int q = nwg / NXCD, r = nwg % NXCD, xcd = wgid % NXCD, off = wgid / NXCD; wgid = (xcd < r ? xcd * (q + 1) : r * (q + 1) + (xcd - r) * q) + off; }
        const int nig = WGM * nN, gid = wgid / nig, fm = gid * WGM, gsz = (nM - fm) < WGM ? (nM - fm) : WGM;
        u.pm = fm + ((wgid % nig) % gsz); u.pn = (wgid % nig) / gsz;
        const int p = u.pm; u.e = (p >= t1) + (p >= t2) + (p >= t3) + (p >= t4) + (p >= t5) + (p >= t6) + (p >= t7);
        if (capA) { int ts = 0; ts = p >= t1 ? t1 : ts; ts = p >= t2 ? t2 : ts; ts = p >= t3 ? t3 : ts; ts = p >= t4 ? t4 : ts; ts = p >= t5 ? t5 : ts; ts = p >= t6 ? t6 : ts; ts = p >= t7 ? t7 : ts; u.pa = u.e * 64 + (p - ts); }
        else u.pa = p;
        u.ks = 0; return true;
    }
    __device__ __forceinline__ void a_ready(const Unit&) const {}
    __device__ __forceinline__ void done(const Unit&) const {}
};

struct RemOrder {
    int tm0, nrem, G, c; int t1, t2, t3, t4, t5, t6, t7; static constexpr int NSPLIT = 7;
    __device__ bool next(int i, Unit& u) const {
        const int L = i * G + c; if (L >= nrem * 4 * NSPLIT) return false;
        u.ks = L % NSPLIT; u.pn = (L / NSPLIT) & 3; u.pm = tm0 + L / (4 * NSPLIT); u.pa = u.pm;
        const int p = u.pm; u.e = (p >= t1) + (p >= t2) + (p >= t3) + (p >= t4) + (p >= t5) + (p >= t6) + (p >= t7); return true;
    }
    __device__ __forceinline__ void a_ready(const Unit&) const {}
    __device__ __forceinline__ void done(const Unit&) const {}
};
__device__ __forceinline__ unsigned cvt_pk_bf16(float lo, float hi) { unsigned r; asm volatile("v_cvt_pk_bf16_f32 %0, %1, %2" : "=v"(r) : "v"(lo), "v"(hi)); return r; }
typedef int v8i __attribute__((ext_vector_type(8))); typedef int v4i __attribute__((ext_vector_type(4)));
__device__ __forceinline__ v8i cat8(bf16x8 lo, bf16x8 hi) { const v4i a = __builtin_bit_cast(v4i, lo), b = __builtin_bit_cast(v4i, hi); return __builtin_shufflevector(a, b, 0, 1, 2, 3, 4, 5, 6, 7); }
__device__ __forceinline__ unsigned pk4_fp8(float a, float b, float c, float d) { int w = __builtin_amdgcn_cvt_pk_fp8_f32(a, b, 0, false); w = __builtin_amdgcn_cvt_pk_fp8_f32(c, d, w, true); return (unsigned)w; }
__device__ __forceinline__ float sigm(float x) { return __builtin_amdgcn_rcpf(1.f + __builtin_amdgcn_exp2f(-1.4426950408889634f * x)); }
__device__ __forceinline__ u32x4 pack8(f32x4 v0, f32x4 v1) { u32x4 w; w.x = cvt_pk_bf16(v0[0], v0[1]); w.y = cvt_pk_bf16(v0[2], v0[3]); w.z = cvt_pk_bf16(v1[0], v1[1]); w.w = cvt_pk_bf16(v1[2], v1[3]); return w; }

template <bool NORM> struct EpiBf16 {
    static constexpr bool PERM = true, AFTER_DRAIN = false;
    bf16_t* O; int ldc; float scale; size_t slab;
    const float* ss; const float* cvec;
    __device__ __forceinline__ void operator()(const f32x4 (&acc)[2][2][4][2], const Unit& u, int wr, int wc, int fr, int fq) const {
        const int row0 = u.pm * BM + wr * 64 + fr; const int col0 = u.pn * BM + wc * 32 + 8 * fq;
        f32x4 rc[2][2];
        if constexpr (NORM) {
#pragma unroll
            for (int bj = 0; bj < 2; ++bj)
#pragma unroll
                for (int n = 0; n < 2; ++n) { const f32x4 q = *(const f32x4*)(ss + col0 + bj * HALF + 4 * n);
#pragma unroll
                    for (int i = 0; i < 4; ++i) rc[bj][n][i] = __builtin_amdgcn_rsqf(q[i] * (1.f / 1024.f) + 1e-6f); } }
#pragma unroll
        for (int ai = 0; ai < 2; ++ai)
#pragma unroll
            for (int m = 0; m < 4; ++m) { bf16_t* rowp = O + (size_t)u.ks * slab + (size_t)(row0 + ai * HALF + m * 16) * ldc + col0;
#pragma unroll
                for (int bj = 0; bj < 2; ++bj) { f32x4 v0 = acc[ai][bj][m][0] * scale, v1 = acc[ai][bj][m][1] * scale;
                    if constexpr (NORM) { const float cb = cvec[(size_t)(u.pn >> 3) * 2560 + row0 + ai * HALF + m * 16]; v0 = v0 * rc[bj][0] + cb; v1 = v1 * rc[bj][1] + cb; }
                    *(u32x4*)(rowp + bj * HALF) = pack8(v0, v1); } }
    }
};
template <bool NORM> struct EpiInProj {
    static constexpr bool PERM = true, AFTER_DRAIN = false;
    bf16_t *Z, *Q, *Kt; const float *qg, *kg; float qscale;
    const float* ss; const float* cvec;
    __device__ __forceinline__ void operator()(const f32x4 (&acc)[2][2][4][2], const Unit& u, int wr, int wc, int fr, int fq) const {
        const int row0 = u.pm * BM + wr * 64 + fr;
        f32x4 cv[2][2]; float rr[2][4];
#pragma unroll
        for (int bj = 0; bj < 2; ++bj)
#pragma unroll
            for (int n = 0; n < 2; ++n) { if constexpr (NORM) cv[bj][n] = *(const f32x4*)(cvec + (size_t)(u.pm >> 3) * 2560 + u.pn * BM + bj * HALF + wc * 32 + 8 * fq + 4 * n); else cv[bj][n] = (f32x4){0.f, 0.f, 0.f, 0.f}; }
#pragma unroll
        for (int ai = 0; ai < 2; ++ai)
#pragma unroll
            for (int m = 0; m < 4; ++m) { if constexpr (NORM) rr[ai][m] = __builtin_amdgcn_rsqf(ss[row0 + ai * HALF + m * 16] * (1.f / 1024.f) + 1e-6f); else rr[ai][m] = 1.f; }
#define VAL(ai, bj, m, n) (NORM ? acc[ai][bj][m][n] * rr[ai][m] + cv[bj][n] : acc[ai][bj][m][n])
        if (u.pn < 4) {
            const int col0 = u.pn * 128 + wc * 32 + 8 * fq;
#pragma unroll
            for (int ai = 0; ai < 2; ++ai)
#pragma unroll
                for (int m = 0; m < 4; ++m) { f32x4 z0, z1;
                    const f32x4 a0 = VAL(ai, 0, m, 0), a1 = VAL(ai, 0, m, 1), g0 = VAL(ai, 1, m, 0), g1 = VAL(ai, 1, m, 1);
#pragma unroll
                    for (int i = 0; i < 4; ++i) { z0[i] = a0[i] * sigm(g0[i]); z1[i] = a1[i] * sigm(g1[i]); }
                    *(u32x4*)(Z + (size_t)(row0 + ai * HALF + m * 16) * 512 + col0) = pack8(z0, z1); }
        } else {
            const bool isq = u.pn < 6; bf16_t* O = isq ? Q : Kt; const float* gv = isq ? qg : kg; const float sc = isq ? qscale : 1.f;
            const int head = 4 * (u.pn & 1) + wc;
            f32x4 gw[2][2];
#pragma unroll
            for (int bj = 0; bj < 2; ++bj)
#pragma unroll
                for (int n = 0; n < 2; ++n) gw[bj][n] = *(const f32x4*)(gv + 32 * bj + 8 * fq + 4 * n) * sc;
#pragma unroll
            for (int ai = 0; ai < 2; ++ai)
#pragma unroll
                for (int m = 0; m < 4; ++m) { float hs = 0.f; f32x4 xv[2][2];
#pragma unroll
                    for (int bj = 0; bj < 2; ++bj)
#pragma unroll
                        for (int n = 0; n < 2; ++n) { const f32x4 x = VAL(ai, bj, m, n); xv[bj][n] = x; hs += (x[0] * x[0] + x[1] * x[1]) + (x[2] * x[2] + x[3] * x[3]); }
                    hs += __shfl_xor(hs, 16); hs += __shfl_xor(hs, 32);
                    const float r = __builtin_amdgcn_rsqf(hs * (1.f / 64.f) + 1e-6f);
                    bf16_t* rowp = O + (size_t)(row0 + ai * HALF + m * 16) * 512 + head * 64 + 8 * fq;
#pragma unroll
                    for (int bj = 0; bj < 2; ++bj) *(u32x4*)(rowp + 32 * bj) = pack8(xv[bj][0] * r * gw[bj][0], xv[bj][1] * r * gw[bj][1]); }
        }
#undef VAL
    }
};
template <bool NORM, bool INBF = false, bool OUTBF = false> struct EpiResGate {
    static constexpr bool PERM = false, AFTER_DRAIN = false;
    const float* xin; float* out; const float* gate;
    bf16_t* xg; float* ss; const float* gnext; const float* scnext;
    __device__ __forceinline__ void operator()(const f32x4 (&acc)[2][2][4][2], const Unit& u, int wr, int wc, int fr, int fq) const {
        const int row0 = u.pm * BM + wr * 64 + fr, col0 = u.pn * BM + wc * 32 + 4 * fq; const float* gp = gate + (size_t)(u.pm >> 3) * 6144 + col0;
        f32x4 gv[2][2], gm[2][2];
#pragma unroll
        for (int bj = 0; bj < 2; ++bj)
#pragma unroll
            for (int n = 0; n < 2; ++n) { gv[bj][n] = *(const f32x4*)(gp + bj * HALF + n * 16);
                if constexpr (NORM) gm[bj][n] = *(const f32x4*)(gnext + col0 + bj * HALF + n * 16) * (*(const f32x4*)(scnext + (size_t)(u.pm >> 3) * 6144 + col0 + bj * HALF + n * 16) + 1.f); }
#pragma unroll
        for (int ai = 0; ai < 2; ++ai)
#pragma unroll
            for (int m = 0; m < 4; ++m) { const int row = row0 + ai * HALF + m * 16; const size_t off = (size_t)row * 1024 + col0; float sq = 0.f;
#pragma unroll
                for (int bj = 0; bj < 2; ++bj)
#pragma unroll
                    for (int n = 0; n < 2; ++n) { typedef unsigned u32x2b __attribute__((ext_vector_type(2))); f32x4 xv;
                        if constexpr (INBF) { const u32x2b q = *(const u32x2b*)((const bf16_t*)xin + off + bj * HALF + n * 16); xv = (f32x4){__uint_as_float(q.x << 16), __uint_as_float(q.x & 0xffff0000u), __uint_as_float(q.y << 16), __uint_as_float(q.y & 0xffff0000u)}; }
                        else xv = *(const f32x4*)(xin + off + bj * HALF + n * 16);
                        const f32x4 xn = xv + gv[bj][n] * acc[ai][bj][m][n];
                        if constexpr (OUTBF) { u32x2b w; w.x = cvt_pk_bf16(xn[0], xn[1]); w.y = cvt_pk_bf16(xn[2], xn[3]); *(u32x2b*)((bf16_t*)out + off + bj * HALF + n * 16) = w; }
                        else *(f32x4*)(out + off + bj * HALF + n * 16) = xn;
                        if constexpr (NORM) { sq += (xn[0] * xn[0] + xn[1] * xn[1]) + (xn[2] * xn[2] + xn[3] * xn[3]); const f32x4 t = xn * gm[bj][n];
                            typedef unsigned u32x2 __attribute__((ext_vector_type(2))); u32x2 w; w.x = cvt_pk_bf16(t[0], t[1]); w.y = cvt_pk_bf16(t[2], t[3]); *(u32x2*)(xg + off + bj * HALF + n * 16) = w; } }
                if constexpr (NORM) { sq += __shfl_xor(sq, 16); sq += __shfl_xor(sq, 32); if (fq == 0) atomicAdd(ss + row, sq); } }
    }
};
template <bool F8OUT, bool NORM> struct EpiSwiGLU {
    static constexpr bool PERM = true, AFTER_DRAIN = false;
    bf16_t* O; int ldc; const float* rowscale; float oscale, iscale;
    const float* ss; const float* cvec;
    int ncv;
    __device__ __forceinline__ void operator()(const f32x4 (&acc)[2][2][4][2], const Unit& u, int wr, int wc, int fr, int fq) const {
        const int row0 = u.pm * BM + wr * 64 + fr; const int col0 = u.pn * 128 + wc * 32 + 8 * fq;
        f32x4 cg[2], cu[2];
        if constexpr (NORM) { const float* cp = cvec + (size_t)(u.pm >> 3) * ncv + u.pn * BM + wc * 32 + 8 * fq; cg[0] = *(const f32x4*)cp; cg[1] = *(const f32x4*)(cp + 4); cu[0] = *(const f32x4*)(cp + HALF); cu[1] = *(const f32x4*)(cp + HALF + 4); }
#pragma unroll
        for (int ai = 0; ai < 2; ++ai)
#pragma unroll
            for (int m = 0; m < 4; ++m) { const int row = row0 + ai * HALF + m * 16; const float rs = (rowscale ? rowscale[row + (u.pa - u.pm) * BM] : 1.f) * oscale;   f32x4 z0, z1;
                if constexpr (NORM) { const float r = __builtin_amdgcn_rsqf(ss[row] * (1.f / 1024.f) + 1e-6f);
#pragma unroll
                    for (int i = 0; i < 4; ++i) { const float g0 = r * acc[ai][0][m][0][i] + cg[0][i], g1 = r * acc[ai][0][m][1][i] + cg[1][i], u0 = r * acc[ai][1][m][0][i] + cu[0][i], u1 = r * acc[ai][1][m][1][i] + cu[1][i];
                        z0[i] = g0 * sigm(g0) * u0 * rs; z1[i] = g1 * sigm(g1) * u1 * rs; } }
                else {
#pragma unroll
                for (int i = 0; i < 4; ++i) { const float g0 = acc[ai][0][m][0][i] * iscale, g1 = acc[ai][0][m][1][i] * iscale;
                    z0[i] = g0 * sigm(g0) * acc[ai][1][m][0][i] * rs; z1[i] = g1 * sigm(g1) * acc[ai][1][m][1][i] * rs; } }
                if constexpr (F8OUT) { typedef unsigned u32x2 __attribute__((ext_vector_type(2))); u32x2 w; w.x = pk4_fp8(z0[0], z0[1], z0[2], z0[3]); w.y = pk4_fp8(z1[0], z1[1], z1[2], z1[3]);
                    *(u32x2*)((unsigned char*)O + (size_t)row * ldc + col0) = w; }
                else *(u32x4*)(O + (size_t)row * ldc + col0) = pack8(z0, z1); }
    }
};
struct EpiNone {
    static constexpr bool PERM = true, AFTER_DRAIN = false;
    __device__ __forceinline__ void operator()(const f32x4 (&acc)[2][2][4][2], const Unit& u, int wr, int wc, int fr, int fq) const {
#pragma unroll
        for (int ai = 0; ai < 2; ++ai)
#pragma unroll
            for (int bj = 0; bj < 2; ++bj)
#pragma unroll
                for (int m = 0; m < 4; ++m)
#pragma unroll
                    for (int n = 0; n < 2; ++n) asm volatile("" :: "v"(acc[ai][bj][m][n]));
    }
};
__device__ __forceinline__ const char* uptr(const char* p) { unsigned long long v = (unsigned long long)p; const unsigned lo = __builtin_amdgcn_readfirstlane((unsigned)v), hi = __builtin_amdgcn_readfirstlane((unsigned)(v >> 32)); unsigned long long r = ((unsigned long long)hi << 32) | lo; asm volatile("" : "+s"(r)); return (const char*)r; }
template <class Epi, class Sched, bool ALIGN_EPI = false, bool SP2 = false, bool FP8 = false>
__device__ __forceinline__ void gemm_phase(PG8_LAS unsigned char* lds, const Gemm g, const Sched& S, const Epi& E) {
    int tid_ = threadIdx.x; asm volatile("" : "+v"(tid_)); const int tid = tid_, wid = __builtin_amdgcn_readfirstlane(tid >> 6), lane = tid & 63, wr = wid >> 2, wc = wid & 3, fr = lane & 15, fq = lane >> 4;
    const int KB0 = FP8 ? g.K : g.K * 2, nt = KB0 / (BK * 2), KB = g.ld ? (FP8 ? g.ld : g.ld * 2) : KB0;
    unsigned voffA, voffB;
    { int R, C; stage_rc(tid * 16, R, C); const int Rb = Epi::PERM ? ((R & ~31) + perm32(R & 31)) : R;
        voffA = (unsigned)(R * KB + C * 2); voffB = (unsigned)(Rb * KB + C * 2); }
    const unsigned pstep = 64u * KB;
    constexpr unsigned kstep = BK * 2;
    const unsigned hstep = (unsigned)HALF * KB;
    const unsigned tstep = 2 * hstep;
    const unsigned ldsw = (unsigned)wid * 1024u;
    const int aoff = lds_byte(wr * 64 + fr, fq * 8), boff = lds_byte(wc * 32 + fr, fq * 8);
#define PG8_SA(b, h) (((b) * 2 + (h)) * HTB)
#define PG8_SB(b, h) ((4 + (b) * 2 + (h)) * HTB)
#define PG8_STAGE(bufoff, gbase, voff) do { unsigned vo_ = (voff); asm volatile("" : "+v"(vo_));   \
        _Pragma("unroll") for (int _i = 0; _i < 2; ++_i) \
        __builtin_amdgcn_global_load_lds((const unsigned*)((const char*)(gbase) + _i * pstep + vo_), (PG8_LAS unsigned*)(lds + (bufoff) + ldsw + _i * 8192), 16, 0, 0); } while (0)
#define PG8_LDA(dst, b, h) do { _Pragma("unroll") for (int m = 0; m < 4; ++m) { if constexpr (FP8) { const v4i lo_ = *(const PG8_LAS v4i*)(lds + PG8_SA(b, h) + aoff + m * 2048), hi_ = *(const PG8_LAS v4i*)(lds + PG8_SA(b, h) + aoff + m * 2048 + 1024); dst##8[m] = __builtin_shufflevector(lo_, hi_, 0, 1, 2, 3, 4, 5, 6, 7); } \
        else { _Pragma("unroll") for (int k = 0; k < 2; ++k) dst[m][k] = *(const PG8_LAS bf16x8*)(lds + PG8_SA(b, h) + aoff + m * 2048 + k * 1024); } } } while (0)
#define PG8_LDB(dst, b, h) do { _Pragma("unroll") for (int n = 0; n < 2; ++n) { if constexpr (FP8) { const v4i lo_ = *(const PG8_LAS v4i*)(lds + PG8_SB(b, h) + boff + n * 2048), hi_ = *(const PG8_LAS v4i*)(lds + PG8_SB(b, h) + boff + n * 2048 + 1024); dst##8[n] = __builtin_shufflevector(lo_, hi_, 0, 1, 2, 3, 4, 5, 6, 7); } \
        else { _Pragma("unroll") for (int k = 0; k < 2; ++k) dst[n][k] = *(const PG8_LAS bf16x8*)(lds + PG8_SB(b, h) + boff + n * 2048 + k * 1024); } } } while (0)
#define PG8_MMA(ai, bj, At, Bt) do { __builtin_amdgcn_s_setprio(1); _Pragma("unroll") for (int m = 0; m < 4; ++m) _Pragma("unroll") for (int n = 0; n < 2; ++n) { \
        if constexpr (FP8) asm volatile("v_mfma_f32_16x16x128_f8f6f4 %0, %1, %2, %0" : "+v"(acc[ai][bj][m][n]) : "v"(Bt##8[n]), "v"(At##8[m]));   \
        else { _Pragma("unroll") for (int k = 0; k < 2; ++k) acc[ai][bj][m][n] = __builtin_amdgcn_mfma_f32_16x16x32_bf16(Bt[n][k], At[m][k], acc[ai][bj][m][n], 0, 0, 0); } } \
        __builtin_amdgcn_s_setprio(0); } while (0)
#define PG8_WAIT_V(n) asm volatile("s_waitcnt vmcnt(" #n ")" ::: "memory")
#define PG8_WAIT_L(n) asm volatile("s_waitcnt lgkmcnt(" #n ")" ::: "memory")
#define PG8_BAR __builtin_amdgcn_s_barrier()
#define PG8_SCHED __builtin_amdgcn_sched_barrier(0)
    Unit cur, nxt; int ui = 0;
    if (!S.next(0, cur)) return;
    f32x4 acc[2][2][4][2];
#pragma unroll
    for (int a = 0; a < 2; ++a)
#pragma unroll
        for (int b = 0; b < 2; ++b)
#pragma unroll
            for (int m = 0; m < 4; ++m)
#pragma unroll
                for (int n = 0; n < 2; ++n) acc[a][b][m][n] = (f32x4){0.f, 0.f, 0.f, 0.f};
    bf16x8 At[4][2], B0[2][2], B1[2][2]; v8i At8[4], B08[2], B18[2];
    const char* cA = (const char*)g.A + (unsigned)cur.pa * tstep + (unsigned)cur.ks * (unsigned)KB0; const char* cB = (const char*)g.Bt + (unsigned)cur.e * g.bstride + (unsigned)cur.pn * tstep + (unsigned)cur.ks * (unsigned)KB0;
    S.a_ready(cur);
    if constexpr (SP2) {
        PG8_STAGE(PG8_SB(0, 0), cB, voffB); PG8_STAGE(PG8_SB(0, 1), cB + hstep, voffB); PG8_STAGE(PG8_SA(0, 0), cA, voffA); PG8_STAGE(PG8_SA(0, 1), cA + hstep, voffA);
        if (wr == 1) PG8_BAR;
        PG8_WAIT_V(2); PG8_BAR;
        PG8_STAGE(PG8_SB(1, 0), cB + kstep, voffB); PG8_STAGE(PG8_SA(1, 0), cA + kstep, voffA); PG8_STAGE(PG8_SB(1, 1), cB + hstep + kstep, voffB);
        PG8_WAIT_V(6); PG8_BAR;
    } else {
        PG8_STAGE(PG8_SB(0, 0), cB, voffB); PG8_STAGE(PG8_SA(0, 0), cA, voffA); PG8_STAGE(PG8_SB(0, 1), cB + hstep, voffB); PG8_STAGE(PG8_SA(0, 1), cA + hstep, voffA);
        if (wr == 1) PG8_BAR;
        PG8_WAIT_V(4); PG8_BAR;
        PG8_STAGE(PG8_SB(1, 0), cB + kstep, voffB); PG8_STAGE(PG8_SA(1, 0), cA + kstep, voffA); PG8_STAGE(PG8_SB(1, 1), cB + hstep + kstep, voffB);
        PG8_WAIT_V(6); PG8_BAR;
    }
    for (;;) {
        const bool has_next = S.next(ui + 1, nxt);
        const char* nA = has_next ? (const char*)g.A + (unsigned)nxt.pa * tstep + (unsigned)nxt.ks * (unsigned)KB0 : cA; const char* nB = has_next ? (const char*)g.Bt + (unsigned)nxt.e * g.bstride + (unsigned)nxt.pn * tstep + (unsigned)nxt.ks * (unsigned)KB0 : cB;
#pragma unroll 1
        for (int t = 0; t < nt; t += 2) {
            const bool last = (t == nt - 2);
            const char* a1 = cA + (unsigned)(t + 1) * kstep;
            const char* a2 = last ? nA : cA + (unsigned)(t + 2) * kstep; const char* b2 = last ? nB : cB + (unsigned)(t + 2) * kstep;
            const char* a3 = a2 + kstep; const char* b3 = b2 + kstep;
            a1 = uptr(a1); a2 = uptr(a2); b2 = uptr(b2); a3 = uptr(a3); b3 = uptr(b3);
            if (last && has_next) S.a_ready(nxt);
            if constexpr (SP2) {
            PG8_LDB(B0, 0, 0); PG8_LDB(B1, 0, 1); PG8_SCHED; PG8_LDA(At, 0, 0); PG8_STAGE(PG8_SA(1, 1), a1 + hstep, voffA);
            PG8_WAIT_V(8); PG8_WAIT_L(0); PG8_BAR; PG8_MMA(0, 0, At, B0); PG8_MMA(0, 1, At, B1); PG8_BAR; PG8_SCHED;
            PG8_LDA(At, 0, 1); PG8_STAGE(PG8_SB(0, 0), b2, voffB); PG8_STAGE(PG8_SB(0, 1), b2 + hstep, voffB); PG8_STAGE(PG8_SA(0, 0), a2, voffA);
            PG8_WAIT_V(8); PG8_WAIT_L(0); PG8_BAR; PG8_MMA(1, 0, At, B0); PG8_MMA(1, 1, At, B1); PG8_BAR; PG8_SCHED;
            PG8_LDB(B0, 1, 0); PG8_LDB(B1, 1, 1); PG8_SCHED; PG8_LDA(At, 1, 0); PG8_STAGE(PG8_SA(0, 1), a2 + hstep, voffA);
            PG8_WAIT_V(8); PG8_WAIT_L(0); PG8_BAR; PG8_MMA(0, 0, At, B0); PG8_MMA(0, 1, At, B1); PG8_BAR; PG8_SCHED;
            PG8_LDA(At, 1, 1); PG8_STAGE(PG8_SB(1, 0), b3, voffB); PG8_STAGE(PG8_SB(1, 1), b3 + hstep, voffB); PG8_STAGE(PG8_SA(1, 0), a3, voffA);
            PG8_WAIT_V(8); PG8_WAIT_L(0); PG8_BAR; PG8_MMA(1, 0, At, B0); PG8_MMA(1, 1, At, B1); PG8_BAR; PG8_SCHED;
            } else {
            PG8_LDB(B0, 0, 0); PG8_SCHED; PG8_LDA(At, 0, 0); PG8_STAGE(PG8_SA(1, 1), a1 + hstep, voffA);
            PG8_WAIT_L(8); PG8_BAR; PG8_WAIT_L(0); PG8_MMA(0, 0, At, B0); PG8_BAR; PG8_SCHED;
            PG8_LDB(B1, 0, 1); PG8_STAGE(PG8_SB(0, 0), b2, voffB);
            PG8_BAR; PG8_WAIT_L(0); PG8_MMA(0, 1, At, B1); PG8_BAR;
            PG8_LDA(At, 0, 1); PG8_STAGE(PG8_SA(0, 0), a2, voffA);
            PG8_BAR; PG8_WAIT_L(0); PG8_MMA(1, 0, At, B0); PG8_BAR; PG8_SCHED;
            PG8_STAGE(PG8_SB(0, 1), b2 + hstep, voffB);
            PG8_WAIT_V(6); PG8_BAR; PG8_MMA(1, 1, At, B1); PG8_BAR;
            PG8_LDB(B0, 1, 0); PG8_SCHED; PG8_LDA(At, 1, 0); PG8_STAGE(PG8_SA(0, 1), a2 + hstep, voffA);
            PG8_WAIT_L(8); PG8_BAR; PG8_WAIT_L(0); PG8_MMA(0, 0, At, B0); PG8_BAR; PG8_SCHED;
            PG8_LDB(B1, 1, 1); PG8_STAGE(PG8_SB(1, 0), b3, voffB);
            PG8_BAR; PG8_WAIT_L(0); PG8_MMA(0, 1, At, B1); PG8_BAR;
            PG8_LDA(At, 1, 1); PG8_STAGE(PG8_SA(1, 0), a3, voffA);
            PG8_BAR; PG8_WAIT_L(0); PG8_MMA(1, 0, At, B0); PG8_BAR; PG8_SCHED;
            PG8_STAGE(PG8_SB(1, 1), b3 + hstep, voffB);
            PG8_WAIT_V(6); PG8_BAR; PG8_MMA(1, 1, At, B1); PG8_BAR;
            }
        }
        if constexpr (FP8) asm volatile("s_nop 15\n\ts_nop 15" ::: "memory");
        if constexpr (ALIGN_EPI) { if (wr == 0) PG8_BAR; }
        if constexpr (!Epi::AFTER_DRAIN) { int l_ = threadIdx.x; asm volatile("" : "+v"(l_)); const int fr_ = l_ & 15, fq_ = (l_ >> 4) & 3; E(acc, cur, wr, wc, fr_, fq_); S.done(cur); }
        if (!has_next) break;
#pragma unroll
        for (int a = 0; a < 2; ++a)
#pragma unroll
            for (int b = 0; b < 2; ++b)
#pragma unroll
                for (int m = 0; m < 4; ++m)
#pragma unroll
                    for (int n = 0; n < 2; ++n) acc[a][b][m][n] = (f32x4){0.f, 0.f, 0.f, 0.f};
        cur = nxt; cA = nA; cB = nB; ++ui;
        if constexpr (ALIGN_EPI) { if (wr == 1) PG8_BAR; }
    }
    PG8_WAIT_V(0);
    if constexpr (!ALIGN_EPI) { if (wr == 0) PG8_BAR; }
    PG8_BAR;
    if constexpr (Epi::AFTER_DRAIN) { E.fused(acc, cur, wr, wc, fr, fq, lds, wid, lane); S.done(cur); }
#undef PG8_SA
#undef PG8_SB
#undef PG8_STAGE
#undef PG8_LDA
#undef PG8_LDB
#undef PG8_MMA
#undef PG8_WAIT_V
#undef PG8_WAIT_L
#undef PG8_BAR
#undef PG8_SCHED
}
}

namespace fk {
using pg8::bf16_t; using pg8::bf16x8; using pg8::f32x4; using pg8::u32x4;
constexpr int NWAVES = 8, NTHR = 512, GRID = 256, NGW = GRID * NWAVES;
constexpr int B_ = 8, S_ = 2048, D = 1024, M = B_ * S_, DIN = 2560, DC = 512, FFD = 2816, NE = 8, FFE = 3584, CW = 31, NREL = 257;
constexpr float LOG2E = 1.4426950408889634f, QSCALE = 0.125f * LOG2E, EPS = 1e-6f;
constexpr size_t MiB = 1u << 20;
constexpr size_t WS_CTL = 0, CTL_ZERO_BYTES = 1 * MiB;
constexpr size_t WS_SS1 = 256 * 1024, WS_SS2 = 320 * 1024;
constexpr size_t WS_MODP = 1 * MiB;
constexpr size_t WS_CFF = 1 * MiB, WS_CIN = 1 * MiB + 256 * 1024;
constexpr size_t WS_MOD = 4 * MiB;
constexpr size_t WS_PAIR = 4 * MiB + 512 * 1024;
constexpr size_t WS_LIST = 5 * MiB;
constexpr size_t WS_WL = 5 * MiB + 512 * 1024;
constexpr size_t WS_WLG = 6 * MiB;
constexpr size_t WS_WMGU = 8 * MiB;
constexpr size_t WS_WMD = 120 * MiB;
constexpr size_t WS_XB = 64 * MiB;
constexpr size_t WS_FP = 148 * MiB;
constexpr size_t WS_WIN = 176 * MiB;
constexpr size_t WS_WOUT = 186 * MiB;
constexpr size_t WS_WGU = 190 * MiB;
constexpr size_t WS_WD = 201 * MiB;
constexpr size_t WS_H = 207 * MiB;
constexpr size_t WS_Z = 239 * MiB, WS_Q = 255 * MiB, WS_K = 271 * MiB, WS_VT = 287 * MiB;
constexpr size_t WS_YC = 303 * MiB;
constexpr size_t WS_ACT = 239 * MiB;
constexpr size_t WS_HG = 363 * MiB;
constexpr size_t WS_F = 176 * MiB;
constexpr size_t WS_ACTM = 244 * MiB;
constexpr size_t WS_END = 491 * MiB;
constexpr int MAXROWS = 34816;
constexpr int CW_BAR = 4096, CW_CNT = 16384;
constexpr int RING_BYTES = 131072, LDSCTL_OFF = RING_BYTES, MISC_OFF = LDSCTL_OFF + 320, MOETAB_OFF = LDSCTL_OFF + 512;
constexpr int LDS_BYTES = 147456;

#define GAS __attribute__((address_space(1)))
#define LAS __attribute__((address_space(3)))
typedef unsigned short bf16;
typedef unsigned v4u __attribute__((ext_vector_type(4)));
typedef unsigned v2u __attribute__((ext_vector_type(2)));
typedef float f32x16 __attribute__((ext_vector_type(16)));
typedef short s16x4 __attribute__((ext_vector_type(4)));
typedef float f32x2_t __attribute__((ext_vector_type(2))); typedef __bf16 bf16x2_t __attribute__((ext_vector_type(2)));
__device__ __forceinline__ unsigned pk2(float lo, float hi) { f32x2_t v = {lo, hi}; bf16x2_t b = __builtin_convertvector(v, bf16x2_t); return __builtin_bit_cast(unsigned, b); }
__device__ __forceinline__ float bf2f(bf16 v) { return __uint_as_float((unsigned)v << 16); }
#define DPP_F(v, ctrl) __uint_as_float((unsigned)__builtin_amdgcn_update_dpp(0, (int)__float_as_uint(v), (ctrl), 0xF, 0xF, true))
#define DPP_XOR1 0xB1
#define DPP_XOR2 0x4E
#define DPP_HMIRROR 0x141
#define DPP_MIRROR 0x140
#define DPP_ROR8 0x128
#define RDLANE_F(v, l) __uint_as_float((unsigned)__builtin_amdgcn_readlane((int)__float_as_uint(v), (l)))
__device__ __forceinline__ float wave_sum(float v) {
    v += DPP_F(v, DPP_XOR1); v += DPP_F(v, DPP_XOR2); v += DPP_F(v, DPP_HMIRROR); v += DPP_F(v, DPP_MIRROR);
    return (RDLANE_F(v, 0) + RDLANE_F(v, 16)) + (RDLANE_F(v, 32) + RDLANE_F(v, 48));
}
__device__ __forceinline__ float sigm(float x) { return __builtin_amdgcn_rcpf(1.f + __builtin_amdgcn_exp2f(-LOG2E * x)); }
using pg8::pk4_fp8;
constexpr float W8_SCALE = 64.f, H8_SCALE = 8.f, A8_SCALE = 4.f;
constexpr int E8_W = (127 - 6) * 0x01010101, E8_H = (127 - 3) * 0x01010101, E8_A = (127 - 2) * 0x01010101;
#define LDS_WAIT() asm volatile("s_waitcnt lgkmcnt(0)" ::: "memory")
#define RFL(x) __builtin_amdgcn_readfirstlane(x)

#define XB_TMO      128
#define XB_XCNT(j)  (256  + 64 * (j))
#define XB_XSUB(j)  (1280 + 64 * (j))
#define XB_XGEN(j)  (2304 + 64 * (j))
#define XB_TOP      3328
#define XB_TOPGEN   3392
#define XCD_BAR_WORDS 3456
#define XB_SPIN_CAP (1u << 18)

__device__ __forceinline__ unsigned xb_ld(unsigned* p)              { return __hip_atomic_load(p, __ATOMIC_RELAXED, __HIP_MEMORY_SCOPE_AGENT); }
__device__ __forceinline__ unsigned xb_add(unsigned* p, unsigned v) { return __hip_atomic_fetch_add(p, v, __ATOMIC_RELAXED, __HIP_MEMORY_SCOPE_AGENT); }
__device__ __forceinline__ unsigned xb_xcc_id() { return (unsigned)__builtin_amdgcn_s_getreg((3 << 11) | 20) & 0xFu; }
#define XB_SPIN(cond, bar) do { unsigned _sp = 0; while (cond) { __builtin_amdgcn_s_sleep(1); \
    if ((++_sp & 255u) == 0u) { if (xb_ld(&(bar)[XB_TMO])) break; if (_sp > XB_SPIN_CAP) { atomicAdd(&(bar)[XB_TMO], 1u); break; } } } } while (0)

struct XcdBarrier {
    unsigned* bar; unsigned x;
    volatile LAS unsigned* st;
};

__device__ __forceinline__ XcdBarrier xcd_barrier_post(unsigned* bar, volatile LAS unsigned* st) {
    XcdBarrier b; b.bar = bar; b.x = xb_xcc_id(); b.st = st;
    if (threadIdx.x == 0) (void)xb_add(&bar[XB_XCNT(b.x)], 1u);
    return b;
}
__device__ __forceinline__ void xcd_barrier_complete(unsigned* bar, unsigned x, unsigned& nloc, unsigned& nx) {
    const unsigned G = gridDim.x * gridDim.y * gridDim.z;
    unsigned sum, cnt, mine, sp = 0u;
    for (;;) {
        sum = 0u; cnt = 0u; mine = 0u;
#pragma unroll
        for (unsigned j = 0; j < 16; ++j) { const unsigned c = xb_ld(&bar[XB_XCNT(j)]); sum += c; cnt += (c > 0u) ? 1u : 0u; mine = (j == x) ? c : mine; }
        if (sum == G) break;
        __builtin_amdgcn_s_sleep(1);
        if ((++sp & 255u) == 0u) { if (xb_ld(&bar[XB_TMO])) break; if (sp > XB_SPIN_CAP) { atomicAdd(&bar[XB_TMO], 1u); break; } }
    }
    nloc = mine > 0u ? mine : 1u; nx = cnt > 0u ? cnt : 1u;
}

__device__ __forceinline__ void xcd_barrier(const XcdBarrier& b) {
    asm volatile("s_waitcnt vmcnt(0)" ::: "memory");
    __syncthreads();
    if (threadIdx.x == 0) {
        unsigned* bar = b.bar;
        __builtin_amdgcn_s_waitcnt(0);
        unsigned nloc = b.st[0], nx = b.st[1];
        if (nloc == 0u) { xcd_barrier_complete(bar, b.x, nloc, nx); b.st[0] = nloc; b.st[1] = nx; }
        const unsigned old = xb_add(&bar[XB_XSUB(b.x)], 1u);
        const unsigned gen = old / nloc;
        if (old + 1u == (gen + 1u) * nloc) {
            __builtin_amdgcn_fence(__ATOMIC_RELEASE, "agent");
            asm volatile("s_waitcnt vmcnt(0)" ::: "memory");
            const unsigned og = xb_add(&bar[XB_TOP], 1u);
            const unsigned tg = og / nx;
            if (og + 1u == (tg + 1u) * nx) xb_add(&bar[XB_TOPGEN], 1u);
            else XB_SPIN(xb_ld(&bar[XB_TOPGEN]) == tg, bar);
            __builtin_amdgcn_fence(__ATOMIC_ACQUIRE, "agent");
            xb_add(&bar[XB_XGEN(b.x)], 1u);
            asm volatile("s_waitcnt vmcnt(0)" ::: "memory");
        } else {
            XB_SPIN(xb_ld(&bar[XB_XGEN(b.x)]) == gen, bar);
            __builtin_amdgcn_fence(__ATOMIC_ACQUIRE, "agent");
            asm volatile("s_waitcnt vmcnt(0)" ::: "memory");
        }
    }
    __syncthreads();
}


#ifndef FUSE_NORM
#define FUSE_NORM 0
#endif
#ifndef REPMASK
#define REPMASK 0
#endif
struct Params { const float* in[23]; float* out; unsigned char* ws; int stop; int pad; };

__device__ __forceinline__ void tr_item(const float* W, int K, int N, bf16* WT, int kb, int nb, int drow0, LAS float* scr, int lane) {
    const int k0 = 64 * kb, n0 = 32 * nb;
    { f32x4 v[8];
#pragma unroll
      for (int i = 0; i < 8; ++i) v[i] = *(const GAS f32x4*)(W + (size_t)(k0 + 8 * i + (lane >> 3)) * N + n0 + (lane & 7) * 4);
#pragma unroll
      for (int i = 0; i < 8; ++i) { LAS float* d = scr + (8 * i + (lane >> 3)) * 33 + (lane & 7) * 4; d[0] = v[i].x; d[1] = v[i].y; d[2] = v[i].z; d[3] = v[i].w; } }
    LDS_WAIT(); asm volatile("" ::: "memory");
    const int c = lane & 7;
#pragma unroll
    for (int j = 0; j < 4; ++j) { const int n = (lane >> 3) + 8 * j; const LAS float* s = scr + (8 * c) * 33 + n;
        v4u o; o.x = pk2(s[0 * 33], s[1 * 33]); o.y = pk2(s[2 * 33], s[3 * 33]); o.z = pk2(s[4 * 33], s[5 * 33]); o.w = pk2(s[6 * 33], s[7 * 33]);
        *(GAS v4u*)(WT + (size_t)(drow0 + n) * K + k0 + 8 * c) = o; }
    LDS_WAIT(); asm volatile("" ::: "memory");
}
__device__ __forceinline__ void tr_item_f8(const float* W, int K, int N, unsigned char* WT, int kb, int nb, int drow0, LAS float* scr, int lane, float scale) {
    const int k0 = 64 * kb, n0 = 32 * nb;
    { f32x4 v[8];
#pragma unroll
      for (int i = 0; i < 8; ++i) v[i] = __builtin_nontemporal_load((const GAS f32x4*)(W + (size_t)(k0 + 8 * i + (lane >> 3)) * N + n0 + (lane & 7) * 4));
#pragma unroll
      for (int i = 0; i < 8; ++i) { LAS float* d = scr + (8 * i + (lane >> 3)) * 33 + (lane & 7) * 4; d[0] = v[i].x; d[1] = v[i].y; d[2] = v[i].z; d[3] = v[i].w; } }
    LDS_WAIT(); asm volatile("" ::: "memory");
    const int c = lane & 7;
#pragma unroll
    for (int j = 0; j < 4; ++j) { const int n = (lane >> 3) + 8 * j; const LAS float* s = scr + (8 * c) * 33 + n;
        v2u o; o.x = pk4_fp8(s[0 * 33] * scale, s[1 * 33] * scale, s[2 * 33] * scale, s[3 * 33] * scale); o.y = pk4_fp8(s[4 * 33] * scale, s[5 * 33] * scale, s[6 * 33] * scale, s[7 * 33] * scale);
        __builtin_nontemporal_store(o, (GAS v2u*)(WT + (size_t)(drow0 + n) * K + k0 + 8 * c)); }
    LDS_WAIT(); asm volatile("" ::: "memory");
}
__device__ __forceinline__ int rowmap_win(int n0) {
    if (n0 < 512) return 256 * (n0 >> 7) + (n0 & 127);
    if (n0 < 1024) { const int m = n0 - 512; return 256 * (m >> 7) + 128 + (m & 127); }
    if (n0 < 2048) { const int isk = n0 >= 1536; const int m = n0 - (isk ? 1536 : 1024); const int head = m >> 6, bj = (m >> 5) & 1; return 256 * (4 + 2 * isk + (head >> 2)) + 128 * bj + 32 * (head & 3); }
    return n0;
}
__device__ __forceinline__ int rowmap_gu(int n0, int up) { return 256 * (n0 >> 7) + 128 * up + (n0 & 127); }

constexpr int MOE_ITEMS = 16 * (16 * 112) + 8 * (56 * 32);
constexpr int FILL_S0 = 10240, FILL_S1 = 22528, FILL_S2 = 32768, FILL_MIX = 0, FILL_P0 = FILL_S2 + 2 * FILL_MIX;
struct MoeItem { const float* src; unsigned char* dst; int N, K; };
__device__ __forceinline__ MoeItem moe_item_decode(const Params& P, int r, int lane) {
    constexpr int I_MG = 16 * 112, I_MD = 56 * 32; MoeItem m;
    if (r < 16 * I_MG) { const int mat = r / I_MG, q = r % I_MG, e = mat >> 1, up = mat & 1; const int kb = q / 112, nb = q % 112;
        m.N = FFE; m.K = D; m.src = (up ? P.in[21] : P.in[20]) + (size_t)e * D * FFE + (size_t)(64 * kb + (lane >> 3)) * FFE + 32 * nb + (lane & 7) * 4;
        m.dst = (unsigned char*)(P.ws + WS_WMGU) + (size_t)e * 7168 * D + (size_t)rowmap_gu(32 * nb, up) * D + 64 * kb; }
    else { r -= 16 * I_MG; const int e = r / I_MD, q = r % I_MD; const int kb = q / 32, nb = q % 32;
        m.N = D; m.K = FFE; m.src = P.in[22] + (size_t)e * FFE * D + (size_t)(64 * kb + (lane >> 3)) * D + 32 * nb + (lane & 7) * 4;
        m.dst = (unsigned char*)(P.ws + WS_WMD) + (size_t)e * D * FFE + (size_t)(32 * nb) * FFE + 64 * kb; }
    return m;
}
__device__ __forceinline__ void moe_item_load(const MoeItem& m, f32x4 (&v)[8]) {
#pragma unroll
    for (int i = 0; i < 8; ++i) v[i] = __builtin_nontemporal_load((const GAS f32x4*)(m.src + (size_t)(8 * i) * m.N));
}
__device__ __forceinline__ void moe_item_finish(const MoeItem& m, const f32x4 (&v)[8], LAS float* scr, int lane) {
#pragma unroll
    for (int i = 0; i < 8; ++i) { LAS float* d = scr + (8 * i + (lane >> 3)) * 33 + (lane & 7) * 4; d[0] = v[i].x; d[1] = v[i].y; d[2] = v[i].z; d[3] = v[i].w; }
    LDS_WAIT(); asm volatile("" ::: "memory");
    const int c = lane & 7;
#pragma unroll
    for (int j = 0; j < 4; ++j) { const int n = (lane >> 3) + 8 * j; const LAS float* s = scr + (8 * c) * 33 + n;
        v2u o; o.x = pk4_fp8(s[0 * 33] * W8_SCALE, s[1 * 33] * W8_SCALE, s[2 * 33] * W8_SCALE, s[3 * 33] * W8_SCALE); o.y = pk4_fp8(s[4 * 33] * W8_SCALE, s[5 * 33] * W8_SCALE, s[6 * 33] * W8_SCALE, s[7 * 33] * W8_SCALE);
        __builtin_nontemporal_store(o, (GAS v2u*)(m.dst + (size_t)n * m.K + 8 * c)); }
    LDS_WAIT(); asm volatile("" ::: "memory");
}
__device__ __forceinline__ void moe_fill_run(const Params& P, LAS unsigned char* lds, int first, int stride, int hi, int lane, int wave);
__device__ __forceinline__ void moe_filler(const Params& P, LAS unsigned char* lds, int lo, int hi, int lane, int wave, int wgi) {
    if (wgi < 128) return;
    moe_fill_run(P, lds, lo + (wgi - 128) * NWAVES + wave, 128 * NWAVES, hi, lane, wave);
}
__device__ __forceinline__ void moe_fill_run(const Params& P, LAS unsigned char* lds, int first, int stride, int hi, int lane, int wave) {
    LAS float* scr = (LAS float*)(lds + wave * 8448);
    int it = first; if (it >= hi) return;
    MoeItem cur = moe_item_decode(P, it, lane); f32x4 v[8]; moe_item_load(cur, v);
    for (;;) { const int nx = it + stride; const bool more = nx < hi;
        MoeItem nxt = cur; f32x4 vn[8];
        if (more) { nxt = moe_item_decode(P, nx, lane); moe_item_load(nxt, vn); }
        moe_item_finish(cur, v, scr, lane);
        if (!more) break;
        cur = nxt; it = nx;
#pragma unroll
        for (int i = 0; i < 8; ++i) v[i] = vn[i];
    }
}

__device__ __forceinline__ void phase0(const Params& P, LAS unsigned char* lds, int tid, int lane, int wave, int gw) {
    LAS float* cact = (LAS float*)(lds + 69632);
    { const float* c = P.in[1]; for (int i = tid; i < B_ * D; i += NTHR) { const float v = c[i]; cact[i] = v * sigm(v); } }
    __syncthreads();
    {
        const float* w_ada = P.in[2]; float* modp = (float*)(P.ws + WS_MODP);
        for (int it = gw; it < 1536; it += NGW) {
            const int ks = it & 7, jb = (it >> 3) % 96, l = it / 768;
            const float* wp = w_ada + ((size_t)l * D + ks * 128) * 6144 + jb * 64 + lane;
            float acc[8];
#pragma unroll
            for (int b = 0; b < 8; ++b) acc[b] = 0.f;
#pragma unroll 8
            for (int k = 0; k < 128; ++k) { const float w = wp[(size_t)k * 6144];
#pragma unroll
                for (int b = 0; b < 8; ++b) acc[b] += cact[b * D + ks * 128 + k] * w; }
#pragma unroll
            for (int b = 0; b < 8; ++b) modp[(((size_t)ks * 2 + l) * 8 + b) * 6144 + jb * 64 + lane] = acc[b];
        }
    }
    LAS float* scr = (LAS float*)(lds + wave * 8448);
    constexpr int I_WIN = 16 * 80, I_WOUT = 16 * 32, I_FG = 16 * 88, I_FD = 44 * 32, I_MG = 16 * 112, I_MD = 56 * 32;
    constexpr int NITEMS = 2 * I_WIN + 2 * I_WOUT + 2 * I_FG + I_FD + 16 * I_MG + 8 * I_MD; static_assert(16 * I_MG + 8 * I_MD == MOE_ITEMS, "item counts");
    for (int it = gw; it < NITEMS - MOE_ITEMS; it += NGW) {
        int r = it;
        if (r < 2 * I_WIN) { const int l = r / I_WIN, q = r % I_WIN; const int kb = q / 80, nb = q % 80;
            tr_item(P.in[6] + (size_t)l * D * DIN, D, DIN, (bf16*)(P.ws + WS_WIN) + (size_t)l * DIN * D, kb, nb, rowmap_win(32 * nb), scr, lane); continue; }
        r -= 2 * I_WIN;
        if (r < 2 * I_WOUT) { const int l = r / I_WOUT, q = r % I_WOUT; const int kb = q / 32, nb = q % 32;
            tr_item(P.in[7] + (size_t)l * D * D, D, D, (bf16*)(P.ws + WS_WOUT) + (size_t)l * D * D, kb, nb, 32 * nb, scr, lane); continue; }
        r -= 2 * I_WOUT;
        if (r < 2 * I_FG) { const int up = r / I_FG, q = r % I_FG; const int kb = q / 88, nb = q % 88;
            tr_item((up ? P.in[16] : P.in[15]), D, FFD, (bf16*)(P.ws + WS_WGU), kb, nb, rowmap_gu(32 * nb, up), scr, lane); continue; }
        r -= 2 * I_FG;
        { const int kb = r / 32, nb = r % 32; tr_item(P.in[17], FFD, D, (bf16*)(P.ws + WS_WD), kb, nb, 32 * nb, scr, lane); }
    }    moe_fill_run(P, lds, FILL_P0 + gw, NGW, MOE_ITEMS, lane, wave);
}

__device__ __forceinline__ void cvec_fill(const Params& P, LAS unsigned char* lds, int tid, int lane, int wave, int wgi) {
    if (wgi < 128) return;
    LAS float* shL = (LAS float*)lds;
    const float* mod = (const float*)(P.ws + WS_MOD);
    for (int i = tid; i < 2 * 8 * D; i += NTHR) { const int which = i >> 13, b = (i >> 10) & 7, k = i & 1023; shL[i] = which ? mod[((size_t)8 + b) * 6144 + k] : mod[(size_t)b * 6144 + 3072 + k]; }
    __syncthreads();
    const bf16* Wgu = (const bf16*)(P.ws + WS_WGU); const bf16* Win1 = (const bf16*)(P.ws + WS_WIN) + (size_t)DIN * D;
    float* cff = (float*)(P.ws + WS_CFF); float* cin = (float*)(P.ws + WS_CIN);
    for (int r = (wgi - 128) * NWAVES + wave; r < 2 * FFD + DIN; r += 128 * NWAVES) {
        const bool ff = r < 2 * FFD; const int n = ff ? r : r - 2 * FFD; const bf16* wr = (ff ? Wgu : Win1) + (size_t)n * D + 16 * lane;
        const v4u w0 = *(const GAS v4u*)wr, w1 = *(const GAS v4u*)(wr + 8); float wv[16];
#pragma unroll
        for (int j = 0; j < 4; ++j) { wv[2 * j] = __uint_as_float(w0[j] << 16); wv[2 * j + 1] = __uint_as_float(w0[j] & 0xffff0000u); wv[8 + 2 * j] = __uint_as_float(w1[j] << 16); wv[8 + 2 * j + 1] = __uint_as_float(w1[j] & 0xffff0000u); }
        const LAS float* sp = shL + (ff ? 0 : 8 * D) + 16 * lane; float mine = 0.f;
#pragma unroll
        for (int b = 0; b < 8; ++b) { float s = 0.f;
#pragma unroll
            for (int j = 0; j < 4; ++j) { const f32x4 s4 = *(const LAS f32x4*)(sp + b * D + 4 * j); s += (s4.x * wv[4 * j] + s4.y * wv[4 * j + 1]) + (s4.z * wv[4 * j + 2] + s4.w * wv[4 * j + 3]); }
            s = wave_sum(s); if (lane == b) mine = s; }
        if (lane < 8) (ff ? cff + (size_t)lane * (2 * FFD) : cin + (size_t)lane * DIN)[n] = mine;
    }
    __syncthreads();
}

__device__ __forceinline__ float modp_sum(const float* modp, const float* b_ada, int l, int b, int j) {
    float s = b_ada[l * 6144 + j];
#pragma unroll
    for (int ks = 0; ks < 8; ++ks) s += modp[(((size_t)ks * 2 + l) * 8 + b) * 6144 + j];
    return s;
}
template <bool INBF> __device__ __forceinline__ void row_load(const float* xrow, int lane, f32x4 (&h)[4]) {
    if constexpr (INBF) { const GAS v2u* xr = (const GAS v2u*)xrow + lane;
#pragma unroll
        for (int j = 0; j < 4; ++j) { const v2u q = xr[64 * j]; h[j] = (f32x4){__uint_as_float(q.x << 16), __uint_as_float(q.x & 0xffff0000u), __uint_as_float(q.y << 16), __uint_as_float(q.y & 0xffff0000u)}; } }
    else { const GAS f32x4* xr = (const GAS f32x4*)xrow + lane;
#pragma unroll
        for (int j = 0; j < 4; ++j) h[j] = xr[64 * j]; }
}
__device__ __forceinline__ void row_finish(const LAS float* gm, const LAS float* shv, int lane, f32x4 (&h)[4]) {
    float ss = 0.f;
#pragma unroll
    for (int j = 0; j < 4; ++j) ss += (h[j].x * h[j].x + h[j].y * h[j].y) + (h[j].z * h[j].z + h[j].w * h[j].w);
    const float r = __builtin_amdgcn_rsqf(wave_sum(ss) * (1.f / D) + EPS);
#pragma unroll
    for (int j = 0; j < 4; ++j) { const f32x4 g4 = *(const LAS f32x4*)(gm + 4 * lane + 256 * j), s4 = *(const LAS f32x4*)(shv + 4 * lane + 256 * j); h[j] = h[j] * r * g4 + s4; }
}
__device__ __forceinline__ void norm_row(const float* xrow, const LAS float* gm, const LAS float* shv, int lane, f32x4 (&h)[4]) { row_load<false>(xrow, lane, h); row_finish(gm, shv, lane, h); }
__device__ __forceinline__ void store_row_bf16(bf16* orow, int lane, const f32x4 (&h)[4]) {
    GAS v2u* o8 = (GAS v2u*)orow + lane;
#pragma unroll
    for (int j = 0; j < 4; ++j) { v2u w; w.x = pk2(h[j].x, h[j].y); w.y = pk2(h[j].z, h[j].w); o8[64 * j] = w; }
}
template <bool INBF> __device__ __forceinline__ void norm_phase(const Params& P, LAS unsigned char* lds, const float* xin, const float* gvec, int l, int sh_off, int sc_off, bool from_partials, int tid, int lane, int wave, int wgi) {
    LAS float* gm = (LAS float*)lds; LAS float* shv = (LAS float*)(lds + 4096);
    const float* modp = (const float*)(P.ws + WS_MODP); float* mod = (float*)(P.ws + WS_MOD); const float* b_ada = P.in[3];
    const int b = wgi >> 5;
    if (from_partials) {
        if (tid < 384) { const int idx = wgi * 384 + tid; const int ll = idx / 49152, rem = idx % 49152, bb = rem / 6144, j = rem % 6144; mod[idx] = modp_sum(modp, b_ada, ll, bb, j); }
        for (int c = tid; c < D; c += NTHR) { gm[c] = gvec[c] * (1.f + modp_sum(modp, b_ada, l, b, sc_off + c)); shv[c] = modp_sum(modp, b_ada, l, b, sh_off + c); }
    } else {
        const float* ml = mod + ((size_t)l * 8 + b) * 6144;
        for (int c = tid; c < D; c += NTHR) { gm[c] = gvec[c] * (1.f + ml[sc_off + c]); shv[c] = ml[sh_off + c]; }
    }
    __syncthreads();
    bf16* H = (bf16*)(P.ws + WS_H);
    constexpr int RS = INBF ? D / 2 : D;
    for (int i = 0; i < 8; i += 4) { const int row = wgi * 64 + wave * 8 + i; f32x4 h[4][4];
#pragma unroll
        for (int q = 0; q < 4; ++q) row_load<INBF>(xin + (size_t)(row + q) * RS, lane, h[q]);
#pragma unroll
        for (int q = 0; q < 4; ++q) { row_finish(gm, shv, lane, h[q]); store_row_bf16(H + (size_t)(row + q) * D, lane, h[q]); } }
    __syncthreads();
}
__device__ __forceinline__ void router_phase(const Params& P, LAS unsigned char* lds, const float* xin, int tid, int lane, int wave, int wgi) {
    LAS float* gm = (LAS float*)lds; LAS float* shv = (LAS float*)(lds + 4096); LAS float* wrT = (LAS float*)(lds + 8192);
    LAS int* pe = (LAS int*)(lds + 40960); LAS float* pw = (LAS float*)(lds + 41472); LAS int* cw = (LAS int*)(lds + 41984); LAS int* baseL = (LAS int*)(lds + 42048);
    const float* mod = (const float*)(P.ws + WS_MOD); const int b = wgi >> 5; const float* ml = mod + ((size_t)1 * 8 + b) * 6144; const float* gvec = P.in[5] + D;
    for (int c = tid; c < D; c += NTHR) { gm[c] = gvec[c] * (1.f + ml[4096 + c]); shv[c] = ml[3072 + c]; }
    { const float* wr = P.in[18]; for (int i = tid; i < D * NE; i += NTHR) { const int c = i >> 3, e = i & 7; wrT[e * D + c] = wr[i]; } }
    __syncthreads();
#if defined(TSDBG)
    if (wgi == 0 && tid == 0) ((unsigned long long*)(P.ws + WS_CTL) + 16384)[100] = __builtin_amdgcn_s_memrealtime();
#endif
    f32x4 wreg[8][4];
#pragma unroll
    for (int e = 0; e < 8; ++e)
#pragma unroll
        for (int j = 0; j < 4; ++j) wreg[e][j] = *(const LAS f32x4*)(wrT + e * D + 4 * lane + 256 * j);
    float brv[8];
#pragma unroll
    for (int e = 0; e < 8; ++e) brv[e] = P.in[19][e];
    f32x4 hq[3][4];
    row_load<false>(xin + (size_t)(wgi * 64 + wave * 8) * D, lane, hq[0]); row_load<false>(xin + (size_t)(wgi * 64 + wave * 8 + 1) * D, lane, hq[1]);
#pragma unroll
    for (int i = 0; i < 8; ++i) { const int rl = wave * 8 + i, row = wgi * 64 + rl; f32x4 h[4];
        if (i < 6) row_load<false>(xin + (size_t)(row + 2) * D, lane, hq[(i + 2) % 3]);
#pragma unroll
        for (int j = 0; j < 4; ++j) h[j] = hq[i % 3][j];
        row_finish(gm, shv, lane, h);
        float lg[8];
#pragma unroll
        for (int e = 0; e < 8; ++e) { float s = 0.f;
#pragma unroll
            for (int j = 0; j < 4; ++j) { const f32x4 w4 = wreg[e][j]; s = fmaf(h[j].x, w4.x, s); s = fmaf(h[j].y, w4.y, s); s = fmaf(h[j].z, w4.z, s); s = fmaf(h[j].w, w4.w, s); }
            lg[e] = s; }
        {
            float w4[4], u2[2];
#pragma unroll
            for (int i = 0; i < 4; ++i) { const bool hi1 = lane & 1; const float keep = hi1 ? lg[2 * i + 1] : lg[2 * i], send = hi1 ? lg[2 * i] : lg[2 * i + 1]; w4[i] = keep + DPP_F(send, DPP_XOR1); }
#pragma unroll
            for (int i = 0; i < 2; ++i) { const bool hi2 = lane & 2; const float keep = hi2 ? w4[2 * i + 1] : w4[2 * i], send = hi2 ? w4[2 * i] : w4[2 * i + 1]; u2[i] = keep + DPP_F(send, DPP_XOR2); }
            const bool hi4 = lane & 4; float z = (hi4 ? u2[1] : u2[0]) + __shfl_xor(hi4 ? u2[0] : u2[1], 4);
            z += DPP_F(z, DPP_ROR8);
#pragma unroll
            for (int e = 0; e < 8; ++e) lg[e] = ((RDLANE_F(z, e) + RDLANE_F(z, 16 + e)) + (RDLANE_F(z, 32 + e) + RDLANE_F(z, 48 + e))) + brv[e];
        }
        int e1 = 0; float v1 = lg[0];
#pragma unroll
        for (int e = 1; e < 8; ++e) if (lg[e] > v1) { v1 = lg[e]; e1 = e; }
        int e2 = -1; float v2 = -3.0e38f;
#pragma unroll
        for (int e = 0; e < 8; ++e) if (e != e1 && lg[e] > v2) { v2 = lg[e]; e2 = e; }
        const float p2 = __expf(v2 - v1), inv = 1.f / (1.f + p2);
        if (lane == 0) { pe[2 * rl] = e1; pe[2 * rl + 1] = e2; pw[2 * rl] = inv; pw[2 * rl + 1] = p2 * inv; }
        { LAS unsigned* r4 = (LAS unsigned*)(lds + 65536 + rl * 1024) + lane;
#pragma unroll
          for (int j = 0; j < 4; ++j) r4[64 * j] = pk4_fp8(h[j].x * H8_SCALE, h[j].y * H8_SCALE, h[j].z * H8_SCALE, h[j].w * H8_SCALE); } }
    __syncthreads();
#if defined(TSDBG)
    if (wgi == 0 && tid == 0) ((unsigned long long*)(P.ws + WS_CTL) + 16384)[101] = __builtin_amdgcn_s_memrealtime();
#endif
    int e = 0, rank = 0;
    if (tid < 128) { e = pe[tid];
#pragma unroll
        for (int ee = 0; ee < 8; ++ee) { const unsigned long long mk = __ballot(e == ee); if (e == ee) rank = __popcll(mk & ((1ull << lane) - 1ull)); if (lane == 0) cw[wave * 8 + ee] = __popcll(mk); } }
    __syncthreads();
    if (tid < 8) { const int tot = cw[tid] + cw[8 + tid]; unsigned* cnt = (unsigned*)(P.ws + WS_CTL) + CW_CNT + 64 * tid;
        baseL[tid] = (int)__hip_atomic_fetch_add(cnt, (unsigned)tot, __ATOMIC_RELAXED, __HIP_MEMORY_SCOPE_AGENT); }
    __syncthreads();
    if (tid < 128) { const int slot = baseL[e] + rank + (wave == 1 ? cw[e] : 0); const int token = wgi * 64 + (tid >> 1);
        ((float*)(P.ws + WS_WL))[e * M + slot] = pw[tid]; ((int*)(P.ws + WS_PAIR))[token * 2 + (tid & 1)] = e * M + slot; pe[tid] = e * M + slot; }
    __syncthreads();
#if defined(TSDBG)
    if (wgi == 0 && tid == 0) ((unsigned long long*)(P.ws + WS_CTL) + 16384)[102] = __builtin_amdgcn_s_memrealtime();
#endif
    for (int i = 0; i < 16; ++i) { const int p = wave * 16 + i; const int dst = pe[p];
        const v4u v = *(const LAS v4u*)(lds + 65536 + (p >> 1) * 1024 + lane * 16); *(GAS v4u*)(P.ws + WS_HG + (size_t)dst * D + lane * 16) = v; }
    __syncthreads();
}
__device__ __forceinline__ void moe_tables(const Params& P, LAS unsigned char* lds, int tid) {
    LAS int* tab = (LAS int*)(lds + MOETAB_OFF);
    if (tid == 0) { const unsigned* ctl = (const unsigned*)(P.ws + WS_CTL); int rb = 0;
        for (int e = 0; e < 8; ++e) { int c = (int)__hip_atomic_load(ctl + CW_CNT + 64 * e, __ATOMIC_RELAXED, __HIP_MEMORY_SCOPE_AGENT); c = c < 0 ? 0 : (c > M ? M : c); tab[e] = rb; tab[9 + e] = c; rb += (c + 255) & ~255; }
        tab[8] = rb; }
    __syncthreads();
}
__device__ __forceinline__ void gather_phase(const Params& P, LAS unsigned char* lds, const float* xin, int tid, int lane, int wave, int gw) {
    LAS float* gmA = (LAS float*)lds; LAS float* shA = (LAS float*)(lds + 32768); const LAS int* tab = (const LAS int*)(lds + MOETAB_OFF);
    const float* mod1 = (const float*)(P.ws + WS_MOD) + (size_t)8 * 6144; const float* gvec = P.in[5] + D;
    for (int i = tid; i < 8 * D; i += NTHR) { const int b = i >> 10, c = i & 1023; gmA[i] = gvec[c] * (1.f + mod1[b * 6144 + 4096 + c]); shA[i] = mod1[b * 6144 + 3072 + c]; }
    __syncthreads();
    const int ptot = tab[8]; const int* list = (const int*)(P.ws + WS_LIST); const float* wl = (const float*)(P.ws + WS_WL); float* wlg = (float*)(P.ws + WS_WLG); unsigned char* HG = (unsigned char*)(P.ws + WS_HG);
    for (int p = gw; p < ptot; p += NGW) {
        int e = 0;
#pragma unroll
        for (int k = 1; k < 8; ++k) e += (p >= tab[k]);
        const int slot = p - tab[e], cn = tab[9 + e]; const bool valid = slot < cn; const int token = list[e * M + (valid ? slot : cn - 1)]; const int b = token >> 11;
        f32x4 h[4]; norm_row(xin + (size_t)token * D, gmA + b * D, shA + b * D, lane, h);
        { GAS unsigned* o4 = (GAS unsigned*)(HG + (size_t)p * D) + lane;
#pragma unroll
          for (int j = 0; j < 4; ++j) o4[64 * j] = pk4_fp8(h[j].x * H8_SCALE, h[j].y * H8_SCALE, h[j].z * H8_SCALE, h[j].w * H8_SCALE); }
        if (lane == 0) wlg[p] = valid ? wl[e * M + slot] : 0.f;
    }
    __syncthreads();
}
__device__ __forceinline__ void combine_phase(const Params& P, LAS unsigned char* lds, int lane, int gw) {
    const LAS int* tab = (const LAS int*)(lds + MOETAB_OFF); const int* pair = (const int*)(P.ws + WS_PAIR); const bf16* F = (const bf16*)(P.ws + WS_F);
    const float* mod1 = (const float*)(P.ws + WS_MOD) + (size_t)8 * 6144;
    for (int t = gw; t < M; t += NGW) {
        const int pa = pair[2 * t], pb = pair[2 * t + 1]; const int ra = tab[pa >> 14] + (pa & 16383), rb = tab[pb >> 14] + (pb & 16383); const int b = t >> 11;
        const bf16* FP = (const bf16*)(P.ws + WS_FP);
        f32x4 fs[4];
#pragma unroll
        for (int j = 0; j < 4; ++j) fs[j] = (f32x4){0.f, 0.f, 0.f, 0.f};
#pragma unroll
        for (int side = 0; side < 2; ++side) { const int r = side ? rb : ra;
            if (r < 32768) { const GAS v2u* fp = (const GAS v2u*)(F + (size_t)r * D) + lane;
#pragma unroll
                for (int j = 0; j < 4; ++j) { const v2u a = fp[64 * j]; fs[j] = fs[j] + (f32x4){__uint_as_float(a.x << 16), __uint_as_float(a.x & 0xffff0000u), __uint_as_float(a.y << 16), __uint_as_float(a.y & 0xffff0000u)}; } }
            else for (int ks = 0; ks < 7; ++ks) { const GAS v2u* fp = (const GAS v2u*)(FP + ((size_t)ks * 2048 + (r - 32768)) * D) + lane;
#pragma unroll
                for (int j = 0; j < 4; ++j) { const v2u a = fp[64 * j]; fs[j] = fs[j] + (f32x4){__uint_as_float(a.x << 16), __uint_as_float(a.x & 0xffff0000u), __uint_as_float(a.y << 16), __uint_as_float(a.y & 0xffff0000u)}; } } }
        GAS f32x4* xo = (GAS f32x4*)(P.out + (size_t)t * D) + lane; const GAS f32x4* g2 = (const GAS f32x4*)(mod1 + b * 6144 + 5120) + lane;
#pragma unroll
        for (int j = 0; j < 4; ++j) xo[64 * j] = xo[64 * j] + g2[64 * j] * fs[j];
    }
}

__device__ __forceinline__ void conv_stage(const bf16* Z, LAS unsigned char* zt, int unit, int tid) {
    const int tok0 = unit * 32, tp0 = tok0 & (S_ - 1);
#pragma unroll
    for (int i = 0; i < 8; ++i) { const int idx = i * NTHR + tid;
        if (idx < 62 * 64) { const int row = idx >> 6, pc = idx & 63; const bool ok = tp0 + row - 30 >= 0;
            v4u v = *(const GAS v4u*)(Z + (size_t)(tok0 + (ok ? row - 30 : -tp0)) * DC + pc * 8); if (!ok) v = (v4u){0u, 0u, 0u, 0u};
            *(LAS v4u*)(zt + idx * 16) = v; } }
}
__device__ __forceinline__ void conv_unit(const LAS unsigned char* zt, const float (&w)[CW], float bias, bf16* YC, const float* lg, const float* lb, LAS float* tile, int unit, int tid, int wave, int lane) {
    const int tok0 = unit * 32, c = tid;
    const LAS bf16* zc = (const LAS bf16*)zt + c;
#pragma unroll
    for (int half = 0; half < 2; ++half) {
        float in[46];
#pragma unroll
        for (int i = 0; i < 46; ++i) in[i] = bf2f(zc[(16 * half + i) * DC]);
#pragma unroll
        for (int q = 0; q < 16; ++q) { float a = bias;
#pragma unroll
            for (int j = 0; j < CW; ++j) a += w[j] * in[q + j];
            tile[(16 * half + q) * DC + c] = a; }
    }
    __syncthreads();
    const f32x4 g0 = *(const f32x4*)(lg + lane * 8), g1 = *(const f32x4*)(lg + lane * 8 + 4), b0 = *(const f32x4*)(lb + lane * 8), b1 = *(const f32x4*)(lb + lane * 8 + 4);
#pragma unroll
    for (int tt = 0; tt < 4; ++tt) { const int t = wave * 4 + tt;
        f32x4 v0 = *(const LAS f32x4*)(tile + t * DC + lane * 8), v1 = *(const LAS f32x4*)(tile + t * DC + lane * 8 + 4);
        const float mean = wave_sum((v0.x + v0.y) + (v0.z + v0.w) + (v1.x + v1.y) + (v1.z + v1.w)) * (1.f / DC);
        v0 = v0 - mean; v1 = v1 - mean;
        const float var = wave_sum((v0.x * v0.x + v0.y * v0.y) + (v0.z * v0.z + v0.w * v0.w) + (v1.x * v1.x + v1.y * v1.y) + (v1.z * v1.z + v1.w * v1.w)) * (1.f / DC);
        const float rstd = __builtin_amdgcn_rsqf(var + EPS);
        f32x4 y0 = v0 * rstd * g0 + b0, y1 = v1 * rstd * g1 + b1;
#pragma unroll
        for (int i = 0; i < 4; ++i) { y0[i] = y0[i] * sigm(y0[i]); y1[i] = y1[i] * sigm(y1[i]); }
        v4u o; o.x = pk2(y0.x, y0.y); o.y = pk2(y0.z, y0.w); o.z = pk2(y1.x, y1.y); o.w = pk2(y1.z, y1.w);
        *(GAS v4u*)(YC + (size_t)(tok0 + t) * D + lane * 8) = o; }
    __syncthreads();
}
__device__ __forceinline__ int crow(int r, int hi) { return (r & 3) + 8 * (r >> 2) + 4 * hi; }
#define MFMA32(a, b, c) __builtin_amdgcn_mfma_f32_32x32x16_bf16((a), (b), (c), 0, 0, 0)
__device__ __forceinline__ void attn_stage(const LAS unsigned char* stage, int kc0, int n, int qh, int r32, int hi, int lane, const LAS float* btile, const bf16x8 (&qf)[4], const f32x16& cinit, f32x16& o0, f32x16& o1, float& l) {
    const int fsw = (r32 >> 1) & 7;
#pragma unroll
    for (int sub = 0; sub < 2; ++sub) {
        const int kc = kc0 + sub; const LAS unsigned char* buf = stage + sub * 16384;
        if (kc >= n - 8 && kc <= n) {
            bf16x8 kf[2][4], vf[2][2][2]; f32x16 sc[2];
#pragma unroll
            for (int kb = 0; kb < 2; ++kb)
#pragma unroll
                for (int d0 = 0; d0 < 4; ++d0) kf[kb][d0] = *(const LAS bf16x8*)(buf + (kb * 32 + r32) * 128 + (((2 * d0 + hi) ^ fsw) << 4));
            if (n - kc >= 3) { sc[0] = cinit; sc[1] = cinit; }
            else {
#pragma unroll
                for (int kb = 0; kb < 2; ++kb) { const LAS f32x4* tp = (const LAS f32x4*)(btile + ((qh * 6 + (n - kc) * 2 + kb) * 4) * 256) + lane;
#pragma unroll
                    for (int q4 = 0; q4 < 4; ++q4) { const f32x4 t4 = tp[q4 * 64]; sc[kb][4 * q4] = t4.x; sc[kb][4 * q4 + 1] = t4.y; sc[kb][4 * q4 + 2] = t4.z; sc[kb][4 * q4 + 3] = t4.w; } } }
#pragma unroll
            for (int kb = 0; kb < 2; ++kb)
#pragma unroll
                for (int db = 0; db < 2; ++db)
#pragma unroll
                    for (int s2 = 0; s2 < 2; ++s2) vf[kb][db][s2] = *(const LAS bf16x8*)(buf + 8192 + (db * 32 + r32) * 128 + (((kb * 4 + 2 * s2 + hi) ^ fsw) << 4));
#pragma unroll
            for (int d0 = 0; d0 < 4; ++d0) { sc[0] = MFMA32(kf[0][d0], qf[d0], sc[0]); sc[1] = MFMA32(kf[1][d0], qf[d0], sc[1]); }
            float ps0 = 0.f, ps1 = 0.f;
#pragma unroll
            for (int r = 0; r < 16; ++r) { sc[0][r] = __builtin_amdgcn_exp2f(sc[0][r]); ps0 += sc[0][r]; }
#pragma unroll
            for (int r = 0; r < 16; ++r) { sc[1][r] = __builtin_amdgcn_exp2f(sc[1][r]); ps1 += sc[1][r]; }
            l += ps0 + ps1;
            bf16x8 pb[2][2];
#pragma unroll
            for (int kb = 0; kb < 2; ++kb) { v4u p0, p1;
                p0.x = pk2(sc[kb][0], sc[kb][1]); p0.y = pk2(sc[kb][2], sc[kb][3]); p0.z = pk2(sc[kb][4], sc[kb][5]); p0.w = pk2(sc[kb][6], sc[kb][7]);
                p1.x = pk2(sc[kb][8], sc[kb][9]); p1.y = pk2(sc[kb][10], sc[kb][11]); p1.z = pk2(sc[kb][12], sc[kb][13]); p1.w = pk2(sc[kb][14], sc[kb][15]);
                pb[kb][0] = __builtin_bit_cast(bf16x8, p0); pb[kb][1] = __builtin_bit_cast(bf16x8, p1); }
#pragma unroll
            for (int kb = 0; kb < 2; ++kb)
#pragma unroll
                for (int s2 = 0; s2 < 2; ++s2) { o0 = MFMA32(vf[kb][0][s2], pb[kb][s2], o0); o1 = MFMA32(vf[kb][1][s2], pb[kb][s2], o1); }
        }
    }
}
__device__ __forceinline__ void attn_unit(const bf16* Q, const bf16* K, const bf16* VT, bf16* YC, const LAS float* btile, float c0, LAS unsigned char* kv, int b, int h, int g, int tid, int wave, int lane) {
    const int r32 = lane & 31, hi = lane >> 5;
    const int n0 = 4 * g, n = n0 + (wave >> 1), qh = wave & 1;
    const size_t rowq = (size_t)b * S_ + n * 64 + qh * 32 + r32;
    bf16x8 qf[4];
#pragma unroll
    for (int d0 = 0; d0 < 4; ++d0) qf[d0] = *(const GAS bf16x8*)(Q + rowq * DC + h * 64 + d0 * 16 + hi * 8);
    float l = 0.f; f32x16 o0, o1, cinit;
#pragma unroll
    for (int r = 0; r < 16; ++r) { o0[r] = 0.f; o1[r] = 0.f; cinit[r] = c0; }
    const int kc_lo = n0 - 8 < 0 ? 0 : n0 - 8, nt = (n0 + 4 - kc_lo) >> 1;
    const int lrow = tid >> 3, lc = tid & 7, lsw = (lrow >> 1) & 7; const int kofs = lrow * 128 + ((lc ^ lsw) << 4);
    const int vofs0 = lrow * 128 + ((((lc & 6) | 0) ^ lsw) << 4) + (lc & 1) * 8, vofs1 = lrow * 128 + ((((lc & 6) | 1) ^ lsw) << 4) + (lc & 1) * 8;
    const bf16* kg = K + ((size_t)b * S_ + lrow) * DC + h * 64 + lc * 8 + (size_t)kc_lo * 64 * DC;
    const bf16* vg = VT + (size_t)(h * 64 + lrow) * M + (size_t)b * S_ + lc * 8 + kc_lo * 64;
#define ATT_GET(t, R) do { R[0] = *(const GAS v4u*)(kg + (size_t)(2 * (t)) * 64 * DC); R[1] = *(const GAS v4u*)(vg + (2 * (t)) * 64); R[2] = *(const GAS v4u*)(kg + (size_t)(2 * (t) + 1) * 64 * DC); R[3] = *(const GAS v4u*)(vg + (2 * (t) + 1) * 64); } while (0)
#define ATT_PUT(base, R) do { *(LAS v4u*)((base) + kofs) = R[0]; *(LAS v2u*)((base) + 8192 + vofs0) = (v2u){R[1].x, R[1].y}; *(LAS v2u*)((base) + 8192 + vofs1) = (v2u){R[1].z, R[1].w}; \
        *(LAS v4u*)((base) + 16384 + kofs) = R[2]; *(LAS v2u*)((base) + 24576 + vofs0) = (v2u){R[3].x, R[3].y}; *(LAS v2u*)((base) + 24576 + vofs1) = (v2u){R[3].z, R[3].w}; } while (0)
    v4u RA[4], RB[4];
    ATT_GET(0, RA); ATT_GET(1, RB);
    ATT_PUT(kv, RA);
    __syncthreads();
    asm volatile("" : "+v"(qf[0]), "+v"(qf[1]), "+v"(qf[2]), "+v"(qf[3]));
    for (int t = 0; t < nt; t += 2) {
        { const int tg = t + 2 < nt ? t + 2 : nt - 1; ATT_GET(tg, RA); }
        attn_stage(kv, kc_lo + 2 * t, n, qh, r32, hi, lane, btile, qf, cinit, o0, o1, l);
        ATT_PUT(kv + 32768, RB);
        __syncthreads();
        { const int tg = t + 3 < nt ? t + 3 : nt - 1; ATT_GET(tg, RB); }
        attn_stage(kv + 32768, kc_lo + 2 * t + 2, n, qh, r32, hi, lane, btile, qf, cinit, o0, o1, l);
        if (t + 2 < nt) ATT_PUT(kv, RA);
        __syncthreads();
    }
#undef ATT_PUT
#undef ATT_GET
    l += __shfl_xor(l, 32); const float il = 1.f / l;
    bf16* yp = YC + rowq * D + DC + h * 64 + 4 * hi;
#pragma unroll
    for (int gq = 0; gq < 4; ++gq) { v2u w0, w1; w0.x = pk2(o0[4 * gq] * il, o0[4 * gq + 1] * il); w0.y = pk2(o0[4 * gq + 2] * il, o0[4 * gq + 3] * il);
        w1.x = pk2(o1[4 * gq] * il, o1[4 * gq + 1] * il); w1.y = pk2(o1[4 * gq + 2] * il, o1[4 * gq + 3] * il);
        *(GAS v2u*)(yp + 8 * gq) = w0; *(GAS v2u*)(yp + 32 + 8 * gq) = w1; }
}
__device__ __forceinline__ void mixer_phase(const Params& P, LAS unsigned char* lds, int l, int tid, int lane, int wave, int wgi) {
#if defined(TSDBG)
    if (wgi == 0 && tid == 0) ((unsigned long long*)(P.ws + WS_CTL) + 16384)[40 + 4 * l] = __builtin_amdgcn_s_memrealtime();
#endif
    LAS unsigned char* zt = lds; LAS float* tile = (LAS float*)(lds + 63488); LAS float* biasL = (LAS float*)(lds + LDSCTL_OFF + 1024); LAS unsigned char* kv = lds + 49152;
    { const float* rb = P.in[14] + l * 8 * NREL; for (int i = tid; i < 8 * NREL; i += NTHR) biasL[i] = rb[i] * LOG2E; }
    __syncthreads();
    const bf16* Z = (const bf16*)(P.ws + WS_Z); const bf16* Q = (const bf16*)(P.ws + WS_Q); const bf16* K = (const bf16*)(P.ws + WS_K); const bf16* VT = (const bf16*)(P.ws + WS_VT); bf16* YC = (bf16*)(P.ws + WS_YC);
    {   float w[CW]; const float* cw = P.in[8] + l * CW * DC;
#pragma unroll
        for (int j = 0; j < CW; ++j) w[j] = cw[j * DC + tid];
        const float cbias = P.in[9][l * DC + tid];
        for (int cu = 0; cu < 2; ++cu) { conv_stage(Z, zt, wgi * 2 + cu, tid); __syncthreads();
            conv_unit(zt, w, cbias, YC, P.in[10] + l * DC, P.in[11] + l * DC, tile, wgi * 2 + cu, tid, wave, lane); } }
#if defined(TSDBG)
    if (wgi == 0 && tid == 0) ((unsigned long long*)(P.ws + WS_CTL) + 16384)[40 + 4 * l + 1] = __builtin_amdgcn_s_memrealtime();
#endif
#if defined(TSDBG)
    if (tid == 0) atomicMax((unsigned long long*)(P.ws + WS_CTL) + 16384 + 74 + l, (unsigned long long)__builtin_amdgcn_s_memrealtime());
#endif
    { const int b = wgi >> 5, h = (wgi >> 2) & 7, gp = wgi & 3;
      LAS float* btl = (LAS float*)lds;
      float Bref; { LAS float* red = (LAS float*)(lds + 49152);
          float gq = 0.f, gk = 0.f, bm = 0.f;
          if (tid < 64) { gq = fabsf(P.in[12][l * 64 + tid]); gk = fabsf(P.in[13][l * 64 + tid]); }
          if (tid < NREL) bm = fabsf(biasL[h * NREL + tid]);
#pragma unroll
          for (int o = 1; o < 64; o <<= 1) { gq = fmaxf(gq, __shfl_xor(gq, o)); gk = fmaxf(gk, __shfl_xor(gk, o)); bm = fmaxf(bm, __shfl_xor(bm, o)); }
          if (lane == 0) { red[wave] = gq; red[8 + wave] = gk; red[16 + wave] = bm; }
          __syncthreads();
          gq = red[0]; gk = red[8]; bm = fmaxf(fmaxf(fmaxf(red[16], red[17]), fmaxf(red[18], red[19])), red[20]);
          Bref = 1.02f * (LOG2E * 8.f * gq * gk + bm); }
#pragma unroll
      for (int k = 0; k < 24; ++k) { const int i = tid + NTHR * k; const int jbq = k >> 1, qh = jbq / 6, jb = jbq % 6;
          const int ln = (i >> 2) & 63, r = ((i >> 8) & 3) * 4 + (i & 3);
          int rel = -64 * (jb >> 1) + 32 * (jb & 1) - 32 * qh + crow(r, ln >> 5) - (ln & 31); rel = rel < -128 ? -128 : (rel > 128 ? 128 : rel); btl[i] = biasL[h * NREL + rel + 128] - Bref; }
      const float b0 = biasL[h * NREL] - Bref;
      __syncthreads();
      for (int rp = 0; rp < 1 + ((REPMASK >> 21) & 1); ++rp)
#if defined(TSDBG)
      if ((wgi == 0 || wgi == 3) && tid == 0) ((unsigned long long*)(P.ws + WS_CTL) + 16384)[60 + 8 * l + (wgi ? 4 : 0)] = __builtin_amdgcn_s_memrealtime();
#endif
#if defined(TSDBG)
      const unsigned long long att_t0 = __builtin_amdgcn_s_memrealtime();
#endif
      for (int au = 0; au < 2; ++au) attn_unit(Q, K, VT, YC, btl, b0, kv, b, h, au ? 7 - gp : gp, tid, wave, lane);
      __syncthreads();
#if defined(TSDBG)
      if ((wgi == 0 || wgi == 3) && tid == 0) ((unsigned long long*)(P.ws + WS_CTL) + 16384)[61 + 8 * l + (wgi ? 4 : 0)] = __builtin_amdgcn_s_memrealtime();
#endif
#if defined(TSDBG)
      if (tid == 0) { const unsigned long long dt = __builtin_amdgcn_s_memrealtime() - att_t0; atomicMax((unsigned long long*)(P.ws + WS_CTL) + 16384 + 80 + 4 * l + gp, dt); }
#endif
      const int mlo = FILL_S2 + l * FILL_MIX;
      if constexpr (FILL_MIX > 0) {
      if (gp == 0) moe_fill_run(P, lds, mlo + (wgi >> 2) * NWAVES + wave, 64 * NWAVES, mlo + (FILL_MIX * 3) / 4, lane, wave);
      else if (gp == 1) moe_fill_run(P, lds, mlo + (FILL_MIX * 3) / 4 + (wgi >> 2) * NWAVES + wave, 64 * NWAVES, mlo + FILL_MIX, lane, wave); } }
    __syncthreads();
#if defined(TSDBG)
    if (wgi == 0 && tid == 0) ((unsigned long long*)(P.ws + WS_CTL) + 16384)[40 + 4 * l + 2] = __builtin_amdgcn_s_memrealtime();
    if (tid == 0) atomicMax((unsigned long long*)(P.ws + WS_CTL) + 16384 + 70 + l, (unsigned long long)__builtin_amdgcn_s_memrealtime());
#endif
}

#define PHASE(k, ...) do { { __VA_ARGS__ } if constexpr ((REPMASK >> (k)) & 1) { xcd_barrier(bar); RETID(); { __VA_ARGS__ } } } while (0)
__global__ void __launch_bounds__(NTHR, 2) fwd(Params P) {
    extern __shared__ __attribute__((aligned(16))) unsigned char lds_raw[];
    LAS unsigned char* lds = (LAS unsigned char*)lds_raw;
    int tid = threadIdx.x, lane = tid & 63, wave = __builtin_amdgcn_readfirstlane(tid >> 6); const int wgi = blockIdx.x; int gw = wgi * NWAVES + wave;
#define RETID() do { tid = threadIdx.x; asm volatile("" : "+v"(tid)); lane = tid & 63; wave = __builtin_amdgcn_readfirstlane(tid >> 6); gw = wgi * NWAVES + wave; } while (0)
    for (int u = tid; u < (LDS_BYTES - LDSCTL_OFF) / 4; u += NTHR) ((LAS unsigned*)(lds + LDSCTL_OFF))[u] = 0u;
    __syncthreads();
    unsigned* ctl = (unsigned*)(P.ws + WS_CTL);
    XcdBarrier bar = xcd_barrier_post(ctl + CW_BAR, (volatile LAS unsigned*)(lds + MISC_OFF) + 8);
    const int stop = P.stop;
#if defined(TSDBG)
    unsigned long long* tsbuf = (unsigned long long*)(P.ws + WS_CTL) + 16384;
    int tsn = 0;
#define STAMP() do { if (wgi == 0 && tid == 0) tsbuf[tsn] = __builtin_amdgcn_s_memrealtime(); ++tsn; } while (0)
#else
#define STAMP() do {} while (0)
#endif
    STAMP();
#define SEAM(k) do { if (stop == (k)) return; xcd_barrier(bar); RETID(); STAMP(); } while (0)
    bf16* H = (bf16*)(P.ws + WS_H); float* mod = (float*)(P.ws + WS_MOD); const float* XB = (const float*)(P.ws + WS_XB);

    PHASE(0, phase0(P, lds, tid, lane, wave, gw););                                                      SEAM(0);
    PHASE(1, norm_phase<false>(P, lds, P.in[0], P.in[4], 0, 0, 1024, true, tid, lane, wave, wgi););             SEAM(1);
#define LAYER_COMMON(l, pb, xin) \
    PHASE(2,   \
        const bf16* Wl = (const bf16*)(P.ws + WS_WIN) + (size_t)(l) * DIN * D; \
        { pg8::Gemm g{H, Wl, M, 2048, D, 0}; pg8::StaticOrder S; S.init(M, 2048, GRID, wgi); \
          pg8::EpiInProj<FUSE_NORM && (l) != 0> E{(bf16*)(P.ws + WS_Z), (bf16*)(P.ws + WS_Q), (bf16*)(P.ws + WS_K), P.in[12] + (l) * 64, P.in[13] + (l) * 64, QSCALE, (const float*)(P.ws + WS_SS2), (const float*)(P.ws + WS_CIN)}; \
          pg8::gemm_phase<pg8::EpiInProj<FUSE_NORM && (l) != 0>, pg8::StaticOrder, true, true>(lds, g, S, E); } \
        { pg8::Gemm g{Wl + (size_t)2048 * D, H, 512, M, D, 0}; pg8::StaticOrder S; S.init(512, M, GRID, wgi); \
          pg8::EpiBf16<FUSE_NORM && (l) != 0> E{(bf16*)(P.ws + WS_VT), M, 1.f, 0, (const float*)(P.ws + WS_SS2), (const float*)(P.ws + WS_CIN) + 2048}; \
          pg8::gemm_phase<pg8::EpiBf16<FUSE_NORM && (l) != 0>, pg8::StaticOrder, true, true>(lds, g, S, E); } \
        if (FUSE_NORM && (l) == 0) cvec_fill(P, lds, tid, lane, wave, wgi); \
        moe_filler(P, lds, (l) == 0 ? 0 : FILL_S1, (l) == 0 ? FILL_S0 : FILL_S2, lane, wave, wgi); ); \
    SEAM(pb); \
    PHASE(3, mixer_phase(P, lds, (l), tid, lane, wave, wgi);); \
    SEAM((pb) + 1); \
    PHASE(4 + 10 * (l),   \
        pg8::Gemm g{(const bf16*)(P.ws + WS_YC), (const bf16*)(P.ws + WS_WOUT) + (size_t)(l) * D * D, M, D, D, 0}; pg8::StaticOrder S; S.init(M, D, GRID, wgi); \
        pg8::EpiResGate<FUSE_NORM && (l) == 0, (l) != 0, (l) == 0> E{(l) == 0 ? P.in[0] : XB, (l) == 0 ? (float*)XB : P.out, mod + (size_t)(l) * 8 * 6144 + 2048, H, (float*)(P.ws + WS_SS1), P.in[5], mod + 4096};   \
        pg8::gemm_phase<pg8::EpiResGate<FUSE_NORM && (l) == 0, (l) != 0, (l) == 0>, pg8::StaticOrder, true, true>(lds, g, S, E); ); \
    SEAM((pb) + 2);

    LAYER_COMMON(0, 2, P.in[0])
    if constexpr (!FUSE_NORM) { PHASE(5, norm_phase<true>(P, lds, XB, P.in[5], 0, 3072, 4096, false, tid, lane, wave, wgi);); SEAM(5); }
    PHASE(6, pg8::Gemm g{H, (const bf16*)(P.ws + WS_WGU), M, 2 * FFD, D, 0}; pg8::StaticOrder S; S.init(M, 2 * FFD, GRID, wgi);
             pg8::EpiSwiGLU<false, FUSE_NORM != 0> E{(bf16*)(P.ws + WS_ACT), FFD, nullptr, 1.f, 1.f, (const float*)(P.ws + WS_SS1), (const float*)(P.ws + WS_CFF), 2 * FFD};
             pg8::gemm_phase<pg8::EpiSwiGLU<false, FUSE_NORM != 0>, pg8::StaticOrder, true, true>(lds, g, S, E);
             moe_filler(P, lds, FILL_S0, FILL_S1, lane, wave, wgi););
    SEAM(6);
    PHASE(30, pg8::Gemm g{(const bf16*)(P.ws + WS_ACT), (const bf16*)(P.ws + WS_WD), M, D, FFD, 0}; pg8::StaticOrder S; S.init(M, D, GRID, wgi);
              pg8::EpiResGate<FUSE_NORM != 0, true, true> E{XB, (float*)XB, mod + 5120, H, (float*)(P.ws + WS_SS2), P.in[4] + D, mod + (size_t)8 * 6144 + 1024};
              pg8::gemm_phase<pg8::EpiResGate<FUSE_NORM != 0, true, true>, pg8::StaticOrder, true, true>(lds, g, S, E););
    SEAM(7);
    if constexpr (!FUSE_NORM) { PHASE(8, norm_phase<true>(P, lds, XB, P.in[4] + D, 1, 0, 1024, false, tid, lane, wave, wgi);); SEAM(8); }
    LAYER_COMMON(1, 9, P.out)
    PHASE(31, router_phase(P, lds, P.out, tid, lane, wave, wgi););                                       SEAM(12);
    moe_tables(P, lds, tid);
    {
        const LAS int* tab = (const LAS int*)(lds + MOETAB_OFF);
        const int ptot = RFL(tab[8]);
        PHASE(11, pg8::Gemm g{(const bf16*)(P.ws + WS_HG), (const bf16*)(P.ws + WS_WMGU), ptot, 2 * FFE, D, (unsigned)(2 * FFE * D)};
                  pg8::MoeOrder S; S.nM = ptot >> 8; S.nN = 2 * FFE / 256; S.nwg = S.nM * S.nN; S.G = GRID; S.c = wgi; S.capA = true;
                  S.t1 = RFL(tab[1] >> 8); S.t2 = RFL(tab[2] >> 8); S.t3 = RFL(tab[3] >> 8); S.t4 = RFL(tab[4] >> 8); S.t5 = RFL(tab[5] >> 8); S.t6 = RFL(tab[6] >> 8); S.t7 = RFL(tab[7] >> 8);
                  pg8::EpiSwiGLU<true, false> E{(bf16*)(P.ws + WS_ACTM), FFE, (const float*)(P.ws + WS_WL), A8_SCALE / (H8_SCALE * W8_SCALE), 1.f / (H8_SCALE * W8_SCALE), nullptr, nullptr, 0};
                  pg8::gemm_phase<pg8::EpiSwiGLU<true, false>, pg8::MoeOrder, true, true, true>(lds, g, S, E););
        if constexpr ((REPMASK >> 22) & 1) { xcd_barrier(bar); RETID();
                  pg8::Gemm g{(const bf16*)(P.ws + WS_HG), (const bf16*)(P.ws + WS_WMGU), ptot, 2 * FFE, D, (unsigned)(2 * FFE * D)};
                  pg8::MoeOrder S; S.nM = ptot >> 8; S.nN = 2 * FFE / 256; S.nwg = S.nM * S.nN; S.G = GRID; S.c = wgi; S.capA = true;
                  S.t1 = RFL(tab[1] >> 8); S.t2 = RFL(tab[2] >> 8); S.t3 = RFL(tab[3] >> 8); S.t4 = RFL(tab[4] >> 8); S.t5 = RFL(tab[5] >> 8); S.t6 = RFL(tab[6] >> 8); S.t7 = RFL(tab[7] >> 8);
                  pg8::EpiNone E{};
                  pg8::gemm_phase<pg8::EpiNone, pg8::MoeOrder, true, true, true>(lds, g, S, E); }
        SEAM(14);
        PHASE(12, const int tall = ptot >> 8, tmain = tall < 128 ? tall : 128;
                  { pg8::Gemm g{(const bf16*)(P.ws + WS_ACTM), (const bf16*)(P.ws + WS_WMD), ptot, D, FFE, (unsigned)(D * FFE), 0};
                    pg8::MoeOrder S; S.nM = tmain; S.nN = D / 256; S.nwg = S.nM * S.nN; S.G = GRID; S.c = wgi; S.capA = false;
                    S.t1 = RFL(tab[1] >> 8); S.t2 = RFL(tab[2] >> 8); S.t3 = RFL(tab[3] >> 8); S.t4 = RFL(tab[4] >> 8); S.t5 = RFL(tab[5] >> 8); S.t6 = RFL(tab[6] >> 8); S.t7 = RFL(tab[7] >> 8);
                    pg8::EpiBf16<false> E{(bf16*)(P.ws + WS_F), D, 1.f / (A8_SCALE * W8_SCALE), 0, nullptr, nullptr};
                    pg8::gemm_phase<pg8::EpiBf16<false>, pg8::MoeOrder, true, true, true>(lds, g, S, E); }
                  if (tall > 128) { pg8::Gemm g{(const bf16*)(P.ws + WS_ACTM), (const bf16*)(P.ws + WS_WMD), ptot, D, FFE / pg8::RemOrder::NSPLIT, (unsigned)(D * FFE), FFE};
                    pg8::RemOrder S; S.tm0 = 128; S.nrem = tall - 128; S.G = GRID; S.c = wgi;
                    S.t1 = RFL(tab[1] >> 8); S.t2 = RFL(tab[2] >> 8); S.t3 = RFL(tab[3] >> 8); S.t4 = RFL(tab[4] >> 8); S.t5 = RFL(tab[5] >> 8); S.t6 = RFL(tab[6] >> 8); S.t7 = RFL(tab[7] >> 8);
                    pg8::EpiBf16<false> E{(bf16*)(P.ws + WS_FP) - (size_t)128 * 256 * D, D, 1.f / (A8_SCALE * W8_SCALE), (size_t)2048 * D, nullptr, nullptr};
                    pg8::gemm_phase<pg8::EpiBf16<false>, pg8::RemOrder, true, true, true>(lds, g, S, E); } );
        SEAM(15);
        PHASE(29, combine_phase(P, lds, lane, gw););
        __syncthreads(); STAMP();
    }
#undef SEAM
}
static int launch_fast(void* const* d_in, float* out, unsigned char* ws, hipStream_t stream, int stop) {
    static int ready = 0;
    if (ready == 0) {
        if (hipFuncSetAttribute((const void*)fwd, hipFuncAttributeMaxDynamicSharedMemorySize, LDS_BYTES) != hipSuccess) { fprintf(stderr, "kernel_launch: hipFuncSetAttribute failed\n"); ready = -1; return -1; }
        int per_cu = 0; if (hipOccupancyMaxActiveBlocksPerMultiprocessor(&per_cu, (const void*)fwd, NTHR, LDS_BYTES) != hipSuccess || per_cu < 1) fprintf(stderr, "kernel_launch: occupancy query reports %d blocks per CU\n", per_cu);
        (void)hipGetLastError(); ready = 1;
    }
    if (ready < 0) return -1;
    if (hipMemsetAsync(ws + WS_CTL, 0, CTL_ZERO_BYTES, stream) != hipSuccess) return -1;
    Params p{}; for (int i = 0; i < 23; ++i) p.in[i] = (const float*)d_in[i]; p.out = out; p.ws = ws; p.stop = stop; p.pad = 0;
    hipLaunchKernelGGL(fwd, dim3(GRID), dim3(NTHR), LDS_BYTES, stream, p);
    return hipPeekAtLastError() == hipSuccess ? 0 : -1;
}
}
#ifndef DBG_STAGE
#define DBG_STAGE 0
#endif
extern "C" void kernel_launch(void* const* d_in, const int* in_sizes, int n_in, void* d_out, int out_size, void* d_ws, size_t ws_size, hipStream_t stream) {
    if (n_in != 23 || out_size != fk::M * fk::D || ws_size < fk::WS_END) { fprintf(stderr, "kernel_launch: unexpected shapes / workspace (%d inputs, out %d, ws %zu)\n", n_in, out_size, ws_size); return; }
    unsigned char* ws = (unsigned char*)d_ws; float* out = (float*)d_out;
#if DBG_STAGE == 0
    fk::launch_fast(d_in, out, ws, stream, -1);
#elif defined(TSDBG)
    fk::launch_fast(d_in, out, ws, stream, -1);
    nv::k_savets<<<1, 64, 0, stream>>>((const unsigned long long*)ws + 16384, (float*)(ws + 389 * ((size_t)1 << 20)), TS_A0, TS_A1, TS_B0, TS_B1);
    nv::forward(d_in, out, ws, stream);
    nv::k_encode<<<(unsigned)(((size_t)fk::M * 1024 + 255) / 256), 256, 0, stream>>>(out, (size_t)fk::M * 1024, (const float*)(ws + 389 * ((size_t)1 << 20)));
#else
    constexpr int S = DBG_STAGE; constexpr size_t MiB = 1u << 20;
    float* ckf = (float*)(ws + 390 * MiB); float* acc = (float*)(ws + 389 * MiB);
    int stop = -1; size_t off = 0, n = 0; float scale = 1.f; bool isf32 = false;
    const size_t NM = (size_t)fk::M;
    switch (S) {
        case 1: stop = 1; off = fk::WS_H; n = NM * 1024; break;
        case 2: stop = 2; off = fk::WS_Z; n = NM * 512; break;
        case 3: stop = 2; off = fk::WS_Q; n = NM * 512; scale = 1.f / fk::QSCALE; break;
        case 4: stop = 2; off = fk::WS_K; n = NM * 512; break;
        case 5: stop = 3; off = fk::WS_YC; n = NM * 1024; break;
        case 6: stop = 4; isf32 = true; n = NM * 1024; break;
        case 7: stop = 5; off = fk::WS_H; n = NM * 1024; break;
        case 8: stop = 6; off = fk::WS_ACT; n = NM * 1024; break;
        case 9: stop = 7; isf32 = true; n = NM * 1024; break;
        case 11: stop = 8; off = fk::WS_H; n = NM * 1024; break;
        case 12: stop = 9; off = fk::WS_Z; n = NM * 512; break;
        case 13: stop = 9; off = fk::WS_Q; n = NM * 512; scale = 1.f / fk::QSCALE; break;
        case 14: stop = 9; off = fk::WS_K; n = NM * 512; break;
        case 15: stop = 10; off = fk::WS_YC; n = NM * 1024; break;
        case 16: stop = 11; isf32 = true; n = NM * 1024; break;
        default: stop = -1; isf32 = true; n = NM * 1024; break;
    }
    fk::launch_fast(d_in, out, ws, stream, stop);
    if (isf32) nv::k_copy<<<(unsigned)((n + 255) / 256), 256, 0, stream>>>(out, ckf, n);
    else nv::k_cvt<<<(unsigned)((n + 255) / 256), 256, 0, stream>>>((const unsigned short*)(ws + off), ckf, n, scale);
    hipMemsetAsync(acc, 0, 256, stream);
    nv::forward(d_in, out, ws, stream, S, ckf, acc);
    if (S == 99) nv::k_cmp<<<1024, 256, 0, stream>>>(ckf, out, n, acc);
    nv::k_scale<<<(unsigned)((NM * 1024 + 255) / 256), 256, 0, stream>>>(out, NM * 1024, acc);
#endif
}
```

```cpp
#include <hip/hip_runtime.h>
#include <cstdio>
#include <cstdint>
#define DBG_STAGE 0
#define REPMASK 0
namespace pg8 {
#define PG8_LAS __attribute__((address_space(3)))
typedef unsigned short bf16_t;
typedef short bf16x8 __attribute__((ext_vector_type(8)));
typedef float f32x4 __attribute__((ext_vector_type(4)));
typedef unsigned u32x4 __attribute__((ext_vector_type(4)));
constexpr int BM = 256, BK = 64, HALF = 128, HTB = HALF * BK * 2  , STAGE_BYTES = 8 * HTB, NXCD = 8, WGM = 8;

__host__ __device__ __forceinline__ int lds_byte(int r, int c) { const int st = (r >> 4) * 2 + (c >> 5), rr = r & 15, cc = c & 31, ob = rr * 64 + cc * 2; return st * 1024 + (ob ^ (((ob >> 9) & 1) << 5)); }
__host__ __device__ __forceinline__ void stage_rc(int b, int& R, int& C) { const int st = b / 1024, sb = b % 1024, swz = sb ^ (((sb >> 9) & 1) << 5); R = (st >> 1) * 16 + swz / 64; C = (st & 1) * 32 + (swz % 64) / 2; }
__host__ __device__ __forceinline__ int perm32(int rho) { const int n = rho >> 4, i = rho & 15; return 8 * (i >> 2) + 4 * n + (i & 3); }

struct Unit { int pm, pn, e, pa, ks; };
struct Gemm { const bf16_t* A; const bf16_t* Bt; int M, N, K; unsigned bstride; int ld; };

struct StaticOrder {
    int nM, nN, nwg, G, c;
    __device__ void init(int M, int N, int G_, int c_) { nM = M / BM; nN = N / BM; nwg = nM * nN; G = G_; c = c_; }
    __device__ bool next(int i, Unit& u) const {
        const long L = (long)i * G + c; if (L >= nwg) return false;
        int wgid = (int)L; { const int q = nwg / NXCD, r = nwg % NXCD, xcd = wgid % NXCD, off = wgid / NXCD; wgid = (xcd < r ? xcd * (q + 1) : r * (q + 1) + (xcd - r) * q) + off; }
        const int nig = WGM * nN, gid = wgid / nig, fm = gid * WGM, gsz = (nM - fm) < WGM ? (nM - fm) : WGM;
        u.pm = fm + ((wgid % nig) % gsz); u.pn = (wgid % nig) / gsz; u.e = 0; u.pa = u.pm; u.ks = 0; return true;
    }
    __device__ __forceinline__ void a_ready(const Unit&) const {}
    __device__ __forceinline__ void done(const Unit&) const {}
};
struct MoeOrder {
    int nM, nN, nwg, G, c; int t1, t2, t3, t4, t5, t6, t7; bool capA;
    __device__ bool next(int i, Unit& u) const {
        const long L = (long)i * G + c; if (L >= nwg) return false;
        int wgid = (int)L; { const int q = nwg / NXCD, r = nwg % NXCD, xcd = wgid % NXCD, off = wgid / NXCD; wgid = (xcd < r ? xcd * (q + 1) : r * (q + 1) + (xcd - r) * q) + off; }
        const int nig = WGM * nN, gid = wgid / nig, fm = gid * WGM, gsz = (nM - fm) < WGM ? (nM - fm) : WGM;
        u.pm = fm + ((wgid % nig) % gsz); u.pn = (wgid % nig) / gsz;
        const int p = u.pm; u.e = (p >= t1) + (p >= t2) + (p >= t3) + (p >= t4) + (p >= t5) + (p >= t6) + (p >= t7);
        if (capA) { int ts = 0; ts = p >= t1 ? t1 : ts; ts = p >= t2 ? t2 : ts; ts = p >= t3 ? t3 : ts; ts = p >= t4 ? t4 : ts; ts = p >= t5 ? t5 : ts; ts = p >= t6 ? t6 : ts; ts = p >= t7 ? t7 : ts; u.pa = u.e * 64 + (p - ts); }
        else u.pa = p;
        u.ks = 0; return true;
    }
    __device__ __forceinline__ void a_ready(const Unit&) const {}
    __device__ __forceinline__ void done(const Unit&) const {}
};

struct RemOrder {
    int tm0, nrem, G, c; int t1, t2, t3, t4, t5, t6, t7; static constexpr int NSPLIT = 7;
    __device__ bool next(int i, Unit& u) const {
        const int L = i * G + c; if (L >= nrem * 4 * NSPLIT) return false;
        u.ks = L % NSPLIT; u.pn = (L / NSPLIT) & 3; u.pm = tm0 + L / (4 * NSPLIT); u.pa = u.pm;
        const int p = u.pm; u.e = (p >= t1) + (p >= t2) + (p >= t3) + (p >= t4) + (p >= t5) + (p >= t6) + (p >= t7); return true;
    }
    __device__ __forceinline__ void a_ready(const Unit&) const {}
    __device__ __forceinline__ void done(const Unit&) const {}
};
__device__ __forceinline__ unsigned cvt_pk_bf16(float lo, float hi) { unsigned r; asm volatile("v_cvt_pk_bf16_f32 %0, %1, %2" : "=v"(r) : "v"(lo), "v"(hi)); return r; }
typedef int v8i __attribute__((ext_vector_type(8))); typedef int v4i __attribute__((ext_vector_type(4)));
__device__ __forceinline__ v8i cat8(bf16x8 lo, bf16x8 hi) { const v4i a = __builtin_bit_cast(v4i, lo), b = __builtin_bit_cast(v4i, hi); return __builtin_shufflevector(a, b, 0, 1, 2, 3, 4, 5, 6, 7); }
__device__ __forceinline__ unsigned pk4_fp8(float a, float b, float c, float d) { int w = __builtin_amdgcn_cvt_pk_fp8_f32(a, b, 0, false); w = __builtin_amdgcn_cvt_pk_fp8_f32(c, d, w, true); return (unsigned)w; }
__device__ __forceinline__ float sigm(float x) { return __builtin_amdgcn_rcpf(1.f + __builtin_amdgcn_exp2f(-1.4426950408889634f * x)); }
__device__ __forceinline__ u32x4 pack8(f32x4 v0, f32x4 v1) { u32x4 w; w.x = cvt_pk_bf16(v0[0], v0[1]); w.y = cvt_pk_bf16(v0[2], v0[3]); w.z = cvt_pk_bf16(v1[0], v1[1]); w.w = cvt_pk_bf16(v1[2], v1[3]); return w; }

template <bool NORM> struct EpiBf16 {
    static constexpr bool PERM = true, AFTER_DRAIN = false;
    bf16_t* O; int ldc; float scale; size_t slab;
    const float* ss; const float* cvec;
    __device__ __forceinline__ void operator()(const f32x4 (&acc)[2][2][4][2], const Unit& u, int wr, int wc, int fr, int fq) const {
        const int row0 = u.pm * BM + wr * 64 + fr; const int col0 = u.pn * BM + wc * 32 + 8 * fq;
        f32x4 rc[2][2];
        if constexpr (NORM) {
#pragma unroll
            for (int bj = 0; bj < 2; ++bj)
#pragma unroll
                for (int n = 0; n < 2; ++n) { const f32x4 q = *(const f32x4*)(ss + col0 + bj * HALF + 4 * n);
#pragma unroll
                    for (int i = 0; i < 4; ++i) rc[bj][n][i] = __builtin_amdgcn_rsqf(q[i] * (1.f / 1024.f) + 1e-6f); } }
#pragma unroll
        for (int ai = 0; ai < 2; ++ai)
#pragma unroll
            for (int m = 0; m < 4; ++m) { bf16_t* rowp = O + (size_t)u.ks * slab + (size_t)(row0 + ai * HALF + m * 16) * ldc + col0;
#pragma unroll
                for (int bj = 0; bj < 2; ++bj) { f32x4 v0 = acc[ai][bj][m][0] * scale, v1 = acc[ai][bj][m][1] * scale;
                    if constexpr (NORM) { const float cb = cvec[(size_t)(u.pn >> 3) * 2560 + row0 + ai * HALF + m * 16]; v0 = v0 * rc[bj][0] + cb; v1 = v1 * rc[bj][1] + cb; }
                    *(u32x4*)(rowp + bj * HALF) = pack8(v0, v1); } }
    }
};
template <bool NORM> struct EpiInProj {
    static constexpr bool PERM = true, AFTER_DRAIN = false;
    bf16_t *Z, *Q, *Kt; const float *qg, *kg; float qscale;
    const float* ss; const float* cvec;
    __device__ __forceinline__ void operator()(const f32x4 (&acc)[2][2][4][2], const Unit& u, int wr, int wc, int fr, int fq) const {
        const int row0 = u.pm * BM + wr * 64 + fr;
        f32x4 cv[2][2]; float rr[2][4];
#pragma unroll
        for (int bj = 0; bj < 2; ++bj)
#pragma unroll
            for (int n = 0; n < 2; ++n) { if constexpr (NORM) cv[bj][n] = *(const f32x4*)(cvec + (size_t)(u.pm >> 3) * 2560 + u.pn * BM + bj * HALF + wc * 32 + 8 * fq + 4 * n); else cv[bj][n] = (f32x4){0.f, 0.f, 0.f, 0.f}; }
#pragma unroll
        for (int ai = 0; ai < 2; ++ai)
#pragma unroll
            for (int m = 0; m < 4; ++m) { if constexpr (NORM) rr[ai][m] = __builtin_amdgcn_rsqf(ss[row0 + ai * HALF + m * 16] * (1.f / 1024.f) + 1e-6f); else rr[ai][m] = 1.f; }
#define VAL(ai, bj, m, n) (NORM ? acc[ai][bj][m][n] * rr[ai][m] + cv[bj][n] : acc[ai][bj][m][n])
        if (u.pn < 4) {
            const int col0 = u.pn * 128 + wc * 32 + 8 * fq;
#pragma unroll
            for (int ai = 0; ai < 2; ++ai)
#pragma unroll
                for (int m = 0; m < 4; ++m) { f32x4 z0, z1;
                    const f32x4 a0 = VAL(ai, 0, m, 0), a1 = VAL(ai, 0, m, 1), g0 = VAL(ai, 1, m, 0), g1 = VAL(ai, 1, m, 1);
#pragma unroll
                    for (int i = 0; i < 4; ++i) { z0[i] = a0[i] * sigm(g0[i]); z1[i] = a1[i] * sigm(g1[i]); }
                    *(u32x4*)(Z + (size_t)(row0 + ai * HALF + m * 16) * 512 + col0) = pack8(z0, z1); }
        } else {
            const bool isq = u.pn < 6; bf16_t* O = isq ? Q : Kt; const float* gv = isq ? qg : kg; const float sc = isq ? qscale : 1.f;
            const int head = 4 * (u.pn & 1) + wc;
            f32x4 gw[2][2];
#pragma unroll
            for (int bj = 0; bj < 2; ++bj)
#pragma unroll
                for (int n = 0; n < 2; ++n) gw[bj][n] = *(const f32x4*)(gv + 32 * bj + 8 * fq + 4 * n) * sc;
#pragma unroll
            for (int ai = 0; ai < 2; ++ai)
#pragma unroll
                for (int m = 0; m < 4; ++m) { float hs = 0.f; f32x4 xv[2][2];
#pragma unroll
                    for (int bj = 0; bj < 2; ++bj)
#pragma unroll
                        for (int n = 0; n < 2; ++n) { const f32x4 x = VAL(ai, bj, m, n); xv[bj][n] = x; hs += (x[0] * x[0] + x[1] * x[1]) + (x[2] * x[2] + x[3] * x[3]); }
                    hs += __shfl_xor(hs, 16); hs += __shfl_xor(hs, 32);
                    const float r = __builtin_amdgcn_rsqf(hs * (1.f / 64.f) + 1e-6f);
                    bf16_t* rowp = O + (size_t)(row0 + ai * HALF + m * 16) * 512 + head * 64 + 8 * fq;
#pragma unroll
                    for (int bj = 0; bj < 2; ++bj) *(u32x4*)(rowp + 32 * bj) = pack8(xv[bj][0] * r * gw[bj][0], xv[bj][1] * r * gw[bj][1]); }
        }
#undef VAL
    }
};
template <bool NORM, bool INBF = false, bool OUTBF = false> struct EpiResGate {
    static constexpr bool PERM = false, AFTER_DRAIN = false;
    const float* xin; float* out; const float* gate;
    bf16_t* xg; float* ss; const float* gnext; const float* scnext;
    __device__ __forceinline__ void operator()(const f32x4 (&acc)[2][2][4][2], const Unit& u, int wr, int wc, int fr, int fq) const {
        const int row0 = u.pm * BM + wr * 64 + fr, col0 = u.pn * BM + wc * 32 + 4 * fq; const float* gp = gate + (size_t)(u.pm >> 3) * 6144 + col0;
        f32x4 gv[2][2], gm[2][2];
#pragma unroll
        for (int bj = 0; bj < 2; ++bj)
#pragma unroll
            for (int n = 0; n < 2; ++n) { gv[bj][n] = *(const f32x4*)(gp + bj * HALF + n * 16);
                if constexpr (NORM) gm[bj][n] = *(const f32x4*)(gnext + col0 + bj * HALF + n * 16) * (*(const f32x4*)(scnext + (size_t)(u.pm >> 3) * 6144 + col0 + bj * HALF + n * 16) + 1.f); }
#pragma unroll
        for (int ai = 0; ai < 2; ++ai)
#pragma unroll
            for (int m = 0; m < 4; ++m) { const int row = row0 + ai * HALF + m * 16; const size_t off = (size_t)row * 1024 + col0; float sq = 0.f;
#pragma unroll
                for (int bj = 0; bj < 2; ++bj)
#pragma unroll
                    for (int n = 0; n < 2; ++n) { typedef unsigned u32x2b __attribute__((ext_vector_type(2))); f32x4 xv;
                        if constexpr (INBF) { const u32x2b q = *(const u32x2b*)((const bf16_t*)xin + off + bj * HALF + n * 16); xv = (f32x4){__uint_as_float(q.x << 16), __uint_as_float(q.x & 0xffff0000u), __uint_as_float(q.y << 16), __uint_as_float(q.y & 0xffff0000u)}; }
                        else xv = *(const f32x4*)(xin + off + bj * HALF + n * 16);
                        const f32x4 xn = xv + gv[bj][n] * acc[ai][bj][m][n];
                        if constexpr (OUTBF) { u32x2b w; w.x = cvt_pk_bf16(xn[0], xn[1]); w.y = cvt_pk_bf16(xn[2], xn[3]); *(u32x2b*)((bf16_t*)out + off + bj * HALF + n * 16) = w; }
                        else *(f32x4*)(out + off + bj * HALF + n * 16) = xn;
                        if constexpr (NORM) { sq += (xn[0] * xn[0] + xn[1] * xn[1]) + (xn[2] * xn[2] + xn[3] * xn[3]); const f32x4 t = xn * gm[bj][n];
                            typedef unsigned u32x2 __attribute__((ext_vector_type(2))); u32x2 w; w.x = cvt_pk_bf16(t[0], t[1]); w.y = cvt_pk_bf16(t[2], t[3]); *(u32x2*)(xg + off + bj * HALF + n * 16) = w; } }
                if constexpr (NORM) { sq += __shfl_xor(sq, 16); sq += __shfl_xor(sq, 32); if (fq == 0) atomicAdd(ss + row, sq); } }
    }
};
template <bool F8OUT, bool NORM> struct EpiSwiGLU {
    static constexpr bool PERM = true, AFTER_DRAIN = false;
    bf16_t* O; int ldc; const float* rowscale; float oscale, iscale;
    const float* ss; const float* cvec;
    int ncv;
    __device__ __forceinline__ void operator()(const f32x4 (&acc)[2][2][4][2], const Unit& u, int wr, int wc, int fr, int fq) const {
        const int row0 = u.pm * BM + wr * 64 + fr; const int col0 = u.pn * 128 + wc * 32 + 8 * fq;
        f32x4 cg[2], cu[2];
        if constexpr (NORM) { const float* cp = cvec + (size_t)(u.pm >> 3) * ncv + u.pn * BM + wc * 32 + 8 * fq; cg[0] = *(const f32x4*)cp; cg[1] = *(const f32x4*)(cp + 4); cu[0] = *(const f32x4*)(cp + HALF); cu[1] = *(const f32x4*)(cp + HALF + 4); }
#pragma unroll
        for (int ai = 0; ai < 2; ++ai)
#pragma unroll
            for (int m = 0; m < 4; ++m) { const int row = row0 + ai * HALF + m * 16; const float rs = (rowscale ? rowscale[row + (u.pa - u.pm) * BM] : 1.f) * oscale;   f32x4 z0, z1;
                if constexpr (NORM) { const float r = __builtin_amdgcn_rsqf(ss[row] * (1.f / 1024.f) + 1e-6f);
#pragma unroll
                    for (int i = 0; i < 4; ++i) { const float g0 = r * acc[ai][0][m][0][i] + cg[0][i], g1 = r * acc[ai][0][m][1][i] + cg[1][i], u0 = r * acc[ai][1][m][0][i] + cu[0][i], u1 = r * acc[ai][1][m][1][i] + cu[1][i];
                        z0[i] = g0 * sigm(g0) * u0 * rs; z1[i] = g1 * sigm(g1) * u1 * rs; } }
                else {
#pragma unroll
                for (int i = 0; i < 4; ++i) { const float g0 = acc[ai][0][m][0][i] * iscale, g1 = acc[ai][0][m][1][i] * iscale;
                    z0[i] = g0 * sigm(g0) * acc[ai][1][m][0][i] * rs; z1[i] = g1 * sigm(g1) * acc[ai][1][m][1][i] * rs; } }
                if constexpr (F8OUT) { typedef unsigned u32x2 __attribute__((ext_vector_type(2))); u32x2 w; w.x = pk4_fp8(z0[0], z0[1], z0[2], z0[3]); w.y = pk4_fp8(z1[0], z1[1], z1[2], z1[3]);
                    *(u32x2*)((unsigned char*)O + (size_t)row * ldc + col0) = w; }
                else *(u32x4*)(O + (size_t)row * ldc + col0) = pack8(z0, z1); }
    }
};
struct EpiNone {
    static constexpr bool PERM = true, AFTER_DRAIN = false;
    __device__ __forceinline__ void operator()(const f32x4 (&acc)[2][2][4][2], const Unit& u, int wr, int wc, int fr, int fq) const {
#pragma unroll
        for (int ai = 0; ai < 2; ++ai)
#pragma unroll
            for (int bj = 0; bj < 2; ++bj)
#pragma unroll
                for (int m = 0; m < 4; ++m)
#pragma unroll
                    for (int n = 0; n < 2; ++n) asm volatile("" :: "v"(acc[ai][bj][m][n]));
    }
};
__device__ __forceinline__ const char* uptr(const char* p) { unsigned long long v = (unsigned long long)p; const unsigned lo = __builtin_amdgcn_readfirstlane((unsigned)v), hi = __builtin_amdgcn_readfirstlane((unsigned)(v >> 32)); unsigned long long r = ((unsigned long long)hi << 32) | lo; asm volatile("" : "+s"(r)); return (const char*)r; }
template <class Epi, class Sched, bool ALIGN_EPI = false, bool SP2 = false, bool FP8 = false>
__device__ __forceinline__ void gemm_phase(PG8_LAS unsigned char* lds, const Gemm g, const Sched& S, const Epi& E) {
    int tid_ = threadIdx.x; asm volatile("" : "+v"(tid_)); const int tid = tid_, wid = __builtin_amdgcn_readfirstlane(tid >> 6), lane = tid & 63, wr = wid >> 2, wc = wid & 3, fr = lane & 15, fq = lane >> 4;
    const int KB0 = FP8 ? g.K : g.K * 2, nt = KB0 / (BK * 2), KB = g.ld ? (FP8 ? g.ld : g.ld * 2) : KB0;
    unsigned voffA, voffB;
    { int R, C; stage_rc(tid * 16, R, C); const int Rb = Epi::PERM ? ((R & ~31) + perm32(R & 31)) : R;
        voffA = (unsigned)(R * KB + C * 2); voffB = (unsigned)(Rb * KB + C * 2); }
    const unsigned pstep = 64u * KB;
    constexpr unsigned kstep = BK * 2;
    const unsigned hstep = (unsigned)HALF * KB;
    const unsigned tstep = 2 * hstep;
    const unsigned ldsw = (unsigned)wid * 1024u;
    const int aoff = lds_byte(wr * 64 + fr, fq * 8), boff = lds_byte(wc * 32 + fr, fq * 8);
#define PG8_SA(b, h) (((b) * 2 + (h)) * HTB)
#define PG8_SB(b, h) ((4 + (b) * 2 + (h)) * HTB)
#define PG8_STAGE(bufoff, gbase, voff) do { unsigned vo_ = (voff); asm volatile("" : "+v"(vo_));   \
        _Pragma("unroll") for (int _i = 0; _i < 2; ++_i) \
        __builtin_amdgcn_global_load_lds((const unsigned*)((const char*)(gbase) + _i * pstep + vo_), (PG8_LAS unsigned*)(lds + (bufoff) + ldsw + _i * 8192), 16, 0, 0); } while (0)
#define PG8_LDA(dst, b, h) do { _Pragma("unroll") for (int m = 0; m < 4; ++m) { if constexpr (FP8) { const v4i lo_ = *(const PG8_LAS v4i*)(lds + PG8_SA(b, h) + aoff + m * 2048), hi_ = *(const PG8_LAS v4i*)(lds + PG8_SA(b, h) + aoff + m * 2048 + 1024); dst##8[m] = __builtin_shufflevector(lo_, hi_, 0, 1, 2, 3, 4, 5, 6, 7); } \
        else { _Pragma("unroll") for (int k = 0; k < 2; ++k) dst[m][k] = *(const PG8_LAS bf16x8*)(lds + PG8_SA(b, h) + aoff + m * 2048 + k * 1024); } } } while (0)
#define PG8_LDB(dst, b, h) do { _Pragma("unroll") for (int n = 0; n < 2; ++n) { if constexpr (FP8) { const v4i lo_ = *(const PG8_LAS v4i*)(lds + PG8_SB(b, h) + boff + n * 2048), hi_ = *(const PG8_LAS v4i*)(lds + PG8_SB(b, h) + boff + n * 2048 + 1024); dst##8[n] = __builtin_shufflevector(lo_, hi_, 0, 1, 2, 3, 4, 5, 6, 7); } \
        else { _Pragma("unroll") for (int k = 0; k < 2; ++k) dst[n][k] = *(const PG8_LAS bf16x8*)(lds + PG8_SB(b, h) + boff + n * 2048 + k * 1024); } } } while (0)
#define PG8_MMA(ai, bj, At, Bt) do { __builtin_amdgcn_s_setprio(1); _Pragma("unroll") for (int m = 0; m < 4; ++m) _Pragma("unroll") for (int n = 0; n < 2; ++n) { \
        if constexpr (FP8) asm volatile("v_mfma_f32_16x16x128_f8f6f4 %0, %1, %2, %0" : "+v"(acc[ai][bj][m][n]) : "v"(Bt##8[n]), "v"(At##8[m]));   \
        else { _Pragma("unroll") for (int k = 0; k < 2; ++k) acc[ai][bj][m][n] = __builtin_amdgcn_mfma_f32_16x16x32_bf16(Bt[n][k], At[m][k], acc[ai][bj][m][n], 0, 0, 0); } } \
        __builtin_amdgcn_s_setprio(0); } while (0)
#define PG8_WAIT_V(n) asm volatile("s_waitcnt vmcnt(" #n ")" ::: "memory")
#define PG8_WAIT_L(n) asm volatile("s_waitcnt lgkmcnt(" #n ")" ::: "memory")
#define PG8_BAR __builtin_amdgcn_s_barrier()
#define PG8_SCHED __builtin_amdgcn_sched_barrier(0)
    Unit cur, nxt; int ui = 0;
    if (!S.next(0, cur)) return;
    f32x4 acc[2][2][4][2];
#pragma unroll
    for (int a = 0; a < 2; ++a)
#pragma unroll
        for (int b = 0; b < 2; ++b)
#pragma unroll
            for (int m = 0; m < 4; ++m)
#pragma unroll
                for (int n = 0; n < 2; ++n) acc[a][b][m][n] = (f32x4){0.f, 0.f, 0.f, 0.f};
    bf16x8 At[4][2], B0[2][2], B1[2][2]; v8i At8[4], B08[2], B18[2];
    const char* cA = (const char*)g.A + (unsigned)cur.pa * tstep + (unsigned)cur.ks * (unsigned)KB0; const char* cB = (const char*)g.Bt + (unsigned)cur.e * g.bstride + (unsigned)cur.pn * tstep + (unsigned)cur.ks * (unsigned)KB0;
    S.a_ready(cur);
    if constexpr (SP2) {
        PG8_STAGE(PG8_SB(0, 0), cB, voffB); PG8_STAGE(PG8_SB(0, 1), cB + hstep, voffB); PG8_STAGE(PG8_SA(0, 0), cA, voffA); PG8_STAGE(PG8_SA(0, 1), cA + hstep, voffA);
        if (wr == 1) PG8_BAR;
        PG8_WAIT_V(2); PG8_BAR;
        PG8_STAGE(PG8_SB(1, 0), cB + kstep, voffB); PG8_STAGE(PG8_SA(1, 0), cA + kstep, voffA); PG8_STAGE(PG8_SB(1, 1), cB + hstep + kstep, voffB);
        PG8_WAIT_V(6); PG8_BAR;
    } else {
        PG8_STAGE(PG8_SB(0, 0), cB, voffB); PG8_STAGE(PG8_SA(0, 0), cA, voffA); PG8_STAGE(PG8_SB(0, 1), cB + hstep, voffB); PG8_STAGE(PG8_SA(0, 1), cA + hstep, voffA);
        if (wr == 1) PG8_BAR;
        PG8_WAIT_V(4); PG8_BAR;
        PG8_STAGE(PG8_SB(1, 0), cB + kstep, voffB); PG8_STAGE(PG8_SA(1, 0), cA + kstep, voffA); PG8_STAGE(PG8_SB(1, 1), cB + hstep + kstep, voffB);
        PG8_WAIT_V(6); PG8_BAR;
    }
    for (;;) {
        const bool has_next = S.next(ui + 1, nxt);
        const char* nA = has_next ? (const char*)g.A + (unsigned)nxt.pa * tstep + (unsigned)nxt.ks * (unsigned)KB0 : cA; const char* nB = has_next ? (const char*)g.Bt + (unsigned)nxt.e * g.bstride + (unsigned)nxt.pn * tstep + (unsigned)nxt.ks * (unsigned)KB0 : cB;
#pragma unroll 1
        for (int t = 0; t < nt; t += 2) {
            const bool last = (t == nt - 2);
            const char* a1 = cA + (unsigned)(t + 1) * kstep;
            const char* a2 = last ? nA : cA + (unsigned)(t + 2) * kstep; const char* b2 = last ? nB : cB + (unsigned)(t + 2) * kstep;
            const char* a3 = a2 + kstep; const char* b3 = b2 + kstep;
            a1 = uptr(a1); a2 = uptr(a2); b2 = uptr(b2); a3 = uptr(a3); b3 = uptr(b3);
            if (last && has_next) S.a_ready(nxt);
            if constexpr (SP2) {
            PG8_LDB(B0, 0, 0); PG8_LDB(B1, 0, 1); PG8_SCHED; PG8_LDA(At, 0, 0); PG8_STAGE(PG8_SA(1, 1), a1 + hstep, voffA);
            PG8_WAIT_V(8); PG8_WAIT_L(0); PG8_BAR; PG8_MMA(0, 0, At, B0); PG8_MMA(0, 1, At, B1); PG8_BAR; PG8_SCHED;
            PG8_LDA(At, 0, 1); PG8_STAGE(PG8_SB(0, 0), b2, voffB); PG8_STAGE(PG8_SB(0, 1), b2 + hstep, voffB); PG8_STAGE(PG8_SA(0, 0), a2, voffA);
            PG8_WAIT_V(8); PG8_WAIT_L(0); PG8_BAR; PG8_MMA(1, 0, At, B0); PG8_MMA(1, 1, At, B1); PG8_BAR; PG8_SCHED;
            PG8_LDB(B0, 1, 0); PG8_LDB(B1, 1, 1); PG8_SCHED; PG8_LDA(At, 1, 0); PG8_STAGE(PG8_SA(0, 1), a2 + hstep, voffA);
            PG8_WAIT_V(8); PG8_WAIT_L(0); PG8_BAR; PG8_MMA(0, 0, At, B0); PG8_MMA(0, 1, At, B1); PG8_BAR; PG8_SCHED;
            PG8_LDA(At, 1, 1); PG8_STAGE(PG8_SB(1, 0), b3, voffB); PG8_STAGE(PG8_SB(1, 1), b3 + hstep, voffB); PG8_STAGE(PG8_SA(1, 0), a3, voffA);
            PG8_WAIT_V(8); PG8_WAIT_L(0); PG8_BAR; PG8_MMA(1, 0, At, B0); PG8_MMA(1, 1, At, B1); PG8_BAR; PG8_SCHED;
            } else {
            PG8_LDB(B0, 0, 0); PG8_SCHED; PG8_LDA(At, 0, 0); PG8_STAGE(PG8_SA(1, 1), a1 + hstep, voffA);
            PG8_WAIT_L(8); PG8_BAR; PG8_WAIT_L(0); PG8_MMA(0, 0, At, B0); PG8_BAR; PG8_SCHED;
            PG8_LDB(B1, 0, 1); PG8_STAGE(PG8_SB(0, 0), b2, voffB);
            PG8_BAR; PG8_WAIT_L(0); PG8_MMA(0, 1, At, B1); PG8_BAR;
            PG8_LDA(At, 0, 1); PG8_STAGE(PG8_SA(0, 0), a2, voffA);
            PG8_BAR; PG8_WAIT_L(0); PG8_MMA(1, 0, At, B0); PG8_BAR; PG8_SCHED;
            PG8_STAGE(PG8_SB(0, 1), b2 + hstep, voffB);
            PG8_WAIT_V(6); PG8_BAR; PG8_MMA(1, 1, At, B1); PG8_BAR;
            PG8_LDB(B0, 1, 0); PG8_SCHED; PG8_LDA(At, 1, 0); PG8_STAGE(PG8_SA(0, 1), a2 + hstep, voffA);
            PG8_WAIT_L(8); PG8_BAR; PG8_WAIT_L(0); PG8_MMA(0, 0, At, B0); PG8_BAR; PG8_SCHED;
            PG8_LDB(B1, 1, 1); PG8_STAGE(PG8_SB(1, 0), b3, voffB);
            PG8_BAR; PG8_WAIT_L(0); PG8_MMA(0, 1, At, B1); PG8_BAR;
            PG8_LDA(At, 1, 1); PG8_STAGE(PG8_SA(1, 0), a3, voffA);
            PG8_BAR; PG8_WAIT_L(0); PG8_MMA(1, 0, At, B0); PG8_BAR; PG8_SCHED;
            PG8_STAGE(PG8_SB(1, 1), b3 + hstep, voffB);
            PG8_WAIT_V(6); PG8_BAR; PG8_MMA(1, 1, At, B1); PG8_BAR;
            }
        }
        if constexpr (FP8) asm volatile("s_nop 15\n\ts_nop 15" ::: "memory");
        if constexpr (ALIGN_EPI) { if (wr == 0) PG8_BAR; }
        if constexpr (!Epi::AFTER_DRAIN) { int l_ = threadIdx.x; asm volatile("" : "+v"(l_)); const int fr_ = l_ & 15, fq_ = (l_ >> 4) & 3; E(acc, cur, wr, wc, fr_, fq_); S.done(cur); }
        if (!has_next) break;
#pragma unroll
        for (int a = 0; a < 2; ++a)
#pragma unroll
            for (int b = 0; b < 2; ++b)
#pragma unroll
                for (int m = 0; m < 4; ++m)
#pragma unroll
                    for (int n = 0; n < 2; ++n) acc[a][b][m][n] = (f32x4){0.f, 0.f, 0.f, 0.f};
        cur = nxt; cA = nA; cB = nB; ++ui;
        if constexpr (ALIGN_EPI) { if (wr == 1) PG8_BAR; }
    }
    PG8_WAIT_V(0);
    if constexpr (!ALIGN_EPI) { if (wr == 0) PG8_BAR; }
    PG8_BAR;
    if constexpr (Epi::AFTER_DRAIN) { E.fused(acc, cur, wr, wc, fr, fq, lds, wid, lane); S.done(cur); }
#undef PG8_SA
#undef PG8_SB
#undef PG8_STAGE
#undef PG8_LDA
#undef PG8_LDB
#undef PG8_MMA
#undef PG8_WAIT_V
#undef PG8_WAIT_L
#undef PG8_BAR
#undef PG8_SCHED
}
}

namespace fk {
using pg8::bf16_t; using pg8::bf16x8; using pg8::f32x4; using pg8::u32x4;
constexpr int NWAVES = 8, NTHR = 512, GRID = 256, NGW = GRID * NWAVES;
constexpr int B_ = 8, S_ = 2048, D = 1024, M = B_ * S_, DIN = 2560, DC = 512, FFD = 2816, NE = 8, FFE = 3584, CW = 31, NREL = 257;
constexpr float LOG2E = 1.4426950408889634f, QSCALE = 0.125f * LOG2E, EPS = 1e-6f;
constexpr size_t MiB = 1u << 20;
constexpr size_t WS_CTL = 0, CTL_ZERO_BYTES = 1 * MiB;
constexpr size_t WS_SS1 = 256 * 1024, WS_SS2 = 320 * 1024;
constexpr size_t WS_MODP = 1 * MiB;
constexpr size_t WS_CFF = 1 * MiB, WS_CIN = 1 * MiB + 256 * 1024;
constexpr size_t WS_MOD = 4 * MiB;
constexpr size_t WS_PAIR = 4 * MiB + 512 * 1024;
constexpr size_t WS_LIST = 5 * MiB;
constexpr size_t WS_WL = 5 * MiB + 512 * 1024;
constexpr size_t WS_WLG = 6 * MiB;
constexpr size_t WS_WMGU = 8 * MiB;
constexpr size_t WS_WMD = 120 * MiB;
constexpr size_t WS_XB = 64 * MiB;
constexpr size_t WS_FP = 148 * MiB;
constexpr size_t WS_WIN = 176 * MiB;
constexpr size_t WS_WOUT = 186 * MiB;
constexpr size_t WS_WGU = 190 * MiB;
constexpr size_t WS_WD = 201 * MiB;
constexpr size_t WS_H = 207 * MiB;
constexpr size_t WS_Z = 239 * MiB, WS_Q = 255 * MiB, WS_K = 271 * MiB, WS_VT = 287 * MiB;
constexpr size_t WS_YC = 303 * MiB;
constexpr size_t WS_ACT = 239 * MiB;
constexpr size_t WS_HG = 363 * MiB;
constexpr size_t WS_F = 176 * MiB;
constexpr size_t WS_ACTM = 244 * MiB;
constexpr size_t WS_END = 491 * MiB;
constexpr int MAXROWS = 34816;
constexpr int CW_BAR = 4096, CW_CNT = 16384;
constexpr int RING_BYTES = 131072, LDSCTL_OFF = RING_BYTES, MISC_OFF = LDSCTL_OFF + 320, MOETAB_OFF = LDSCTL_OFF + 512;
constexpr int LDS_BYTES = 147456;

#define GAS __attribute__((address_space(1)))
#define LAS __attribute__((address_space(3)))
typedef unsigned short bf16;
typedef unsigned v4u __attribute__((ext_vector_type(4)));
typedef unsigned v2u __attribute__((ext_vector_type(2)));
typedef float f32x16 __attribute__((ext_vector_type(16)));
typedef short s16x4 __attribute__((ext_vector_type(4)));
typedef float f32x2_t __attribute__((ext_vector_type(2))); typedef __bf16 bf16x2_t __attribute__((ext_vector_type(2)));
__device__ __forceinline__ unsigned pk2(float lo, float hi) { f32x2_t v = {lo, hi}; bf16x2_t b = __builtin_convertvector(v, bf16x2_t); return __builtin_bit_cast(unsigned, b); }
__device__ __forceinline__ float bf2f(bf16 v) { return __uint_as_float((unsigned)v << 16); }
#define DPP_F(v, ctrl) __uint_as_float((unsigned)__builtin_amdgcn_update_dpp(0, (int)__float_as_uint(v), (ctrl), 0xF, 0xF, true))
#define DPP_XOR1 0xB1
#define DPP_XOR2 0x4E
#define DPP_HMIRROR 0x141
#define DPP_MIRROR 0x140
#define DPP_ROR8 0x128
#define RDLANE_F(v, l) __uint_as_float((unsigned)__builtin_amdgcn_readlane((int)__float_as_uint(v), (l)))
__device__ __forceinline__ float wave_sum(float v) {
    v += DPP_F(v, DPP_XOR1); v += DPP_F(v, DPP_XOR2); v += DPP_F(v, DPP_HMIRROR); v += DPP_F(v, DPP_MIRROR);
    return (RDLANE_F(v, 0) + RDLANE_F(v, 16)) + (RDLANE_F(v, 32) + RDLANE_F(v, 48));
}
__device__ __forceinline__ float sigm(float x) { return __builtin_amdgcn_rcpf(1.f + __builtin_amdgcn_exp2f(-LOG2E * x)); }
using pg8::pk4_fp8;
constexpr float W8_SCALE = 64.f, H8_SCALE = 8.f, A8_SCALE = 4.f;
constexpr int E8_W = (127 - 6) * 0x01010101, E8_H = (127 - 3) * 0x01010101, E8_A = (127 - 2) * 0x01010101;
#define LDS_WAIT() asm volatile("s_waitcnt lgkmcnt(0)" ::: "memory")
#define RFL(x) __builtin_amdgcn_readfirstlane(x)

#define XB_TMO      128
#define XB_XCNT(j)  (256  + 64 * (j))
#define XB_XSUB(j)  (1280 + 64 * (j))
#define XB_XGEN(j)  (2304 + 64 * (j))
#define XB_TOP      3328
#define XB_TOPGEN   3392
#define XCD_BAR_WORDS 3456
#define XB_SPIN_CAP (1u << 18)

__device__ __forceinline__ unsigned xb_ld(unsigned* p)              { return __hip_atomic_load(p, __ATOMIC_RELAXED, __HIP_MEMORY_SCOPE_AGENT); }
__device__ __forceinline__ unsigned xb_add(unsigned* p, unsigned v) { return __hip_atomic_fetch_add(p, v, __ATOMIC_RELAXED, __HIP_MEMORY_SCOPE_AGENT); }
__device__ __forceinline__ unsigned xb_xcc_id() { return (unsigned)__builtin_amdgcn_s_getreg((3 << 11) | 20) & 0xFu; }
#define XB_SPIN(cond, bar) do { unsigned _sp = 0; while (cond) { __builtin_amdgcn_s_sleep(1); \
    if ((++_sp & 255u) == 0u) { if (xb_ld(&(bar)[XB_TMO])) break; if (_sp > XB_SPIN_CAP) { atomicAdd(&(bar)[XB_TMO], 1u); break; } } } } while (0)

struct XcdBarrier {
    unsigned* bar; unsigned x;
    volatile LAS unsigned* st;
};

__device__ __forceinline__ XcdBarrier xcd_barrier_post(unsigned* bar, volatile LAS unsigned* st) {
    XcdBarrier b; b.bar = bar; b.x = xb_xcc_id(); b.st = st;
    if (threadIdx.x == 0) (void)xb_add(&bar[XB_XCNT(b.x)], 1u);
    return b;
}
__device__ __forceinline__ void xcd_barrier_complete(unsigned* bar, unsigned x, unsigned& nloc, unsigned& nx) {
    const unsigned G = gridDim.x * gridDim.y * gridDim.z;
    unsigned sum, cnt, mine, sp = 0u;
    for (;;) {
        sum = 0u; cnt = 0u; mine = 0u;
#pragma unroll
        for (unsigned j = 0; j < 16; ++j) { const unsigned c = xb_ld(&bar[XB_XCNT(j)]); sum += c; cnt += (c > 0u) ? 1u : 0u; mine = (j == x) ? c : mine; }
        if (sum == G) break;
        __builtin_amdgcn_s_sleep(1);
        if ((++sp & 255u) == 0u) { if (xb_ld(&bar[XB_TMO])) break; if (sp > XB_SPIN_CAP) { atomicAdd(&bar[XB_TMO], 1u); break; } }
    }
    nloc = mine > 0u ? mine : 1u; nx = cnt > 0u ? cnt : 1u;
}

__device__ __forceinline__ void xcd_barrier(const XcdBarrier& b) {
    asm volatile("s_waitcnt vmcnt(0)" ::: "memory");
    __syncthreads();
    if (threadIdx.x == 0) {
        unsigned* bar = b.bar;
        __builtin_amdgcn_s_waitcnt(0);
        unsigned nloc = b.st[0], nx = b.st[1];
        if (nloc == 0u) { xcd_barrier_complete(bar, b.x, nloc, nx); b.st[0] = nloc; b.st[1] = nx; }
        const unsigned old = xb_add(&bar[XB_XSUB(b.x)], 1u);
        const unsigned gen = old / nloc;
        if (old + 1u == (gen + 1u) * nloc) {
            __builtin_amdgcn_fence(__ATOMIC_RELEASE, "agent");
            asm volatile("s_waitcnt vmcnt(0)" ::: "memory");
            const unsigned og = xb_add(&bar[XB_TOP], 1u);
            const unsigned tg = og / nx;
            if (og + 1u == (tg + 1u) * nx) xb_add(&bar[XB_TOPGEN], 1u);
            else XB_SPIN(xb_ld(&bar[XB_TOPGEN]) == tg, bar);
            __builtin_amdgcn_fence(__ATOMIC_ACQUIRE, "agent");
            xb_add(&bar[XB_XGEN(b.x)], 1u);
            asm volatile("s_waitcnt vmcnt(0)" ::: "memory");
        } else {
            XB_SPIN(xb_ld(&bar[XB_XGEN(b.x)]) == gen, bar);
            __builtin_amdgcn_fence(__ATOMIC_ACQUIRE, "agent");
            asm volatile("s_waitcnt vmcnt(0)" ::: "memory");
        }
    }
    __syncthreads();
}


#ifndef FUSE_NORM
#define FUSE_NORM 0
#endif
#ifndef REPMASK
#define REPMASK 0
#endif
struct Params { const float* in[23]; float* out; unsigned char* ws; int stop; int pad; };

__device__ __forceinline__ void tr_item(const float* W, int K, int N, bf16* WT, int kb, int nb, int drow0, LAS float* scr, int lane) {
    const int k0 = 64 * kb, n0 = 32 * nb;
    { f32x4 v[8];
#pragma unroll
      for (int i = 0; i < 8; ++i) v[i] = *(const GAS f32x4*)(W + (size_t)(k0 + 8 * i + (lane >> 3)) * N + n0 + (lane & 7) * 4);
#pragma unroll
      for (int i = 0; i < 8; ++i) { LAS float* d = scr + (8 * i + (lane >> 3)) * 33 + (lane & 7) * 4; d[0] = v[i].x; d[1] = v[i].y; d[2] = v[i].z; d[3] = v[i].w; } }
    LDS_WAIT(); asm volatile("" ::: "memory");
    const int c = lane & 7;
#pragma unroll
    for (int j = 0; j < 4; ++j) { const int n = (lane >> 3) + 8 * j; const LAS float* s = scr + (8 * c) * 33 + n;
        v4u o; o.x = pk2(s[0 * 33], s[1 * 33]); o.y = pk2(s[2 * 33], s[3 * 33]); o.z = pk2(s[4 * 33], s[5 * 33]); o.w = pk2(s[6 * 33], s[7 * 33]);
        *(GAS v4u*)(WT + (size_t)(drow0 + n) * K + k0 + 8 * c) = o; }
    LDS_WAIT(); asm volatile("" ::: "memory");
}
__device__ __forceinline__ void tr_item_f8(const float* W, int K, int N, unsigned char* WT, int kb, int nb, int drow0, LAS float* scr, int lane, float scale) {
    const int k0 = 64 * kb, n0 = 32 * nb;
    { f32x4 v[8];
#pragma unroll
      for (int i = 0; i < 8; ++i) v[i] = __builtin_nontemporal_load((const GAS f32x4*)(W + (size_t)(k0 + 8 * i + (lane >> 3)) * N + n0 + (lane & 7) * 4));
#pragma unroll
      for (int i = 0; i < 8; ++i) { LAS float* d = scr + (8 * i + (lane >> 3)) * 33 + (lane & 7) * 4; d[0] = v[i].x; d[1] = v[i].y; d[2] = v[i].z; d[3] = v[i].w; } }
    LDS_WAIT(); asm volatile("" ::: "memory");
    const int c = lane & 7;
#pragma unroll
    for (int j = 0; j < 4; ++j) { const int n = (lane >> 3) + 8 * j; const LAS float* s = scr + (8 * c) * 33 + n;
        v2u o; o.x = pk4_fp8(s[0 * 33] * scale, s[1 * 33] * scale, s[2 * 33] * scale, s[3 * 33] * scale); o.y = pk4_fp8(s[4 * 33] * scale, s[5 * 33] * scale, s[6 * 33] * scale, s[7 * 33] * scale);
        __builtin_nontemporal_store(o, (GAS v2u*)(WT + (size_t)(drow0 + n) * K + k0 + 8 * c)); }
    LDS_WAIT(); asm volatile("" ::: "memory");
}
__device__ __forceinline__ int rowmap_win(int n0) {
    if (n0 < 512) return 256 * (n0 >> 7) + (n0 & 127);
    if (n0 < 1024) { const int m = n0 - 512; return 256 * (m >> 7) + 128 + (m & 127); }
    if (n0 < 2048) { const int isk = n0 >= 1536; const int m = n0 - (isk ? 1536 : 1024); const int head = m >> 6, bj = (m >> 5) & 1; return 256 * (4 + 2 * isk + (head >> 2)) + 128 * bj + 32 * (head & 3); }
    return n0;
}
__device__ __forceinline__ int rowmap_gu(int n0, int up) { return 256 * (n0 >> 7) + 128 * up + (n0 & 127); }

constexpr int MOE_ITEMS = 16 * (16 * 112) + 8 * (56 * 32);
constexpr int FILL_S0 = 10240, FILL_S1 = 22528, FILL_S2 = 32768, FILL_MIX = 0, FILL_P0 = FILL_S2 + 2 * FILL_MIX;
struct MoeItem { const float* src; unsigned char* dst; int N, K; };
__device__ __forceinline__ MoeItem moe_item_decode(const Params& P, int r, int lane) {
    constexpr int I_MG = 16 * 112, I_MD = 56 * 32; MoeItem m;
    if (r < 16 * I_MG) { const int mat = r / I_MG, q = r % I_MG, e = mat >> 1, up = mat & 1; const int kb = q / 112, nb = q % 112;
        m.N = FFE; m.K = D; m.src = (up ? P.in[21] : P.in[20]) + (size_t)e * D * FFE + (size_t)(64 * kb + (lane >> 3)) * FFE + 32 * nb + (lane & 7) * 4;
        m.dst = (unsigned char*)(P.ws + WS_WMGU) + (size_t)e * 7168 * D + (size_t)rowmap_gu(32 * nb, up) * D + 64 * kb; }
    else { r -= 16 * I_MG; const int e = r / I_MD, q = r % I_MD; const int kb = q / 32, nb = q % 32;
        m.N = D; m.K = FFE; m.src = P.in[22] + (size_t)e * FFE * D + (size_t)(64 * kb + (lane >> 3)) * D + 32 * nb + (lane & 7) * 4;
        m.dst = (unsigned char*)(P.ws + WS_WMD) + (size_t)e * D * FFE + (size_t)(32 * nb) * FFE + 64 * kb; }
    return m;
}
__device__ __forceinline__ void moe_item_load(const MoeItem& m, f32x4 (&v)[8]) {
#pragma unroll
    for (int i = 0; i < 8; ++i) v[i] = __builtin_nontemporal_load((const GAS f32x4*)(m.src + (size_t)(8 * i) * m.N));
}
__device__ __forceinline__ void moe_item_finish(const MoeItem& m, const f32x4 (&v)[8], LAS float* scr, int lane) {
#pragma unroll
    for (int i = 0; i < 8; ++i) { LAS float* d = scr + (8 * i + (lane >> 3)) * 33 + (lane & 7) * 4; d[0] = v[i].x; d[1] = v[i].y; d[2] = v[i].z; d[3] = v[i].w; }
    LDS_WAIT(); asm volatile("" ::: "memory");
    const int c = lane & 7;
#pragma unroll
    for (int j = 0; j < 4; ++j) { const int n = (lane >> 3) + 8 * j; const LAS float* s = scr + (8 * c) * 33 + n;
        v2u o; o.x = pk4_fp8(s[0 * 33] * W8_SCALE, s[1 * 33] * W8_SCALE, s[2 * 33] * W8_SCALE, s[3 * 33] * W8_SCALE); o.y = pk4_fp8(s[4 * 33] * W8_SCALE, s[5 * 33] * W8_SCALE, s[6 * 33] * W8_SCALE, s[7 * 33] * W8_SCALE);
        __builtin_nontemporal_store(o, (GAS v2u*)(m.dst + (size_t)n * m.K + 8 * c)); }
    LDS_WAIT(); asm volatile("" ::: "memory");
}
__device__ __forceinline__ void moe_fill_run(const Params& P, LAS unsigned char* lds, int first, int stride, int hi, int lane, int wave);
__device__ __forceinline__ void moe_filler(const Params& P, LAS unsigned char* lds, int lo, int hi, int lane, int wave, int wgi) {
    if (wgi < 128) return;
    moe_fill_run(P, lds, lo + (wgi - 128) * NWAVES + wave, 128 * NWAVES, hi, lane, wave);
}
__device__ __forceinline__ void moe_fill_run(const Params& P, LAS unsigned char* lds, int first, int stride, int hi, int lane, int wave) {
    LAS float* scr = (LAS float*)(lds + wave * 8448);
    int it = first; if (it >= hi) return;
    MoeItem cur = moe_item_decode(P, it, lane); f32x4 v[8]; moe_item_load(cur, v);
    for (;;) { const int nx = it + stride; const bool more = nx < hi;
        MoeItem nxt = cur; f32x4 vn[8];
        if (more) { nxt = moe_item_decode(P, nx, lane); moe_item_load(nxt, vn); }
        moe_item_finish(cur, v, scr, lane);
        if (!more) break;
        cur = nxt; it = nx;
#pragma unroll
        for (int i = 0; i < 8; ++i) v[i] = vn[i];
    }
}

__device__ __forceinline__ void phase0(const Params& P, LAS unsigned char* lds, int tid, int lane, int wave, int gw) {
    LAS float* cact = (LAS float*)(lds + 69632);
    { const float* c = P.in[1]; for (int i = tid; i < B_ * D; i += NTHR) { const float v = c[i]; cact[i] = v * sigm(v); } }
    __syncthreads();
    {
        const float* w_ada = P.in[2]; float* modp = (float*)(P.ws + WS_MODP);
        for (int it = gw; it < 1536; it += NGW) {
            const int ks = it & 7, jb = (it >> 3) % 96, l = it / 768;
            const float* wp = w_ada + ((size_t)l * D + ks * 128) * 6144 + jb * 64 + lane;
            float acc[8];
#pragma unroll
            for (int b = 0; b < 8; ++b) acc[b] = 0.f;
#pragma unroll 8
            for (int k = 0; k < 128; ++k) { const float w = wp[(size_t)k * 6144];
#pragma unroll
                for (int b = 0; b < 8; ++b) acc[b] += cact[b * D + ks * 128 + k] * w; }
#pragma unroll
            for (int b = 0; b < 8; ++b) modp[(((size_t)ks * 2 + l) * 8 + b) * 6144 + jb * 64 + lane] = acc[b];
        }
    }
    LAS float* scr = (LAS float*)(lds + wave * 8448);
    constexpr int I_WIN = 16 * 80, I_WOUT = 16 * 32, I_FG = 16 * 88, I_FD = 44 * 32, I_MG = 16 * 112, I_MD = 56 * 32;
    constexpr int NITEMS = 2 * I_WIN + 2 * I_WOUT + 2 * I_FG + I_FD + 16 * I_MG + 8 * I_MD; static_assert(16 * I_MG + 8 * I_MD == MOE_ITEMS, "item counts");
    for (int it = gw; it < NITEMS - MOE_ITEMS; it += NGW) {
        int r = it;
        if (r < 2 * I_WIN) { const int l = r / I_WIN, q = r % I_WIN; const int kb = q / 80, nb = q % 80;
            tr_item(P.in[6] + (size_t)l * D * DIN, D, DIN, (bf16*)(P.ws + WS_WIN) + (size_t)l * DIN * D, kb, nb, rowmap_win(32 * nb), scr, lane); continue; }
        r -= 2 * I_WIN;
        if (r < 2 * I_WOUT) { const int l = r / I_WOUT, q = r % I_WOUT; const int kb = q / 32, nb = q % 32;
            tr_item(P.in[7] + (size_t)l * D * D, D, D, (bf16*)(P.ws + WS_WOUT) + (size_t)l * D * D, kb, nb, 32 * nb, scr, lane); continue; }
        r -= 2 * I_WOUT;
        if (r < 2 * I_FG) { const int up = r / I_FG, q = r % I_FG; const int kb = q / 88, nb = q % 88;
            tr_item((up ? P.in[16] : P.in[15]), D, FFD, (bf16*)(P.ws + WS_WGU), kb, nb, rowmap_gu(32 * nb, up), scr, lane); continue; }
        r -= 2 * I_FG;
        { const int kb = r / 32, nb = r % 32; tr_item(P.in[17], FFD, D, (bf16*)(P.ws + WS_WD), kb, nb, 32 * nb, scr, lane); }
    }    moe_fill_run(P, lds, FILL_P0 + gw, NGW, MOE_ITEMS, lane, wave);
}

__device__ __forceinline__ void cvec_fill(const Params& P, LAS unsigned char* lds, int tid, int lane, int wave, int wgi) {
    if (wgi < 128) return;
    LAS float* shL = (LAS float*)lds;
    const float* mod = (const float*)(P.ws + WS_MOD);
    for (int i = tid; i < 2 * 8 * D; i += NTHR) { const int which = i >> 13, b = (i >> 10) & 7, k = i & 1023; shL[i] = which ? mod[((size_t)8 + b) * 6144 + k] : mod[(size_t)b * 6144 + 3072 + k]; }
    __syncthreads();
    const bf16* Wgu = (const bf16*)(P.ws + WS_WGU); const bf16* Win1 = (const bf16*)(P.ws + WS_WIN) + (size_t)DIN * D;
    float* cff = (float*)(P.ws + WS_CFF); float* cin = (float*)(P.ws + WS_CIN);
    for (int r = (wgi - 128) * NWAVES + wave; r < 2 * FFD + DIN; r += 128 * NWAVES) {
        const bool ff = r < 2 * FFD; const int n = ff ? r : r - 2 * FFD; const bf16* wr = (ff ? Wgu : Win1) + (size_t)n * D + 16 * lane;
        const v4u w0 = *(const GAS v4u*)wr, w1 = *(const GAS v4u*)(wr + 8); float wv[16];
#pragma unroll
        for (int j = 0; j < 4; ++j) { wv[2 * j] = __uint_as_float(w0[j] << 16); wv[2 * j + 1] = __uint_as_float(w0[j] & 0xffff0000u); wv[8 + 2 * j] = __uint_as_float(w1[j] << 16); wv[8 + 2 * j + 1] = __uint_as_float(w1[j] & 0xffff0000u); }
        const LAS float* sp = shL + (ff ? 0 : 8 * D) + 16 * lane; float mine = 0.f;
#pragma unroll
        for (int b = 0; b < 8; ++b) { float s = 0.f;
#pragma unroll
            for (int j = 0; j < 4; ++j) { const f32x4 s4 = *(const LAS f32x4*)(sp + b * D + 4 * j); s += (s4.x * wv[4 * j] + s4.y * wv[4 * j + 1]) + (s4.z * wv[4 * j + 2] + s4.w * wv[4 * j + 3]); }
            s = wave_sum(s); if (lane == b) mine = s; }
        if (lane < 8) (ff ? cff + (size_t)lane * (2 * FFD) : cin + (size_t)lane * DIN)[n] = mine;
    }
    __syncthreads();
}

__device__ __forceinline__ float modp_sum(const float* modp, const float* b_ada, int l, int b, int j) {
    float s = b_ada[l * 6144 + j];
#pragma unroll
    for (int ks = 0; ks < 8; ++ks) s += modp[(((size_t)ks * 2 + l) * 8 + b) * 6144 + j];
    return s;
}
template <bool INBF> __device__ __forceinline__ void row_load(const float* xrow, int lane, f32x4 (&h)[4]) {
    if constexpr (INBF) { const GAS v2u* xr = (const GAS v2u*)xrow + lane;
#pragma unroll
        for (int j = 0; j < 4; ++j) { const v2u q = xr[64 * j]; h[j] = (f32x4){__uint_as_float(q.x << 16), __uint_as_float(q.x & 0xffff0000u), __uint_as_float(q.y << 16), __uint_as_float(q.y & 0xffff0000u)}; } }
    else { const GAS f32x4* xr = (const GAS f32x4*)xrow + lane;
#pragma unroll
        for (int j = 0; j < 4; ++j) h[j] = xr[64 * j]; }
}
__device__ __forceinline__ void row_finish(const LAS float* gm, const LAS float* shv, int lane, f32x4 (&h)[4]) {
    float ss = 0.f;
#pragma unroll
    for (int j = 0; j < 4; ++j) ss += (h[j].x * h[j].x + h[j].y * h[j].y) + (h[j].z * h[j].z + h[j].w * h[j].w);
    const float r = __builtin_amdgcn_rsqf(wave_sum(ss) * (1.f / D) + EPS);
#pragma unroll
    for (int j = 0; j < 4; ++j) { const f32x4 g4 = *(const LAS f32x4*)(gm + 4 * lane + 256 * j), s4 = *(const LAS f32x4*)(shv + 4 * lane + 256 * j); h[j] = h[j] * r * g4 + s4; }
}
__device__ __forceinline__ void norm_row(const float* xrow, const LAS float* gm, const LAS float* shv, int lane, f32x4 (&h)[4]) { row_load<false>(xrow, lane, h); row_finish(gm, shv, lane, h); }
__device__ __forceinline__ void store_row_bf16(bf16* orow, int lane, const f32x4 (&h)[4]) {
    GAS v2u* o8 = (GAS v2u*)orow + lane;
#pragma unroll
    for (int j = 0; j < 4; ++j) { v2u w; w.x = pk2(h[j].x, h[j].y); w.y = pk2(h[j].z, h[j].w); o8[64 * j] = w; }
}
template <bool INBF> __device__ __forceinline__ void norm_phase(const Params& P, LAS unsigned char* lds, const float* xin, const float* gvec, int l, int sh_off, int sc_off, bool from_partials, int tid, int lane, int wave, int wgi) {
    LAS float* gm = (LAS float*)lds; LAS float* shv = (LAS float*)(lds + 4096);
    const float* modp = (const float*)(P.ws + WS_MODP); float* mod = (float*)(P.ws + WS_MOD); const float* b_ada = P.in[3];
    const int b = wgi >> 5;
    if (from_partials) {
        if (tid < 384) { const int idx = wgi * 384 + tid; const int ll = idx / 49152, rem = idx % 49152, bb = rem / 6144, j = rem % 6144; mod[idx] = modp_sum(modp, b_ada, ll, bb, j); }
        for (int c = tid; c < D; c += NTHR) { gm[c] = gvec[c] * (1.f + modp_sum(modp, b_ada, l, b, sc_off + c)); shv[c] = modp_sum(modp, b_ada, l, b, sh_off + c); }
    } else {
        const float* ml = mod + ((size_t)l * 8 + b) * 6144;
        for (int c = tid; c < D; c += NTHR) { gm[c] = gvec[c] * (1.f + ml[sc_off + c]); shv[c] = ml[sh_off + c]; }
    }
    __syncthreads();
    bf16* H = (bf16*)(P.ws + WS_H);
    constexpr int RS = INBF ? D / 2 : D;
    for (int i = 0; i < 8; i += 4) { const int row = wgi * 64 + wave * 8 + i; f32x4 h[4][4];
#pragma unroll
        for (int q = 0; q < 4; ++q) row_load<INBF>(xin + (size_t)(row + q) * RS, lane, h[q]);
#pragma unroll
        for (int q = 0; q < 4; ++q) { row_finish(gm, shv, lane, h[q]); store_row_bf16(H + (size_t)(row + q) * D, lane, h[q]); } }
    __syncthreads();
}
__device__ __forceinline__ void router_phase(const Params& P, LAS unsigned char* lds, const float* xin, int tid, int lane, int wave, int wgi) {
    LAS float* gm = (LAS float*)lds; LAS float* shv = (LAS float*)(lds + 4096); LAS float* wrT = (LAS float*)(lds + 8192);
    LAS int* pe = (LAS int*)(lds + 40960); LAS float* pw = (LAS float*)(lds + 41472); LAS int* cw = (LAS int*)(lds + 41984); LAS int* baseL = (LAS int*)(lds + 42048);
    const float* mod = (const float*)(P.ws + WS_MOD); const int b = wgi >> 5; const float* ml = mod + ((size_t)1 * 8 + b) * 6144; const float* gvec = P.in[5] + D;
    for (int c = tid; c < D; c += NTHR) { gm[c] = gvec[c] * (1.f + ml[4096 + c]); shv[c] = ml[3072 + c]; }
    { const float* wr = P.in[18]; for (int i = tid; i < D * NE; i += NTHR) { const int c = i >> 3, e = i & 7; wrT[e * D + c] = wr[i]; } }
    __syncthreads();
#if defined(TSDBG)
    if (wgi == 0 && tid == 0) ((unsigned long long*)(P.ws + WS_CTL) + 16384)[100] = __builtin_amdgcn_s_memrealtime();
#endif
    f32x4 wreg[8][4];
#pragma unroll
    for (int e = 0; e < 8; ++e)
#pragma unroll
        for (int j = 0; j < 4; ++j) wreg[e][j] = *(const LAS f32x4*)(wrT + e * D + 4 * lane + 256 * j);
    float brv[8];
#pragma unroll
    for (int e = 0; e < 8; ++e) brv[e] = P.in[19][e];
    f32x4 hq[3][4];
    row_load<false>(xin + (size_t)(wgi * 64 + wave * 8) * D, lane, hq[0]); row_load<false>(xin + (size_t)(wgi * 64 + wave * 8 + 1) * D, lane, hq[1]);
#pragma unroll
    for (int i = 0; i < 8; ++i) { const int rl = wave * 8 + i, row = wgi * 64 + rl; f32x4 h[4];
        if (i < 6) row_load<false>(xin + (size_t)(row + 2) * D, lane, hq[(i + 2) % 3]);
#pragma unroll
        for (int j = 0; j < 4; ++j) h[j] = hq[i % 3][j];
        row_finish(gm, shv, lane, h);
        float lg[8];
#pragma unroll
        for (int e = 0; e < 8; ++e) { float s = 0.f;
#pragma unroll
            for (int j = 0; j < 4; ++j) { const f32x4 w4 = wreg[e][j]; s = fmaf(h[j].x, w4.x, s); s = fmaf(h[j].y, w4.y, s); s = fmaf(h[j].z, w4.z, s); s = fmaf(h[j].w, w4.w, s); }
            lg[e] = s; }
        {
            float w4[4], u2[2];
#pragma unroll
            for (int i = 0; i < 4; ++i) { const bool hi1 = lane & 1; const float keep = hi1 ? lg[2 * i + 1] : lg[2 * i], send = hi1 ? lg[2 * i] : lg[2 * i + 1]; w4[i] = keep + DPP_F(send, DPP_XOR1); }
#pragma unroll
            for (int i = 0; i < 2; ++i) { const bool hi2 = lane & 2; const float keep = hi2 ? w4[2 * i + 1] : w4[2 * i], send = hi2 ? w4[2 * i] : w4[2 * i + 1]; u2[i] = keep + DPP_F(send, DPP_XOR2); }
            const bool hi4 = lane & 4; float z = (hi4 ? u2[1] : u2[0]) + __shfl_xor(hi4 ? u2[0] : u2[1], 4);
            z += DPP_F(z, DPP_ROR8);
#pragma unroll
            for (int e = 0; e < 8; ++e) lg[e] = ((RDLANE_F(z, e) + RDLANE_F(z, 16 + e)) + (RDLANE_F(z, 32 + e) + RDLANE_F(z, 48 + e))) + brv[e];
        }
        int e1 = 0; float v1 = lg[0];
#pragma unroll
        for (int e = 1; e < 8; ++e) if (lg[e] > v1) { v1 = lg[e]; e1 = e; }
        int e2 = -1; float v2 = -3.0e38f;
#pragma unroll
        for (int e = 0; e < 8; ++e) if (e != e1 && lg[e] > v2) { v2 = lg[e]; e2 = e; }
        const float p2 = __expf(v2 - v1), inv = 1.f / (1.f + p2);
        if (lane == 0) { pe[2 * rl] = e1; pe[2 * rl + 1] = e2; pw[2 * rl] = inv; pw[2 * rl + 1] = p2 * inv; }
        { LAS unsigned* r4 = (LAS unsigned*)(lds + 65536 + rl * 1024) + lane;
#pragma unroll
          for (int j = 0; j < 4; ++j) r4[64 * j] = pk4_fp8(h[j].x * H8_SCALE, h[j].y * H8_SCALE, h[j].z * H8_SCALE, h[j].w * H8_SCALE); } }
    __syncthreads();
#if defined(TSDBG)
    if (wgi == 0 && tid == 0) ((unsigned long long*)(P.ws + WS_CTL) + 16384)[101] = __builtin_amdgcn_s_memrealtime();
#endif
    int e = 0, rank = 0;
    if (tid < 128) { e = pe[tid];
#pragma unroll
        for (int ee = 0; ee < 8; ++ee) { const unsigned long long mk = __ballot(e == ee); if (e == ee) rank = __popcll(mk & ((1ull << lane) - 1ull)); if (lane == 0) cw[wave * 8 + ee] = __popcll(mk); } }
    __syncthreads();
    if (tid < 8) { const int tot = cw[tid] + cw[8 + tid]; unsigned* cnt = (unsigned*)(P.ws + WS_CTL) + CW_CNT + 64 * tid;
        baseL[tid] = (int)__hip_atomic_fetch_add(cnt, (unsigned)tot, __ATOMIC_RELAXED, __HIP_MEMORY_SCOPE_AGENT); }
    __syncthreads();
    if (tid < 128) { const int slot = baseL[e] + rank + (wave == 1 ? cw[e] : 0); const int token = wgi * 64 + (tid >> 1);
        ((float*)(P.ws + WS_WL))[e * M + slot] = pw[tid]; ((int*)(P.ws + WS_PAIR))[token * 2 + (tid & 1)] = e * M + slot; pe[tid] = e * M + slot; }
    __syncthreads();
#if defined(TSDBG)
    if (wgi == 0 && tid == 0) ((unsigned long long*)(P.ws + WS_CTL) + 16384)[102] = __builtin_amdgcn_s_memrealtime();
#endif
    for (int i = 0; i < 16; ++i) { const int p = wave * 16 + i; const int dst = pe[p];
        const v4u v = *(const LAS v4u*)(lds + 65536 + (p >> 1) * 1024 + lane * 16); *(GAS v4u*)(P.ws + WS_HG + (size_t)dst * D + lane * 16) = v; }
    __syncthreads();
}
__device__ __forceinline__ void moe_tables(const Params& P, LAS unsigned char* lds, int tid) {
    LAS int* tab = (LAS int*)(lds + MOETAB_OFF);
    if (tid == 0) { const unsigned* ctl = (const unsigned*)(P.ws + WS_CTL); int rb = 0;
        for (int e = 0; e < 8; ++e) { int c = (int)__hip_atomic_load(ctl + CW_CNT + 64 * e, __ATOMIC_RELAXED, __HIP_MEMORY_SCOPE_AGENT); c = c < 0 ? 0 : (c > M ? M : c); tab[e] = rb; tab[9 + e] = c; rb += (c + 255) & ~255; }
        tab[8] = rb; }
    __syncthreads();
}
__device__ __forceinline__ void gather_phase(const Params& P, LAS unsigned char* lds, const float* xin, int tid, int lane, int wave, int gw) {
    LAS float* gmA = (LAS float*)lds; LAS float* shA = (LAS float*)(lds + 32768); const LAS int* tab = (const LAS int*)(lds + MOETAB_OFF);
    const float* mod1 = (const float*)(P.ws + WS_MOD) + (size_t)8 * 6144; const float* gvec = P.in[5] + D;
    for (int i = tid; i < 8 * D; i += NTHR) { const int b = i >> 10, c = i & 1023; gmA[i] = gvec[c] * (1.f + mod1[b * 6144 + 4096 + c]); shA[i] = mod1[b * 6144 + 3072 + c]; }
    __syncthreads();
    const int ptot = tab[8]; const int* list = (const int*)(P.ws + WS_LIST); const float* wl = (const float*)(P.ws + WS_WL); float* wlg = (float*)(P.ws + WS_WLG); unsigned char* HG = (unsigned char*)(P.ws + WS_HG);
    for (int p = gw; p < ptot; p += NGW) {
        int e = 0;
#pragma unroll
        for (int k = 1; k < 8; ++k) e += (p >= tab[k]);
        const int slot = p - tab[e], cn = tab[9 + e]; const bool valid = slot < cn; const int token = list[e * M + (valid ? slot : cn - 1)]; const int b = token >> 11;
        f32x4 h[4]; norm_row(xin + (size_t)token * D, gmA + b * D, shA + b * D, lane, h);
        { GAS unsigned* o4 = (GAS unsigned*)(HG + (size_t)p * D) + lane;
#pragma unroll
          for (int j = 0; j < 4; ++j) o4[64 * j] = pk4_fp8(h[j].x * H8_SCALE, h[j].y * H8_SCALE, h[j].z * H8_SCALE, h[j].w * H8_SCALE); }
        if (lane == 0) wlg[p] = valid ? wl[e * M + slot] : 0.f;
    }
    __syncthreads();
}
__device__ __forceinline__ void combine_phase(const Params& P, LAS unsigned char* lds, int lane, int gw) {
    const LAS int* tab = (const LAS int*)(lds + MOETAB_OFF); const int* pair = (const int*)(P.ws + WS_PAIR); const bf16* F = (const bf16*)(P.ws + WS_F);
    const float* mod1 = (const float*)(P.ws + WS_MOD) + (size_t)8 * 6144;
    for (int t = gw; t < M; t += NGW) {
        const int pa = pair[2 * t], pb = pair[2 * t + 1]; const int ra = tab[pa >> 14] + (pa & 16383), rb = tab[pb >> 14] + (pb & 16383); const int b = t >> 11;
        const bf16* FP = (const bf16*)(P.ws + WS_FP);
        f32x4 fs[4];
#pragma unroll
        for (int j = 0; j < 4; ++j) fs[j] = (f32x4){0.f, 0.f, 0.f, 0.f};
#pragma unroll
        for (int side = 0; side < 2; ++side) { const int r = side ? rb : ra;
            if (r < 32768) { const GAS v2u* fp = (const GAS v2u*)(F + (size_t)r * D) + lane;
#pragma unroll
                for (int j = 0; j < 4; ++j) { const v2u a = fp[64 * j]; fs[j] = fs[j] + (f32x4){__uint_as_float(a.x << 16), __uint_as_float(a.x & 0xffff0000u), __uint_as_float(a.y << 16), __uint_as_float(a.y & 0xffff0000u)}; } }
            else for (int ks = 0; ks < 7; ++ks) { const GAS v2u* fp = (const GAS v2u*)(FP + ((size_t)ks * 2048 + (r - 32768)) * D) + lane;
#pragma unroll
                for (int j = 0; j < 4; ++j) { const v2u a = fp[64 * j]; fs[j] = fs[j] + (f32x4){__uint_as_float(a.x << 16), __uint_as_float(a.x & 0xffff0000u), __uint_as_float(a.y << 16), __uint_as_float(a.y & 0xffff0000u)}; } } }
        GAS f32x4* xo = (GAS f32x4*)(P.out + (size_t)t * D) + lane; const GAS f32x4* g2 = (const GAS f32x4*)(mod1 + b * 6144 + 5120) + lane;
#pragma unroll
        for (int j = 0; j < 4; ++j) xo[64 * j] = xo[64 * j] + g2[64 * j] * fs[j];
    }
}

__device__ __forceinline__ void conv_stage(const bf16* Z, LAS unsigned char* zt, int unit, int tid) {
    const int tok0 = unit * 32, tp0 = tok0 & (S_ - 1);
#pragma unroll
    for (int i = 0; i < 8; ++i) { const int idx = i * NTHR + tid;
        if (idx < 62 * 64) { const int row = idx >> 6, pc = idx & 63; const bool ok = tp0 + row - 30 >= 0;
            v4u v = *(const GAS v4u*)(Z + (size_t)(tok0 + (ok ? row - 30 : -tp0)) * DC + pc * 8); if (!ok) v = (v4u){0u, 0u, 0u, 0u};
            *(LAS v4u*)(zt + idx * 16) = v; } }
}
__device__ __forceinline__ void conv_unit(const LAS unsigned char* zt, const float (&w)[CW], float bias, bf16* YC, const float* lg, const float* lb, LAS float* tile, int unit, int tid, int wave, int lane) {
    const int tok0 = unit * 32, c = tid;
    const LAS bf16* zc = (const LAS bf16*)zt + c;
#pragma unroll
    for (int half = 0; half < 2; ++half) {
        float in[46];
#pragma unroll
        for (int i = 0; i < 46; ++i) in[i] = bf2f(zc[(16 * half + i) * DC]);
#pragma unroll
        for (int q = 0; q < 16; ++q) { float a = bias;
#pragma unroll
            for (int j = 0; j < CW; ++j) a += w[j] * in[q + j];
            tile[(16 * half + q) * DC + c] = a; }
    }
    __syncthreads();
    const f32x4 g0 = *(const f32x4*)(lg + lane * 8), g1 = *(const f32x4*)(lg + lane * 8 + 4), b0 = *(const f32x4*)(lb + lane * 8), b1 = *(const f32x4*)(lb + lane * 8 + 4);
#pragma unroll
    for (int tt = 0; tt < 4; ++tt) { const int t = wave * 4 + tt;
        f32x4 v0 = *(const LAS f32x4*)(tile + t * DC + lane * 8), v1 = *(const LAS f32x4*)(tile + t * DC + lane * 8 + 4);
        const float mean = wave_sum((v0.x + v0.y) + (v0.z + v0.w) + (v1.x + v1.y) + (v1.z + v1.w)) * (1.f / DC);
        v0 = v0 - mean; v1 = v1 - mean;
        const float var = wave_sum((v0.x * v0.x + v0.y * v0.y) + (v0.z * v0.z + v0.w * v0.w) + (v1.x * v1.x + v1.y * v1.y) + (v1.z * v1.z + v1.w * v1.w)) * (1.f / DC);
        const float rstd = __builtin_amdgcn_rsqf(var + EPS);
        f32x4 y0 = v0 * rstd * g0 + b0, y1 = v1 * rstd * g1 + b1;
#pragma unroll
        for (int i = 0; i < 4; ++i) { y0[i] = y0[i] * sigm(y0[i]); y1[i] = y1[i] * sigm(y1[i]); }
        v4u o; o.x = pk2(y0.x, y0.y); o.y = pk2(y0.z, y0.w); o.z = pk2(y1.x, y1.y); o.w = pk2(y1.z, y1.w);
        *(GAS v4u*)(YC + (size_t)(tok0 + t) * D + lane * 8) = o; }
    __syncthreads();
}
__device__ __forceinline__ int crow(int r, int hi) { return (r & 3) + 8 * (r >> 2) + 4 * hi; }
#define MFMA32(a, b, c) __builtin_amdgcn_mfma_f32_32x32x16_bf16((a), (b), (c), 0, 0, 0)
__device__ __forceinline__ void attn_stage(const LAS unsigned char* stage, int kc0, int n, int qh, int r32, int hi, int lane, const LAS float* btile, const bf16x8 (&qf)[4], const f32x16& cinit, f32x16& o0, f32x16& o1, float& l) {
    const int fsw = (r32 >> 1) & 7;
#pragma unroll
    for (int sub = 0; sub < 2; ++sub) {
        const int kc = kc0 + sub; const LAS unsigned char* buf = stage + sub * 16384;
#if defined(TSDBG) && defined(ATT_VAR) && ATT_VAR == 2
        l += 1.f;
        if (false) {
#else
        if (kc >= n - 8 && kc <= n) {
#endif
            bf16x8 kf[2][4], vf[2][2][2]; f32x16 sc[2];
#pragma unroll
            for (int kb = 0; kb < 2; ++kb)
#pragma unroll
                for (int d0 = 0; d0 < 4; ++d0) kf[kb][d0] = *(const LAS bf16x8*)(buf + (kb * 32 + r32) * 128 + (((2 * d0 + hi) ^ fsw) << 4));
            if (n - kc >= 3) { sc[0] = cinit; sc[1] = cinit; }
            else {
#pragma unroll
                for (int kb = 0; kb < 2; ++kb) { const LAS f32x4* tp = (const LAS f32x4*)(btile + ((qh * 6 + (n - kc) * 2 + kb) * 4) * 256) + lane;
#pragma unroll
                    for (int q4 = 0; q4 < 4; ++q4) { const f32x4 t4 = tp[q4 * 64]; sc[kb][4 * q4] = t4.x; sc[kb][4 * q4 + 1] = t4.y; sc[kb][4 * q4 + 2] = t4.z; sc[kb][4 * q4 + 3] = t4.w; } } }
#pragma unroll
            for (int kb = 0; kb < 2; ++kb)
#pragma unroll
                for (int db = 0; db < 2; ++db)
#pragma unroll
                    for (int s2 = 0; s2 < 2; ++s2) vf[kb][db][s2] = *(const LAS bf16x8*)(buf + 8192 + (db * 32 + r32) * 128 + (((kb * 4 + 2 * s2 + hi) ^ fsw) << 4));
#pragma unroll
            for (int d0 = 0; d0 < 4; ++d0) {
#if defined(TSDBG) && defined(ATT_VAR) && ATT_VAR == 4
                asm volatile("" :: "v"(kf[0][d0]), "v"(kf[1][d0]));
#else
                sc[0] = MFMA32(kf[0][d0], qf[d0], sc[0]); sc[1] = MFMA32(kf[1][d0], qf[d0], sc[1]);
#endif
            }
            float ps0 = 0.f, ps1 = 0.f;
#pragma unroll
#if defined(TSDBG) && defined(ATT_VAR) && ATT_VAR == 1
            for (int r = 0; r < 16; ++r) { ps0 += sc[0][r]; ps1 += sc[1][r]; }
#else
            for (int r = 0; r < 16; ++r) { sc[0][r] = __builtin_amdgcn_exp2f(sc[0][r]); ps0 += sc[0][r]; }
#pragma unroll
            for (int r = 0; r < 16; ++r) { sc[1][r] = __builtin_amdgcn_exp2f(sc[1][r]); ps1 += sc[1][r]; }
#endif
            l += ps0 + ps1;
            bf16x8 pb[2][2];
#pragma unroll
            for (int kb = 0; kb < 2; ++kb) { v4u p0, p1;
                p0.x = pk2(sc[kb][0], sc[kb][1]); p0.y = pk2(sc[kb][2], sc[kb][3]); p0.z = pk2(sc[kb][4], sc[kb][5]); p0.w = pk2(sc[kb][6], sc[kb][7]);
                p1.x = pk2(sc[kb][8], sc[kb][9]); p1.y = pk2(sc[kb][10], sc[kb][11]); p1.z = pk2(sc[kb][12], sc[kb][13]); p1.w = pk2(sc[kb][14], sc[kb][15]);
                pb[kb][0] = __builtin_bit_cast(bf16x8, p0); pb[kb][1] = __builtin_bit_cast(bf16x8, p1); }
#pragma unroll
            for (int kb = 0; kb < 2; ++kb)
#pragma unroll
#if defined(TSDBG) && defined(ATT_VAR) && ATT_VAR == 3
                for (int s2 = 0; s2 < 2; ++s2) { asm volatile("" :: "v"(vf[kb][0][s2]), "v"(vf[kb][1][s2]), "v"(pb[kb][s2])); }
#else
                for (int s2 = 0; s2 < 2; ++s2) { o0 = MFMA32(vf[kb][0][s2], pb[kb][s2], o0); o1 = MFMA32(vf[kb][1][s2], pb[kb][s2], o1); }
#endif
        }
    }
}
__device__ __forceinline__ void attn_unit(const bf16* Q, const bf16* K, const bf16* VT, bf16* YC, const LAS float* btile, float c0, LAS unsigned char* kv, int b, int h, int g, int tid, int wave, int lane) {
    const int r32 = lane & 31, hi = lane >> 5;
    const int n0 = 4 * g, n = n0 + (wave >> 1), qh = wave & 1;
    const size_t rowq = (size_t)b * S_ + n * 64 + qh * 32 + r32;
    bf16x8 qf[4];
#pragma unroll
    for (int d0 = 0; d0 < 4; ++d0) qf[d0] = *(const GAS bf16x8*)(Q + rowq * DC + h * 64 + d0 * 16 + hi * 8);
    float l = 0.f; f32x16 o0, o1, cinit;
#pragma unroll
    for (int r = 0; r < 16; ++r) { o0[r] = 0.f; o1[r] = 0.f; cinit[r] = c0; }
    const int kc_lo = n0 - 8 < 0 ? 0 : n0 - 8, nt = (n0 + 4 - kc_lo) >> 1;
    const int lrow = tid >> 3, lc = tid & 7, lsw = (lrow >> 1) & 7; const int kofs = lrow * 128 + ((lc ^ lsw) << 4);
    const int vofs0 = lrow * 128 + ((((lc & 6) | 0) ^ lsw) << 4) + (lc & 1) * 8, vofs1 = lrow * 128 + ((((lc & 6) | 1) ^ lsw) << 4) + (lc & 1) * 8;
    const bf16* kg = K + ((size_t)b * S_ + lrow) * DC + h * 64 + lc * 8 + (size_t)kc_lo * 64 * DC;
    const bf16* vg = VT + (size_t)(h * 64 + lrow) * M + (size_t)b * S_ + lc * 8 + kc_lo * 64;
#define ATT_GET(t, R) do { R[0] = *(const GAS v4u*)(kg + (size_t)(2 * (t)) * 64 * DC); R[1] = *(const GAS v4u*)(vg + (2 * (t)) * 64); R[2] = *(const GAS v4u*)(kg + (size_t)(2 * (t) + 1) * 64 * DC); R[3] = *(const GAS v4u*)(vg + (2 * (t) + 1) * 64); } while (0)
#define ATT_PUT(base, R) do { *(LAS v4u*)((base) + kofs) = R[0]; *(LAS v2u*)((base) + 8192 + vofs0) = (v2u){R[1].x, R[1].y}; *(LAS v2u*)((base) + 8192 + vofs1) = (v2u){R[1].z, R[1].w}; \
        *(LAS v4u*)((base) + 16384 + kofs) = R[2]; *(LAS v2u*)((base) + 24576 + vofs0) = (v2u){R[3].x, R[3].y}; *(LAS v2u*)((base) + 24576 + vofs1) = (v2u){R[3].z, R[3].w}; } while (0)
    v4u RA[4], RB[4];
    ATT_GET(0, RA); ATT_GET(1, RB);
    ATT_PUT(kv, RA);
    __syncthreads();
    asm volatile("" : "+v"(qf[0]), "+v"(qf[1]), "+v"(qf[2]), "+v"(qf[3]));
    for (int t = 0; t < nt; t += 2) {
        { const int tg = t + 2 < nt ? t + 2 : nt - 1; ATT_GET(tg, RA); }
        attn_stage(kv, kc_lo + 2 * t, n, qh, r32, hi, lane, btile, qf, cinit, o0, o1, l);
        ATT_PUT(kv + 32768, RB);
        __syncthreads();
        { const int tg = t + 3 < nt ? t + 3 : nt - 1; ATT_GET(tg, RB); }
        attn_stage(kv + 32768, kc_lo + 2 * t + 2, n, qh, r32, hi, lane, btile, qf, cinit, o0, o1, l);
        if (t + 2 < nt) ATT_PUT(kv, RA);
        __syncthreads();
    }
#undef ATT_PUT
#undef ATT_GET
    l += __shfl_xor(l, 32); const float il = 1.f / l;
    bf16* yp = YC + rowq * D + DC + h * 64 + 4 * hi;
#pragma unroll
    for (int gq = 0; gq < 4; ++gq) { v2u w0, w1; w0.x = pk2(o0[4 * gq] * il, o0[4 * gq + 1] * il); w0.y = pk2(o0[4 * gq + 2] * il, o0[4 * gq + 3] * il);
        w1.x = pk2(o1[4 * gq] * il, o1[4 * gq + 1] * il); w1.y = pk2(o1[4 * gq + 2] * il, o1[4 * gq + 3] * il);
        *(GAS v2u*)(yp + 8 * gq) = w0; *(GAS v2u*)(yp + 32 + 8 * gq) = w1; }
}
__device__ __forceinline__ void mixer_phase(const Params& P, LAS unsigned char* lds, int l, int tid, int lane, int wave, int wgi) {
#if defined(TSDBG)
    if (wgi == 0 && tid == 0) ((unsigned long long*)(P.ws + WS_CTL) + 16384)[40 + 4 * l] = __builtin_amdgcn_s_memrealtime();
#endif
    LAS unsigned char* zt = lds; LAS float* tile = (LAS float*)(lds + 63488); LAS float* biasL = (LAS float*)(lds + LDSCTL_OFF + 1024); LAS unsigned char* kv = lds + 49152;
    { const float* rb = P.in[14] + l * 8 * NREL; for (int i = tid; i < 8 * NREL; i += NTHR) biasL[i] = rb[i] * LOG2E; }
    __syncthreads();
    const bf16* Z = (const bf16*)(P.ws + WS_Z); const bf16* Q = (const bf16*)(P.ws + WS_Q); const bf16* K = (const bf16*)(P.ws + WS_K); const bf16* VT = (const bf16*)(P.ws + WS_VT); bf16* YC = (bf16*)(P.ws + WS_YC);
    {   float w[CW]; const float* cw = P.in[8] + l * CW * DC;
#pragma unroll
        for (int j = 0; j < CW; ++j) w[j] = cw[j * DC + tid];
        const float cbias = P.in[9][l * DC + tid];
        for (int cu = 0; cu < 2; ++cu) { conv_stage(Z, zt, wgi * 2 + cu, tid); __syncthreads();
            conv_unit(zt, w, cbias, YC, P.in[10] + l * DC, P.in[11] + l * DC, tile, wgi * 2 + cu, tid, wave, lane); } }
#if defined(TSDBG)
    if (wgi == 0 && tid == 0) ((unsigned long long*)(P.ws + WS_CTL) + 16384)[40 + 4 * l + 1] = __builtin_amdgcn_s_memrealtime();
#endif
#if defined(TSDBG)
    if (tid == 0) atomicMax((unsigned long long*)(P.ws + WS_CTL) + 16384 + 74 + l, (unsigned long long)__builtin_amdgcn_s_memrealtime());
#endif
    { const int vw = (wgi & 7) * 32 + (wgi >> 3);
      const int b = vw >> 5, h = (vw >> 2) & 7, gp = vw & 3;
      LAS float* btl = (LAS float*)lds;
      float Bref; { LAS float* red = (LAS float*)(lds + 49152);
          float gq = 0.f, gk = 0.f, bm = 0.f;
          if (tid < 64) { gq = fabsf(P.in[12][l * 64 + tid]); gk = fabsf(P.in[13][l * 64 + tid]); }
          if (tid < NREL) bm = fabsf(biasL[h * NREL + tid]);
#pragma unroll
          for (int o = 1; o < 64; o <<= 1) { gq = fmaxf(gq, __shfl_xor(gq, o)); gk = fmaxf(gk, __shfl_xor(gk, o)); bm = fmaxf(bm, __shfl_xor(bm, o)); }
          if (lane == 0) { red[wave] = gq; red[8 + wave] = gk; red[16 + wave] = bm; }
          __syncthreads();
          gq = red[0]; gk = red[8]; bm = fmaxf(fmaxf(fmaxf(red[16], red[17]), fmaxf(red[18], red[19])), red[20]);
          Bref = 1.02f * (LOG2E * 8.f * gq * gk + bm); }
#pragma unroll
      for (int k = 0; k < 24; ++k) { const int i = tid + NTHR * k; const int jbq = k >> 1, qh = jbq / 6, jb = jbq % 6;
          const int ln = (i >> 2) & 63, r = ((i >> 8) & 3) * 4 + (i & 3);
          int rel = -64 * (jb >> 1) + 32 * (jb & 1) - 32 * qh + crow(r, ln >> 5) - (ln & 31); rel = rel < -128 ? -128 : (rel > 128 ? 128 : rel); btl[i] = biasL[h * NREL + rel + 128] - Bref; }
      const float b0 = biasL[h * NREL] - Bref;
      __syncthreads();
      for (int rp = 0; rp < 1 + ((REPMASK >> 21) & 1); ++rp)
#if defined(TSDBG)
      if ((wgi == 0 || wgi == 24) && tid == 0) ((unsigned long long*)(P.ws + WS_CTL) + 16384)[60 + 8 * l + (wgi ? 4 : 0)] = __builtin_amdgcn_s_memrealtime();
#endif
#if defined(TSDBG)
      const unsigned long long att_t0 = __builtin_amdgcn_s_memrealtime();
#endif
      for (int au = 0; au < 2; ++au) attn_unit(Q, K, VT, YC, btl, b0, kv, b, h, au ? 7 - gp : gp, tid, wave, lane);
      __syncthreads();
#if defined(TSDBG)
      if ((wgi == 0 || wgi == 24) && tid == 0) ((unsigned long long*)(P.ws + WS_CTL) + 16384)[61 + 8 * l + (wgi ? 4 : 0)] = __builtin_amdgcn_s_memrealtime();
#endif
#if defined(TSDBG)
      if (tid == 0) { const unsigned long long dt = __builtin_amdgcn_s_memrealtime() - att_t0; atomicMax((unsigned long long*)(P.ws + WS_CTL) + 16384 + 80 + 4 * l + gp, dt); }
#endif
      const int mlo = FILL_S2 + l * FILL_MIX;
      if constexpr (FILL_MIX > 0) {
      if (gp == 0) moe_fill_run(P, lds, mlo + (wgi >> 2) * NWAVES + wave, 64 * NWAVES, mlo + (FILL_MIX * 3) / 4, lane, wave);
      else if (gp == 1) moe_fill_run(P, lds, mlo + (FILL_MIX * 3) / 4 + (wgi >> 2) * NWAVES + wave, 64 * NWAVES, mlo + FILL_MIX, lane, wave); } }
    __syncthreads();
#if defined(TSDBG)
    if (wgi == 0 && tid == 0) ((unsigned long long*)(P.ws + WS_CTL) + 16384)[40 + 4 * l + 2] = __builtin_amdgcn_s_memrealtime();
    if (tid == 0) atomicMax((unsigned long long*)(P.ws + WS_CTL) + 16384 + 70 + l, (unsigned long long)__builtin_amdgcn_s_memrealtime());
#endif
}

#define PHASE(k, ...) do { { __VA_ARGS__ } if constexpr ((REPMASK >> (k)) & 1) { xcd_barrier(bar); RETID(); { __VA_ARGS__ } } } while (0)
__global__ void __launch_bounds__(NTHR, 2) fwd(Params P) {
    extern __shared__ __attribute__((aligned(16))) unsigned char lds_raw[];
    LAS unsigned char* lds = (LAS unsigned char*)lds_raw;
    int tid = threadIdx.x, lane = tid & 63, wave = __builtin_amdgcn_readfirstlane(tid >> 6); const int wgi = blockIdx.x; int gw = wgi * NWAVES + wave;
#define RETID() do { tid = threadIdx.x; asm volatile("" : "+v"(tid)); lane = tid & 63; wave = __builtin_amdgcn_readfirstlane(tid >> 6); gw = wgi * NWAVES + wave; } while (0)
    for (int u = tid; u < (LDS_BYTES - LDSCTL_OFF) / 4; u += NTHR) ((LAS unsigned*)(lds + LDSCTL_OFF))[u] = 0u;
    __syncthreads();
    unsigned* ctl = (unsigned*)(P.ws + WS_CTL);
    XcdBarrier bar = xcd_barrier_post(ctl + CW_BAR, (volatile LAS unsigned*)(lds + MISC_OFF) + 8);
    const int stop = P.stop;
#if defined(TSDBG)
    unsigned long long* tsbuf = (unsigned long long*)(P.ws + WS_CTL) + 16384;
    int tsn = 0;
#define STAMP() do { if (wgi == 0 && tid == 0) tsbuf[tsn] = __builtin_amdgcn_s_memrealtime(); ++tsn; } while (0)
#else
#define STAMP() do {} while (0)
#endif
    STAMP();
#define SEAM(k) do { if (stop == (k)) return; xcd_barrier(bar); RETID(); STAMP(); } while (0)
    bf16* H = (bf16*)(P.ws + WS_H); float* mod = (float*)(P.ws + WS_MOD); const float* XB = (const float*)(P.ws + WS_XB);

    PHASE(0, phase0(P, lds, tid, lane, wave, gw););                                                      SEAM(0);
    PHASE(1, norm_phase<false>(P, lds, P.in[0], P.in[4], 0, 0, 1024, true, tid, lane, wave, wgi););             SEAM(1);
#define LAYER_COMMON(l, pb, xin) \
    PHASE(2,   \
        const bf16* Wl = (const bf16*)(P.ws + WS_WIN) + (size_t)(l) * DIN * D; \
        { pg8::Gemm g{H, Wl, M, 2048, D, 0}; pg8::StaticOrder S; S.init(M, 2048, GRID, wgi); \
          pg8::EpiInProj<FUSE_NORM && (l) != 0> E{(bf16*)(P.ws + WS_Z), (bf16*)(P.ws + WS_Q), (bf16*)(P.ws + WS_K), P.in[12] + (l) * 64, P.in[13] + (l) * 64, QSCALE, (const float*)(P.ws + WS_SS2), (const float*)(P.ws + WS_CIN)}; \
          pg8::gemm_phase<pg8::EpiInProj<FUSE_NORM && (l) != 0>, pg8::StaticOrder, true, true>(lds, g, S, E); } \
        { pg8::Gemm g{Wl + (size_t)2048 * D, H, 512, M, D, 0}; pg8::StaticOrder S; S.init(512, M, GRID, wgi); \
          pg8::EpiBf16<FUSE_NORM && (l) != 0> E{(bf16*)(P.ws + WS_VT), M, 1.f, 0, (const float*)(P.ws + WS_SS2), (const float*)(P.ws + WS_CIN) + 2048}; \
          pg8::gemm_phase<pg8::EpiBf16<FUSE_NORM && (l) != 0>, pg8::StaticOrder, true, true>(lds, g, S, E); } \
        if (FUSE_NORM && (l) == 0) cvec_fill(P, lds, tid, lane, wave, wgi); \
        moe_filler(P, lds, (l) == 0 ? 0 : FILL_S1, (l) == 0 ? FILL_S0 : FILL_S2, lane, wave, wgi); ); \
    SEAM(pb); \
    PHASE(3, mixer_phase(P, lds, (l), tid, lane, wave, wgi);); \
    SEAM((pb) + 1); \
    PHASE(4 + 10 * (l),   \
        pg8::Gemm g{(const bf16*)(P.ws + WS_YC), (const bf16*)(P.ws + WS_WOUT) + (size_t)(l) * D * D, M, D, D, 0}; pg8::StaticOrder S; S.init(M, D, GRID, wgi); \
        pg8::EpiResGate<FUSE_NORM && (l) == 0, (l) != 0, (l) == 0> E{(l) == 0 ? P.in[0] : XB, (l) == 0 ? (float*)XB : P.out, mod + (size_t)(l) * 8 * 6144 + 2048, H, (float*)(P.ws + WS_SS1), P.in[5], mod + 4096};   \
        pg8::gemm_phase<pg8::EpiResGate<FUSE_NORM && (l) == 0, (l) != 0, (l) == 0>, pg8::StaticOrder, true, true>(lds, g, S, E); ); \
    SEAM((pb) + 2);

    LAYER_COMMON(0, 2, P.in[0])
    if constexpr (!FUSE_NORM) { PHASE(5, norm_phase<true>(P, lds, XB, P.in[5], 0, 3072, 4096, false, tid, lane, wave, wgi);); SEAM(5); }
    PHASE(6, pg8::Gemm g{H, (const bf16*)(P.ws + WS_WGU), M, 2 * FFD, D, 0}; pg8::StaticOrder S; S.init(M, 2 * FFD, GRID, wgi);
             pg8::EpiSwiGLU<false, FUSE_NORM != 0> E{(bf16*)(P.ws + WS_ACT), FFD, nullptr, 1.f, 1.f, (const float*)(P.ws + WS_SS1), (const float*)(P.ws + WS_CFF), 2 * FFD};
             pg8::gemm_phase<pg8::EpiSwiGLU<false, FUSE_NORM != 0>, pg8::StaticOrder, true, true>(lds, g, S, E);
             moe_filler(P, lds, FILL_S0, FILL_S1, lane, wave, wgi););
    SEAM(6);
    PHASE(30, pg8::Gemm g{(const bf16*)(P.ws + WS_ACT), (const bf16*)(P.ws + WS_WD), M, D, FFD, 0}; pg8::StaticOrder S; S.init(M, D, GRID, wgi);
              pg8::EpiResGate<FUSE_NORM != 0, true, true> E{XB, (float*)XB, mod + 5120, H, (float*)(P.ws + WS_SS2), P.in[4] + D, mod + (size_t)8 * 6144 + 1024};
              pg8::gemm_phase<pg8::EpiResGate<FUSE_NORM != 0, true, true>, pg8::StaticOrder, true, true>(lds, g, S, E););
    SEAM(7);
    if constexpr (!FUSE_NORM) { PHASE(8, norm_phase<true>(P, lds, XB, P.in[4] + D, 1, 0, 1024, false, tid, lane, wave, wgi);); SEAM(8); }
    LAYER_COMMON(1, 9, P.out)
    PHASE(31, router_phase(P, lds, P.out, tid, lane, wave, wgi););                                       SEAM(12);
    moe_tables(P, lds, tid);
    {
        const LAS int* tab = (const LAS int*)(lds + MOETAB_OFF);
        const int ptot = RFL(tab[8]);
        PHASE(11, pg8::Gemm g{(const bf16*)(P.ws + WS_HG), (const bf16*)(P.ws + WS_WMGU), ptot, 2 * FFE, D, (unsigned)(2 * FFE * D)};
                  pg8::MoeOrder S; S.nM = ptot >> 8; S.nN = 2 * FFE / 256; S.nwg = S.nM * S.nN; S.G = GRID; S.c = wgi; S.capA = true;
                  S.t1 = RFL(tab[1] >> 8); S.t2 = RFL(tab[2] >> 8); S.t3 = RFL(tab[3] >> 8); S.t4 = RFL(tab[4] >> 8); S.t5 = RFL(tab[5] >> 8); S.t6 = RFL(tab[6] >> 8); S.t7 = RFL(tab[7] >> 8);
                  pg8::EpiSwiGLU<true, false> E{(bf16*)(P.ws + WS_ACTM), FFE, (const float*)(P.ws + WS_WL), A8_SCALE / (H8_SCALE * W8_SCALE), 1.f / (H8_SCALE * W8_SCALE), nullptr, nullptr, 0};
                  pg8::gemm_phase<pg8::EpiSwiGLU<true, false>, pg8::MoeOrder, true, true, true>(lds, g, S, E););
        if constexpr ((REPMASK >> 22) & 1) { xcd_barrier(bar); RETID();
                  pg8::Gemm g{(const bf16*)(P.ws + WS_HG), (const bf16*)(P.ws + WS_WMGU), ptot, 2 * FFE, D, (unsigned)(2 * FFE * D)};
                  pg8::MoeOrder S; S.nM = ptot >> 8; S.nN = 2 * FFE / 256; S.nwg = S.nM * S.nN; S.G = GRID; S.c = wgi; S.capA = true;
                  S.t1 = RFL(tab[1] >> 8); S.t2 = RFL(tab[2] >> 8); S.t3 = RFL(tab[3] >> 8); S.t4 = RFL(tab[4] >> 8); S.t5 = RFL(tab[5] >> 8); S.t6 = RFL(tab[6] >> 8); S.t7 = RFL(tab[7] >> 8);
                  pg8::EpiNone E{};
                  pg8::gemm_phase<pg8::EpiNone, pg8::MoeOrder, true, true, true>(lds, g, S, E); }
        SEAM(14);
        PHASE(12, const int tall = ptot >> 8, tmain = tall < 128 ? tall : 128;
                  { pg8::Gemm g{(const bf16*)(P.ws + WS_ACTM), (const bf16*)(P.ws + WS_WMD), ptot, D, FFE, (unsigned)(D * FFE), 0};
                    pg8::MoeOrder S; S.nM = tmain; S.nN = D / 256; S.nwg = S.nM * S.nN; S.G = GRID; S.c = wgi; S.capA = false;
                    S.t1 = RFL(tab[1] >> 8); S.t2 = RFL(tab[2] >> 8); S.t3 = RFL(tab[3] >> 8); S.t4 = RFL(tab[4] >> 8); S.t5 = RFL(tab[5] >> 8); S.t6 = RFL(tab[6] >> 8); S.t7 = RFL(tab[7] >> 8);
                    pg8::EpiBf16<false> E{(bf16*)(P.ws + WS_F), D, 1.f / (A8_SCALE * W8_SCALE), 0, nullptr, nullptr};
                    pg8::gemm_phase<pg8::EpiBf16<false>, pg8::MoeOrder, true, true, true>(lds, g, S, E); }
                  if (tall > 128) { pg8::Gemm g{(const bf16*)(P.ws + WS_ACTM), (const bf16*)(P.ws + WS_WMD), ptot, D, FFE / pg8::RemOrder::NSPLIT, (unsigned)(D * FFE), FFE};
                    pg8::RemOrder S; S.tm0 = 128; S.nrem = tall - 128; S.G = GRID; S.c = wgi;
                    S.t1 = RFL(tab[1] >> 8); S.t2 = RFL(tab[2] >> 8); S.t3 = RFL(tab[3] >> 8); S.t4 = RFL(tab[4] >> 8); S.t5 = RFL(tab[5] >> 8); S.t6 = RFL(tab[6] >> 8); S.t7 = RFL(tab[7] >> 8);
                    pg8::EpiBf16<false> E{(bf16*)(P.ws + WS_FP) - (size_t)128 * 256 * D, D, 1.f / (A8_SCALE * W8_SCALE), (size_t)2048 * D, nullptr, nullptr};
                    pg8::gemm_phase<pg8::EpiBf16<false>, pg8::RemOrder, true, true, true>(lds, g, S, E); } );
        SEAM(15);
        PHASE(29, combine_phase(P, lds, lane, gw););
        __syncthreads(); STAMP();
    }
#undef SEAM
}
static int launch_fast(void* const* d_in, float* out, unsigned char* ws, hipStream_t stream, int stop) {
    static int ready = 0;
    if (ready == 0) {
        if (hipFuncSetAttribute((const void*)fwd, hipFuncAttributeMaxDynamicSharedMemorySize, LDS_BYTES) != hipSuccess) { fprintf(stderr, "kernel_launch: hipFuncSetAttribute failed\n"); ready = -1; return -1; }
        int per_cu = 0; if (hipOccupancyMaxActiveBlocksPerMultiprocessor(&per_cu, (const void*)fwd, NTHR, LDS_BYTES) != hipSuccess || per_cu < 1) fprintf(stderr, "kernel_launch: occupancy query reports %d blocks per CU\n", per_cu);
        (void)hipGetLastError(); ready = 1;
    }
    if (ready < 0) return -1;
    if (hipMemsetAsync(ws + WS_CTL, 0, CTL_ZERO_BYTES, stream) != hipSuccess) return -1;
    Params p{}; for (int i = 0; i < 23; ++i) p.in[i] = (const float*)d_in[i]; p.out = out; p.ws = ws; p.stop = stop; p.pad = 0;
    hipLaunchKernelGGL(fwd, dim3(GRID), dim3(NTHR), LDS_BYTES, stream, p);
    return hipPeekAtLastError() == hipSuccess ? 0 : -1;
}
}
#ifndef DBG_STAGE
#define DBG_STAGE 0
#endif
extern "C" void kernel_launch(void* const* d_in, const int* in_sizes, int n_in, void* d_out, int out_size, void* d_ws, size_t ws_size, hipStream_t stream) {
    if (n_in != 23 || out_size != fk::M * fk::D || ws_size < fk::WS_END) { fprintf(stderr, "kernel_launch: unexpected shapes / workspace (%d inputs, out %d, ws %zu)\n", n_in, out_size, ws_size); return; }
    unsigned char* ws = (unsigned char*)d_ws; float* out = (float*)d_out;
#if DBG_STAGE == 0
    fk::launch_fast(d_in, out, ws, stream, -1);
#elif defined(TSDBG)
    fk::launch_fast(d_in, out, ws, stream, -1);
    nv::k_savets<<<1, 64, 0, stream>>>((const unsigned long long*)ws + 16384, (float*)(ws + 389 * ((size_t)1 << 20)), TS_A0, TS_A1, TS_B0, TS_B1);
    nv::forward(d_in, out, ws, stream);
    nv::k_encode<<<(unsigned)(((size_t)fk::M * 1024 + 255) / 256), 256, 0, stream>>>(out, (size_t)fk::M * 1024, (const float*)(ws + 389 * ((size_t)1 << 20)));
#else
    constexpr int S = DBG_STAGE; constexpr size_t MiB = 1u << 20;
    float* ckf = (float*)(ws + 390 * MiB); float* acc = (float*)(ws + 389 * MiB);
    int stop = -1; size_t off = 0, n = 0; float scale = 1.f; bool isf32 = false;
    const size_t NM = (size_t)fk::M;
    switch (S) {
        case 1: stop = 1; off = fk::WS_H; n = NM * 1024; break;
        case 2: stop = 2; off = fk::WS_Z; n = NM * 512; break;
        case 3: stop = 2; off = fk::WS_Q; n = NM * 512; scale = 1.f / fk::QSCALE; break;
        case 4: stop = 2; off = fk::WS_K; n = NM * 512; break;
        case 5: stop = 3; off = fk::WS_YC; n = NM * 1024; break;
        case 6: stop = 4; isf32 = true; n = NM * 1024; break;
        case 7: stop = 5; off = fk::WS_H; n = NM * 1024; break;
        case 8: stop = 6; off = fk::WS_ACT; n = NM * 1024; break;
        case 9: stop = 7; isf32 = true; n = NM * 1024; break;
        case 11: stop = 8; off = fk::WS_H; n = NM * 1024; break;
        case 12: stop = 9; off = fk::WS_Z; n = NM * 512; break;
        case 13: stop = 9; off = fk::WS_Q; n = NM * 512; scale = 1.f / fk::QSCALE; break;
        case 14: stop = 9; off = fk::WS_K; n = NM * 512; break;
        case 15: stop = 10; off = fk::WS_YC; n = NM * 1024; break;
        case 16: stop = 11; isf32 = true; n = NM * 1024; break;
        default: stop = -1; isf32 = true; n = NM * 1024; break;
    }
    fk::launch_fast(d_in, out, ws, stream, stop);
    if (isf32) nv::k_copy<<<(unsigned)((n + 255) / 256), 256, 0, stream>>>(out, ckf, n);
    else nv::k_cvt<<<(unsigned)((n + 255) / 256), 256, 0, stream>>>((const unsigned short*)(ws + off), ckf, n, scale);
    hipMemsetAsync(acc, 0, 256, stream);
    nv::forward(d_in, out, ws, stream, S, ckf, acc);
    if (S == 99) nv::k_cmp<<<1024, 256, 0, stream>>>(ckf, out, n, acc);
    nv::k_scale<<<(unsigned)((NM * 1024 + 255) / 256), 256, 0, stream>>>(out, NM * 1024, acc);
#endif
}
```
